# Optimizing an MI355X kernel written in HIP

```python
import math
import jax, jax.numpy as jnp
from jax import lax
import numpy as np

D_MODEL = 2048
BATCH = 2
SEQ = 16384
DEPTH = 4
DEC_BATCH = 8
DEC_SEQ = 32
PAST_LEN = 1024

CHUNK = 64
N_META = 16
D_CONV = D_MODEL // 2
D_SSM = D_MODEL // 2
D_MIX = D_CONV + D_SSM
CONV_WIDTH = 3
SSM_GROUP = 16
N_SSM_GROUPS = D_SSM // SSM_GROUP
SSM_STATE = 64
D_FF = 5632
D_IN_PROJ = 3 * D_CONV + D_SSM
EPS = 1e-6
DT_MIN = 1e-3
DT_MAX = 1e-1

kernel_name = "hymba_conv_s5_macaron_stream"


def rmsnorm(x, g):
    xf = x.astype(jnp.float32)
    y = xf * lax.rsqrt(jnp.mean(xf * xf, axis=-1, keepdims=True) + EPS)
    return (y * g.astype(jnp.float32)).astype(x.dtype)


def swiglu(x, w_gate, w_up, w_down):
    return (jax.nn.silu(x @ w_gate) * (x @ w_up)) @ w_down


def short_conv(b_gate, c_gate, h, conv_buf, conv_w):
    v = c_gate * h
    vp = jnp.concatenate([conv_buf.astype(v.dtype), v], axis=1)
    t = v.shape[1]
    w = conv_w.astype(v.dtype)
    y = w[0] * vp[:, :t] + w[1] * vp[:, 1:t + 1] + w[2] * vp[:, 2:]
    return b_gate * y, vp[:, t:]


def s5_ssm(u, h0_re, h0_im, lam_re, lam_im, log_dt, b_re, b_im, c_re, c_im, d_skip, glu_w):
    f32 = jnp.float32
    bsz, t, _ = u.shape
    lam = lax.complex(lam_re.astype(f32), lam_im.astype(f32))
    dt = jnp.exp(log_dt.astype(f32))[:, None]
    a_bar = jnp.exp(lam * dt)
    b = lax.complex(b_re.astype(f32), b_im.astype(f32))
    b_bar = ((a_bar - 1.0) / lam)[..., None] * b
    c = lax.complex(c_re.astype(f32), c_im.astype(f32))
    ug = u.astype(f32).reshape(bsz, t, N_SSM_GROUPS, SSM_GROUP)
    bu = jnp.einsum('btgh,gph->btgp', ug.astype(jnp.complex64), b_bar)
    h0 = lax.complex(h0_re.astype(f32), h0_im.astype(f32))
    bu = bu.at[:, 0].add(a_bar * h0)
    a_seq = jnp.broadcast_to(a_bar, bu.shape)

    def combine(left, right):
        a_l, b_l = left
        a_r, b_r = right
        return a_r * a_l, a_r * b_l + b_r

    _, hs = lax.associative_scan(combine, (a_seq, bu), axis=1)
    y = jnp.einsum('btgp,ghp->btgh', hs, c).real + d_skip.astype(f32) * ug
    y = jax.nn.gelu(y.reshape(bsz, t, D_SSM))
    y = y * jax.nn.sigmoid(y @ glu_w.astype(f32))
    h_last = hs[:, -1]
    return y.astype(u.dtype), h_last.real.astype(h0_re.dtype), h_last.imag.astype(h0_re.dtype)


def trunk_layer(x, conv_buf, h_re, h_im, lp):
    x = x + 0.5 * swiglu(rmsnorm(x, lp['ffn1_norm']), lp['ffn1_w_gate'], lp['ffn1_w_up'], lp['ffn1_w_down'])
    xn = rmsnorm(x, lp['mix_norm'])
    proj = xn @ lp['w_in']
    b_gate, c_gate, h_conv, u = jnp.split(proj, [D_CONV, 2 * D_CONV, 3 * D_CONV], axis=-1)
    y_conv, new_buf = short_conv(b_gate, c_gate, h_conv, conv_buf, lp['conv_w'])
    y_ssm, new_re, new_im = s5_ssm(u, h_re, h_im, lp['ssm_lambda_re'], lp['ssm_lambda_im'],
                                   lp['ssm_log_dt'], lp['ssm_b_re'], lp['ssm_b_im'],
                                   lp['ssm_c_re'], lp['ssm_c_im'], lp['ssm_d'], lp['ssm_glu_w'])
    mixed = jnp.concatenate([rmsnorm(y_conv, lp['conv_out_norm']),
                             rmsnorm(y_ssm, lp['ssm_out_norm'])], axis=-1)
    x = x + mixed @ lp['w_out']
    x = x + 0.5 * swiglu(rmsnorm(x, lp['ffn2_norm']), lp['ffn2_w_gate'], lp['ffn2_w_up'], lp['ffn2_w_down'])
    return x, new_buf, new_re, new_im


def setup_inputs(seed: int = 0) -> dict:
    key = jax.random.key(seed)
    ks = jax.random.split(key, 40)
    f32 = jnp.float32
    nrm = lambda k, shape, scale: scale * jax.random.normal(k, shape, f32)
    gain = lambda k, shape: 1.0 + 0.05 * jax.random.normal(k, shape, f32)
    G, P, H, L = N_SSM_GROUPS, SSM_STATE, SSM_GROUP, DEPTH
    lam_im_base = jnp.broadcast_to(jnp.pi * jnp.arange(P, dtype=f32), (L, G, P))
    return {
        'x_prompt': nrm(ks[0], (BATCH, SEQ, D_MODEL), 1.0),
        'x_sample': nrm(ks[1], (DEC_BATCH, DEC_SEQ, D_MODEL), 1.0),
        'cache_conv': nrm(ks[2], (L, DEC_BATCH, CONV_WIDTH - 1, D_CONV), 0.5),
        'state_ssm_re': nrm(ks[3], (L, DEC_BATCH, G, P), 0.5),
        'state_ssm_im': nrm(ks[4], (L, DEC_BATCH, G, P), 0.5),
        'meta_tokens': nrm(ks[5], (N_META, D_MODEL), 1.0),
        'ffn1_norm': gain(ks[6], (L, D_MODEL)),
        'ffn1_w_gate': nrm(ks[7], (L, D_MODEL, D_FF), D_MODEL ** -0.5),
        'ffn1_w_up': nrm(ks[8], (L, D_MODEL, D_FF), D_MODEL ** -0.5),
        'ffn1_w_down': nrm(ks[9], (L, D_FF, D_MODEL), D_FF ** -0.5),
        'mix_norm': gain(ks[10], (L, D_MODEL)),
        'w_in': nrm(ks[11], (L, D_MODEL, D_IN_PROJ), D_MODEL ** -0.5),
        'conv_w': nrm(ks[12], (L, CONV_WIDTH, D_CONV), CONV_WIDTH ** -0.5),
        'conv_out_norm': gain(ks[13], (L, D_CONV)),
        'ssm_lambda_re': -0.5 + 0.01 * jax.random.normal(ks[14], (L, G, P), f32),
        'ssm_lambda_im': lam_im_base + 0.01 * jax.random.normal(ks[15], (L, G, P), f32),
        'ssm_log_dt': jax.random.uniform(ks[16], (L, G), f32, math.log(DT_MIN), math.log(DT_MAX)),
        'ssm_b_re': nrm(ks[17], (L, G, P, H), (2.0 * H) ** -0.5),
        'ssm_b_im': nrm(ks[18], (L, G, P, H), (2.0 * H) ** -0.5),
        'ssm_c_re': nrm(ks[19], (L, G, H, P), (2.0 * P) ** -0.5),
        'ssm_c_im': nrm(ks[20], (L, G, H, P), (2.0 * P) ** -0.5),
        'ssm_d': nrm(ks[21], (L, G, H), 1.0),
        'ssm_glu_w': nrm(ks[22], (L, D_SSM, D_SSM), D_SSM ** -0.5),
        'ssm_out_norm': gain(ks[23], (L, D_SSM)),
        'w_out': nrm(ks[24], (L, D_MIX, D_MODEL), D_MIX ** -0.5),
        'ffn2_norm': gain(ks[25], (L, D_MODEL)),
        'ffn2_w_gate': nrm(ks[26], (L, D_MODEL, D_FF), D_MODEL ** -0.5),
        'ffn2_w_up': nrm(ks[27], (L, D_MODEL, D_FF), D_MODEL ** -0.5),
        'ffn2_w_down': nrm(ks[28], (L, D_FF, D_MODEL), D_FF ** -0.5),
        'final_norm': gain(ks[29], (D_MODEL,)),
    }


def reference(x_prompt, x_sample, cache_conv, state_ssm_re, state_ssm_im, meta_tokens,
              ffn1_norm, ffn1_w_gate, ffn1_w_up, ffn1_w_down,
              mix_norm, w_in, conv_w, conv_out_norm,
              ssm_lambda_re, ssm_lambda_im, ssm_log_dt, ssm_b_re, ssm_b_im,
              ssm_c_re, ssm_c_im, ssm_d, ssm_glu_w, ssm_out_norm, w_out,
              ffn2_norm, ffn2_w_gate, ffn2_w_up, ffn2_w_down, final_norm):
    bsz = x_prompt.shape[0]
    meta = jnp.broadcast_to(meta_tokens.astype(x_prompt.dtype)[None], (bsz, N_META, D_MODEL))
    xp = jnp.concatenate([meta, x_prompt], axis=1)
    xs = x_sample
    zero_buf = jnp.zeros((bsz, CONV_WIDTH - 1, D_CONV), xp.dtype)
    zero_h = jnp.zeros((bsz, N_SSM_GROUPS, SSM_STATE), state_ssm_re.dtype)

    conv_p, re_p, im_p, conv_s, re_s, im_s = [], [], [], [], [], []
    for l in range(DEPTH):
        lp = {
            'ffn1_norm': ffn1_norm[l], 'ffn1_w_gate': ffn1_w_gate[l], 'ffn1_w_up': ffn1_w_up[l],
            'ffn1_w_down': ffn1_w_down[l], 'mix_norm': mix_norm[l], 'w_in': w_in[l],
            'conv_w': conv_w[l], 'conv_out_norm': conv_out_norm[l],
            'ssm_lambda_re': ssm_lambda_re[l], 'ssm_lambda_im': ssm_lambda_im[l],
            'ssm_log_dt': ssm_log_dt[l], 'ssm_b_re': ssm_b_re[l], 'ssm_b_im': ssm_b_im[l],
            'ssm_c_re': ssm_c_re[l], 'ssm_c_im': ssm_c_im[l], 'ssm_d': ssm_d[l],
            'ssm_glu_w': ssm_glu_w[l], 'ssm_out_norm': ssm_out_norm[l], 'w_out': w_out[l],
            'ffn2_norm': ffn2_norm[l], 'ffn2_w_gate': ffn2_w_gate[l], 'ffn2_w_up': ffn2_w_up[l],
            'ffn2_w_down': ffn2_w_down[l],
        }
        xp, b_p, r_p, i_p = trunk_layer(xp, zero_buf, zero_h, zero_h, lp)
        xs, b_s, r_s, i_s = trunk_layer(xs, cache_conv[l], state_ssm_re[l], state_ssm_im[l], lp)
        conv_p.append(b_p); re_p.append(r_p); im_p.append(i_p)
        conv_s.append(b_s); re_s.append(r_s); im_s.append(i_s)

    y_prompt = rmsnorm(xp, final_norm)[:, N_META:]
    y_sample = rmsnorm(xs, final_norm)
    new_conv_prompt = jnp.stack(conv_p)
    new_ssm_re_prompt = jnp.stack(re_p)
    new_ssm_im_prompt = jnp.stack(im_p)
    new_conv_sample = jnp.stack(conv_s)
    new_ssm_re_sample = jnp.stack(re_s)
    new_ssm_im_sample = jnp.stack(im_s)
    return (y_prompt, y_sample, new_conv_prompt, new_ssm_re_prompt, new_ssm_im_prompt,
            new_conv_sample, new_ssm_re_sample, new_ssm_im_sample)
```

```cpp
#include <hip/hip_runtime.h>
#include <cstdio>
#include <cstdint>
namespace pg8 {
#define PG8_LAS __attribute__((address_space(3)))
typedef unsigned short bf16_t;
typedef short bf16x8 __attribute__((ext_vector_type(8)));
typedef float f32x4 __attribute__((ext_vector_type(4)));
typedef unsigned u32x4 __attribute__((ext_vector_type(4)));
constexpr int BM = 256, BK = 64, HALF = 128, HTB = HALF * BK * 2  , STAGE_BYTES = 8 * HTB, NXCD = 8, WGM = 8;

__host__ __device__ __forceinline__ int lds_byte(int r, int c) { const int st = (r >> 4) * 2 + (c >> 5), rr = r & 15, cc = c & 31, ob = rr * 64 + cc * 2; return st * 1024 + (ob ^ (((ob >> 9) & 1) << 5)); }
__host__ __device__ __forceinline__ void stage_rc(int b, int& R, int& C) { const int st = b / 1024, sb = b % 1024, swz = sb ^ (((sb >> 9) & 1) << 5); R = (st >> 1) * 16 + swz / 64; C = (st & 1) * 32 + (swz % 64) / 2; }
__host__ __device__ __forceinline__ int perm32(int rho) { const int n = rho >> 4, i = rho & 15; return 8 * (i >> 2) + 4 * n + (i & 3); }

struct Unit { int pm, pn; };
struct Gemm { const bf16_t* A; const bf16_t* Bt; int M, N, K; };

struct StaticOrder {
    int nM, nN, nwg, G, c;
    __host__ __device__ void init(int M, int N, int G_, int c_) { nM = M / BM; nN = N / BM; nwg = nM * nN; G = G_; c = c_; }
    __host__ __device__ bool next(int i, Unit& u) const {
        const long L = (long)i * G + c; if (L >= nwg) return false;
        int wgid = (int)L; { const int q = nwg / NXCD, r = nwg % NXCD, xcd = wgid % NXCD, off = wgid / NXCD; wgid = (xcd < r ? xcd * (q + 1) : r * (q + 1) + (xcd - r) * q) + off; }
        const int nig = WGM * nN, gid = wgid / nig, fm = gid * WGM, gsz = (nM - fm) < WGM ? (nM - fm) : WGM;
        u.pm = fm + ((wgid % nig) % gsz); u.pn = (wgid % nig) / gsz; return true;
    }
    __device__ __forceinline__ void a_ready(const Unit&) const {}
    __device__ __forceinline__ void done(const Unit&) const {}
};
__device__ __forceinline__ unsigned cvt_pk_bf16(float lo, float hi) { unsigned r; asm volatile("v_cvt_pk_bf16_f32 %0, %1, %2" : "=v"(r) : "v"(lo), "v"(hi)); return r; }
typedef float f32x2 __attribute__((ext_vector_type(2)));
__device__ __forceinline__ float fast_sigmoid(float z) { return __builtin_amdgcn_rcpf(1.0f + __expf(-z)); }
struct EpiSwiglu {
    static constexpr bool PERM = true, AFTER_DRAIN = false;
    bf16_t* H; int ldc;
    __device__ __forceinline__ void operator()(const f32x4 (&acc)[2][2][4][2], const Unit& u, int wr, int wc, int fr, int fq) const {
        const int row0 = u.pm * BM + wr * 64 + fr, col0 = u.pn * HALF + wc * 32 + 8 * fq;
#pragma unroll
        for (int ai = 0; ai < 2; ++ai)
#pragma unroll
            for (int m = 0; m < 4; ++m) { bf16_t* rowp = H + (size_t)(row0 + ai * HALF + m * 16) * ldc + col0;
                float o[8];
#pragma unroll
                for (int n = 0; n < 2; ++n)
#pragma unroll
                    for (int j = 0; j < 4; ++j) { const float g = acc[ai][0][m][n][j], up = acc[ai][1][m][n][j]; o[4 * n + j] = g * up * fast_sigmoid(g); }
                u32x4 w; w.x = cvt_pk_bf16(o[0], o[1]); w.y = cvt_pk_bf16(o[2], o[3]); w.z = cvt_pk_bf16(o[4], o[5]); w.w = cvt_pk_bf16(o[6], o[7]);
                *(u32x4*)rowp = w; }
    }
};
struct EpiResid {
    static constexpr bool PERM = false, AFTER_DRAIN = false;
    float* X; int ldc; float scale;
    __device__ __forceinline__ void operator()(const f32x4 (&acc)[2][2][4][2], const Unit& u, int wr, int wc, int fr, int fq) const {
        const int row0 = u.pm * BM + wr * 64 + fr, col0 = u.pn * BM + wc * 32 + 4 * fq;
#pragma unroll
        for (int ai = 0; ai < 2; ++ai)
#pragma unroll
            for (int m = 0; m < 4; ++m) { float* rowp = X + (size_t)(row0 + ai * HALF + m * 16) * ldc + col0;
#pragma unroll
                for (int bj = 0; bj < 2; ++bj)
#pragma unroll
                    for (int n = 0; n < 2; ++n) { f32x4* p = (f32x4*)(rowp + bj * HALF + n * 16); *p = *p + acc[ai][bj][m][n] * scale; }
                asm volatile("" ::: "memory"); }
    }
};
struct EpiStoreBf16 {
    static constexpr bool PERM = true, AFTER_DRAIN = false;
    bf16_t* O; int ldc;
    __device__ __forceinline__ void operator()(const f32x4 (&acc)[2][2][4][2], const Unit& u, int wr, int wc, int fr, int fq) const {
        const int row0 = u.pm * BM + wr * 64 + fr, col0 = u.pn * BM + wc * 32 + 8 * fq;
#pragma unroll
        for (int ai = 0; ai < 2; ++ai)
#pragma unroll
            for (int m = 0; m < 4; ++m) { bf16_t* rowp = O + (size_t)(row0 + ai * HALF + m * 16) * ldc + col0;
#pragma unroll
                for (int bj = 0; bj < 2; ++bj) { const f32x4 v0 = acc[ai][bj][m][0], v1 = acc[ai][bj][m][1];
                    u32x4 w; w.x = cvt_pk_bf16(v0[0], v0[1]); w.y = cvt_pk_bf16(v0[2], v0[3]); w.z = cvt_pk_bf16(v1[0], v1[1]); w.w = cvt_pk_bf16(v1[2], v1[3]);
                    *(u32x4*)(rowp + bj * HALF) = w; } }
    }
};
struct EpiGlu {
    static constexpr bool PERM = true, AFTER_DRAIN = false;
    const bf16_t* Y; int ldy; bf16_t* O; int ldo;
    __device__ __forceinline__ void operator()(const f32x4 (&acc)[2][2][4][2], const Unit& u, int wr, int wc, int fr, int fq) const {
        const int row0 = u.pm * BM + wr * 64 + fr, col0 = u.pn * BM + wc * 32 + 8 * fq;
#pragma unroll
        for (int ai = 0; ai < 2; ++ai)
#pragma unroll
            for (int m = 0; m < 4; ++m) { const size_t r = (size_t)(row0 + ai * HALF + m * 16);
#pragma unroll
                for (int bj = 0; bj < 2; ++bj) { const u32x4 yv = *(const u32x4*)(Y + r * ldy + col0 + bj * HALF); const f32x4 z0 = acc[ai][bj][m][0], z1 = acc[ai][bj][m][1];
                    float o[8];
#pragma unroll
                    for (int q = 0; q < 4; ++q) { const unsigned w = yv[q]; const float ylo = __uint_as_float(w << 16), yhi = __uint_as_float(w & 0xffff0000u);
                        const float za = (q < 2) ? z0[2 * q] : z1[2 * q - 4], zb = (q < 2) ? z0[2 * q + 1] : z1[2 * q - 3];
                        o[2 * q] = ylo * fast_sigmoid(za); o[2 * q + 1] = yhi * fast_sigmoid(zb); }
                    u32x4 w; w.x = cvt_pk_bf16(o[0], o[1]); w.y = cvt_pk_bf16(o[2], o[3]); w.z = cvt_pk_bf16(o[4], o[5]); w.w = cvt_pk_bf16(o[6], o[7]);
                    *(u32x4*)(O + r * ldo + col0 + bj * HALF) = w; }
                asm volatile("" ::: "memory"); }
    }
};

template <class Epi, class Sched, bool ALIGN_EPI = false, bool SP2 = false>
__device__ __forceinline__ void gemm_phase(PG8_LAS unsigned char* lds, const Gemm g, const Sched& S, const Epi& E, const int tid_in) {
    const int tid = tid_in, wid = __builtin_amdgcn_readfirstlane(tid >> 6), lane = tid & 63, wr = wid >> 2, wc = wid & 3, fr = lane & 15, fq = lane >> 4;
    const int K = g.K, nt = K / BK;
    unsigned voffA[2], voffB[2];
#pragma unroll
    for (int i = 0; i < 2; ++i) { int R, C; stage_rc(tid * 16 + i * 8192, R, C); const int Rb = Epi::PERM ? ((R & ~31) + perm32(R & 31)) : R;
        voffA[i] = (unsigned)(R * K + C) * 2u; voffB[i] = (unsigned)(Rb * K + C) * 2u; }
    const size_t kstep = (size_t)(BK * 2);
    const size_t hstep = (size_t)HALF * K * 2;
    const size_t tstep = 2 * hstep;
    const unsigned ldsw = (unsigned)wid * 1024u;
    const int aoff = lds_byte(wr * 64 + fr, fq * 8), boff = lds_byte(wc * 32 + fr, fq * 8);
#define PG8_SA(b, h) (((b) * 2 + (h)) * HTB)
#define PG8_SB(b, h) ((4 + (b) * 2 + (h)) * HTB)
#define PG8_STAGE(bufoff, gbase, voff) do { _Pragma("unroll") for (int _i = 0; _i < 2; ++_i) \
        __builtin_amdgcn_global_load_lds((const unsigned*)((const char*)(gbase) + (voff)[_i]), (PG8_LAS unsigned*)(lds + (bufoff) + ldsw + _i * 8192), 16, 0, 0); } while (0)
#define PG8_LDA(dst, b, h) do { _Pragma("unroll") for (int m = 0; m < 4; ++m) _Pragma("unroll") for (int k = 0; k < 2; ++k) dst[m][k] = *(const PG8_LAS bf16x8*)(lds + PG8_SA(b, h) + aoff + m * 2048 + k * 1024); } while (0)
#define PG8_LDB(dst, b, h) do { _Pragma("unroll") for (int n = 0; n < 2; ++n) _Pragma("unroll") for (int k = 0; k < 2; ++k) dst[n][k] = *(const PG8_LAS bf16x8*)(lds + PG8_SB(b, h) + boff + n * 2048 + k * 1024); } while (0)
#define PG8_MMA(ai, bj, At, Bt) do { __builtin_amdgcn_s_setprio(1); _Pragma("unroll") for (int m = 0; m < 4; ++m) _Pragma("unroll") for (int n = 0; n < 2; ++n) _Pragma("unroll") for (int k = 0; k < 2; ++k) \
        acc[ai][bj][m][n] = __builtin_amdgcn_mfma_f32_16x16x32_bf16(Bt[n][k], At[m][k], acc[ai][bj][m][n], 0, 0, 0); __builtin_amdgcn_s_setprio(0); } while (0)
#define PG8_WAIT_V(n) asm volatile("s_waitcnt vmcnt(" #n ")" ::: "memory")
#define PG8_WAIT_L(n) asm volatile("s_waitcnt lgkmcnt(" #n ")" ::: "memory")
#define PG8_BAR __builtin_amdgcn_s_barrier()
#define PG8_SCHED __builtin_amdgcn_sched_barrier(0)
    Unit cur, nxt; int ui = 0;
    if (!S.next(0, cur)) return;
    f32x4 acc[2][2][4][2];
#pragma unroll
    for (int a = 0; a < 2; ++a)
#pragma unroll
        for (int b = 0; b < 2; ++b)
#pragma unroll
            for (int m = 0; m < 4; ++m)
#pragma unroll
                for (int n = 0; n < 2; ++n) acc[a][b][m][n] = (f32x4){0.f, 0.f, 0.f, 0.f};
    bf16x8 At[4][2], B0[2][2], B1[2][2];
    const char* cA = (const char*)g.A + (size_t)cur.pm * tstep; const char* cB = (const char*)g.Bt + (size_t)cur.pn * tstep;
    S.a_ready(cur);
    if constexpr (SP2) {
        PG8_STAGE(PG8_SB(0, 0), cB, voffB); PG8_STAGE(PG8_SB(0, 1), cB + hstep, voffB); PG8_STAGE(PG8_SA(0, 0), cA, voffA); PG8_STAGE(PG8_SA(0, 1), cA + hstep, voffA);
        if (wr == 1) PG8_BAR;
        PG8_WAIT_V(2); PG8_BAR;
        PG8_STAGE(PG8_SB(1, 0), cB + kstep, voffB); PG8_STAGE(PG8_SA(1, 0), cA + kstep, voffA); PG8_STAGE(PG8_SB(1, 1), cB + hstep + kstep, voffB);
        PG8_WAIT_V(6); PG8_BAR;
    } else {
        PG8_STAGE(PG8_SB(0, 0), cB, voffB); PG8_STAGE(PG8_SA(0, 0), cA, voffA); PG8_STAGE(PG8_SB(0, 1), cB + hstep, voffB); PG8_STAGE(PG8_SA(0, 1), cA + hstep, voffA);
        if (wr == 1) PG8_BAR;
        PG8_WAIT_V(4); PG8_BAR;
        PG8_STAGE(PG8_SB(1, 0), cB + kstep, voffB); PG8_STAGE(PG8_SA(1, 0), cA + kstep, voffA); PG8_STAGE(PG8_SB(1, 1), cB + hstep + kstep, voffB);
        PG8_WAIT_V(6); PG8_BAR;
    }
    for (;;) {
        const bool has_next = S.next(ui + 1, nxt);
        const char* nA = has_next ? (const char*)g.A + (size_t)nxt.pm * tstep : cA; const char* nB = has_next ? (const char*)g.Bt + (size_t)nxt.pn * tstep : cB;
        for (int t = 0; t < nt; t += 2) {
            const bool last = (t == nt - 2);
            const char* a1 = cA + (size_t)(t + 1) * kstep;
            const char* a2 = last ? nA : cA + (size_t)(t + 2) * kstep; const char* b2 = last ? nB : cB + (size_t)(t + 2) * kstep;
            const char* a3 = a2 + kstep; const char* b3 = b2 + kstep;
            if (last && has_next) S.a_ready(nxt);
            if constexpr (SP2) {
            PG8_LDB(B0, 0, 0); PG8_LDB(B1, 0, 1); PG8_SCHED; PG8_LDA(At, 0, 0); PG8_STAGE(PG8_SA(1, 1), a1 + hstep, voffA);
            PG8_WAIT_V(8); PG8_WAIT_L(0); PG8_BAR; PG8_MMA(0, 0, At, B0); PG8_MMA(0, 1, At, B1); PG8_BAR; PG8_SCHED;
            PG8_LDA(At, 0, 1); PG8_STAGE(PG8_SB(0, 0), b2, voffB); PG8_STAGE(PG8_SB(0, 1), b2 + hstep, voffB); PG8_STAGE(PG8_SA(0, 0), a2, voffA);
            PG8_WAIT_V(8); PG8_WAIT_L(0); PG8_BAR; PG8_MMA(1, 0, At, B0); PG8_MMA(1, 1, At, B1); PG8_BAR; PG8_SCHED;
            PG8_LDB(B0, 1, 0); PG8_LDB(B1, 1, 1); PG8_SCHED; PG8_LDA(At, 1, 0); PG8_STAGE(PG8_SA(0, 1), a2 + hstep, voffA);
            PG8_WAIT_V(8); PG8_WAIT_L(0); PG8_BAR; PG8_MMA(0, 0, At, B0); PG8_MMA(0, 1, At, B1); PG8_BAR; PG8_SCHED;
            PG8_LDA(At, 1, 1); PG8_STAGE(PG8_SB(1, 0), b3, voffB); PG8_STAGE(PG8_SB(1, 1), b3 + hstep, voffB); PG8_STAGE(PG8_SA(1, 0), a3, voffA);
            PG8_WAIT_V(8); PG8_WAIT_L(0); PG8_BAR; PG8_MMA(1, 0, At, B0); PG8_MMA(1, 1, At, B1); PG8_BAR; PG8_SCHED;
            } else {
            PG8_LDB(B0, 0, 0); PG8_SCHED; PG8_LDA(At, 0, 0); PG8_STAGE(PG8_SA(1, 1), a1 + hstep, voffA);
            PG8_WAIT_L(8); PG8_BAR; PG8_WAIT_L(0); PG8_MMA(0, 0, At, B0); PG8_BAR; PG8_SCHED;
            PG8_LDB(B1, 0, 1); PG8_STAGE(PG8_SB(0, 0), b2, voffB);
            PG8_BAR; PG8_WAIT_L(0); PG8_MMA(0, 1, At, B1); PG8_BAR;
            PG8_LDA(At, 0, 1); PG8_STAGE(PG8_SA(0, 0), a2, voffA);
            PG8_BAR; PG8_WAIT_L(0); PG8_MMA(1, 0, At, B0); PG8_BAR; PG8_SCHED;
            PG8_STAGE(PG8_SB(0, 1), b2 + hstep, voffB);
            PG8_WAIT_V(6); PG8_BAR; PG8_MMA(1, 1, At, B1); PG8_BAR;
            PG8_LDB(B0, 1, 0); PG8_SCHED; PG8_LDA(At, 1, 0); PG8_STAGE(PG8_SA(0, 1), a2 + hstep, voffA);
            PG8_WAIT_L(8); PG8_BAR; PG8_WAIT_L(0); PG8_MMA(0, 0, At, B0); PG8_BAR; PG8_SCHED;
            PG8_LDB(B1, 1, 1); PG8_STAGE(PG8_SB(1, 0), b3, voffB);
            PG8_BAR; PG8_WAIT_L(0); PG8_MMA(0, 1, At, B1); PG8_BAR;
            PG8_LDA(At, 1, 1); PG8_STAGE(PG8_SA(1, 0), a3, voffA);
            PG8_BAR; PG8_WAIT_L(0); PG8_MMA(1, 0, At, B0); PG8_BAR; PG8_SCHED;
            PG8_STAGE(PG8_SB(1, 1), b3 + hstep, voffB);
            PG8_WAIT_V(6); PG8_BAR; PG8_MMA(1, 1, At, B1); PG8_BAR;
            }
        }
        if constexpr (ALIGN_EPI) { if (wr == 0) PG8_BAR; }
        if constexpr (!Epi::AFTER_DRAIN) { E(acc, cur, wr, wc, fr, fq); S.done(cur); }
        if (!has_next) break;
#pragma unroll
        for (int a = 0; a < 2; ++a)
#pragma unroll
            for (int b = 0; b < 2; ++b)
#pragma unroll
                for (int m = 0; m < 4; ++m)
#pragma unroll
                    for (int n = 0; n < 2; ++n) acc[a][b][m][n] = (f32x4){0.f, 0.f, 0.f, 0.f};
        cur = nxt; cA = nA; cB = nB; ++ui;
        if constexpr (ALIGN_EPI) { if (wr == 1) PG8_BAR; }
    }
    PG8_WAIT_V(0);
    if constexpr (!ALIGN_EPI) { if (wr == 0) PG8_BAR; }
    PG8_BAR;
    if constexpr (Epi::AFTER_DRAIN) { E.fused(acc, cur, wr, wc, fr, fq, lds, wid, lane); S.done(cur); }
#undef PG8_SA
#undef PG8_SB
#undef PG8_STAGE
#undef PG8_LDA
#undef PG8_LDB
#undef PG8_MMA
#undef PG8_WAIT_V
#undef PG8_WAIT_L
#undef PG8_BAR
#undef PG8_SCHED
}
}
#define GAS __attribute__((address_space(1)))
#define LAS __attribute__((address_space(3)))
typedef unsigned short bf16;
typedef unsigned v4u __attribute__((ext_vector_type(4)));
typedef float f32x4 __attribute__((ext_vector_type(4)));
typedef short bf16x8 __attribute__((ext_vector_type(8)));
typedef GAS unsigned gu32;
typedef GAS unsigned long long gu64;
#define RLX_AGENT __ATOMIC_RELAXED, __HIP_MEMORY_SCOPE_AGENT
#define LDS_WAIT() asm volatile("s_waitcnt lgkmcnt(0)" ::: "memory")
#define VM_WAIT() asm volatile("s_waitcnt vmcnt(0)" ::: "memory")
__device__ __forceinline__ unsigned long long rt() { return __builtin_amdgcn_s_memrealtime(); }
__device__ __forceinline__ unsigned f2bf(float f) { unsigned u = __builtin_bit_cast(unsigned, f); return (u + 0x7fffu + ((u >> 16) & 1u)) >> 16; }
__device__ __forceinline__ unsigned pk2(float lo, float hi) { return f2bf(lo) | (f2bf(hi) << 16); }

#define XB_TMO      128
#define XB_XCNT(j)  (256  + 64 * (j))
#define XB_XSUB(j)  (1280 + 64 * (j))
#define XB_XGEN(j)  (2304 + 64 * (j))
#define XB_TOP      3328
#define XB_TOPGEN   3392
#define XCD_BAR_WORDS 3456
#define XB_SPIN_CAP (1u << 18)

__device__ __forceinline__ unsigned xb_ld(unsigned* p)              { return __hip_atomic_load(p, __ATOMIC_RELAXED, __HIP_MEMORY_SCOPE_AGENT); }
__device__ __forceinline__ unsigned xb_add(unsigned* p, unsigned v) { return __hip_atomic_fetch_add(p, v, __ATOMIC_RELAXED, __HIP_MEMORY_SCOPE_AGENT); }
__device__ __forceinline__ unsigned xb_xcc_id() { return (unsigned)__builtin_amdgcn_s_getreg((3 << 11) | 20) & 0xFu; }
#define XB_SPIN(cond, bar) do { unsigned _sp = 0; while (cond) { __builtin_amdgcn_s_sleep(1); \
    if ((++_sp & 255u) == 0u) { if (xb_ld(&(bar)[XB_TMO])) break; if (_sp > XB_SPIN_CAP) { atomicAdd(&(bar)[XB_TMO], 1u); break; } } } } while (0)

struct XcdBarrier {
    unsigned* bar; unsigned x;
    volatile LAS unsigned* st;
};

__device__ __forceinline__ XcdBarrier xcd_barrier_post(unsigned* bar, volatile LAS unsigned* st) {
    XcdBarrier b; b.bar = bar; b.x = xb_xcc_id(); b.st = st;
    if (threadIdx.x == 0) (void)xb_add(&bar[XB_XCNT(b.x)], 1u);
    return b;
}
__device__ __forceinline__ void xcd_barrier_complete(unsigned* bar, unsigned x, unsigned& nloc, unsigned& nx) {
    const unsigned G = gridDim.x * gridDim.y * gridDim.z;
    unsigned sum, cnt, mine, sp = 0u;
    for (;;) {
        sum = 0u; cnt = 0u; mine = 0u;
#pragma unroll
        for (unsigned j = 0; j < 16; ++j) { const unsigned c = xb_ld(&bar[XB_XCNT(j)]); sum += c; cnt += (c > 0u) ? 1u : 0u; mine = (j == x) ? c : mine; }
        if (sum == G) break;
        __builtin_amdgcn_s_sleep(1);
        if ((++sp & 255u) == 0u) { if (xb_ld(&bar[XB_TMO])) break; if (sp > XB_SPIN_CAP) { atomicAdd(&bar[XB_TMO], 1u); break; } }
    }
    nloc = mine > 0u ? mine : 1u; nx = cnt > 0u ? cnt : 1u;
}

__device__ __forceinline__ void xcd_barrier(const XcdBarrier& b) {
    asm volatile("s_waitcnt vmcnt(0)" ::: "memory");
    __syncthreads();
    if (threadIdx.x == 0) {
        unsigned* bar = b.bar;
        __builtin_amdgcn_s_waitcnt(0);
        unsigned nloc = b.st[0], nx = b.st[1];
        if (nloc == 0u) { xcd_barrier_complete(bar, b.x, nloc, nx); b.st[0] = nloc; b.st[1] = nx; }
        const unsigned old = xb_add(&bar[XB_XSUB(b.x)], 1u);
        const unsigned gen = old / nloc;
        if (old + 1u == (gen + 1u) * nloc) {
            __builtin_amdgcn_fence(__ATOMIC_RELEASE, "agent");
            asm volatile("s_waitcnt vmcnt(0)" ::: "memory");
            const unsigned og = xb_add(&bar[XB_TOP], 1u);
            const unsigned tg = og / nx;
            if (og + 1u == (tg + 1u) * nx) xb_add(&bar[XB_TOPGEN], 1u);
            else XB_SPIN(xb_ld(&bar[XB_TOPGEN]) == tg, bar);
            __builtin_amdgcn_fence(__ATOMIC_ACQUIRE, "agent");
            xb_add(&bar[XB_XGEN(b.x)], 1u);
            asm volatile("s_waitcnt vmcnt(0)" ::: "memory");
        } else {
            XB_SPIN(xb_ld(&bar[XB_XGEN(b.x)]) == gen, bar);
            __builtin_amdgcn_fence(__ATOMIC_ACQUIRE, "agent");
            asm volatile("s_waitcnt vmcnt(0)" ::: "memory");
        }
    }
    __syncthreads();
}
namespace mk {
typedef float f32x2 __attribute__((ext_vector_type(2)));
typedef unsigned u32x2 __attribute__((ext_vector_type(2)));
constexpr int NWAVES = 8;
constexpr int D = 2048, FF = 5632, DCV = 1024, DSS = 1024, DIN = 4096, NL = 4;
constexpr int SEQ = 16384, NMETA = 16, TP = SEQ + NMETA, NBP = 2, NBS = 8, TS = 32;
constexpr int MPROMPT = NBP * TP;
constexpr int MREAL = MPROMPT + NBS * TS;
constexpr int MPAD = 33280;
constexpr int NCHUNK = MPAD / 16;
constexpr int NCH_REAL = MREAL / 16;
constexpr int CH_PER_SEQ = TP / 16;
constexpr int NCT = NCHUNK / 16;
constexpr int SG = 64, SP = 64, SH = 16;
constexpr float EPS = 1e-6f;
static_assert(MPAD % 256 == 0 && MPAD >= MREAL && MREAL % 16 == 0 && TP % 16 == 0, "row geometry");

enum { I_XP = 0, I_XS, I_CACHE, I_SRE, I_SIM, I_META, I_F1N, I_F1G, I_F1U, I_F1D, I_MIXN, I_WIN, I_CONVW, I_CONVN, I_LRE, I_LIM, I_LDT, I_BRE, I_BIM, I_CRE, I_CIM, I_SD,
       I_GLU, I_SSMN, I_WOUT, I_F2N, I_F2G, I_F2U, I_F2D, I_FINN, N_IN };
constexpr size_t O_YP = 0, O_YS = O_YP + (size_t)NBP * SEQ * D, O_CVP = O_YS + (size_t)NBS * TS * D, O_REP = O_CVP + (size_t)NL * NBP * 2 * DCV,
                 O_IMP = O_REP + (size_t)NL * NBP * SG * SP, O_CVS = O_IMP + (size_t)NL * NBP * SG * SP, O_RES = O_CVS + (size_t)NL * NBS * 2 * DCV,
                 O_IMS = O_RES + (size_t)NL * NBS * SG * SP, O_END = O_IMS + (size_t)NL * NBS * SG * SP;
static_assert(O_END == 68042752, "output size");

constexpr size_t CTL_BYTES = 1u << 20;
constexpr size_t WS_X = CTL_BYTES;
constexpr size_t WS_XN = WS_X + (size_t)MPAD * D * 4;
constexpr size_t WS_WGU0 = WS_XN + (size_t)MPAD * D * 2;
constexpr size_t WS_WGU1 = WS_WGU0 + (size_t)2 * FF * D * 2;
constexpr size_t WS_WD0 = WS_WGU1 + (size_t)2 * FF * D * 2;
constexpr size_t WS_WD1 = WS_WD0 + (size_t)D * FF * 2;
constexpr size_t WS_WIN = WS_WD1 + (size_t)D * FF * 2;
constexpr size_t WS_WGLU = WS_WIN + (size_t)DIN * D * 2;
constexpr size_t WS_WOUT = WS_WGLU + (size_t)DSS * DSS * 2;
constexpr size_t WS_WBT = WS_WOUT + (size_t)D * D * 2;
constexpr size_t WS_BMT = WS_WBT + (size_t)SG * 256 * 384 * 2;
constexpr size_t WS_APOW = WS_BMT + (size_t)SG * 128 * 256 * 2;
constexpr size_t WS_BBAR = WS_APOW + (size_t)NL * 17 * SG * SP * 8;
constexpr size_t WS_R = WS_BBAR + (size_t)NL * SG * SP * SH * 8;
constexpr size_t WS_H = WS_R;
constexpr size_t WS_PROJ = WS_R;
constexpr size_t WS_MIXED = WS_PROJ + (size_t)MPAD * DIN * 2;
constexpr size_t WS_YS = WS_MIXED + (size_t)MPAD * D * 2;
constexpr size_t WS_SLOC = WS_YS + (size_t)MPAD * DSS * 2;
constexpr size_t WS_SIN = WS_SLOC + (size_t)NCHUNK * SG * 128 * 4;
constexpr size_t WS_END_A = WS_H + (size_t)MPAD * FF * 2, WS_END_B = WS_SIN + (size_t)NCHUNK * SG * 128 * 2;
constexpr size_t WS_END = WS_END_A > WS_END_B ? WS_END_A : WS_END_B;
static_assert(WS_R % 256 == 0 && WS_SLOC % 256 == 0, "alignment");
constexpr int CW_BAR = 4096;

constexpr int RING_OFF = 0, RING_BYTES = 131072;
constexpr int LDSCTL_OFF = RING_BYTES, MISC_OFF = LDSCTL_OFF + 320;
constexpr int LDS_BYTES = 147456;

__device__ __forceinline__ float wave_sum(float v) {
#pragma unroll
    for (int o = 1; o < 64; o <<= 1) v += __shfl_xor(v, o);
    return v;
}
__device__ __forceinline__ unsigned pkbf(float lo, float hi) { return pg8::cvt_pk_bf16(lo, hi); }
__device__ __forceinline__ float bflo(unsigned w) { return __uint_as_float(w << 16); }
__device__ __forceinline__ float bfhi(unsigned w) { return __uint_as_float(w & 0xffff0000u); }

__device__ __forceinline__ void transpose_item(const float* W, int K, int N, bf16* WT, int mode, LAS float* scr, int item, int lane) {
    const int nblk = N / 32, kb = item / nblk, nb = item % nblk, k0 = 64 * kb, n0 = 32 * nb;
    const int drow0 = (mode == 0) ? n0 : (256 * (n0 >> 7) + 128 * (mode - 1) + (n0 & 127));
#pragma unroll 8
    for (int i = 0; i < 32; ++i) { const int kk = 2 * i + (lane >> 5); scr[kk * 33 + (lane & 31)] = W[(size_t)(k0 + kk) * N + n0 + (lane & 31)]; }
    LDS_WAIT(); asm volatile("" ::: "memory");
    const int c = lane & 7;
#pragma unroll
    for (int j = 0; j < 4; ++j) { const int n = (lane >> 3) + 8 * j; const LAS float* s = scr + (8 * c) * 33 + n;
        v4u o; o.x = pkbf(s[0 * 33], s[1 * 33]); o.y = pkbf(s[2 * 33], s[3 * 33]); o.z = pkbf(s[4 * 33], s[5 * 33]); o.w = pkbf(s[6 * 33], s[7 * 33]);
        *(v4u*)(WT + (size_t)(drow0 + n) * K + k0 + 8 * c) = o; }
    LDS_WAIT(); asm volatile("" ::: "memory");
}

__device__ __forceinline__ void norm_row(const float* src, const float* gain, bf16* dst, float* xcopy, int lane) {
    f32x4 v[8]; float s = 0.f;
    if (src) { const f32x4* xr = (const f32x4*)src + lane;
#pragma unroll
        for (int j = 0; j < 8; ++j) { v[j] = xr[64 * j]; s += (v[j].x * v[j].x + v[j].y * v[j].y) + (v[j].z * v[j].z + v[j].w * v[j].w); } }
    else {
#pragma unroll
        for (int j = 0; j < 8; ++j) v[j] = (f32x4){0.f, 0.f, 0.f, 0.f}; }
    if (xcopy) { f32x4* xc = (f32x4*)xcopy + lane;
#pragma unroll
        for (int j = 0; j < 8; ++j) xc[64 * j] = v[j]; }
    const float r = 1.0f / sqrtf(wave_sum(s) * (1.0f / D) + EPS);
    const f32x4* gr = (const f32x4*)gain + lane; u32x2* o8 = (u32x2*)dst + lane;
#pragma unroll
    for (int j = 0; j < 8; ++j) { const f32x4 g = gr[64 * j]; u32x2 w; w.x = pkbf(v[j].x * r * g.x, v[j].y * r * g.y); w.y = pkbf(v[j].z * r * g.z, v[j].w * r * g.w); o8[64 * j] = w; }
}
__device__ __forceinline__ void final_row(const float* src, const float* gain, float* dst, int lane) {
    f32x4 v[8]; float s = 0.f; const f32x4* xr = (const f32x4*)src + lane;
#pragma unroll
    for (int j = 0; j < 8; ++j) { v[j] = xr[64 * j]; s += (v[j].x * v[j].x + v[j].y * v[j].y) + (v[j].z * v[j].z + v[j].w * v[j].w); }
    const float r = 1.0f / sqrtf(wave_sum(s) * (1.0f / D) + EPS);
    const f32x4* gr = (const f32x4*)gain + lane; f32x4* o = (f32x4*)dst + lane;
#pragma unroll
    for (int j = 0; j < 8; ++j) { const f32x4 g = gr[64 * j]; o[64 * j] = v[j] * r * g; }
}
__device__ __forceinline__ const float* input_row(int r, const float* xp, const float* xs, const float* meta) {
    if (r < MPROMPT) { const int b = r / TP, pos = r - b * TP; return pos < NMETA ? meta + (size_t)pos * D : xp + ((size_t)b * SEQ + (pos - NMETA)) * D; }
    if (r < MREAL) return xs + (size_t)(r - MPROMPT) * D;
    return nullptr;
}

__device__ __forceinline__ void ssm_tables(int t, const float* lre_, const float* lim_, const float* ldt, const float* bre, const float* bim, f32x2* apow, f32x2* bbar) {
    const int l = t / (SG * SP), gp = t % (SG * SP), g = gp / SP;
    const double dtd = exp((double)ldt[l * SG + g]);
    const float lre = lre_[t], lim = lim_[t];
    const double xr = (double)lre * dtd, th = (double)lim * dtd;
    float c1 = 1.f, s1 = 0.f;
    for (int k = 0; k <= 16; ++k) {
        const double ang = th * (double)k; const double n = rint(ang * 0.15915494309189535); const float r = (float)(ang - n * 6.283185307179586);
        const float mag = expf((float)(xr * (double)k)); const float cs = cosf(r), sn = sinf(r);
        apow[((size_t)(l * 17 + k)) * (SG * SP) + gp] = (f32x2){mag * cs, mag * sn};
        if (k == 1) { c1 = cs; s1 = sn; }
    }
    const float em1 = expm1f((float)xr);
    const float hv = 0.5f * (1.0f - c1);
    const float are = em1 * c1 - 2.0f * hv, aim = (1.0f + em1) * s1;
    const float den = 1.0f / (lre * lre + lim * lim);
    const float qre = (are * lre + aim * lim) * den, qim = (aim * lre - are * lim) * den;
    const float* br = bre + (size_t)t * SH; const float* bi = bim + (size_t)t * SH; f32x2* bo = bbar + (size_t)t * SH;
#pragma unroll 4
    for (int h = 0; h < SH; ++h) { const float x = br[h], y = bi[h]; bo[h] = (f32x2){qre * x - qim * y, qre * y + qim * x}; }
}
__device__ __forceinline__ void ssm_matrices(int l, size_t t0, size_t tstride, const f32x2* apow, const f32x2* bbar, const float* cre, const float* cim, const float* dsk, bf16* WBT, bf16* BMT) {
    const f32x2* ap = apow + (size_t)l * 17 * SG * SP; const f32x2* bb = bbar + (size_t)l * SG * SP * SH;
    const float* cr = cre + (size_t)l * SG * SH * SP; const float* ci = cim + (size_t)l * SG * SH * SP; const float* dd = dsk + (size_t)l * SG * SH;
    constexpr size_t NA = (size_t)SG * 16 * 256, NB = (size_t)SG * 256 * SP, NC = (size_t)SG * SP * 256;
    for (size_t t = t0; t < NA + NB + NC; t += tstride) {
        if (t < NA) {
            const int g = (int)(t / 4096), k = (int)(t / 256) % 16, h = (int)(t / 16) % 16, hp = (int)t % 16;
            float s = 0.f;
            for (int p = 0; p < SP; ++p) { const f32x2 a = ap[((size_t)k * SG + g) * SP + p], b = bb[((size_t)g * SP + p) * SH + hp]; const float x = cr[((size_t)g * SH + h) * SP + p], y = ci[((size_t)g * SH + h) * SP + p];
                const float abr = a.x * b.x - a.y * b.y, abi = a.x * b.y + a.y * b.x; s += x * abr - y * abi; }
            if (k == 0 && h == hp) s += dd[g * SH + h];
            const unsigned short sv = (unsigned short)(pkbf(s, 0.f) & 0xffffu);
            for (int m = 0; m + k < 16; ++m) { WBT[((size_t)g * 256 + (size_t)(k + m) * 16 + h) * 384 + m * 16 + hp] = sv;
                if (k > 0) WBT[((size_t)g * 256 + (size_t)m * 16 + h) * 384 + (k + m) * 16 + hp] = 0; }
        } else if (t < NA + NB) {
            const size_t u = t - NA; const int g = (int)(u / 16384), i = (int)(u / 1024) % 16, h = (int)(u / 64) % 16, p = (int)u % 64;
            const f32x2 a = ap[((size_t)(i + 1) * SG + g) * SP + p]; const float x = cr[((size_t)g * SH + h) * SP + p], y = ci[((size_t)g * SH + h) * SP + p];
            const size_t o = ((size_t)g * 256 + i * 16 + h) * 384 + 256 + p;
            WBT[o] = (unsigned short)(pkbf(x * a.x - y * a.y, 0.f) & 0xffffu); WBT[o + 64] = (unsigned short)(pkbf(-(x * a.y + y * a.x), 0.f) & 0xffffu);
        } else {
            const size_t u = t - NA - NB; const int g = (int)(u / 16384), p = (int)(u / 256) % 64, j = (int)(u / 16) % 16, hp = (int)u % 16;
            const f32x2 a = ap[((size_t)(15 - j) * SG + g) * SP + p], b = bb[((size_t)g * SP + p) * SH + hp];
            const size_t o = ((size_t)g * 128 + p) * 256 + j * 16 + hp;
            BMT[o] = (unsigned short)(pkbf(a.x * b.x - a.y * b.y, 0.f) & 0xffffu); BMT[o + (size_t)64 * 256] = (unsigned short)(pkbf(a.x * b.y + a.y * b.x, 0.f) & 0xffffu);
        }
    }
}

__device__ __forceinline__ float gelu_tanh(float x) { const float z = 0.7978845608028654f * (x + 0.044715f * x * x * x); return x * __builtin_amdgcn_rcpf(1.0f + __expf(-2.0f * z)); }

__device__ __forceinline__ void conv_row(int r, int l, const bf16* PROJ, bf16* MIXED, const float* cache, const float* convw, const float* cgain, float* out, int lane) {
    v4u* mo = (v4u*)(MIXED + (size_t)r * D);
    if (r >= MREAL) { mo[lane] = (v4u){0u, 0u, 0u, 0u}; mo[64 + lane] = (v4u){0u, 0u, 0u, 0u}; return; }
    int pos, T; const float* cb = nullptr; float* ob;
    if (r < MPROMPT) { const int b = r / TP; pos = r - b * TP; T = TP; ob = out + O_CVP + (size_t)(l * NBP + b) * 2 * DCV; }
    else { const int s = (r - MPROMPT) / TS; pos = (r - MPROMPT) - s * TS; T = TS; cb = cache + (size_t)(l * NBS + s) * 2 * DCV; ob = out + O_CVS + (size_t)(l * NBS + s) * 2 * DCV; }
    float y[16], vkeep1[16], vkeep0[16]; float ss = 0.f;
#pragma unroll
    for (int hf = 0; hf < 2; ++hf) {
        const int c0 = hf * 512 + lane * 8;
        const bf16* pr = PROJ + (size_t)r * DIN + c0;
        const v4u bg = *(const v4u*)pr, cg0 = *(const v4u*)(pr + DCV), hg0 = *(const v4u*)(pr + 2 * DCV);
        float v0[8], v1[8], v2[8];
#pragma unroll
        for (int q = 0; q < 4; ++q) { v0[2 * q] = bflo(cg0[q]) * bflo(hg0[q]); v0[2 * q + 1] = bfhi(cg0[q]) * bfhi(hg0[q]); }
        if (pos >= 1) { const v4u cg = *(const v4u*)(pr - DIN + DCV), hg = *(const v4u*)(pr - DIN + 2 * DCV);
#pragma unroll
            for (int q = 0; q < 4; ++q) { v1[2 * q] = bflo(cg[q]) * bflo(hg[q]); v1[2 * q + 1] = bfhi(cg[q]) * bfhi(hg[q]); } }
        else {
#pragma unroll
            for (int e = 0; e < 8; ++e) v1[e] = cb ? cb[DCV + c0 + e] : 0.f; }
        if (pos >= 2) { const v4u cg = *(const v4u*)(pr - 2 * DIN + DCV), hg = *(const v4u*)(pr - 2 * DIN + 2 * DCV);
#pragma unroll
            for (int q = 0; q < 4; ++q) { v2[2 * q] = bflo(cg[q]) * bflo(hg[q]); v2[2 * q + 1] = bfhi(cg[q]) * bfhi(hg[q]); } }
        else {
#pragma unroll
            for (int e = 0; e < 8; ++e) v2[e] = cb ? cb[(pos == 1 ? DCV : 0) + c0 + e] : 0.f; }
        const float* w = convw + (size_t)l * 3 * DCV + c0;
#pragma unroll
        for (int e = 0; e < 8; ++e) { const float bgv = (e & 1) ? bfhi(bg[e >> 1]) : bflo(bg[e >> 1]);
            const float yy = bgv * (w[e] * v2[e] + w[DCV + e] * v1[e] + w[2 * DCV + e] * v0[e]); y[hf * 8 + e] = yy; ss += yy * yy; vkeep1[hf * 8 + e] = v1[e]; vkeep0[hf * 8 + e] = v0[e]; }
    }
    const float rn = 1.0f / sqrtf(wave_sum(ss) * (1.0f / DCV) + EPS);
#pragma unroll
    for (int hf = 0; hf < 2; ++hf) { const int c0 = hf * 512 + lane * 8; const float* g = cgain + (size_t)l * DCV + c0; v4u w;
#pragma unroll
        for (int q = 0; q < 4; ++q) w[q] = pkbf(y[hf * 8 + 2 * q] * rn * g[2 * q], y[hf * 8 + 2 * q + 1] * rn * g[2 * q + 1]);
        mo[hf * 64 + lane] = w;
        if (pos == T - 1) {
#pragma unroll
            for (int e = 0; e < 8; ++e) { ob[c0 + e] = vkeep1[hf * 8 + e]; ob[DCV + c0 + e] = vkeep0[hf * 8 + e]; } }
    }
}
__device__ __forceinline__ void norm_s_row(int r, bf16* MIXED, const float* gain, int lane) {
    v4u* p = (v4u*)(MIXED + (size_t)r * D + DCV); const v4u a = p[lane], b = p[64 + lane]; float v[16]; float ss = 0.f;
#pragma unroll
    for (int q = 0; q < 4; ++q) { v[2 * q] = bflo(a[q]); v[2 * q + 1] = bfhi(a[q]); v[8 + 2 * q] = bflo(b[q]); v[8 + 2 * q + 1] = bfhi(b[q]); }
#pragma unroll
    for (int e = 0; e < 16; ++e) ss += v[e] * v[e];
    const float rn = 1.0f / sqrtf(wave_sum(ss) * (1.0f / DSS) + EPS);
    v4u wa, wb; const float* g0 = gain + lane * 8; const float* g1 = gain + 512 + lane * 8;
#pragma unroll
    for (int q = 0; q < 4; ++q) { wa[q] = pkbf(v[2 * q] * rn * g0[2 * q], v[2 * q + 1] * rn * g0[2 * q + 1]); wb[q] = pkbf(v[8 + 2 * q] * rn * g1[2 * q], v[8 + 2 * q + 1] * rn * g1[2 * q + 1]); }
    p[lane] = wa; p[64 + lane] = wb;
}

__device__ __forceinline__ void ssm_gemm_a(int ct, int g, const bf16* PROJ, const bf16* BMT, float* SLOC, int lane) {
    const int fr = lane & 15, fq = lane >> 4;
    f32x4 acc[8];
#pragma unroll
    for (int i = 0; i < 8; ++i) acc[i] = (f32x4){0.f, 0.f, 0.f, 0.f};
    const bf16* ub = PROJ + ((size_t)(ct * 16 + fr) * 16 + (fq >> 1)) * DIN + 3 * DCV + g * SH + (fq & 1) * 8;
    const bf16* wb = BMT + ((size_t)g * 128 + fr) * 256 + fq * 8;
#pragma unroll 2
    for (int ks = 0; ks < 8; ++ks) {
        const bf16x8 uf = *(const bf16x8*)(ub + (size_t)(2 * ks) * DIN);
#pragma unroll
        for (int nf = 0; nf < 8; ++nf) { const bf16x8 wf = *(const bf16x8*)(wb + (size_t)nf * 16 * 256 + ks * 32); acc[nf] = __builtin_amdgcn_mfma_f32_16x16x32_bf16(wf, uf, acc[nf], 0, 0, 0); }
    }
    float* so = SLOC + ((size_t)(ct * 16 + fr) * SG + g) * 128 + 4 * fq;
#pragma unroll
    for (int nf = 0; nf < 8; ++nf) *(f32x4*)(so + nf * 16) = acc[nf];
}
__device__ __forceinline__ void ssm_gemm_b(int ct, int g, const bf16* PROJ, const bf16* SIN, const bf16* WBT, bf16* YS, int lane) {
    const int fr = lane & 15, fq = lane >> 4;
    f32x4 acc[16];
#pragma unroll
    for (int i = 0; i < 16; ++i) acc[i] = (f32x4){0.f, 0.f, 0.f, 0.f};
    const bf16* ub = PROJ + ((size_t)(ct * 16 + fr) * 16 + (fq >> 1)) * DIN + 3 * DCV + g * SH + (fq & 1) * 8;
    const bf16* sb = SIN + ((size_t)(ct * 16 + fr) * SG + g) * 128 + fq * 8;
    const bf16* wb = WBT + ((size_t)g * 256 + fr) * 384 + fq * 8;
#pragma unroll 2
    for (int ks = 0; ks < 8; ++ks) {
        const bf16x8 uf = *(const bf16x8*)(ub + (size_t)(2 * ks) * DIN);
#pragma unroll
        for (int nf = 0; nf < 16; ++nf) { const bf16x8 wf = *(const bf16x8*)(wb + (size_t)nf * 16 * 384 + ks * 32); acc[nf] = __builtin_amdgcn_mfma_f32_16x16x32_bf16(wf, uf, acc[nf], 0, 0, 0); }
    }
#pragma unroll 2
    for (int ks = 8; ks < 12; ++ks) {
        const bf16x8 uf = *(const bf16x8*)(sb + (ks - 8) * 32);
#pragma unroll
        for (int nf = 0; nf < 16; ++nf) { const bf16x8 wf = *(const bf16x8*)(wb + (size_t)nf * 16 * 384 + ks * 32); acc[nf] = __builtin_amdgcn_mfma_f32_16x16x32_bf16(wf, uf, acc[nf], 0, 0, 0); }
    }
    bf16* yo = YS + ((size_t)(ct * 16 + fr) * 16) * DSS + g * SH + 4 * fq;
#pragma unroll
    for (int nf = 0; nf < 16; ++nf) { u32x2 w; w.x = pkbf(gelu_tanh(acc[nf][0]), gelu_tanh(acc[nf][1])); w.y = pkbf(gelu_tanh(acc[nf][2]), gelu_tanh(acc[nf][3])); *(u32x2*)(yo + (size_t)nf * DSS) = w; }
}
__device__ __forceinline__ void ssm_carry(int w, int l, const f32x2* apow, const float* SLOC, bf16* SIN, const float* sre, const float* sim, float* out, int lane) {
    if (w >= 128 + NBS * SG) {
        const int u = w - (128 + NBS * SG); const int c = NCH_REAL + u / SG, g = u % SG; if (c >= NCHUNK) return;
        ((unsigned*)(SIN + ((size_t)c * SG + g) * 128))[lane] = 0u; return; }
    int c0, nc, g; float sr = 0.f, si = 0.f; float* ore; float* oim;
    if (w < 128) { const int b = w / SG; g = w % SG; c0 = b * CH_PER_SEQ; nc = CH_PER_SEQ; ore = out + O_REP + ((size_t)(l * NBP + b) * SG + g) * SP; oim = out + O_IMP + ((size_t)(l * NBP + b) * SG + g) * SP; }
    else { const int s = (w - 128) / SG; g = (w - 128) % SG; c0 = NBP * CH_PER_SEQ + s * (TS / 16); nc = TS / 16; const size_t o = ((size_t)(l * NBS + s) * SG + g) * SP + lane; sr = sre[o]; si = sim[o];
        ore = out + O_RES + ((size_t)(l * NBS + s) * SG + g) * SP; oim = out + O_IMS + ((size_t)(l * NBS + s) * SG + g) * SP; }
    const f32x2 a = apow[((size_t)(l * 17 + 16) * SG + g) * SP + lane];
    const float* sl = SLOC + ((size_t)c0 * SG + g) * 128 + lane; bf16* so = SIN + ((size_t)c0 * SG + g) * 128 + lane;
    constexpr size_t CS = (size_t)SG * 128;
    int c = 0;
    for (; c + 8 <= nc; c += 8) {
        float lr[8], li[8];
#pragma unroll
        for (int q = 0; q < 8; ++q) { lr[q] = sl[(size_t)(c + q) * CS]; li[q] = sl[(size_t)(c + q) * CS + 64]; }
#pragma unroll
        for (int q = 0; q < 8; ++q) { so[(size_t)(c + q) * CS] = (unsigned short)(pkbf(sr, 0.f) & 0xffffu); so[(size_t)(c + q) * CS + 64] = (unsigned short)(pkbf(si, 0.f) & 0xffffu);
            const float nr = a.x * sr - a.y * si + lr[q], ni = a.x * si + a.y * sr + li[q]; sr = nr; si = ni; }
    }
    for (; c < nc; ++c) { const float lr = sl[(size_t)c * CS], li = sl[(size_t)c * CS + 64];
        so[(size_t)c * CS] = (unsigned short)(pkbf(sr, 0.f) & 0xffffu); so[(size_t)c * CS + 64] = (unsigned short)(pkbf(si, 0.f) & 0xffffu);
        const float nr = a.x * sr - a.y * si + lr, ni = a.x * si + a.y * sr + li; sr = nr; si = ni; }
    ore[lane] = sr; oim[lane] = si;
}
struct Args { const float* in[N_IN]; float* out; unsigned char* ws; };
static_assert(sizeof(Args) == 8 * (N_IN + 2), "no padding in Args");
typedef const __attribute__((address_space(4))) Args* ArgsP;

#define PHASE_BEGIN() \
    int tid = threadIdx.x; asm volatile("" : "+v"(tid)); \
    ArgsP A = (ArgsP)__builtin_amdgcn_kernarg_segment_ptr(); asm volatile("" : "+s"(A)); \
    const int lane = tid & 63, wave = __builtin_amdgcn_readfirstlane(tid >> 6); \
    const int gw = vcu * NWAVES + wave, NGW = G * NWAVES; \
    unsigned char* ws = A->ws; (void)lane; (void)gw; (void)NGW; (void)ws;

__global__ void __launch_bounds__(NWAVES * 64, 2) hymba_fwd(Args args_unused) {
    extern __shared__ __attribute__((aligned(16))) unsigned char lds_raw[];
    LAS unsigned char* lds = (LAS unsigned char*)lds_raw;
    const int G = gridDim.x; const int bx = blockIdx.x; const int vcu = (G % 8 == 0) ? (bx % 8) * (G / 8) + bx / 8 : bx;
    XcdBarrier bar;
    {
        PHASE_BEGIN();
        for (int u = tid; u < (LDS_BYTES - LDSCTL_OFF) / 4; u += NWAVES * 64) ((LAS unsigned*)(lds + LDSCTL_OFF))[u] = 0u;
        __syncthreads();
        bar = xcd_barrier_post((unsigned*)(ws) + CW_BAR, (volatile LAS unsigned*)(lds + MISC_OFF) + 8);
    }
#define GRID_BAR() xcd_barrier(bar)

    {
        PHASE_BEGIN();
        for (int t = bx * (NWAVES * 64) + tid; t < NL * SG * SP; t += G * NWAVES * 64)
            ssm_tables(t, A->in[I_LRE], A->in[I_LIM], A->in[I_LDT], A->in[I_BRE], A->in[I_BIM], (f32x2*)(ws + WS_APOW), (f32x2*)(ws + WS_BBAR));
    }
    for (int hl = 0; hl < 2 * NL; ++hl) {
        const int l = hl >> 1, second = hl & 1;
        if (!second) {
            PHASE_BEGIN();
            LAS float* scr = (LAS float*)(lds + RING_OFF + wave * 16384);
            constexpr int I_GU = (D / 64) * (FF / 32), I_DN = (FF / 64) * (D / 32), I_IN = (D / 64) * (DIN / 32), I_GL = (DSS / 64) * (DSS / 32), I_OUT = (D / 64) * (D / 32);
            constexpr int NITEMS = 4 * I_GU + 2 * I_DN + I_IN + I_GL + I_OUT;
            for (int it = gw; it < NITEMS; it += NGW) {
                int r = it;
                if (r < 4 * I_GU) { const int q = r / I_GU; r -= q * I_GU;
                    const float* W = A->in[q == 0 ? I_F1G : q == 1 ? I_F1U : q == 2 ? I_F2G : I_F2U] + (size_t)l * D * FF;
                    transpose_item(W, D, FF, (bf16*)(ws + (q < 2 ? WS_WGU0 : WS_WGU1)), 1 + (q & 1), scr, r, lane); continue; }
                r -= 4 * I_GU;
                if (r < 2 * I_DN) { const int q = r / I_DN; r -= q * I_DN;
                    transpose_item(A->in[q ? I_F2D : I_F1D] + (size_t)l * FF * D, FF, D, (bf16*)(ws + (q ? WS_WD1 : WS_WD0)), 0, scr, r, lane); continue; }
                r -= 2 * I_DN;
                if (r < I_IN) { transpose_item(A->in[I_WIN] + (size_t)l * D * DIN, D, DIN, (bf16*)(ws + WS_WIN), 0, scr, r, lane); continue; }
                r -= I_IN;
                if (r < I_GL) { transpose_item(A->in[I_GLU] + (size_t)l * DSS * DSS, DSS, DSS, (bf16*)(ws + WS_WGLU), 0, scr, r, lane); continue; }
                r -= I_GL;
                transpose_item(A->in[I_WOUT] + (size_t)l * D * D, D, D, (bf16*)(ws + WS_WOUT), 0, scr, r, lane);
            }
        }
        {
            PHASE_BEGIN();
            float* X = (float*)(ws + WS_X); bf16* XN = (bf16*)(ws + WS_XN);
            const float* gain = A->in[second ? I_F2N : I_F1N] + (size_t)l * D;
            if (hl == 0) { const float* xp = A->in[I_XP]; const float* xs = A->in[I_XS]; const float* meta = A->in[I_META];
                for (int r = gw; r < MPAD; r += NGW) norm_row(input_row(r, xp, xs, meta), gain, XN + (size_t)r * D, X + (size_t)r * D, lane); }
            else { for (int r = gw; r < MPAD; r += NGW) norm_row(X + (size_t)r * D, gain, XN + (size_t)r * D, nullptr, lane); }
        }
        GRID_BAR();
        {
            PHASE_BEGIN();
            pg8::Gemm g{(const bf16*)(ws + WS_XN), (const bf16*)(ws + (second ? WS_WGU1 : WS_WGU0)), MPAD, 2 * FF, D}; pg8::StaticOrder S; S.init(MPAD, 2 * FF, G, bx);
            pg8::EpiSwiglu E{(bf16*)(ws + WS_H), FF};
            pg8::gemm_phase<pg8::EpiSwiglu, pg8::StaticOrder, true, true>(lds + RING_OFF, g, S, E, tid);
        }
        GRID_BAR();
        {
            PHASE_BEGIN();
            pg8::Gemm g{(const bf16*)(ws + WS_H), (const bf16*)(ws + (second ? WS_WD1 : WS_WD0)), MPAD, D, FF}; pg8::StaticOrder S; S.init(MPAD, D, G, bx);
            pg8::EpiResid E{(float*)(ws + WS_X), D, 0.5f};
            pg8::gemm_phase<pg8::EpiResid, pg8::StaticOrder, true, true>(lds + RING_OFF, g, S, E, tid);
        }
        GRID_BAR();
        if (second) continue;
        {
            PHASE_BEGIN();
            float* X = (float*)(ws + WS_X); bf16* XN = (bf16*)(ws + WS_XN); const float* gain = A->in[I_MIXN] + (size_t)l * D;
            for (int r = gw; r < MPAD; r += NGW) norm_row(X + (size_t)r * D, gain, XN + (size_t)r * D, nullptr, lane);
            ssm_matrices(l, (size_t)bx * (NWAVES * 64) + tid, (size_t)G * NWAVES * 64, (const f32x2*)(ws + WS_APOW), (const f32x2*)(ws + WS_BBAR), A->in[I_CRE], A->in[I_CIM], A->in[I_SD],
                         (bf16*)(ws + WS_WBT), (bf16*)(ws + WS_BMT));
        }
        GRID_BAR();
        {
            PHASE_BEGIN();
            pg8::Gemm g{(const bf16*)(ws + WS_XN), (const bf16*)(ws + WS_WIN), MPAD, DIN, D}; pg8::StaticOrder S; S.init(MPAD, DIN, G, bx);
            pg8::EpiStoreBf16 E{(bf16*)(ws + WS_PROJ), DIN};
            pg8::gemm_phase<pg8::EpiStoreBf16, pg8::StaticOrder, true, true>(lds + RING_OFF, g, S, E, tid);
        }
        GRID_BAR();
        {
            PHASE_BEGIN();
            const bf16* PROJ = (const bf16*)(ws + WS_PROJ);
            { bf16* MIXED = (bf16*)(ws + WS_MIXED); const float* cache = A->in[I_CACHE]; const float* convw = A->in[I_CONVW]; const float* cgain = A->in[I_CONVN]; float* out = A->out;
              for (int r = gw; r < MPAD; r += NGW) conv_row(r, l, PROJ, MIXED, cache, convw, cgain, out, lane); }
            { const bf16* BMT = (const bf16*)(ws + WS_BMT); float* SLOC = (float*)(ws + WS_SLOC);
              for (int it = gw; it < NCT * SG; it += NGW) ssm_gemm_a(it / SG, it % SG, PROJ, BMT, SLOC, lane); }
        }
        GRID_BAR();
        {
            PHASE_BEGIN();
            for (int w = gw; w < 128 + NBS * SG + (NCHUNK - NCH_REAL) * SG; w += NGW)
                ssm_carry(w, l, (const f32x2*)(ws + WS_APOW), (const float*)(ws + WS_SLOC), (bf16*)(ws + WS_SIN), A->in[I_SRE], A->in[I_SIM], A->out, lane);
        }
        GRID_BAR();
        {
            PHASE_BEGIN();
            for (int it = gw; it < NCT * SG; it += NGW) ssm_gemm_b(it / SG, it % SG, (const bf16*)(ws + WS_PROJ), (const bf16*)(ws + WS_SIN), (const bf16*)(ws + WS_WBT), (bf16*)(ws + WS_YS), lane);
        }
        GRID_BAR();
        {
            PHASE_BEGIN();
            pg8::Gemm g{(const bf16*)(ws + WS_YS), (const bf16*)(ws + WS_WGLU), MPAD, DSS, DSS}; pg8::StaticOrder S; S.init(MPAD, DSS, G, bx);
            pg8::EpiGlu E{(const bf16*)(ws + WS_YS), DSS, (bf16*)(ws + WS_MIXED) + DCV, D};
            pg8::gemm_phase<pg8::EpiGlu, pg8::StaticOrder, true, true>(lds + RING_OFF, g, S, E, tid);
        }
        GRID_BAR();
        {
            PHASE_BEGIN();
            bf16* MIXED = (bf16*)(ws + WS_MIXED); const float* gain = A->in[I_SSMN] + (size_t)l * DSS;
            for (int r = gw; r < MPAD; r += NGW) norm_s_row(r, MIXED, gain, lane);
        }
        GRID_BAR();
        {
            PHASE_BEGIN();
            pg8::Gemm g{(const bf16*)(ws + WS_MIXED), (const bf16*)(ws + WS_WOUT), MPAD, D, D}; pg8::StaticOrder S; S.init(MPAD, D, G, bx);
            pg8::EpiResid E{(float*)(ws + WS_X), D, 1.0f};
            pg8::gemm_phase<pg8::EpiResid, pg8::StaticOrder, true, true>(lds + RING_OFF, g, S, E, tid);
        }
        GRID_BAR();
    }
    {
        PHASE_BEGIN();
        const float* X = (const float*)(ws + WS_X); float* out = A->out; const float* gain = A->in[I_FINN];
        for (int r = gw; r < MREAL; r += NGW) {
            float* dst;
            if (r < MPROMPT) { const int b = r / TP, pos = r - b * TP; if (pos < NMETA) continue; dst = out + O_YP + ((size_t)b * SEQ + (pos - NMETA)) * D; }
            else dst = out + O_YS + (size_t)(r - MPROMPT) * D;
            final_row(X + (size_t)r * D, gain, dst, lane);
        }
    }
}
}

extern "C" void kernel_launch(void* const* d_in, const int* in_sizes, int n_in, void* d_out, int out_size, void* d_ws, size_t ws_size, hipStream_t stream) {
    using namespace mk;
    static int grid = 0;
    if (grid == 0) {
        if (n_in != N_IN || (size_t)out_size != O_END || ws_size < WS_END) { fprintf(stderr, "kernel_launch: unexpected shapes (n_in %d, out %d, ws %zu, need %zu)\n", n_in, out_size, ws_size, (size_t)WS_END); grid = -1; return; }
        int dev = 0, cus = 0, per_cu = 0;
        if (hipGetDevice(&dev) != hipSuccess || hipDeviceGetAttribute(&cus, hipDeviceAttributeMultiprocessorCount, dev) != hipSuccess) { grid = -1; return; }
        if (hipFuncSetAttribute((const void*)hymba_fwd, hipFuncAttributeMaxDynamicSharedMemorySize, LDS_BYTES) != hipSuccess) { fprintf(stderr, "kernel_launch: hipFuncSetAttribute failed\n"); grid = -1; return; }
        if (hipOccupancyMaxActiveBlocksPerMultiprocessor(&per_cu, (const void*)hymba_fwd, NWAVES * 64, LDS_BYTES) != hipSuccess || per_cu < 1) { fprintf(stderr, "kernel_launch: occupancy query says %d\n", per_cu); }
        (void)hipGetLastError();
        grid = cus;
    }
    if (grid < 0) return;
    if (hipMemsetAsync(d_ws, 0, CTL_BYTES, stream) != hipSuccess) return;
    Args a{};
    for (int i = 0; i < N_IN; ++i) a.in[i] = (const float*)d_in[i];
    a.out = (float*)d_out; a.ws = (unsigned char*)d_ws;
    hipLaunchKernelGGL(hymba_fwd, dim3(grid), dim3(NWAVES * 64), LDS_BYTES, stream, a);
}
```

```cpp
#include <hip/hip_runtime.h>
#include <cstdio>
#include <cstdint>
namespace pg8 {
#define PG8_LAS __attribute__((address_space(3)))
typedef unsigned short bf16_t;
typedef short bf16x8 __attribute__((ext_vector_type(8)));
typedef float f32x4 __attribute__((ext_vector_type(4)));
typedef unsigned u32x4 __attribute__((ext_vector_type(4)));
typedef int i32x4 __attribute__((ext_vector_type(4)));
typedef int i32x8 __attribute__((ext_vector_type(8)));
typedef unsigned u32x2 __attribute__((ext_vector_type(2)));
constexpr int BM = 256, BK = 64, HALF = 128, HTB = HALF * BK * 2  , STAGE_BYTES = 8 * HTB, NXCD = 8, WGM = 8;

__host__ __device__ __forceinline__ int lds_byte(int r, int c) { const int st = (r >> 4) * 2 + (c >> 5), rr = r & 15, cc = c & 31, ob = rr * 64 + cc * 2; return st * 1024 + (ob ^ (((ob >> 9) & 1) << 5)); }
__host__ __device__ __forceinline__ void stage_rc(int b, int& R, int& C) { const int st = b / 1024, sb = b % 1024, swz = sb ^ (((sb >> 9) & 1) << 5); R = (st >> 1) * 16 + swz / 64; C = (st & 1) * 32 + (swz % 64) / 2; }
__host__ __device__ __forceinline__ int perm32(int rho) { const int n = rho >> 4, i = rho & 15; return 8 * (i >> 2) + 4 * n + (i & 3); }

struct Unit { int pm, pn, mh; };
struct Gemm { const bf16_t* A; const bf16_t* Bt; int M, N, K; int lda, ldb; int gpanels; size_t gstride; };

struct StaticOrder {
    int nM, nN, nwg, G, c, split, pass;
#ifdef PROBE_SPLIT
    int r0, r1;
#endif
#ifdef PROBE_REP
    int rep;
#else
    static constexpr int rep = 1;
#endif
    __host__ __device__ void init(int M, int N, int G_, int c_) { nM = M / BM; nN = N / BM; nwg = nM * nN; G = G_; c = c_; split = 0; pass = 0;
#ifdef PROBE_SPLIT
        r0 = 0; r1 = 1 << 30;
#endif
#ifdef PROBE_REP
        rep = 1;
#endif
    }
    __host__ __device__ bool next(int i, Unit& u) const {
        const int nfull = split ? (nwg / G) * G : nwg;
        long L; u.mh = -1;
        if (pass == 0) { L = (long)(i / rep) * G + c; if (L >= nfull) return false; }
        else { const long hq = (long)i * G + c; if (hq >= 2 * (long)(nwg - nfull)) return false; L = nfull + (hq >> 1); u.mh = (int)(hq & 1); }
        int wgid = (int)L; { const int q = nwg / NXCD, r = nwg % NXCD, xcd = wgid % NXCD, off = wgid / NXCD; wgid = (xcd < r ? xcd * (q + 1) : r * (q + 1) + (xcd - r) * q) + off; }
        const int nig = WGM * nN, gid = wgid / nig, fm = gid * WGM, gsz = (nM - fm) < WGM ? (nM - fm) : WGM;
        u.pm = fm + ((wgid % nig) % gsz); u.pn = (wgid % nig) / gsz; return true;
    }
    __device__ __forceinline__ void a_ready(const Unit&) const {}
    __device__ __forceinline__ void done(const Unit&) const {}
};
__device__ __forceinline__ unsigned cvt_pk_bf16(float lo, float hi) { unsigned r; asm volatile("v_cvt_pk_bf16_f32 %0, %1, %2" : "=v"(r) : "v"(lo), "v"(hi)); return r; }
typedef float f32x2 __attribute__((ext_vector_type(2)));
__device__ __forceinline__ float fast_sigmoid(float z) { return __builtin_amdgcn_rcpf(1.0f + __expf(-z)); }
__device__ __forceinline__ float row_rnorm_lds(const PG8_LAS float* rssl, int lr, float inv_n, float eps) {
    const PG8_LAS f32x4* p = (const PG8_LAS f32x4*)(rssl + lr * 8); const f32x4 a = p[0], b = p[1];
    const float s = ((a[0] + a[1]) + (a[2] + a[3])) + ((b[0] + b[1]) + (b[2] + b[3]));
    return __builtin_amdgcn_rsqf(s * inv_n + eps); }
struct EpiSwiglu {
    static constexpr bool MID = false;
    static constexpr bool PERM = true, AFTER_DRAIN = false;
    static constexpr bool RSS = true;
    unsigned char* H; int ldc; const float* rss; const PG8_LAS float* rssl; float inv_n, eps, oscale, iscale; int f8;
    __device__ __forceinline__ void operator()(const f32x4 (&acc)[2][2][4][2], const Unit& u, int wr, int wc, int fr, int fq) const {
        const int nai = u.mh < 0 ? 2 : 1, row0 = u.pm * BM + (u.mh > 0 ? HALF : 0) + wr * 64 + fr, col0 = u.pn * HALF + wc * 32 + 8 * fq;
#pragma unroll
        for (int ai = 0; ai < 2; ++ai) if (ai < nai)
#pragma unroll
            for (int m = 0; m < 4; ++m) { const int row = row0 + ai * HALF + m * 16; const float r = row_rnorm_lds(rssl, ai * HALF + wr * 64 + m * 16 + fr, inv_n, eps) * iscale;
                float o[8]; const float ru = r * oscale;
#pragma unroll
                for (int n = 0; n < 2; ++n)
#pragma unroll
                    for (int j = 0; j < 4; j += 2) {
                        const f32x2 g = (f32x2){acc[ai][0][m][n][j], acc[ai][0][m][n][j + 1]} * r, up = (f32x2){acc[ai][1][m][n][j], acc[ai][1][m][n][j + 1]} * ru;
                        f32x2 e = g * (-1.4426950408889634f); e.x = __builtin_amdgcn_exp2f(e.x); e.y = __builtin_amdgcn_exp2f(e.y); e = e + 1.0f;
                        f32x2 sg; sg.x = __builtin_amdgcn_rcpf(e.x); sg.y = __builtin_amdgcn_rcpf(e.y);
                        const f32x2 ov = (g * up) * sg; o[4 * n + j] = ov.x; o[4 * n + j + 1] = ov.y; }
                if (f8) {
                    int w0 = __builtin_amdgcn_cvt_pk_fp8_f32(o[0], o[1], 0, false); w0 = __builtin_amdgcn_cvt_pk_fp8_f32(o[2], o[3], w0, true);
                    int w1 = __builtin_amdgcn_cvt_pk_fp8_f32(o[4], o[5], 0, false); w1 = __builtin_amdgcn_cvt_pk_fp8_f32(o[6], o[7], w1, true);
                    u32x2 w; w.x = (unsigned)w0; w.y = (unsigned)w1; *(u32x2*)(H + (size_t)row * ldc + col0) = w;
                } else {
                    u32x4 w; w.x = cvt_pk_bf16(o[0], o[1]); w.y = cvt_pk_bf16(o[2], o[3]); w.z = cvt_pk_bf16(o[4], o[5]); w.w = cvt_pk_bf16(o[6], o[7]);
                    *(u32x4*)((bf16_t*)H + (size_t)row * ldc + col0) = w; } }
    }
};
template <bool MIDS> struct EpiResidNorm {
    static constexpr bool PERM = true, AFTER_DRAIN = false;
    static constexpr bool RSS = MIDS, MID = MIDS;
    bf16_t* XB; int ldc; float scale; float* rss_out; unsigned char* XB8; PG8_LAS float* red; const float* rss; const PG8_LAS float* rssl; float inv_n, eps;
    __device__ __forceinline__ void mid(f32x4 (&acc)[2][2][4][2], const Unit& u, int wr, int fr) const {
        const int nai = u.mh < 0 ? 2 : 1;
#pragma unroll
        for (int ai = 0; ai < 2; ++ai) if (ai < nai)
#pragma unroll
            for (int m = 0; m < 4; ++m) { const PG8_LAS f32x4* p = (const PG8_LAS f32x4*)(rssl + (ai * HALF + wr * 64 + m * 16 + fr) * 8); const f32x4 a = p[0], b = p[1];
                const float c = __builtin_amdgcn_sqrtf((((a[0] + a[1]) + (a[2] + a[3])) + ((b[0] + b[1]) + (b[2] + b[3]))) * inv_n + eps);
#pragma unroll
                for (int bj = 0; bj < 2; ++bj)
#pragma unroll
                    for (int n = 0; n < 2; ++n) acc[ai][bj][m][n] = acc[ai][bj][m][n] * c; }
    }
    __device__ __forceinline__ void operator()(const f32x4 (&acc)[2][2][4][2], const Unit& u, int wr, int wc, int fr, int fq) const {
        const int nai = u.mh < 0 ? 2 : 1, row0 = u.pm * BM + (u.mh > 0 ? HALF : 0) + wr * 64 + fr, col0 = u.pn * BM + wc * 32 + 8 * fq;
#pragma unroll
        for (int ai = 0; ai < 2; ++ai) if (ai < nai) {
            u32x4 xin[4][2];
#pragma unroll
            for (int m = 0; m < 4; ++m)
#pragma unroll
                for (int bj = 0; bj < 2; ++bj) xin[m][bj] = *(const u32x4*)(XB + (size_t)(row0 + ai * HALF + m * 16) * ldc + col0 + bj * HALF);
#pragma unroll
            for (int m = 0; m < 4; ++m) { const int row = row0 + ai * HALF + m * 16; bf16_t* rowb = XB + (size_t)row * ldc + col0; float ss = 0.f;
                const float scale = MIDS ? this->scale * row_rnorm_lds(rssl, ai * HALF + wr * 64 + m * 16 + fr, inv_n, eps) : this->scale;
#pragma unroll
                for (int bj = 0; bj < 2; ++bj) { const u32x4 xo = xin[m][bj]; const f32x4 a0 = acc[ai][bj][m][0], a1 = acc[ai][bj][m][1];
                    f32x4 v0, v1;
                    v0[0] = __uint_as_float(xo.x << 16) + a0[0] * scale; v0[1] = __uint_as_float(xo.x & 0xffff0000u) + a0[1] * scale; v0[2] = __uint_as_float(xo.y << 16) + a0[2] * scale; v0[3] = __uint_as_float(xo.y & 0xffff0000u) + a0[3] * scale;
                    v1[0] = __uint_as_float(xo.z << 16) + a1[0] * scale; v1[1] = __uint_as_float(xo.z & 0xffff0000u) + a1[1] * scale; v1[2] = __uint_as_float(xo.w << 16) + a1[2] * scale; v1[3] = __uint_as_float(xo.w & 0xffff0000u) + a1[3] * scale;
                    ss += (v0[0] * v0[0] + v0[1] * v0[1]) + (v0[2] * v0[2] + v0[3] * v0[3]) + (v1[0] * v1[0] + v1[1] * v1[1]) + (v1[2] * v1[2] + v1[3] * v1[3]);
                    u32x4 w; w.x = cvt_pk_bf16(v0[0], v0[1]); w.y = cvt_pk_bf16(v0[2], v0[3]); w.z = cvt_pk_bf16(v1[0], v1[1]); w.w = cvt_pk_bf16(v1[2], v1[3]);
                    *(u32x4*)(rowb + bj * HALF) = w;
                    if (XB8) { int w0 = __builtin_amdgcn_cvt_pk_fp8_f32(v0[0], v0[1], 0, false); w0 = __builtin_amdgcn_cvt_pk_fp8_f32(v0[2], v0[3], w0, true);
                        int w1 = __builtin_amdgcn_cvt_pk_fp8_f32(v1[0], v1[1], 0, false); w1 = __builtin_amdgcn_cvt_pk_fp8_f32(v1[2], v1[3], w1, true);
                        u32x2 w8; w8.x = (unsigned)w0; w8.y = (unsigned)w1; *(u32x2*)(XB8 + (size_t)row * ldc + col0 + bj * HALF) = w8; } }
                ss += __shfl_xor(ss, 16); ss += __shfl_xor(ss, 32);
                if (fq == 0) red[(ai * HALF + wr * 64 + m * 16 + fr) * 4 + wc] = ss; }
            asm volatile("" ::: "memory"); }
        asm volatile("s_waitcnt lgkmcnt(0)" ::: "memory"); __builtin_amdgcn_s_barrier(); asm volatile("" ::: "memory");
        { const int t = (wr * 4 + wc) * 64 + fq * 16 + fr;
          if (t < nai * HALF) { const f32x4 q = *(const PG8_LAS f32x4*)(red + t * 4); rss_out[((size_t)u.pm * BM + (u.mh > 0 ? HALF : 0) + t) * 8 + u.pn] = (q[0] + q[1]) + (q[2] + q[3]); } }
    }
};
struct EpiStoreBf16 {
    static constexpr bool MID = false;
    static constexpr bool PERM = true, AFTER_DRAIN = false;
    static constexpr bool RSS = true;
    bf16_t* O; int ldc; const float* rss; const PG8_LAS float* rssl; float inv_n, eps; bf16_t* UG; int ucol0, ug_chunks, ug_ld;
    __device__ __forceinline__ void operator()(const f32x4 (&acc)[2][2][4][2], const Unit& u, int wr, int wc, int fr, int fq) const {
        const int nai = u.mh < 0 ? 2 : 1, row0 = u.pm * BM + (u.mh > 0 ? HALF : 0) + wr * 64 + fr, col0 = u.pn * BM + wc * 32 + 8 * fq; const bool isu = (u.pn * BM >= ucol0);
#pragma unroll
        for (int ai = 0; ai < 2; ++ai) if (ai < nai)
#pragma unroll
            for (int m = 0; m < 4; ++m) { const int row = row0 + ai * HALF + m * 16; const float r = row_rnorm_lds(rssl, ai * HALF + wr * 64 + m * 16 + fr, inv_n, eps);
#pragma unroll
                for (int bj = 0; bj < 2; ++bj) { const f32x4 v0 = acc[ai][bj][m][0] * r, v1 = acc[ai][bj][m][1] * r;
                    u32x4 w; w.x = cvt_pk_bf16(v0[0], v0[1]); w.y = cvt_pk_bf16(v0[2], v0[3]); w.z = cvt_pk_bf16(v1[0], v1[1]); w.w = cvt_pk_bf16(v1[2], v1[3]);
                    const int c = col0 + bj * HALF;
                    bf16_t* dst = isu ? UG + ((size_t)((c - ucol0) >> 4) * ug_chunks + (row >> 4)) * ug_ld + (row & 15) * 16 + (c & 15) : O + (size_t)row * ldc + c;
                    *(u32x4*)dst = w; } }
    }
};
struct EpiSloc {
    static constexpr bool MID = false;
    static constexpr bool RSS = false;
    static constexpr bool PERM = false, AFTER_DRAIN = false;
    float* S; int cpg, nchunk, ngrp;
    __device__ __forceinline__ void operator()(const f32x4 (&acc)[2][2][4][2], const Unit& u, int wr, int wc, int fr, int fq) const {
        const int nai = u.mh < 0 ? 2 : 1, R0 = u.pm * BM + (u.mh > 0 ? HALF : 0) + wr * 64 + fr, g = R0 / cpg, c0 = R0 - g * cpg, col0 = wc * 32 + 4 * fq;
#pragma unroll
        for (int ai = 0; ai < 2; ++ai) if (ai < nai)
#pragma unroll
            for (int m = 0; m < 4; ++m) { const int chunk = c0 + ai * HALF + m * 16; if (chunk < nchunk) { float* p = S + ((size_t)chunk * ngrp + g) * 128 + col0;
#pragma unroll
                for (int n = 0; n < 2; ++n) *(f32x4*)(p + n * 16) = acc[ai][0][m][n]; } }
    }
};
struct EpiYs {
    static constexpr bool MID = false;
    static constexpr bool RSS = false;
    static constexpr bool PERM = true, AFTER_DRAIN = false;
    bf16_t* Y; int ldy, cpg, nchunk;
    __device__ __forceinline__ void operator()(const f32x4 (&acc)[2][2][4][2], const Unit& u, int wr, int wc, int fr, int fq) const {
        const int nai = u.mh < 0 ? 2 : 1, R0 = u.pm * BM + (u.mh > 0 ? HALF : 0) + wr * 64 + fr, g = R0 / cpg, c0 = R0 - g * cpg, col0 = wc * 32 + 8 * fq;
#pragma unroll
        for (int ai = 0; ai < 2; ++ai) if (ai < nai)
#pragma unroll
            for (int m = 0; m < 4; ++m) { const int chunk = c0 + ai * HALF + m * 16; if (chunk < nchunk) {
#pragma unroll
                for (int bj = 0; bj < 2; ++bj) { const int c = col0 + bj * HALF; float o[8];
#pragma unroll
                    for (int n = 0; n < 2; ++n)
#pragma unroll
                        for (int j = 0; j < 4; ++j) { const float x = acc[ai][bj][m][n][j]; const float z = 0.7978845608028654f * (x + 0.044715f * x * x * x); o[4 * n + j] = x * fast_sigmoid(2.0f * z); }
                    u32x4 w; w.x = cvt_pk_bf16(o[0], o[1]); w.y = cvt_pk_bf16(o[2], o[3]); w.z = cvt_pk_bf16(o[4], o[5]); w.w = cvt_pk_bf16(o[6], o[7]);
                    *(u32x4*)(Y + ((size_t)chunk * 16 + (c >> 4)) * ldy + g * 16 + (c & 15)) = w; } } }
    }
};
struct EpiGlu {
    static constexpr bool MID = false;
    static constexpr bool RSS = false;
    static constexpr bool PERM = true, AFTER_DRAIN = false;
    const bf16_t* Y; int ldy; bf16_t* O; int ldo; float* rss_out; PG8_LAS float* red;
    __device__ __forceinline__ void operator()(const f32x4 (&acc)[2][2][4][2], const Unit& u, int wr, int wc, int fr, int fq) const {
        const int nai = u.mh < 0 ? 2 : 1, row0 = u.pm * BM + (u.mh > 0 ? HALF : 0) + wr * 64 + fr, col0 = u.pn * BM + wc * 32 + 8 * fq;
#pragma unroll
        for (int ai = 0; ai < 2; ++ai) if (ai < nai) {
            u32x4 yin[4][2];
#pragma unroll
            for (int m = 0; m < 4; ++m)
#pragma unroll
                for (int bj = 0; bj < 2; ++bj) yin[m][bj] = *(const u32x4*)(Y + (size_t)(row0 + ai * HALF + m * 16) * ldy + col0 + bj * HALF);
#pragma unroll
            for (int m = 0; m < 4; ++m) { const size_t r = (size_t)(row0 + ai * HALF + m * 16); float ss = 0.f;
#pragma unroll
                for (int bj = 0; bj < 2; ++bj) { const u32x4 yv = yin[m][bj]; const f32x4 z0 = acc[ai][bj][m][0], z1 = acc[ai][bj][m][1];
                    float o[8];
#pragma unroll
                    for (int q = 0; q < 4; ++q) { const unsigned w = yv[q]; const float ylo = __uint_as_float(w << 16), yhi = __uint_as_float(w & 0xffff0000u);
                        const float za = (q < 2) ? z0[2 * q] : z1[2 * q - 4], zb = (q < 2) ? z0[2 * q + 1] : z1[2 * q - 3];
                        o[2 * q] = ylo * fast_sigmoid(za); o[2 * q + 1] = yhi * fast_sigmoid(zb); ss += o[2 * q] * o[2 * q] + o[2 * q + 1] * o[2 * q + 1]; }
                    u32x4 w; w.x = cvt_pk_bf16(o[0], o[1]); w.y = cvt_pk_bf16(o[2], o[3]); w.z = cvt_pk_bf16(o[4], o[5]); w.w = cvt_pk_bf16(o[6], o[7]);
                    *(u32x4*)(O + r * ldo + col0 + bj * HALF) = w; }
                ss += __shfl_xor(ss, 16); ss += __shfl_xor(ss, 32);
                if (fq == 0) red[(ai * HALF + wr * 64 + m * 16 + fr) * 4 + wc] = ss; }
            asm volatile("" ::: "memory"); }
        asm volatile("s_waitcnt lgkmcnt(0)" ::: "memory"); __builtin_amdgcn_s_barrier(); asm volatile("" ::: "memory");
        { const int t = (wr * 4 + wc) * 64 + fq * 16 + fr;
          if (t < nai * HALF) { const f32x4 q = *(const PG8_LAS f32x4*)(red + t * 4); float* ro = rss_out + ((size_t)u.pm * BM + (u.mh > 0 ? HALF : 0) + t) * 8 + u.pn; ro[0] = (q[0] + q[1]) + (q[2] + q[3]); ro[4] = 0.f; } }
    }
};
struct EpiSwigluQ {
    static constexpr bool MID = false, RSS = false;
    static constexpr bool PERM = true, AFTER_DRAIN = false;
    const float* QF; unsigned char* H; const float* CSG; int ldc; const float* CSU; int f8; float oscale;
    __device__ __forceinline__ void operator()(const f32x4 (&acc)[2][2][4][2], const Unit& u, int wr, int wc, int fr, int fq) const {
        const int nai = u.mh < 0 ? 2 : 1, row0 = u.pm * BM + (u.mh > 0 ? HALF : 0) + wr * 64 + fr, col0 = u.pn * HALF + wc * 32 + 8 * fq;
        f32x4 cg[2], cu[2]; cg[0] = *(const f32x4*)(CSG + col0); cg[1] = *(const f32x4*)(CSG + col0 + 4); cu[0] = *(const f32x4*)(CSU + col0) * oscale; cu[1] = *(const f32x4*)(CSU + col0 + 4) * oscale;
        float qf[2][4];
#pragma unroll
        for (int ai = 0; ai < 2; ++ai)
#pragma unroll
            for (int m = 0; m < 4; ++m) qf[ai][m] = (ai < nai) ? QF[row0 + ai * HALF + m * 16] : 0.f;
#pragma unroll
        for (int ai = 0; ai < 2; ++ai) if (ai < nai)
#pragma unroll
            for (int m = 0; m < 4; ++m) { const int row = row0 + ai * HALF + m * 16;
                float o[8];
#pragma unroll
                for (int n = 0; n < 2; ++n)
#pragma unroll
                    for (int j = 0; j < 4; j += 2) { const f32x4 ag = acc[ai][0][m][n], au = acc[ai][1][m][n];
                        const float g0 = ag[j], g1 = ag[j + 1], u0 = au[j], u1 = au[j + 1];
                        const f32x2 g = ((f32x2){(float)__float_as_int(g0), (float)__float_as_int(g1)} * qf[ai][m]) * (f32x2){cg[n][j], cg[n][j + 1]};
                        const f32x2 up = ((f32x2){(float)__float_as_int(u0), (float)__float_as_int(u1)} * qf[ai][m]) * (f32x2){cu[n][j], cu[n][j + 1]};
                        f32x2 e = g * (-1.4426950408889634f); e.x = __builtin_amdgcn_exp2f(e.x); e.y = __builtin_amdgcn_exp2f(e.y); e = e + 1.0f;
                        f32x2 sgm; sgm.x = __builtin_amdgcn_rcpf(e.x); sgm.y = __builtin_amdgcn_rcpf(e.y);
                        const f32x2 ov = (g * up) * sgm; o[4 * n + j] = ov.x; o[4 * n + j + 1] = ov.y; }
                if (f8) {
                    int w0 = __builtin_amdgcn_cvt_pk_fp8_f32(o[0], o[1], 0, false); w0 = __builtin_amdgcn_cvt_pk_fp8_f32(o[2], o[3], w0, true);
                    int w1 = __builtin_amdgcn_cvt_pk_fp8_f32(o[4], o[5], 0, false); w1 = __builtin_amdgcn_cvt_pk_fp8_f32(o[6], o[7], w1, true);
                    u32x2 w; w.x = (unsigned)w0; w.y = (unsigned)w1; *(u32x2*)(H + (size_t)row * ldc + col0) = w;
                } else {
                    u32x4 w; w.x = cvt_pk_bf16(o[0], o[1]); w.y = cvt_pk_bf16(o[2], o[3]); w.z = cvt_pk_bf16(o[4], o[5]); w.w = cvt_pk_bf16(o[6], o[7]);
                    *(u32x4*)((bf16_t*)H + (size_t)row * ldc + col0) = w; } }
    }
};
template <class Epi, class Sched, bool ALIGN_EPI = false, bool SP2 = false, int FP8 = 0, bool HM = false>
__device__ __forceinline__ void gemm_phase(PG8_LAS unsigned char* lds, const Gemm g, const Sched& S, const Epi& E, const int tid_in) {   constexpr bool hm = HM;
    const int tid = tid_in, wid = __builtin_amdgcn_readfirstlane(tid >> 6), lane = tid & 63, wr = wid >> 2, wc = wid & 3, fr = lane & 15, fq = lane >> 4;
    const int K = g.K, nt = K / BK;
    unsigned voffA[2], voffB[2];
#pragma unroll
    for (int i = 0; i < 2; ++i) { int R, C; stage_rc(tid * 16 + i * 8192, R, C); const int Rb = Epi::PERM ? ((R & ~31) + perm32(R & 31)) : R;
        voffA[i] = (unsigned)(R * g.lda + C) * 2u; voffB[i] = (unsigned)(Rb * g.ldb + C) * 2u; }
    const size_t kstep = (size_t)(BK * 2);
    const size_t hstepA = (size_t)HALF * g.lda * 2, hstepB = (size_t)HALF * g.ldb * 2;
    const size_t tstepA = 2 * hstepA, tstepB = 2 * hstepB;
    const unsigned ldsw = (unsigned)wid * 1024u;
    const int aoff = lds_byte(wr * 64 + fr, fq * 8), boff = lds_byte(wc * 32 + fr, fq * 8);
#define PG8_SA(b, h) (((b) * 2 + (h)) * HTB)
#define PG8_SB(b, h) ((4 + (b) * 2 + (h)) * HTB)
#define PG8_STAGE(bufoff, gbase, voff) do { _Pragma("unroll") for (int _i = 0; _i < 2; ++_i) \
        __builtin_amdgcn_global_load_lds((const unsigned*)((const char*)(gbase) + (voff)[_i]), (PG8_LAS unsigned*)(lds + (bufoff) + ldsw + _i * 8192), 16, 0, 0); } while (0)
#define PG8_LDA(dst, b, h) do { if constexpr (FP8 == 1) { _Pragma("unroll") for (int m = 0; m < 4; ++m) { const i32x4 lo_ = *(const PG8_LAS i32x4*)(lds + PG8_SA(b, h) + aoff + m * 2048), hi_ = *(const PG8_LAS i32x4*)(lds + PG8_SA(b, h) + aoff + m * 2048 + 1024); \
            dst##8[m] = __builtin_shufflevector(lo_, hi_, 0, 1, 2, 3, 4, 5, 6, 7); } } \
        else { _Pragma("unroll") for (int m = 0; m < 4; ++m) _Pragma("unroll") for (int k = 0; k < 2; ++k) dst[m][k] = *(const PG8_LAS bf16x8*)(lds + PG8_SA(b, h) + aoff + m * 2048 + k * 1024); } } while (0)
#define PG8_LDB(dst, b, h) do { if constexpr (FP8 == 1) { _Pragma("unroll") for (int n = 0; n < 2; ++n) { const i32x4 lo_ = *(const PG8_LAS i32x4*)(lds + PG8_SB(b, h) + boff + n * 2048), hi_ = *(const PG8_LAS i32x4*)(lds + PG8_SB(b, h) + boff + n * 2048 + 1024); \
            dst##8[n] = __builtin_shufflevector(lo_, hi_, 0, 1, 2, 3, 4, 5, 6, 7); } } \
        else { _Pragma("unroll") for (int n = 0; n < 2; ++n) _Pragma("unroll") for (int k = 0; k < 2; ++k) dst[n][k] = *(const PG8_LAS bf16x8*)(lds + PG8_SB(b, h) + boff + n * 2048 + k * 1024); } } while (0)
#define PG8_MMA(ai, bj, At, Bt) do { __builtin_amdgcn_s_setprio(1); \
        if constexpr (FP8 == 1) { _Pragma("unroll") for (int m = 0; m < 4; ++m) _Pragma("unroll") for (int n = 0; n < 2; ++n) \
            asm volatile("v_mfma_scale_f32_16x16x128_f8f6f4 %0, %1, %2, %0, %3, %3 op_sel_hi:[0,0,0]" : "+v"(acc[ai][bj][m][n]) : "v"(Bt##8[n]), "v"(At##8[m]), "v"(one_scale)); } \
        else if constexpr (FP8 == 2) { _Pragma("unroll") for (int m = 0; m < 4; ++m) _Pragma("unroll") for (int n = 0; n < 2; ++n) _Pragma("unroll") for (int k = 0; k < 2; ++k) \
            acc[ai][bj][m][n] = __builtin_bit_cast(f32x4, __builtin_amdgcn_mfma_i32_16x16x64_i8(__builtin_bit_cast(i32x4, Bt[n][k]), __builtin_bit_cast(i32x4, At[m][k]), __builtin_bit_cast(i32x4, acc[ai][bj][m][n]), 0, 0, 0)); } \
        else { _Pragma("unroll") for (int m = 0; m < 4; ++m) _Pragma("unroll") for (int n = 0; n < 2; ++n) _Pragma("unroll") for (int k = 0; k < 2; ++k) \
            acc[ai][bj][m][n] = __builtin_amdgcn_mfma_f32_16x16x32_bf16(Bt[n][k], At[m][k], acc[ai][bj][m][n], 0, 0, 0); } \
        __builtin_amdgcn_s_setprio(0); } while (0)
#define PG8_RSS_DMA() do { if constexpr (Epi::RSS) { if (t == 0) __builtin_amdgcn_global_load_lds((const unsigned*)((const char*)E.rss + ((size_t)cur.pm * BM + (cur.mh > 0 ? HALF : 0)) * 32 + (size_t)tid * 16), \
        (PG8_LAS unsigned*)((PG8_LAS unsigned char*)E.rssl + ldsw), 16, 0, 0); } } while (0)
#define PG8_WAIT_V(n) asm volatile("s_waitcnt vmcnt(" #n ")" ::: "memory")
#define PG8_WAIT_L(n) asm volatile("s_waitcnt lgkmcnt(" #n ")" ::: "memory")
#define PG8_BAR __builtin_amdgcn_s_barrier()
#define PG8_SCHED __builtin_amdgcn_sched_barrier(0)
    Unit cur, nxt; int ui = 0;
    if (!S.next(0, cur)) return;
    f32x4 acc[2][2][4][2];
#pragma unroll
    for (int a = 0; a < 2; ++a)
#pragma unroll
        for (int b = 0; b < 2; ++b)
#pragma unroll
            for (int m = 0; m < 4; ++m)
#pragma unroll
                for (int n = 0; n < 2; ++n) acc[a][b][m][n] = (f32x4){0.f, 0.f, 0.f, 0.f};
    int one_scale = 0x7f7f7f7f; asm volatile("" : "+v"(one_scale));
    bf16x8 At[4][2], B0[2][2], B1[2][2]; i32x8 At8[4], B08[2], B18[2];
    const char* cA = (const char*)g.A + (size_t)cur.pm * tstepA + (cur.mh > 0 ? hstepA : (size_t)0); const char* cB = (const char*)g.Bt + (size_t)cur.pn * tstepB + (g.gpanels ? (size_t)(cur.pm / g.gpanels) * g.gstride : (size_t)0);
    S.a_ready(cur);
    if constexpr (SP2) {
        if constexpr (HM) {
        PG8_STAGE(PG8_SB(0, 0), cB, voffB); PG8_STAGE(PG8_SB(0, 1), cB + hstepB, voffB); PG8_STAGE(PG8_SA(0, 0), cA, voffA);
        if (wr == 1) PG8_BAR;
        PG8_WAIT_V(0); PG8_BAR;
        PG8_STAGE(PG8_SB(1, 0), cB + kstep, voffB); PG8_STAGE(PG8_SA(1, 0), cA + kstep, voffA); PG8_STAGE(PG8_SB(1, 1), cB + hstepB + kstep, voffB);
        PG8_BAR;
        } else {
        PG8_STAGE(PG8_SB(0, 0), cB, voffB); PG8_STAGE(PG8_SB(0, 1), cB + hstepB, voffB); PG8_STAGE(PG8_SA(0, 0), cA, voffA); PG8_STAGE(PG8_SA(0, 1), cA + hstepA, voffA);
        if (wr == 1) PG8_BAR;
        PG8_WAIT_V(2); PG8_BAR;
        PG8_STAGE(PG8_SB(1, 0), cB + kstep, voffB); PG8_STAGE(PG8_SA(1, 0), cA + kstep, voffA); PG8_STAGE(PG8_SB(1, 1), cB + hstepB + kstep, voffB);
        PG8_WAIT_V(6); PG8_BAR;
        }
    } else {
        PG8_STAGE(PG8_SB(0, 0), cB, voffB); PG8_STAGE(PG8_SA(0, 0), cA, voffA); PG8_STAGE(PG8_SB(0, 1), cB + hstepB, voffB); PG8_STAGE(PG8_SA(0, 1), cA + hstepA, voffA);
        if (wr == 1) PG8_BAR;
        PG8_WAIT_V(4); PG8_BAR;
        PG8_STAGE(PG8_SB(1, 0), cB + kstep, voffB); PG8_STAGE(PG8_SA(1, 0), cA + kstep, voffA); PG8_STAGE(PG8_SB(1, 1), cB + hstepB + kstep, voffB);
        PG8_WAIT_V(6); PG8_BAR;
    }
    for (;;) {
        const bool has_next = S.next(ui + 1, nxt);
        const char* nA = has_next ? (const char*)g.A + (size_t)nxt.pm * tstepA + (nxt.mh > 0 ? hstepA : (size_t)0) : cA; const char* nB = has_next ? (const char*)g.Bt + (size_t)nxt.pn * tstepB + (g.gpanels ? (size_t)(nxt.pm / g.gpanels) * g.gstride : (size_t)0) : cB;
#pragma nounroll
        for (int t = 0; t < nt; t += 2) {
            const bool last = (t == nt - 2);
            const char* a1 = cA + (size_t)(t + 1) * kstep;
            const char* a2 = last ? nA : cA + (size_t)(t + 2) * kstep; const char* b2 = last ? nB : cB + (size_t)(t + 2) * kstep;
            const char* a3 = a2 + kstep; const char* b3 = b2 + kstep;
            if (last && has_next) S.a_ready(nxt);
            if constexpr (Epi::MID) { if (t == (nt >> 1)) E.mid(acc, cur, wr, fr); }
            if constexpr (SP2) {
            if constexpr (HM) {
            PG8_LDB(B0, 0, 0); PG8_LDB(B1, 0, 1); PG8_SCHED; PG8_LDA(At, 0, 0);
            PG8_WAIT_L(0); PG8_BAR; PG8_RSS_DMA(); PG8_MMA(0, 0, At, B0); PG8_MMA(0, 1, At, B1); PG8_BAR; PG8_SCHED;
            PG8_STAGE(PG8_SB(0, 0), b2, voffB); PG8_STAGE(PG8_SB(0, 1), b2 + hstepB, voffB); PG8_STAGE(PG8_SA(0, 0), a2, voffA);
            PG8_WAIT_V(6); PG8_BAR; PG8_BAR; PG8_SCHED;
            PG8_LDB(B0, 1, 0); PG8_LDB(B1, 1, 1); PG8_SCHED; PG8_LDA(At, 1, 0);
            PG8_WAIT_L(0); PG8_BAR; PG8_MMA(0, 0, At, B0); PG8_MMA(0, 1, At, B1); PG8_BAR; PG8_SCHED;
            PG8_STAGE(PG8_SB(1, 0), b3, voffB); PG8_STAGE(PG8_SB(1, 1), b3 + hstepB, voffB); PG8_STAGE(PG8_SA(1, 0), a3, voffA);
            PG8_WAIT_V(6); PG8_BAR; PG8_BAR; PG8_SCHED;
            } else {
            PG8_LDB(B0, 0, 0); PG8_LDB(B1, 0, 1); PG8_SCHED; PG8_LDA(At, 0, 0); PG8_STAGE(PG8_SA(1, 1), a1 + hstepA, voffA);
            PG8_WAIT_V(8); PG8_WAIT_L(0); PG8_BAR; PG8_RSS_DMA(); PG8_MMA(0, 0, At, B0); PG8_MMA(0, 1, At, B1); PG8_BAR; PG8_SCHED;
            PG8_LDA(At, 0, 1); PG8_STAGE(PG8_SB(0, 0), b2, voffB); PG8_STAGE(PG8_SB(0, 1), b2 + hstepB, voffB); PG8_STAGE(PG8_SA(0, 0), a2, voffA);
            PG8_WAIT_V(8); PG8_WAIT_L(0); PG8_BAR; PG8_MMA(1, 0, At, B0); PG8_MMA(1, 1, At, B1); PG8_BAR; PG8_SCHED;
            PG8_LDB(B0, 1, 0); PG8_LDB(B1, 1, 1); PG8_SCHED; PG8_LDA(At, 1, 0); PG8_STAGE(PG8_SA(0, 1), a2 + hstepA, voffA);
            PG8_WAIT_V(8); PG8_WAIT_L(0); PG8_BAR; PG8_MMA(0, 0, At, B0); PG8_MMA(0, 1, At, B1); PG8_BAR; PG8_SCHED;
            PG8_LDA(At, 1, 1); PG8_STAGE(PG8_SB(1, 0), b3, voffB); PG8_STAGE(PG8_SB(1, 1), b3 + hstepB, voffB); PG8_STAGE(PG8_SA(1, 0), a3, voffA);
            PG8_WAIT_V(8); PG8_WAIT_L(0); PG8_BAR; PG8_MMA(1, 0, At, B0); PG8_MMA(1, 1, At, B1); PG8_BAR; PG8_SCHED;
            }
            } else {
            PG8_LDB(B0, 0, 0); PG8_SCHED; PG8_LDA(At, 0, 0); PG8_STAGE(PG8_SA(1, 1), a1 + hstepA, voffA);
            PG8_WAIT_L(8); PG8_BAR; PG8_WAIT_L(0); PG8_MMA(0, 0, At, B0); PG8_BAR; PG8_SCHED;
            PG8_LDB(B1, 0, 1); PG8_STAGE(PG8_SB(0, 0), b2, voffB);
            PG8_BAR; PG8_WAIT_L(0); PG8_MMA(0, 1, At, B1); PG8_BAR;
            PG8_LDA(At, 0, 1); PG8_STAGE(PG8_SA(0, 0), a2, voffA);
            PG8_BAR; PG8_WAIT_L(0); PG8_MMA(1, 0, At, B0); PG8_BAR; PG8_SCHED;
            PG8_STAGE(PG8_SB(0, 1), b2 + hstepB, voffB);
            PG8_WAIT_V(6); PG8_BAR; PG8_MMA(1, 1, At, B1); PG8_BAR;
            PG8_LDB(B0, 1, 0); PG8_SCHED; PG8_LDA(At, 1, 0); PG8_STAGE(PG8_SA(0, 1), a2 + hstepA, voffA);
            PG8_WAIT_L(8); PG8_BAR; PG8_WAIT_L(0); PG8_MMA(0, 0, At, B0); PG8_BAR; PG8_SCHED;
            PG8_LDB(B1, 1, 1); PG8_STAGE(PG8_SB(1, 0), b3, voffB);
            PG8_BAR; PG8_WAIT_L(0); PG8_MMA(0, 1, At, B1); PG8_BAR;
            PG8_LDA(At, 1, 1); PG8_STAGE(PG8_SA(1, 0), a3, voffA);
            PG8_BAR; PG8_WAIT_L(0); PG8_MMA(1, 0, At, B0); PG8_BAR; PG8_SCHED;
            PG8_STAGE(PG8_SB(1, 1), b3 + hstepB, voffB);
            PG8_WAIT_V(6); PG8_BAR; PG8_MMA(1, 1, At, B1); PG8_BAR;
            }
        }
        if constexpr (ALIGN_EPI) { if (wr == 0) PG8_BAR; }
        if constexpr (!Epi::AFTER_DRAIN) {
            if constexpr (FP8 == 1) asm volatile("s_nop 15\n\ts_nop 15" ::: "memory");
            int tz = tid; asm volatile("" : "+v"(tz)); const int lz = tz & 63, wz = __builtin_amdgcn_readfirstlane(tz >> 6);
            E(acc, cur, wz >> 2, wz & 3, lz & 15, lz >> 4); S.done(cur); }
        if (!has_next) break;
#pragma unroll
        for (int a = 0; a < 2; ++a)
#pragma unroll
            for (int b = 0; b < 2; ++b)
#pragma unroll
                for (int m = 0; m < 4; ++m)
#pragma unroll
                    for (int n = 0; n < 2; ++n) acc[a][b][m][n] = (f32x4){0.f, 0.f, 0.f, 0.f};
        cur = nxt; cA = nA; cB = nB; ++ui;
        if constexpr (ALIGN_EPI) { if (wr == 1) PG8_BAR; }
    }
    PG8_WAIT_V(0);
    if constexpr (!ALIGN_EPI) { if (wr == 0) PG8_BAR; }
    PG8_BAR;
    if constexpr (Epi::AFTER_DRAIN) { E.fused(acc, cur, wr, wc, fr, fq, lds, wid, lane); S.done(cur); }
#undef PG8_SA
#undef PG8_SB
#undef PG8_STAGE
#undef PG8_LDA
#undef PG8_LDB
#undef PG8_MMA
#undef PG8_WAIT_V
#undef PG8_RSS_DMA
#undef PG8_WAIT_L
#undef PG8_BAR
#undef PG8_SCHED
}
}
#define GAS __attribute__((address_space(1)))
#define LAS __attribute__((address_space(3)))
typedef unsigned short bf16;
typedef unsigned v4u __attribute__((ext_vector_type(4)));
typedef float f32x4 __attribute__((ext_vector_type(4)));
typedef short bf16x8 __attribute__((ext_vector_type(8)));
typedef GAS unsigned gu32;
typedef GAS unsigned long long gu64;
#define RLX_AGENT __ATOMIC_RELAXED, __HIP_MEMORY_SCOPE_AGENT
#define LDS_WAIT() asm volatile("s_waitcnt lgkmcnt(0)" ::: "memory")
#define VM_WAIT() asm volatile("s_waitcnt vmcnt(0)" ::: "memory")
__device__ __forceinline__ unsigned long long rt() { return __builtin_amdgcn_s_memrealtime(); }
__device__ __forceinline__ unsigned f2bf(float f) { unsigned u = __builtin_bit_cast(unsigned, f); return (u + 0x7fffu + ((u >> 16) & 1u)) >> 16; }
__device__ __forceinline__ unsigned pk2(float lo, float hi) { return f2bf(lo) | (f2bf(hi) << 16); }

#define XB_TMO      128
#define XB_XCNT(j)  (256  + 64 * (j))
#define XB_XSUB(j)  (1280 + 64 * (j))
#define XB_XGEN(j)  (2304 + 64 * (j))
#define XB_TOP      3328
#define XB_TOPGEN   3392
#define XCD_BAR_WORDS 3456
#define XB_SPIN_CAP (1u << 18)

__device__ __forceinline__ unsigned xb_ld(unsigned* p)              { return __hip_atomic_load(p, __ATOMIC_RELAXED, __HIP_MEMORY_SCOPE_AGENT); }
__device__ __forceinline__ unsigned xb_add(unsigned* p, unsigned v) { return __hip_atomic_fetch_add(p, v, __ATOMIC_RELAXED, __HIP_MEMORY_SCOPE_AGENT); }
__device__ __forceinline__ unsigned xb_xcc_id() { return (unsigned)__builtin_amdgcn_s_getreg((3 << 11) | 20) & 0xFu; }
#define XB_SPIN(cond, bar) do { unsigned _sp = 0; while (cond) { __builtin_amdgcn_s_sleep(1); \
    if ((++_sp & 255u) == 0u) { if (xb_ld(&(bar)[XB_TMO])) break; if (_sp > XB_SPIN_CAP) { atomicAdd(&(bar)[XB_TMO], 1u); break; } } } } while (0)

struct XcdBarrier {
    unsigned* bar; unsigned x;
    volatile LAS unsigned* st;
};

__device__ __forceinline__ XcdBarrier xcd_barrier_post(unsigned* bar, volatile LAS unsigned* st) {
    XcdBarrier b; b.bar = bar; b.x = xb_xcc_id(); b.st = st;
    if (threadIdx.x == 0) (void)xb_add(&bar[XB_XCNT(b.x)], 1u);
    return b;
}
__device__ __forceinline__ void xcd_barrier_complete(unsigned* bar, unsigned x, unsigned& nloc, unsigned& nx) {
    const unsigned G = gridDim.x * gridDim.y * gridDim.z;
    unsigned sum, cnt, mine, sp = 0u;
    for (;;) {
        sum = 0u; cnt = 0u; mine = 0u;
#pragma unroll
        for (unsigned j = 0; j < 16; ++j) { const unsigned c = xb_ld(&bar[XB_XCNT(j)]); sum += c; cnt += (c > 0u) ? 1u : 0u; mine = (j == x) ? c : mine; }
        if (sum == G) break;
        __builtin_amdgcn_s_sleep(1);
        if ((++sp & 255u) == 0u) { if (xb_ld(&bar[XB_TMO])) break; if (sp > XB_SPIN_CAP) { atomicAdd(&bar[XB_TMO], 1u); break; } }
    }
    nloc = mine > 0u ? mine : 1u; nx = cnt > 0u ? cnt : 1u;
}

__device__ __forceinline__ void xcd_barrier(const XcdBarrier& b) {
    asm volatile("s_waitcnt vmcnt(0)" ::: "memory");
    __syncthreads();
    if (threadIdx.x == 0) {
        unsigned* bar = b.bar;
        __builtin_amdgcn_s_waitcnt(0);
        unsigned nloc = b.st[0], nx = b.st[1];
        if (nloc == 0u) { xcd_barrier_complete(bar, b.x, nloc, nx); b.st[0] = nloc; b.st[1] = nx; }
        const unsigned old = xb_add(&bar[XB_XSUB(b.x)], 1u);
        const unsigned gen = old / nloc;
        if (old + 1u == (gen + 1u) * nloc) {
            __builtin_amdgcn_fence(__ATOMIC_RELEASE, "agent");
            asm volatile("s_waitcnt vmcnt(0)" ::: "memory");
            const unsigned og = xb_add(&bar[XB_TOP], 1u);
            const unsigned tg = og / nx;
            if (og + 1u == (tg + 1u) * nx) xb_add(&bar[XB_TOPGEN], 1u);
            else XB_SPIN(xb_ld(&bar[XB_TOPGEN]) == tg, bar);
            __builtin_amdgcn_fence(__ATOMIC_ACQUIRE, "agent");
            xb_add(&bar[XB_XGEN(b.x)], 1u);
            asm volatile("s_waitcnt vmcnt(0)" ::: "memory");
        } else {
            XB_SPIN(xb_ld(&bar[XB_XGEN(b.x)]) == gen, bar);
            __builtin_amdgcn_fence(__ATOMIC_ACQUIRE, "agent");
            asm volatile("s_waitcnt vmcnt(0)" ::: "memory");
        }
    }
    __syncthreads();
}
namespace mk {
typedef float f32x2 __attribute__((ext_vector_type(2)));
typedef unsigned u32x2 __attribute__((ext_vector_type(2)));
constexpr int NWAVES = 8;
constexpr int D = 2048, FF = 5632, DCV = 1024, DSS = 1024, DIN = 4096, NL = 4;
constexpr int SEQ = 16384, NMETA = 16, TP = SEQ + NMETA, NBP = 2, NBS = 8, TS = 32;
constexpr int MPROMPT = NBP * TP;
constexpr int MREAL = MPROMPT + NBS * TS;
constexpr int MPAD = 33280;
constexpr int NCHUNK = MPAD / 16;
constexpr int NCH_REAL = MREAL / 16;
constexpr int CH_PER_SEQ = TP / 16;
constexpr int NCT = NCHUNK / 16;
constexpr int SG = 64, SP = 64, SH = 16;
constexpr float EPS = 1e-6f;
constexpr int FP8_FROM_HL = 3;
constexpr int FP8_UP_FROM = 2 * NL;
constexpr int UPQ_FROM = 2;
constexpr float QALPHA_UNUSED = 5.5f;
constexpr float H8_SCALE = 4.0f, WD8_SCALE = 256.0f, WGU8_SCALE = 256.0f;
static_assert(MPAD % 256 == 0 && MPAD >= MREAL && MREAL % 16 == 0 && TP % 16 == 0 && TS % 4 == 0 && TP >= 8 && TS >= 8, "row geometry");

enum { I_XP = 0, I_XS, I_CACHE, I_SRE, I_SIM, I_META, I_F1N, I_F1G, I_F1U, I_F1D, I_MIXN, I_WIN, I_CONVW, I_CONVN, I_LRE, I_LIM, I_LDT, I_BRE, I_BIM, I_CRE, I_CIM, I_SD,
       I_GLU, I_SSMN, I_WOUT, I_F2N, I_F2G, I_F2U, I_F2D, I_FINN, N_IN };
constexpr size_t O_YP = 0, O_YS = O_YP + (size_t)NBP * SEQ * D, O_CVP = O_YS + (size_t)NBS * TS * D, O_REP = O_CVP + (size_t)NL * NBP * 2 * DCV,
                 O_IMP = O_REP + (size_t)NL * NBP * SG * SP, O_CVS = O_IMP + (size_t)NL * NBP * SG * SP, O_RES = O_CVS + (size_t)NL * NBS * 2 * DCV,
                 O_IMS = O_RES + (size_t)NL * NBS * SG * SP, O_END = O_IMS + (size_t)NL * NBS * SG * SP;
static_assert(O_END == 68042752, "output size");

constexpr size_t CTL_BYTES = 1u << 20;
constexpr int NRSS = 4 * NL + 1;
constexpr size_t ZERO_BYTES = CTL_BYTES;
constexpr size_t RSS_STRIDE = (size_t)MPAD * 8 + 2048;
constexpr size_t WS_RSS = CTL_BYTES;
constexpr size_t WS_XN = WS_RSS + (size_t)NRSS * RSS_STRIDE * 4;
constexpr size_t WS_W = WS_XN + (size_t)MPAD * D * 2;
constexpr size_t W_GU0 = 0;
constexpr size_t W_GU1 = W_GU0 + (size_t)2 * FF * D * 2;
constexpr size_t W_D0 = W_GU1 + (size_t)2 * FF * D * 2;
constexpr size_t W_D1 = W_D0 + (size_t)D * FF * 2;
constexpr size_t W_IN = W_D1 + (size_t)D * FF * 2;
constexpr size_t W_GLU = W_IN + (size_t)DIN * D * 2;
constexpr size_t W_OUT = W_GLU + (size_t)DSS * DSS * 2;
constexpr size_t W_SET = W_OUT + (size_t)D * D * 2;
constexpr size_t WS_WBT = WS_W + 2 * W_SET;
constexpr size_t WS_BMT = WS_WBT + (size_t)SG * 256 * 384 * 2;
constexpr size_t WS_APOW = WS_BMT + (size_t)SG * 256 * 256 * 2;
constexpr int NPOW = 18;
constexpr size_t WS_BBAR = WS_APOW + (size_t)NL * NPOW * SG * SP * 8;
constexpr size_t WS_R = WS_BBAR + (size_t)NL * SG * SP * SH * 8;
constexpr size_t WS_H = WS_R;
constexpr size_t WS_PROJ = WS_R;
constexpr size_t WS_MIXED = WS_PROJ + (size_t)MPAD * DIN * 2;
constexpr size_t WS_YS = WS_MIXED + (size_t)MPAD * D * 2;
constexpr size_t WS_SLOC = WS_YS + (size_t)MPAD * DSS * 2;
constexpr int CPG = 2304, UGLD = 384;
constexpr size_t WS_UG = WS_SLOC + (size_t)NCHUNK * SG * 128 * 4;
constexpr size_t WS_XB8 = WS_UG + (size_t)SG * CPG * UGLD * 2;
constexpr size_t WS_DUMMY_ = 0;
constexpr size_t WS_END_A = WS_H + (size_t)MPAD * FF * 2, WS_PMAXC = WS_XB8 + (size_t)MPAD * D;
constexpr size_t WS_CS = WS_PMAXC + (size_t)4 * 32 * FF * 4;
constexpr size_t WS_QF = WS_CS + (size_t)2 * 4 * FF * 4;
constexpr size_t WS_END_B = WS_QF + (size_t)MPAD * 4 + 256;
constexpr size_t WS_END = WS_END_A > WS_END_B ? WS_END_A : WS_END_B;
static_assert(WS_R % 256 == 0 && WS_SLOC % 256 == 0, "alignment");
constexpr int CW_BAR = 4096;

constexpr int RING_OFF = 0, RING_BYTES = 131072;
constexpr int LDSCTL_OFF = RING_BYTES, MISC_OFF = LDSCTL_OFF + 320;
constexpr int RED_OFF = RING_BYTES + 512, RSSB_OFF = RED_OFF + 4096;
constexpr int LDS_BYTES = 147456;
static_assert(RSSB_OFF + 8192 <= LDS_BYTES && RSSB_OFF % 16 == 0, "LDS map");

__device__ __forceinline__ float wave_sum(float v) {
#pragma unroll
    for (int o = 1; o < 64; o <<= 1) v += __shfl_xor(v, o);
    return v;
}
__device__ __forceinline__ unsigned pkbf(float lo, float hi) { return pg8::cvt_pk_bf16(lo, hi); }
__device__ __forceinline__ float bflo(unsigned w) { return __uint_as_float(w << 16); }
__device__ __forceinline__ float bfhi(unsigned w) { return __uint_as_float(w & 0xffff0000u); }

__device__ __forceinline__ void transpose_item(const float* W, int K, int N, bf16* WT, int mode, const float* gain, LAS float* scr, int item, int lane, float f8scale = 0.f, int gk0 = 0, const float* cs8 = nullptr) {
    const int nblk = N / 32, kb = item / nblk, nb = item % nblk, k0 = 64 * kb, n0 = 32 * nb;
    const int drow0 = (mode == 0) ? n0 : (256 * (n0 >> 7) + 128 * (mode - 1) + (n0 & 127));
    const int nq = lane & 7, kr = lane >> 3;
    f32x4 v[8];
#pragma unroll
    for (int i = 0; i < 8; ++i) v[i] = *(const f32x4*)(W + (size_t)(k0 + kr + 8 * i) * N + n0 + 4 * nq);
#pragma unroll
    for (int i = 0; i < 8; ++i) { const int kk_ = k0 + kr + 8 * i; const float gk = (gain && kk_ >= gk0) ? gain[kk_ - gk0] : 1.0f; LAS float* d = scr + (kr + 8 * i) * 33 + 4 * nq; d[0] = v[i].x * gk; d[1] = v[i].y * gk; d[2] = v[i].z * gk; d[3] = v[i].w * gk; }
    LDS_WAIT(); asm volatile("" ::: "memory");
    const int c = lane & 7;
#pragma unroll
    for (int j = 0; j < 4; ++j) { const int n = (lane >> 3) + 8 * j; const LAS float* s = scr + (8 * c) * 33 + n;
        if (cs8) {
            const float qs = 1.0f / cs8[n0 + n]; unsigned b[8];
#pragma unroll
            for (int e = 0; e < 8; ++e) { float t = s[e * 33] * qs; t = fminf(fmaxf(t, -127.f), 127.f); b[e] = (unsigned)__float2int_rn(t) & 0xffu; }
            u32x2 o; o.x = b[0] | (b[1] << 8) | (b[2] << 16) | (b[3] << 24); o.y = b[4] | (b[5] << 8) | (b[6] << 16) | (b[7] << 24);
            *(u32x2*)((unsigned char*)WT + (size_t)(drow0 + n) * K + k0 + 8 * c) = o;
        } else if (f8scale != 0.f) {
            int w0 = __builtin_amdgcn_cvt_pk_fp8_f32(s[0 * 33] * f8scale, s[1 * 33] * f8scale, 0, false); w0 = __builtin_amdgcn_cvt_pk_fp8_f32(s[2 * 33] * f8scale, s[3 * 33] * f8scale, w0, true);
            int w1 = __builtin_amdgcn_cvt_pk_fp8_f32(s[4 * 33] * f8scale, s[5 * 33] * f8scale, 0, false); w1 = __builtin_amdgcn_cvt_pk_fp8_f32(s[6 * 33] * f8scale, s[7 * 33] * f8scale, w1, true);
            u32x2 o; o.x = (unsigned)w0; o.y = (unsigned)w1; *(u32x2*)((unsigned char*)WT + (size_t)(drow0 + n) * K + k0 + 8 * c) = o;
        } else {
        v4u o; o.x = pkbf(s[0 * 33], s[1 * 33]); o.y = pkbf(s[2 * 33], s[3 * 33]); o.z = pkbf(s[4 * 33], s[5 * 33]); o.w = pkbf(s[6 * 33], s[7 * 33]);
        *(v4u*)(WT + (size_t)(drow0 + n) * K + k0 + 8 * c) = o; } }
    LDS_WAIT(); asm volatile("" ::: "memory");
}

__device__ __forceinline__ void pmaxc_item(const float* W, int N, const float* gain, float* pmc, int item, int lane) {
    const int nblk = N / 32, kb = item / nblk, nb = item % nblk, k0 = 64 * kb, n0 = 32 * nb; const int nq = lane & 7, kr = lane >> 3;
    f32x4 v[8];
#pragma unroll
    for (int i = 0; i < 8; ++i) v[i] = *(const f32x4*)(W + (size_t)(k0 + kr + 8 * i) * N + n0 + 4 * nq);
    f32x4 m = {0.f, 0.f, 0.f, 0.f};
#pragma unroll
    for (int i = 0; i < 8; ++i) { const float gk = fabsf(gain[k0 + kr + 8 * i]); m.x = fmaxf(m.x, fabsf(v[i].x) * gk); m.y = fmaxf(m.y, fabsf(v[i].y) * gk); m.z = fmaxf(m.z, fabsf(v[i].z) * gk); m.w = fmaxf(m.w, fabsf(v[i].w) * gk); }
#pragma unroll
    for (int o = 8; o < 64; o <<= 1) { m.x = fmaxf(m.x, __shfl_xor(m.x, o)); m.y = fmaxf(m.y, __shfl_xor(m.y, o)); m.z = fmaxf(m.z, __shfl_xor(m.z, o)); m.w = fmaxf(m.w, __shfl_xor(m.w, o)); }
    if (lane < 8) *(f32x4*)(pmc + (size_t)kb * N + n0 + 4 * nq) = m;
}
__device__ __forceinline__ void colstep_reduce(const float* pmc, float* cs, int c) {
    const int q = c / FF, n = c - q * FF; const float* p = pmc + (size_t)q * 32 * FF + n; float m = 1e-30f;
#pragma unroll 8
    for (int kb = 0; kb < 32; ++kb) m = fmaxf(m, p[(size_t)kb * FF]);
    cs[c] = m * (1.0f / 127.0f);
}
static_assert((D / 64) * (FF / 32) == 5632, "gate/up item count");
__device__ __forceinline__ void quant_rows2(const bf16* x0, const bf16* x1, const float* rss0, const float* rss1, unsigned char* q0, unsigned char* q1, float* qf0, float* qf1, bool has1, int lane) {
    v4u a[2][4];
#pragma unroll
    for (int c = 0; c < 2; ++c) { const v4u* p0 = (const v4u*)(x0 + c * 1024 + 16 * lane); a[0][2 * c] = p0[0]; a[0][2 * c + 1] = p0[1]; const v4u* p1 = (const v4u*)(x1 + c * 1024 + 16 * lane); a[1][2 * c] = p1[0]; a[1][2 * c + 1] = p1[1]; }
    const float s0 = wave_sum(lane < 8 ? rss0[lane] : 0.f), s1 = wave_sum(lane < 8 ? rss1[lane] : 0.f);
    unsigned mx[2] = {0u, 0u};
#pragma unroll
    for (int w = 0; w < 2; ++w)
#pragma unroll
        for (int i = 0; i < 4; ++i)
#pragma unroll
            for (int d = 0; d < 4; ++d) { const unsigned u = a[w][i][d]; mx[w] = max(mx[w], max(u & 0x7fffu, (u >> 16) & 0x7fffu)); }
#pragma unroll
    for (int o = 1; o < 64; o <<= 1) { mx[0] = max(mx[0], (unsigned)__shfl_xor((int)mx[0], o)); mx[1] = max(mx[1], (unsigned)__shfl_xor((int)mx[1], o)); }
    const float am[2] = {fmaxf(__uint_as_float(mx[0] << 16), 1e-30f), fmaxf(__uint_as_float(mx[1] << 16), 1e-30f)};
    const float r[2] = {127.0f / am[0], 127.0f / am[1]};
    if (lane == 0) { qf0[0] = am[0] * (1.0f / 127.0f) * __builtin_amdgcn_rsqf(s0 * (1.0f / D) + EPS); if (has1) qf1[0] = am[1] * (1.0f / 127.0f) * __builtin_amdgcn_rsqf(s1 * (1.0f / D) + EPS); }
#pragma unroll
    for (int w = 0; w < 2; ++w) { if (w == 1 && !has1) break; unsigned char* q = w ? q1 : q0;
#pragma unroll
        for (int c = 0; c < 2; ++c) { v4u o;
#pragma unroll
            for (int d = 0; d < 4; ++d) {
                const unsigned w0 = a[w][2 * c + (d >> 1)][(2 * d) & 3], w1 = a[w][2 * c + (d >> 1)][(2 * d + 1) & 3];
                float t0 = bflo(w0) * r[w], t1 = bfhi(w0) * r[w], t2 = bflo(w1) * r[w], t3 = bfhi(w1) * r[w];
                t0 = fminf(fmaxf(t0, -127.f), 127.f); t1 = fminf(fmaxf(t1, -127.f), 127.f); t2 = fminf(fmaxf(t2, -127.f), 127.f); t3 = fminf(fmaxf(t3, -127.f), 127.f);
                o[d] = ((unsigned)__float2int_rn(t0) & 0xffu) | (((unsigned)__float2int_rn(t1) & 0xffu) << 8) | (((unsigned)__float2int_rn(t2) & 0xffu) << 16) | (((unsigned)__float2int_rn(t3) & 0xffu) << 24); }
            *(v4u*)(q + c * 1024 + 16 * lane) = o; } }
}
__device__ __forceinline__ void build_rows2(const float* src0, const float* src1, bf16* xb0, bf16* xb1, float* rss0, float* rss1, bool has1, int lane) {
    f32x4 v0[8], v1[8]; float s0 = 0.f, s1 = 0.f;
#pragma unroll
    for (int j = 0; j < 8; ++j) { v0[j] = src0 ? ((const f32x4*)src0 + lane)[64 * j] : (f32x4){0.f, 0.f, 0.f, 0.f}; v1[j] = src1 ? ((const f32x4*)src1 + lane)[64 * j] : (f32x4){0.f, 0.f, 0.f, 0.f}; }
#pragma unroll
    for (int j = 0; j < 8; ++j) { s0 += (v0[j].x * v0[j].x + v0[j].y * v0[j].y) + (v0[j].z * v0[j].z + v0[j].w * v0[j].w); s1 += (v1[j].x * v1[j].x + v1[j].y * v1[j].y) + (v1[j].z * v1[j].z + v1[j].w * v1[j].w); }
    u32x2* o0 = (u32x2*)xb0 + lane; u32x2* o1 = (u32x2*)xb1 + lane;
#pragma unroll
    for (int j = 0; j < 8; ++j) { u32x2 w; w.x = pkbf(v0[j].x, v0[j].y); w.y = pkbf(v0[j].z, v0[j].w); o0[64 * j] = w; if (has1) { u32x2 w1; w1.x = pkbf(v1[j].x, v1[j].y); w1.y = pkbf(v1[j].z, v1[j].w); o1[64 * j] = w1; } }
    s0 = wave_sum(s0); s1 = wave_sum(s1);
    if (lane < 8) { rss0[lane] = (lane == 0) ? s0 : 0.f; if (has1) rss1[lane] = (lane == 0) ? s1 : 0.f; }
}
__device__ __forceinline__ void final_rows2(const bf16* src0, const bf16* src1, const float* gain, float* dst0, float* dst1, const float* rss0, const float* rss1, int lane) {
    u32x2 w0[8], w1[8];
#pragma unroll
    for (int j = 0; j < 8; ++j) { w0[j] = ((const u32x2*)src0 + lane)[64 * j]; w1[j] = dst1 ? ((const u32x2*)src1 + lane)[64 * j] : (u32x2){0u, 0u}; }
    const float q0 = lane < 8 ? rss0[lane] : 0.f, q1 = (dst1 && lane < 8) ? rss1[lane] : 0.f;
    const float r0 = 1.0f / sqrtf(wave_sum(q0) * (1.0f / D) + EPS), r1 = 1.0f / sqrtf(wave_sum(q1) * (1.0f / D) + EPS);
    const f32x4* gr = (const f32x4*)gain + lane; f32x4* o0 = (f32x4*)dst0 + lane; f32x4* o1 = (f32x4*)dst1 + lane;
#pragma unroll
    for (int j = 0; j < 8; ++j) { const f32x4 g = gr[64 * j]; o0[64 * j] = (f32x4){bflo(w0[j].x) * r0 * g.x, bfhi(w0[j].x) * r0 * g.y, bflo(w0[j].y) * r0 * g.z, bfhi(w0[j].y) * r0 * g.w};
        if (dst1) o1[64 * j] = (f32x4){bflo(w1[j].x) * r1 * g.x, bfhi(w1[j].x) * r1 * g.y, bflo(w1[j].y) * r1 * g.z, bfhi(w1[j].y) * r1 * g.w}; }
}
__device__ __forceinline__ const float* input_row(int r, const float* xp, const float* xs, const float* meta) {
    if (r < MPROMPT) { const int b = r / TP, pos = r - b * TP; return pos < NMETA ? meta + (size_t)pos * D : xp + ((size_t)b * SEQ + (pos - NMETA)) * D; }
    if (r < MREAL) return xs + (size_t)(r - MPROMPT) * D;
    return nullptr;
}

__device__ __forceinline__ void ssm_tables(int t, const float* lre_, const float* lim_, const float* ldt, const float* bre, const float* bim, f32x2* apow, f32x2* bbar) {
    const int l = t / (SG * SP), gp = t % (SG * SP), g = gp / SP;
    const double dtd = exp((double)ldt[l * SG + g]);
    const float lre = lre_[t], lim = lim_[t];
    const double xr = (double)lre * dtd, th = (double)lim * dtd;
    float c1 = 1.f, s1 = 0.f;
    for (int k = 0; k < NPOW; ++k) {
        const double kk = (k <= 16) ? (double)k : 16.0 * 65.0;
        const double ang = th * kk; const double n = rint(ang * 0.15915494309189535); const float r = (float)(ang - n * 6.283185307179586);
        const float mag = expf((float)(xr * kk)); const float cs = cosf(r), sn = sinf(r);
        apow[((size_t)(l * NPOW + k)) * (SG * SP) + gp] = (f32x2){mag * cs, mag * sn};
        if (k == 1) { c1 = cs; s1 = sn; }
    }
    const float em1 = expm1f((float)xr);
    const float hv = 0.5f * (1.0f - c1);
    const float are = em1 * c1 - 2.0f * hv, aim = (1.0f + em1) * s1;
    const float den = 1.0f / (lre * lre + lim * lim);
    const float qre = (are * lre + aim * lim) * den, qim = (aim * lre - are * lim) * den;
    const float* br = bre + (size_t)t * SH; const float* bi = bim + (size_t)t * SH; f32x2* bo = bbar + (size_t)t * SH;
#pragma unroll 4
    for (int h = 0; h < SH; ++h) { const float x = br[h], y = bi[h]; bo[h] = (f32x2){qre * x - qim * y, qre * y + qim * x}; }
}
__device__ __forceinline__ void ssm_matrices(int l, size_t t0, size_t tstride, const f32x2* apow, const f32x2* bbar, const float* cre, const float* cim, const float* dsk, bf16* WBT, bf16* BMT) {
    const f32x2* ap = apow + (size_t)l * NPOW * SG * SP; const f32x2* bb = bbar + (size_t)l * SG * SP * SH;
    const float* cr = cre + (size_t)l * SG * SH * SP; const float* ci = cim + (size_t)l * SG * SH * SP; const float* dd = dsk + (size_t)l * SG * SH;
    constexpr size_t NA = (size_t)SG * 16 * 256, NB = (size_t)SG * 256 * SP, NC = (size_t)SG * SP * 256;
    for (size_t t = t0; t < NA + NB + NC; t += tstride) {
        if (t < NA) {
            const int g = (int)(t / 4096), k = (int)(t / 256) % 16, h = (int)(t / 16) % 16, hp = (int)t % 16;
            float s = 0.f;
            for (int p = 0; p < SP; ++p) { const f32x2 a = ap[((size_t)k * SG + g) * SP + p], b = bb[((size_t)g * SP + p) * SH + hp]; const float x = cr[((size_t)g * SH + h) * SP + p], y = ci[((size_t)g * SH + h) * SP + p];
                const float abr = a.x * b.x - a.y * b.y, abi = a.x * b.y + a.y * b.x; s += x * abr - y * abi; }
            if (k == 0 && h == hp) s += dd[g * SH + h];
            const unsigned short sv = (unsigned short)(pkbf(s, 0.f) & 0xffffu);
            for (int m = 0; m + k < 16; ++m) { WBT[((size_t)g * 256 + (size_t)(k + m) * 16 + h) * 384 + m * 16 + hp] = sv;
                if (k > 0) WBT[((size_t)g * 256 + (size_t)m * 16 + h) * 384 + (k + m) * 16 + hp] = 0; }
        } else if (t < NA + NB) {
            const size_t u = t - NA; const int g = (int)(u / 16384), i = (int)(u / 1024) % 16, h = (int)(u / 64) % 16, p = (int)u % 64;
            const f32x2 a = ap[((size_t)(i + 1) * SG + g) * SP + p]; const float x = cr[((size_t)g * SH + h) * SP + p], y = ci[((size_t)g * SH + h) * SP + p];
            const size_t o = ((size_t)g * 256 + i * 16 + h) * 384 + 256 + p;
            WBT[o] = (unsigned short)(pkbf(x * a.x - y * a.y, 0.f) & 0xffffu); WBT[o + 64] = (unsigned short)(pkbf(-(x * a.y + y * a.x), 0.f) & 0xffffu);
        } else {
            const size_t u = t - NA - NB; const int g = (int)(u / 16384), p = (int)(u / 256) % 64, j = (int)(u / 16) % 16, hp = (int)u % 16;
            const f32x2 a = ap[((size_t)(15 - j) * SG + g) * SP + p], b = bb[((size_t)g * SP + p) * SH + hp];
            const size_t o = ((size_t)g * 256 + p) * 256 + j * 16 + hp;
            BMT[o] = (unsigned short)(pkbf(a.x * b.x - a.y * b.y, 0.f) & 0xffffu); BMT[o + (size_t)64 * 256] = (unsigned short)(pkbf(a.x * b.y + a.y * b.x, 0.f) & 0xffffu);
        }
    }
}

__device__ __forceinline__ float gelu_tanh(float x) { const float z = 0.7978845608028654f * (x + 0.044715f * x * x * x); return x * __builtin_amdgcn_rcpf(1.0f + __expf(-2.0f * z)); }

__device__ __forceinline__ void conv_rows4(int r0, int l, const bf16* PROJ, bf16* MIXED, const float* cache, const float* convw, const float* cgain, float* out, int lane) {
    if (r0 >= MREAL) {
#pragma unroll
        for (int q = 0; q < 4; ++q) { v4u* mo = (v4u*)(MIXED + (size_t)(r0 + q) * D); mo[lane] = (v4u){0u, 0u, 0u, 0u}; mo[64 + lane] = (v4u){0u, 0u, 0u, 0u}; }
        return; }
    int pos0, T; const float* cb = nullptr; float* ob;
    if (r0 < MPROMPT) { const int b = r0 / TP; pos0 = r0 - b * TP; T = TP; ob = out + O_CVP + (size_t)(l * NBP + b) * 2 * DCV; }
    else { const int s = (r0 - MPROMPT) / TS; pos0 = (r0 - MPROMPT) - s * TS; T = TS; cb = cache + (size_t)(l * NBS + s) * 2 * DCV; ob = out + O_CVS + (size_t)(l * NBS + s) * 2 * DCV; }
    float ss[4] = {0.f, 0.f, 0.f, 0.f}; float y[4][16];
#pragma unroll
    for (int hf = 0; hf < 2; ++hf) {
        const int c0 = hf * 512 + lane * 8;
        const bf16* pr = PROJ + (size_t)r0 * DIN + c0;
        v4u cg[6], hg[6], bg[4];
#pragma unroll
        for (int j = 0; j < 6; ++j) { if (j >= 2 || pos0 >= 2 - j) { cg[j] = *(const v4u*)(pr + (ptrdiff_t)(j - 2) * DIN + DCV); hg[j] = *(const v4u*)(pr + (ptrdiff_t)(j - 2) * DIN + 2 * DCV); } else { cg[j] = (v4u){0u, 0u, 0u, 0u}; hg[j] = cg[j]; } }
#pragma unroll
        for (int q = 0; q < 4; ++q) bg[q] = *(const v4u*)(pr + (size_t)q * DIN);
        float cbv[2][8];
#pragma unroll
        for (int e = 0; e < 8; ++e) { cbv[0][e] = (cb && pos0 < 2) ? cb[c0 + e] : 0.f; cbv[1][e] = (cb && pos0 < 1) ? cb[DCV + c0 + e] : 0.f; }
        const float* w = convw + (size_t)l * 3 * DCV + c0;
        float w0[8], w1[8], w2[8];
#pragma unroll
        for (int e = 0; e < 8; ++e) { w0[e] = w[e]; w1[e] = w[DCV + e]; w2[e] = w[2 * DCV + e]; }
        float v[6][8];
#pragma unroll
        for (int j = 0; j < 6; ++j)
#pragma unroll
            for (int qq = 0; qq < 4; ++qq) { v[j][2 * qq] = bflo(cg[j][qq]) * bflo(hg[j][qq]); v[j][2 * qq + 1] = bfhi(cg[j][qq]) * bfhi(hg[j][qq]); }
        if (pos0 == 0) {
#pragma unroll
            for (int e = 0; e < 8; ++e) { v[0][e] = cbv[0][e]; v[1][e] = cbv[1][e]; } }
#pragma unroll
        for (int q = 0; q < 4; ++q)
#pragma unroll
            for (int e = 0; e < 8; ++e) { const float bgv = (e & 1) ? bfhi(bg[q][e >> 1]) : bflo(bg[q][e >> 1]);
                const float yy = bgv * (w0[e] * v[q][e] + w1[e] * v[q + 1][e] + w2[e] * v[q + 2][e]); y[q][hf * 8 + e] = yy; ss[q] += yy * yy; }
        if (pos0 + 4 == T) {
#pragma unroll
            for (int e = 0; e < 8; ++e) { ob[c0 + e] = v[4][e]; ob[DCV + c0 + e] = v[5][e]; } }
    }
#pragma unroll
    for (int q = 0; q < 4; ++q) { const float rn = 1.0f / sqrtf(wave_sum(ss[q]) * (1.0f / DCV) + EPS); v4u* mo = (v4u*)(MIXED + (size_t)(r0 + q) * D);
#pragma unroll
        for (int hf = 0; hf < 2; ++hf) { const float* g = cgain + (size_t)l * DCV + hf * 512 + lane * 8; v4u wv;
#pragma unroll
            for (int qq = 0; qq < 4; ++qq) wv[qq] = pkbf(y[q][hf * 8 + 2 * qq] * rn * g[2 * qq], y[q][hf * 8 + 2 * qq + 1] * rn * g[2 * qq + 1]);
            mo[hf * 64 + lane] = wv; } }
}
__device__ __forceinline__ void norm_s_row(int r, bf16* MIXED, const float* gain, int lane) {
    v4u* p = (v4u*)(MIXED + (size_t)r * D + DCV); const v4u a = p[lane], b = p[64 + lane]; float v[16]; float ss = 0.f;
#pragma unroll
    for (int q = 0; q < 4; ++q) { v[2 * q] = bflo(a[q]); v[2 * q + 1] = bfhi(a[q]); v[8 + 2 * q] = bflo(b[q]); v[8 + 2 * q + 1] = bfhi(b[q]); }
#pragma unroll
    for (int e = 0; e < 16; ++e) ss += v[e] * v[e];
    const float rn = 1.0f / sqrtf(wave_sum(ss) * (1.0f / DSS) + EPS);
    v4u wa, wb; const float* g0 = gain + lane * 8; const float* g1 = gain + 512 + lane * 8;
#pragma unroll
    for (int q = 0; q < 4; ++q) { wa[q] = pkbf(v[2 * q] * rn * g0[2 * q], v[2 * q + 1] * rn * g0[2 * q + 1]); wb[q] = pkbf(v[8 + 2 * q] * rn * g1[2 * q], v[8 + 2 * q + 1] * rn * g1[2 * q + 1]); }
    p[lane] = wa; p[64 + lane] = wb;
}

template <bool WRITE> __device__ __forceinline__ void carry_run(const float* sl, bf16* so, int nc, const f32x2 a, float& sr, float& si) {
    constexpr size_t CS = (size_t)SG * 128, CO = (size_t)UGLD; constexpr int NB = 16;
#define CARRY_LOAD(LR, LI, c0) do { _Pragma("unroll") for (int q = 0; q < NB; ++q) { LR[q] = sl[(size_t)((c0) + q) * CS]; LI[q] = sl[(size_t)((c0) + q) * CS + 64]; } } while (0)
#define CARRY_STEP(LR, LI, c0) do { _Pragma("unroll") for (int q = 0; q < NB; ++q) { \
        if (WRITE) { so[(size_t)((c0) + q) * CO] = (unsigned short)(pkbf(sr, 0.f) & 0xffffu); so[(size_t)((c0) + q) * CO + 64] = (unsigned short)(pkbf(si, 0.f) & 0xffffu); } \
        const float nr = a.x * sr - a.y * si + LR[q], ni = a.x * si + a.y * sr + LI[q]; sr = nr; si = ni; } } while (0)
    float ar[NB], ai[NB], br[NB], bi[NB];
    int c = 0;
    if (nc >= NB) CARRY_LOAD(ar, ai, 0);
    while (c + NB <= nc) {
        if (c + 2 * NB <= nc) CARRY_LOAD(br, bi, c + NB);
        CARRY_STEP(ar, ai, c); c += NB;
        if (c + NB > nc) break;
        if (c + 2 * NB <= nc) CARRY_LOAD(ar, ai, c + NB);
        CARRY_STEP(br, bi, c); c += NB;
    }
#undef CARRY_LOAD
#undef CARRY_STEP
    for (; c < nc; ++c) { const float lr = sl[(size_t)c * CS], li = sl[(size_t)c * CS + 64];
        if (WRITE) { so[(size_t)c * CO] = (unsigned short)(pkbf(sr, 0.f) & 0xffffu); so[(size_t)c * CO + 64] = (unsigned short)(pkbf(si, 0.f) & 0xffffu); }
        const float nr = a.x * sr - a.y * si + lr, ni = a.x * si + a.y * sr + li; sr = nr; si = ni; }
}
constexpr int CSEG = 65, NSEG = 16;
static_assert(NSEG * CSEG >= CH_PER_SEQ && (NSEG - 1) * CSEG < CH_PER_SEQ, "carry segments");
__device__ __forceinline__ void carry_totals2(const float* sa, int na, const float* sb, int nb, const f32x2 a, float& ar, float& ai, float& br, float& bi) {
    constexpr size_t CS = (size_t)SG * 128; constexpr int NB = 8;
    const int nmin = na < nb ? na : nb; int c = 0;
    for (; c + NB <= nmin; c += NB) { float xr[NB], xi[NB], yr[NB], yi[NB];
#pragma unroll
        for (int q = 0; q < NB; ++q) { xr[q] = sa[(size_t)(c + q) * CS]; xi[q] = sa[(size_t)(c + q) * CS + 64]; yr[q] = sb[(size_t)(c + q) * CS]; yi[q] = sb[(size_t)(c + q) * CS + 64]; }
#pragma unroll
        for (int q = 0; q < NB; ++q) { const float n0 = a.x * ar - a.y * ai + xr[q], n1 = a.x * ai + a.y * ar + xi[q]; ar = n0; ai = n1; const float m0 = a.x * br - a.y * bi + yr[q], m1 = a.x * bi + a.y * br + yi[q]; br = m0; bi = m1; } }
    for (int k = c; k < na; ++k) { const float x0 = sa[(size_t)k * CS], x1 = sa[(size_t)k * CS + 64]; const float n0 = a.x * ar - a.y * ai + x0, n1 = a.x * ai + a.y * ar + x1; ar = n0; ai = n1; }
    for (int k = c; k < nb; ++k) { const float y0 = sb[(size_t)k * CS], y1 = sb[(size_t)k * CS + 64]; const float m0 = a.x * br - a.y * bi + y0, m1 = a.x * bi + a.y * br + y1; br = m0; bi = m1; }
}
__device__ __forceinline__ void ssm_carry_prompt(int b, int g, int hb, int l, const f32x2* apow, const float* SLOC, bf16* UG, float* out, LAS float* sh, int wave, int lane) {
    const f32x2 a = apow[((size_t)(l * NPOW + 16) * SG + g) * SP + lane], aseg = apow[((size_t)(l * NPOW + 17) * SG + g) * SP + lane];
    const int seg = 8 * hb + wave, cs = seg * CSEG, len = (CH_PER_SEQ - cs) < CSEG ? (CH_PER_SEQ - cs) : CSEG, c0 = b * CH_PER_SEQ + cs;
    const float* sl = SLOC + ((size_t)c0 * SG + g) * 128 + lane; bf16* so = UG + ((size_t)g * CPG + c0) * UGLD + 256 + lane;
    float tr = 0.f, ti = 0.f, pr = 0.f, pi = 0.f;
    if (hb) { const float* sp = SLOC + ((size_t)(b * CH_PER_SEQ + wave * CSEG) * SG + g) * 128 + lane; carry_totals2(sp, CSEG, sl, len, a, pr, pi, tr, ti);
        sh[(wave * 2) * 64 + lane] = pr; sh[(wave * 2 + 1) * 64 + lane] = pi; }
    else carry_run<false>(sl, so, len, a, tr, ti);
    sh[(seg * 2) * 64 + lane] = tr; sh[(seg * 2 + 1) * 64 + lane] = ti;
    LDS_WAIT(); __syncthreads();
    float sr = 0.f, si = 0.f;
    for (int w = 0; w < seg; ++w) { const float xr = sh[(w * 2) * 64 + lane], xi = sh[(w * 2 + 1) * 64 + lane]; const float nr = aseg.x * sr - aseg.y * si + xr, ni = aseg.x * si + aseg.y * sr + xi; sr = nr; si = ni; }
    carry_run<true>(sl, so, len, a, sr, si);
    if (seg == NSEG - 1) { out[O_REP + ((size_t)(l * NBP + b) * SG + g) * SP + lane] = sr; out[O_IMP + ((size_t)(l * NBP + b) * SG + g) * SP + lane] = si; }
    __syncthreads();
}
__device__ __forceinline__ void ssm_carry_small(int w, int l, const f32x2* apow, const float* SLOC, bf16* UG, const float* sre, const float* sim, float* out, int lane) {
    if (w >= NBS * SG) { const int u = w - NBS * SG; const int c = NCH_REAL + u / SG, g = u % SG; if (c >= NCHUNK) return;
        ((unsigned*)(UG + ((size_t)g * CPG + c) * UGLD + 256))[lane] = 0u; return; }
    const int s = w / SG, g = w % SG, c0 = NBP * CH_PER_SEQ + s * (TS / 16); const size_t o = ((size_t)(l * NBS + s) * SG + g) * SP + lane;
    float sr = sre[o], si = sim[o];
    const f32x2 a = apow[((size_t)(l * NPOW + 16) * SG + g) * SP + lane];
    carry_run<true>(SLOC + ((size_t)c0 * SG + g) * 128 + lane, UG + ((size_t)g * CPG + c0) * UGLD + 256 + lane, TS / 16, a, sr, si);
    out[O_RES + o] = sr; out[O_IMS + o] = si;
}
struct Args { const float* in[N_IN]; float* out; unsigned char* ws; };
static_assert(sizeof(Args) == 8 * (N_IN + 2), "no padding in Args");
typedef const __attribute__((address_space(4))) Args* ArgsP;
#ifdef PROBE_REP
#define PROBE_N(w) ((PROBE_WHICH == (w) || (PROBE_WHICH == 99 && (w) != 6)) ? PROBE_REP : 1)
#define PROBE_SET_REP(S) do { if (PROBE_WHICH == 1 || PROBE_WHICH == 99) (S).rep = PROBE_REP; } while (0)
#define PROBE_SET_REP3(S) do { if (PROBE_WHICH == 3 || PROBE_WHICH == 99) (S).rep = PROBE_REP; } while (0)
#define PROBE_SET_REP_R(S, E) do { if (PROBE_WHICH == 2 || PROBE_WHICH == 99) { (S).rep = PROBE_REP; (E).scale *= 1.0f / PROBE_REP; } } while (0)
#else
#define PROBE_N(w) 1
#define PROBE_SET_REP(S) do {} while (0)
#define PROBE_SET_REP3(S) do {} while (0)
#define PROBE_SET_REP_R(S, E) do {} while (0)
#endif

#define PHASE_BEGIN() \
    int tid = threadIdx.x; asm volatile("" : "+v"(tid)); \
    ArgsP A = (ArgsP)__builtin_amdgcn_kernarg_segment_ptr(); asm volatile("" : "+s"(A)); \
    const int lane = tid & 63, wave = __builtin_amdgcn_readfirstlane(tid >> 6); \
    const int gw = vcu * NWAVES + wave, NGW = G * NWAVES; \
    unsigned char* ws = A->ws; (void)lane; (void)gw; (void)NGW; (void)ws;

__device__ __forceinline__ void convert_layer(int l, ArgsP A, unsigned char* ws, LAS float* scr, int gw, int NGW, int lane, int part = 0, int nparts = 1) {
    unsigned char* wset = ws + WS_W + (size_t)(l & 1) * W_SET;
    constexpr int I_GU = (D / 64) * (FF / 32), I_DN = (FF / 64) * (D / 32), I_IN = (D / 64) * (DIN / 32), I_GL = (DSS / 64) * (DSS / 32), I_OUT = (D / 64) * (D / 32);
    constexpr int NITEMS = 4 * I_GU + 2 * I_DN + I_IN + I_GL + I_OUT;
    const bool q8 = (2 * l >= UPQ_FROM);
    int it0 = (int)((long)NITEMS * part / nparts), it1 = (int)((long)NITEMS * (part + 1) / nparts);
    if (q8) { if (part == 0) { it0 = 0; it1 = NITEMS; } else { it0 = 0; it1 = 4 * I_GU; } }
    for (int it = it0 + gw; it < it1; it += NGW) {
        int r = it;
        if (r < 4 * I_GU) { const int q = r / I_GU; r -= q * I_GU;
            const float* W = A->in[q == 0 ? I_F1G : q == 1 ? I_F1U : q == 2 ? I_F2G : I_F2U] + (size_t)l * D * FF;
            if (q8 && part == 0) { pmaxc_item(W, FF, A->in[q < 2 ? I_F1N : I_F2N] + (size_t)l * D, (float*)(ws + WS_PMAXC) + (size_t)q * 32 * FF, r, lane); continue; }
            transpose_item(W, D, FF, (bf16*)(wset + (q < 2 ? W_GU0 : W_GU1)), 1 + (q & 1), A->in[q < 2 ? I_F1N : I_F2N] + (size_t)l * D, scr, r, lane, 0.f, 0, q8 ? (const float*)(ws + WS_CS) + (size_t)((l & 1) * 4 + q) * FF : nullptr); continue; }
        r -= 4 * I_GU;
        if (r < 2 * I_DN) { const int q = r / I_DN; r -= q * I_DN;
            transpose_item(A->in[q ? I_F2D : I_F1D] + (size_t)l * FF * D, FF, D, (bf16*)(wset + (q ? W_D1 : W_D0)), 0, nullptr, scr, r, lane, (2 * l + q >= FP8_FROM_HL) ? WD8_SCALE : 0.f); continue; }
        r -= 2 * I_DN;
        if (r < I_IN) { transpose_item(A->in[I_WIN] + (size_t)l * D * DIN, D, DIN, (bf16*)(wset + W_IN), 0, A->in[I_MIXN] + (size_t)l * D, scr, r, lane); continue; }
        r -= I_IN;
        if (r < I_GL) { transpose_item(A->in[I_GLU] + (size_t)l * DSS * DSS, DSS, DSS, (bf16*)(wset + W_GLU), 0, nullptr, scr, r, lane); continue; }
        r -= I_GL;
        transpose_item(A->in[I_WOUT] + (size_t)l * D * D, D, D, (bf16*)(wset + W_OUT), 0, A->in[I_SSMN] + (size_t)l * DSS, scr, r, lane, 0.f, DCV);
    }
}

__global__ void __launch_bounds__(NWAVES * 64, 2) hymba_fwd(Args args_unused) {
    extern __shared__ __attribute__((aligned(16))) unsigned char lds_raw[];
    LAS unsigned char* lds = (LAS unsigned char*)lds_raw;
    const int G = gridDim.x; const int bx = blockIdx.x; const int vcu = (G % 8 == 0) ? (bx % 8) * (G / 8) + bx / 8 : bx;
    XcdBarrier bar;
    {
        PHASE_BEGIN();
        for (int u = tid; u < (LDS_BYTES - LDSCTL_OFF) / 4; u += NWAVES * 64) ((LAS unsigned*)(lds + LDSCTL_OFF))[u] = 0u;
        __syncthreads();
        bar = xcd_barrier_post((unsigned*)(ws) + CW_BAR, (volatile LAS unsigned*)(lds + MISC_OFF) + 8);
    }
#define GRID_BAR() do { for (int prep_ = 0; prep_ < PROBE_N(6); ++prep_) xcd_barrier(bar); } while (0)
    {
        PHASE_BEGIN();
        for (int prep = 0; prep < PROBE_N(7); ++prep)
        for (int t = bx * (NWAVES * 64) + tid; t < NL * SG * SP; t += G * NWAVES * 64)
            ssm_tables(t, A->in[I_LRE], A->in[I_LIM], A->in[I_LDT], A->in[I_BRE], A->in[I_BIM], (f32x2*)(ws + WS_APOW), (f32x2*)(ws + WS_BBAR));
    }
    {
        PHASE_BEGIN();
        for (int prep = 0; prep < PROBE_N(7); ++prep) convert_layer(0, A, ws, (LAS float*)(lds + RING_OFF + wave * 16384), gw, NGW, lane);
    }
    {
        PHASE_BEGIN();
        v4u* z = (v4u*)(ws + WS_BMT);
        for (int i = bx * (NWAVES * 64) + tid; i < SG * 128 * 256 * 2 / 16; i += G * NWAVES * 64) { const int g = i / (128 * 256 * 2 / 16), o = i % (128 * 256 * 2 / 16); z[(size_t)g * (256 * 256 * 2 / 16) + (128 * 256 * 2 / 16) + o] = (v4u){0u, 0u, 0u, 0u}; }
    }
    {
        PHASE_BEGIN();
        bf16* XB = (bf16*)(ws + WS_XN); float* rss = (float*)(ws + WS_RSS);
        const float* xp = A->in[I_XP]; const float* xs = A->in[I_XS]; const float* meta = A->in[I_META];
        for (int prep = 0; prep < PROBE_N(7); ++prep)
        for (int r = gw; r < MPAD; r += 2 * NGW) { const int r1 = r + NGW; const bool h1 = r1 < MPAD; const int rr = h1 ? r1 : r;
            build_rows2(input_row(r, xp, xs, meta), h1 ? input_row(r1, xp, xs, meta) : nullptr, XB + (size_t)r * D, XB + (size_t)rr * D, rss + (size_t)r * 8, rss + (size_t)rr * 8, h1, lane); }
    }
    GRID_BAR();
    for (int hl = 0; hl < 2 * NL; ++hl) {
        const int l = hl >> 1, second = hl & 1;
        if (hl >= UPQ_FROM) {
            PHASE_BEGIN();
            const bf16* XB = (const bf16*)(ws + WS_XN); unsigned char* XQ = ws + WS_XB8; const float* rss = (const float*)(ws + WS_RSS) + (size_t)(3 * l + (second ? 2 : 0)) * RSS_STRIDE;
            for (int r = gw; r < MPAD; r += 2 * NGW) { const int r1 = r + NGW; const bool h1 = r1 < MPAD; const int rr = h1 ? r1 : r;
                quant_rows2(XB + (size_t)r * D, XB + (size_t)rr * D, rss + (size_t)r * 8, rss + (size_t)rr * 8, XQ + (size_t)r * D, XQ + (size_t)rr * D, (float*)(ws + WS_QF) + r, (float*)(ws + WS_QF) + rr, h1, lane); }
        }
        if (hl >= UPQ_FROM) GRID_BAR();
        if (hl >= UPQ_FROM) {
            PHASE_BEGIN();
            const float* cs = (const float*)(ws + WS_CS) + (size_t)((l & 1) * 4 + 2 * second) * FF;
            pg8::Gemm g{(const bf16*)(ws + WS_XB8), (const bf16*)(ws + WS_W + (size_t)(l & 1) * W_SET + (second ? W_GU1 : W_GU0)), MPAD, 2 * FF, D / 2, D / 2, D / 2, 0, 0};   pg8::StaticOrder S; S.init(MPAD, 2 * FF, G, bx); PROBE_SET_REP(S);
            pg8::EpiSwigluQ E{(const float*)(ws + WS_QF), (unsigned char*)(ws + WS_H), cs, FF, cs + FF, (hl >= FP8_FROM_HL) ? 1 : 0, (hl >= FP8_FROM_HL) ? H8_SCALE : 1.0f};
            S.split = 1;
            S.pass = 0; pg8::gemm_phase<pg8::EpiSwigluQ, pg8::StaticOrder, true, true, 2, false>(lds + RING_OFF, g, S, E, tid); S.pass = 1; pg8::gemm_phase<pg8::EpiSwigluQ, pg8::StaticOrder, true, true, 2, true>(lds + RING_OFF, g, S, E, tid);
        } else
#ifdef PROBE_SPLIT
        for (int part = 0; part < 2; ++part)
#endif
        {
            PHASE_BEGIN();
            pg8::Gemm g{(const bf16*)(ws + WS_XN), (const bf16*)(ws + WS_W + (size_t)(l & 1) * W_SET + (second ? W_GU1 : W_GU0)), MPAD, 2 * FF, D, D, D, 0, 0}; pg8::StaticOrder S; S.init(MPAD, 2 * FF, G, bx); PROBE_SET_REP(S);
#ifdef PROBE_SPLIT
            if (part == 0) S.r1 = 11; else S.r0 = 11;
#endif
            pg8::EpiSwiglu E{(unsigned char*)(ws + WS_H), FF, (const float*)(ws + WS_RSS) + (size_t)(3 * l + (second ? 2 : 0)) * RSS_STRIDE, (const LAS float*)(lds + RSSB_OFF), 1.0f / D, EPS, (hl >= FP8_FROM_HL) ? H8_SCALE : 1.0f, 1.0f, (hl >= FP8_FROM_HL) ? 1 : 0};
            S.split = 1;
            S.pass = 0; pg8::gemm_phase<pg8::EpiSwiglu, pg8::StaticOrder, true, true, false, false>(lds + RING_OFF, g, S, E, tid); S.pass = 1; pg8::gemm_phase<pg8::EpiSwiglu, pg8::StaticOrder, true, true, false, true>(lds + RING_OFF, g, S, E, tid);
#ifdef PROBE_SPLIT
            if (part == 0) GRID_BAR();
#endif
        }
        GRID_BAR();
        if (hl >= FP8_FROM_HL) {
            PHASE_BEGIN();
            pg8::Gemm g{(const bf16*)(ws + WS_H), (const bf16*)(ws + WS_W + (size_t)(l & 1) * W_SET + (second ? W_D1 : W_D0)), MPAD, D, FF / 2, FF / 2, FF / 2, 0, 0};   pg8::StaticOrder S; S.init(MPAD, D, G, bx);
            pg8::EpiResidNorm<false> E{(bf16*)(ws + WS_XN), D, 0.5f / (H8_SCALE * WD8_SCALE), (float*)(ws + WS_RSS) + (size_t)(second ? 3 * (l + 1) : 3 * l + 1) * RSS_STRIDE, (second && hl + 1 >= FP8_UP_FROM && hl + 1 < 2 * NL) ? (unsigned char*)(ws + WS_XB8) : nullptr, (LAS float*)(lds + RED_OFF), nullptr, nullptr, 0.f, 0.f};
            PROBE_SET_REP_R(S, E);
            S.split = 1;
            S.pass = 0; pg8::gemm_phase<pg8::EpiResidNorm<false>, pg8::StaticOrder, true, true, true, false>(lds + RING_OFF, g, S, E, tid); S.pass = 1; pg8::gemm_phase<pg8::EpiResidNorm<false>, pg8::StaticOrder, true, true, true, true>(lds + RING_OFF, g, S, E, tid);
        } else {
            PHASE_BEGIN();
            pg8::Gemm g{(const bf16*)(ws + WS_H), (const bf16*)(ws + WS_W + (size_t)(l & 1) * W_SET + (second ? W_D1 : W_D0)), MPAD, D, FF, FF, FF, 0, 0}; pg8::StaticOrder S; S.init(MPAD, D, G, bx);
            pg8::EpiResidNorm<false> E{(bf16*)(ws + WS_XN), D, 0.5f, (float*)(ws + WS_RSS) + (size_t)(second ? 3 * (l + 1) : 3 * l + 1) * RSS_STRIDE, (second && hl + 1 >= FP8_UP_FROM && hl + 1 < 2 * NL) ? (unsigned char*)(ws + WS_XB8) : nullptr, (LAS float*)(lds + RED_OFF), nullptr, nullptr, 0.f, 0.f};
            PROBE_SET_REP_R(S, E);
            S.split = 1;
            S.pass = 0; pg8::gemm_phase<pg8::EpiResidNorm<false>, pg8::StaticOrder, true, true, false, false>(lds + RING_OFF, g, S, E, tid); S.pass = 1; pg8::gemm_phase<pg8::EpiResidNorm<false>, pg8::StaticOrder, true, true, false, true>(lds + RING_OFF, g, S, E, tid);
        }
        if (l + 1 < NL) {
            PHASE_BEGIN();
            constexpr int NTAIL = 2 * (((MPAD / 256) * (D / 256)) % 256);
            if (G > 2 * NTAIL) { if (bx >= NTAIL) for (int prep = 0; prep < PROBE_N(4); ++prep) convert_layer(l + 1, A, ws, (LAS float*)(lds + RING_OFF + wave * 16384), (bx - NTAIL) * NWAVES + wave, (G - NTAIL) * NWAVES, lane, second, 2); }
            else convert_layer(l + 1, A, ws, (LAS float*)(lds + RING_OFF + wave * 16384), gw, NGW, lane, second, 2);
        }
        GRID_BAR();
        if (second) continue;
        {
            PHASE_BEGIN();
            pg8::Gemm g{(const bf16*)(ws + WS_XN), (const bf16*)(ws + WS_W + (size_t)(l & 1) * W_SET + W_IN), MPAD, DIN, D, D, D, 0, 0}; pg8::StaticOrder S; S.init(MPAD, DIN, G, bx); PROBE_SET_REP(S);
            pg8::EpiStoreBf16 E{(bf16*)(ws + WS_PROJ), DIN, (const float*)(ws + WS_RSS) + (size_t)(3 * l + 1) * RSS_STRIDE, (const LAS float*)(lds + RSSB_OFF), 1.0f / D, EPS, (bf16*)(ws + WS_UG), 3 * DCV, CPG, UGLD};
            S.split = 1;
            S.pass = 0; pg8::gemm_phase<pg8::EpiStoreBf16, pg8::StaticOrder, true, true, false, false>(lds + RING_OFF, g, S, E, tid); S.pass = 1; pg8::gemm_phase<pg8::EpiStoreBf16, pg8::StaticOrder, true, true, false, true>(lds + RING_OFF, g, S, E, tid);
        }
        {
            PHASE_BEGIN();
            for (int prep = 0; prep < PROBE_N(5); ++prep)
            ssm_matrices(l, (size_t)bx * (NWAVES * 64) + tid, (size_t)G * NWAVES * 64, (const f32x2*)(ws + WS_APOW), (const f32x2*)(ws + WS_BBAR), A->in[I_CRE], A->in[I_CIM], A->in[I_SD],
                         (bf16*)(ws + WS_WBT), (bf16*)(ws + WS_BMT));
        }
        GRID_BAR();
        {
            PHASE_BEGIN();
            const bf16* PROJ = (const bf16*)(ws + WS_PROJ);
            for (int prep = 0; prep < PROBE_N(3); ++prep) {
            { bf16* MIXED = (bf16*)(ws + WS_MIXED); const float* cache = A->in[I_CACHE]; const float* convw = A->in[I_CONVW]; const float* cgain = A->in[I_CONVN]; float* out = A->out;
              for (int r = 4 * gw; r < MPAD; r += 4 * NGW) conv_rows4(r, l, PROJ, MIXED, cache, convw, cgain, out, lane); }
            }
        }
        {
            PHASE_BEGIN();
            pg8::Gemm g{(const bf16*)(ws + WS_UG), (const bf16*)(ws + WS_BMT), SG * CPG, 256, 256, UGLD, 256, CPG / 256, (size_t)256 * 256 * 2}; pg8::StaticOrder S; S.init(SG * CPG, 256, G, bx);
            pg8::EpiSloc E{(float*)(ws + WS_SLOC), CPG, NCHUNK, SG};
            PROBE_SET_REP3(S);
            S.split = 1;
            S.pass = 0; pg8::gemm_phase<pg8::EpiSloc, pg8::StaticOrder, true, true, false, false>(lds + RING_OFF, g, S, E, tid); S.pass = 1; pg8::gemm_phase<pg8::EpiSloc, pg8::StaticOrder, true, true, false, true>(lds + RING_OFF, g, S, E, tid);
        }
        GRID_BAR();
        {
            PHASE_BEGIN();
            const f32x2* apow = (const f32x2*)(ws + WS_APOW); const float* SLOC = (const float*)(ws + WS_SLOC); bf16* UG = (bf16*)(ws + WS_UG);
            for (int prep = 0; prep < PROBE_N(3); ++prep) {
            for (int pi = vcu; pi < 2 * NBP * SG; pi += G) ssm_carry_prompt((pi >> 1) / SG, (pi >> 1) % SG, pi & 1, l, apow, SLOC, UG, A->out, (LAS float*)(lds + RING_OFF), wave, lane);
            for (int w = gw; w < NBS * SG + (NCHUNK - NCH_REAL) * SG; w += NGW) ssm_carry_small(w, l, apow, SLOC, UG, A->in[I_SRE], A->in[I_SIM], A->out, lane);
            }
        }
        GRID_BAR();
        {
            PHASE_BEGIN();
            pg8::Gemm g{(const bf16*)(ws + WS_UG), (const bf16*)(ws + WS_WBT), SG * CPG, 256, UGLD, UGLD, UGLD, CPG / 256, (size_t)256 * UGLD * 2}; pg8::StaticOrder S; S.init(SG * CPG, 256, G, bx);
            pg8::EpiYs E{(bf16*)(ws + WS_YS), DSS, CPG, NCHUNK};
            PROBE_SET_REP3(S);
            S.split = 1;
            S.pass = 0; pg8::gemm_phase<pg8::EpiYs, pg8::StaticOrder, true, true, false, false>(lds + RING_OFF, g, S, E, tid); S.pass = 1; pg8::gemm_phase<pg8::EpiYs, pg8::StaticOrder, true, true, false, true>(lds + RING_OFF, g, S, E, tid);
        }
        GRID_BAR();
        {
            PHASE_BEGIN();
            pg8::Gemm g{(const bf16*)(ws + WS_YS), (const bf16*)(ws + WS_W + (size_t)(l & 1) * W_SET + W_GLU), MPAD, DSS, DSS, DSS, DSS, 0, 0}; pg8::StaticOrder S; S.init(MPAD, DSS, G, bx); PROBE_SET_REP(S);
            pg8::EpiGlu E{(const bf16*)(ws + WS_YS), DSS, (bf16*)(ws + WS_MIXED) + DCV, D, (float*)(ws + WS_RSS) + (size_t)(3 * NL + 1 + l) * RSS_STRIDE, (LAS float*)(lds + RED_OFF)};
            S.split = 1;
            S.pass = 0; pg8::gemm_phase<pg8::EpiGlu, pg8::StaticOrder, true, true, false, false>(lds + RING_OFF, g, S, E, tid); S.pass = 1; pg8::gemm_phase<pg8::EpiGlu, pg8::StaticOrder, true, true, false, true>(lds + RING_OFF, g, S, E, tid);
        }
        GRID_BAR();
        {
            PHASE_BEGIN();
            pg8::Gemm g{(const bf16*)(ws + WS_MIXED), (const bf16*)(ws + WS_W + (size_t)(l & 1) * W_SET + W_OUT), MPAD, D, D, D, D, 0, 0}; pg8::StaticOrder S; S.init(MPAD, D, G, bx);
            pg8::EpiResidNorm<true> E{(bf16*)(ws + WS_XN), D, 1.0f, (float*)(ws + WS_RSS) + (size_t)(3 * l + 2) * RSS_STRIDE, (hl + 1 >= FP8_UP_FROM) ? (unsigned char*)(ws + WS_XB8) : nullptr, (LAS float*)(lds + RED_OFF), (const float*)(ws + WS_RSS) + (size_t)(3 * NL + 1 + l) * RSS_STRIDE, (const LAS float*)(lds + RSSB_OFF), 1.0f / DSS, EPS};
            PROBE_SET_REP_R(S, E);
            S.split = 1;
            S.pass = 0; pg8::gemm_phase<pg8::EpiResidNorm<true>, pg8::StaticOrder, true, true, false, false>(lds + RING_OFF, g, S, E, tid); S.pass = 1; pg8::gemm_phase<pg8::EpiResidNorm<true>, pg8::StaticOrder, true, true, false, true>(lds + RING_OFF, g, S, E, tid);
        }
        if (l + 1 < NL && 2 * (l + 1) >= UPQ_FROM) {
            PHASE_BEGIN();
            for (int c = bx * (NWAVES * 64) + tid; c < 4 * FF; c += G * NWAVES * 64) colstep_reduce((const float*)(ws + WS_PMAXC), (float*)(ws + WS_CS) + (size_t)((l + 1) & 1) * 4 * FF, c);
        }
        GRID_BAR();
    }
    {
        PHASE_BEGIN();
        const bf16* X = (const bf16*)(ws + WS_XN); float* out = A->out; const float* gain = A->in[I_FINN]; const float* rss = (const float*)(ws + WS_RSS) + (size_t)(3 * NL) * RSS_STRIDE;
        for (int prep = 0; prep < PROBE_N(7); ++prep)
#define OUT_ROW(r) ((r) < MPROMPT ? (((r) % TP) < NMETA ? (float*)nullptr : out + O_YP + ((size_t)((r) / TP) * SEQ + (((r) % TP) - NMETA)) * D) : out + O_YS + (size_t)((r) - MPROMPT) * D)
        for (int r = gw; r < MREAL; r += 2 * NGW) { const int r1 = r + NGW;
            float* d0 = OUT_ROW(r); float* d1 = (r1 < MREAL) ? OUT_ROW(r1) : (float*)nullptr; int ra = r, rb = r1;
            if (!d0) { d0 = d1; d1 = nullptr; ra = r1; }
            if (d0) final_rows2(X + (size_t)ra * D, X + (size_t)(d1 ? rb : ra) * D, gain, d0, d1, rss + (size_t)ra * 8, rss + (size_t)(d1 ? rb : ra) * 8, lane); }
#undef OUT_ROW
    }
}
}

extern "C" void kernel_launch(void* const* d_in, const int* in_sizes, int n_in, void* d_out, int out_size, void* d_ws, size_t ws_size, hipStream_t stream) {
    using namespace mk;
    static int grid = 0;
    if (grid == 0) {
        if (n_in != N_IN || (size_t)out_size != O_END || ws_size < WS_END) { fprintf(stderr, "kernel_launch: unexpected shapes (n_in %d, out %d, ws %zu, need %zu)\n", n_in, out_size, ws_size, (size_t)WS_END); grid = -1; return; }
        int dev = 0, cus = 0, per_cu = 0;
        if (hipGetDevice(&dev) != hipSuccess || hipDeviceGetAttribute(&cus, hipDeviceAttributeMultiprocessorCount, dev) != hipSuccess) { grid = -1; return; }
        if (hipFuncSetAttribute((const void*)hymba_fwd, hipFuncAttributeMaxDynamicSharedMemorySize, LDS_BYTES) != hipSuccess) { fprintf(stderr, "kernel_launch: hipFuncSetAttribute failed\n"); grid = -1; return; }
        if (hipOccupancyMaxActiveBlocksPerMultiprocessor(&per_cu, (const void*)hymba_fwd, NWAVES * 64, LDS_BYTES) != hipSuccess || per_cu < 1) { fprintf(stderr, "kernel_launch: occupancy query says %d\n", per_cu); }
        (void)hipGetLastError();
        grid = cus;
    }
    if (grid < 0) return;
    if (hipMemsetAsync(d_ws, 0, ZERO_BYTES, stream) != hipSuccess) return;
    Args a{};
    for (int i = 0; i < N_IN; ++i) a.in[i] = (const float*)d_in[i];
    a.out = (float*)d_out; a.ws = (unsigned char*)d_ws;
    hipLaunchKernelGGL(hymba_fwd, dim3(grid), dim3(NWAVES * 64), LDS_BYTES, stream, a);
}
```

```cpp
#include <hip/hip_runtime.h>
#include <cstdio>
#include <cstdint>
namespace pg8 {
#define PG8_LAS __attribute__((address_space(3)))
typedef unsigned short bf16_t;
typedef short bf16x8 __attribute__((ext_vector_type(8)));
typedef float f32x4 __attribute__((ext_vector_type(4)));
typedef unsigned u32x4 __attribute__((ext_vector_type(4)));
typedef int i32x4 __attribute__((ext_vector_type(4)));
typedef int i32x8 __attribute__((ext_vector_type(8)));
typedef unsigned u32x2 __attribute__((ext_vector_type(2)));
constexpr int BM = 256, BK = 64, HALF = 128, HTB = HALF * BK * 2  , STAGE_BYTES = 8 * HTB, NXCD = 8, WGM = 8;

__host__ __device__ __forceinline__ int lds_byte(int r, int c) { const int st = (r >> 4) * 2 + (c >> 5), rr = r & 15, cc = c & 31, ob = rr * 64 + cc * 2; return st * 1024 + (ob ^ (((ob >> 9) & 1) << 5)); }
__host__ __device__ __forceinline__ void stage_rc(int b, int& R, int& C) { const int st = b / 1024, sb = b % 1024, swz = sb ^ (((sb >> 9) & 1) << 5); R = (st >> 1) * 16 + swz / 64; C = (st & 1) * 32 + (swz % 64) / 2; }
__host__ __device__ __forceinline__ int perm32(int rho) { const int n = rho >> 4, i = rho & 15; return 8 * (i >> 2) + 4 * n + (i & 3); }

struct Unit { int pm, pn, mh; };
struct Gemm { const bf16_t* A; const bf16_t* Bt; int M, N, K; int lda, ldb; int gpanels; size_t gstride; };

struct StaticOrder {
    int nM, nN, nwg, G, c, split, pass;
#ifdef PROBE_SPLIT
    int r0, r1;
#endif
#ifdef PROBE_REP
    int rep;
#else
    static constexpr int rep = 1;
#endif
    __host__ __device__ void init(int M, int N, int G_, int c_) { nM = M / BM; nN = N / BM; nwg = nM * nN; G = G_; c = c_; split = 0; pass = 0;
#ifdef PROBE_SPLIT
        r0 = 0; r1 = 1 << 30;
#endif
#ifdef PROBE_REP
        rep = 1;
#endif
    }
    __host__ __device__ bool next(int i, Unit& u) const {
        const int nfull = split ? (nwg / G) * G : nwg;
        long L; u.mh = -1;
        if (pass == 0) { L = (long)(i / rep) * G + c; if (L >= nfull) return false; }
        else { const long hq = (long)i * G + c; if (hq >= 2 * (long)(nwg - nfull)) return false; L = nfull + (hq >> 1); u.mh = (int)(hq & 1); }
        int wgid = (int)L; { const int q = nwg / NXCD, r = nwg % NXCD, xcd = wgid % NXCD, off = wgid / NXCD; wgid = (xcd < r ? xcd * (q + 1) : r * (q + 1) + (xcd - r) * q) + off; }
        const int nig = WGM * nN, gid = wgid / nig, fm = gid * WGM, gsz = (nM - fm) < WGM ? (nM - fm) : WGM;
        u.pm = fm + ((wgid % nig) % gsz); u.pn = (wgid % nig) / gsz; return true;
    }
    __device__ __forceinline__ void a_ready(const Unit&) const {}
    __device__ __forceinline__ void done(const Unit&) const {}
};
__device__ __forceinline__ unsigned cvt_pk_bf16(float lo, float hi) { unsigned r; asm volatile("v_cvt_pk_bf16_f32 %0, %1, %2" : "=v"(r) : "v"(lo), "v"(hi)); return r; }
typedef float f32x2 __attribute__((ext_vector_type(2)));
__device__ __forceinline__ float fast_sigmoid(float z) { return __builtin_amdgcn_rcpf(1.0f + __expf(-z)); }
__device__ __forceinline__ float row_rnorm_lds(const PG8_LAS float* rssl, int lr, float inv_n, float eps) {
    const PG8_LAS f32x4* p = (const PG8_LAS f32x4*)(rssl + lr * 8); const f32x4 a = p[0], b = p[1];
    const float s = ((a[0] + a[1]) + (a[2] + a[3])) + ((b[0] + b[1]) + (b[2] + b[3]));
    return __builtin_amdgcn_rsqf(s * inv_n + eps); }
struct EpiSwiglu {
    static constexpr bool MID = false;
    static constexpr bool PERM = true, AFTER_DRAIN = false;
    static constexpr bool RSS = true;
    unsigned char* H; int ldc; const float* rss; const PG8_LAS float* rssl; float inv_n, eps, oscale, iscale; int f8;
    __device__ __forceinline__ void operator()(const f32x4 (&acc)[2][2][4][2], const Unit& u, int wr, int wc, int fr, int fq) const {
        const int nai = u.mh < 0 ? 2 : 1, row0 = u.pm * BM + (u.mh > 0 ? HALF : 0) + wr * 64 + fr, col0 = u.pn * HALF + wc * 32 + 8 * fq;
#pragma unroll
        for (int ai = 0; ai < 2; ++ai) if (ai < nai)
#pragma unroll
            for (int m = 0; m < 4; ++m) { const int row = row0 + ai * HALF + m * 16; const float r = row_rnorm_lds(rssl, ai * HALF + wr * 64 + m * 16 + fr, inv_n, eps) * iscale;
                float o[8]; const float ru = r * oscale;
#pragma unroll
                for (int n = 0; n < 2; ++n)
#pragma unroll
                    for (int j = 0; j < 4; j += 2) {
                        const f32x2 g = (f32x2){acc[ai][0][m][n][j], acc[ai][0][m][n][j + 1]} * r, up = (f32x2){acc[ai][1][m][n][j], acc[ai][1][m][n][j + 1]} * ru;
                        f32x2 e = g * (-1.4426950408889634f); e.x = __builtin_amdgcn_exp2f(e.x); e.y = __builtin_amdgcn_exp2f(e.y); e = e + 1.0f;
                        f32x2 sg; sg.x = __builtin_amdgcn_rcpf(e.x); sg.y = __builtin_amdgcn_rcpf(e.y);
                        const f32x2 ov = (g * up) * sg; o[4 * n + j] = ov.x; o[4 * n + j + 1] = ov.y; }
                if (f8) {
                    int w0 = __builtin_amdgcn_cvt_pk_fp8_f32(o[0], o[1], 0, false); w0 = __builtin_amdgcn_cvt_pk_fp8_f32(o[2], o[3], w0, true);
                    int w1 = __builtin_amdgcn_cvt_pk_fp8_f32(o[4], o[5], 0, false); w1 = __builtin_amdgcn_cvt_pk_fp8_f32(o[6], o[7], w1, true);
                    u32x2 w; w.x = (unsigned)w0; w.y = (unsigned)w1; *(u32x2*)(H + (size_t)row * ldc + col0) = w;
                } else {
                    u32x4 w; w.x = cvt_pk_bf16(o[0], o[1]); w.y = cvt_pk_bf16(o[2], o[3]); w.z = cvt_pk_bf16(o[4], o[5]); w.w = cvt_pk_bf16(o[6], o[7]);
                    *(u32x4*)((bf16_t*)H + (size_t)row * ldc + col0) = w; } }
    }
};
template <bool MIDS> struct EpiResidNorm {
    static constexpr bool PERM = true, AFTER_DRAIN = false;
    static constexpr bool RSS = MIDS, MID = MIDS;
    bf16_t* XB; int ldc; float scale; float* rss_out; unsigned char* XB8; PG8_LAS float* red; const float* rss; const PG8_LAS float* rssl; float inv_n, eps;
    __device__ __forceinline__ void mid(f32x4 (&acc)[2][2][4][2], const Unit& u, int wr, int fr) const {
        const int nai = u.mh < 0 ? 2 : 1;
#pragma unroll
        for (int ai = 0; ai < 2; ++ai) if (ai < nai)
#pragma unroll
            for (int m = 0; m < 4; ++m) { const PG8_LAS f32x4* p = (const PG8_LAS f32x4*)(rssl + (ai * HALF + wr * 64 + m * 16 + fr) * 8); const f32x4 a = p[0], b = p[1];
                const float c = __builtin_amdgcn_sqrtf((((a[0] + a[1]) + (a[2] + a[3])) + ((b[0] + b[1]) + (b[2] + b[3]))) * inv_n + eps);
#pragma unroll
                for (int bj = 0; bj < 2; ++bj)
#pragma unroll
                    for (int n = 0; n < 2; ++n) acc[ai][bj][m][n] = acc[ai][bj][m][n] * c; }
    }
    __device__ __forceinline__ void operator()(const f32x4 (&acc)[2][2][4][2], const Unit& u, int wr, int wc, int fr, int fq) const {
        const int nai = u.mh < 0 ? 2 : 1, row0 = u.pm * BM + (u.mh > 0 ? HALF : 0) + wr * 64 + fr, col0 = u.pn * BM + wc * 32 + 8 * fq;
#pragma unroll
        for (int ai = 0; ai < 2; ++ai) if (ai < nai) {
            u32x4 xin[4][2];
#pragma unroll
            for (int m = 0; m < 4; ++m)
#pragma unroll
                for (int bj = 0; bj < 2; ++bj) xin[m][bj] = *(const u32x4*)(XB + (size_t)(row0 + ai * HALF + m * 16) * ldc + col0 + bj * HALF);
#pragma unroll
            for (int m = 0; m < 4; ++m) { const int row = row0 + ai * HALF + m * 16; bf16_t* rowb = XB + (size_t)row * ldc + col0; float ss = 0.f;
                const float scale = MIDS ? this->scale * row_rnorm_lds(rssl, ai * HALF + wr * 64 + m * 16 + fr, inv_n, eps) : this->scale;
#pragma unroll
                for (int bj = 0; bj < 2; ++bj) { const u32x4 xo = xin[m][bj]; const f32x4 a0 = acc[ai][bj][m][0], a1 = acc[ai][bj][m][1];
                    f32x4 v0, v1;
                    v0[0] = __uint_as_float(xo.x << 16) + a0[0] * scale; v0[1] = __uint_as_float(xo.x & 0xffff0000u) + a0[1] * scale; v0[2] = __uint_as_float(xo.y << 16) + a0[2] * scale; v0[3] = __uint_as_float(xo.y & 0xffff0000u) + a0[3] * scale;
                    v1[0] = __uint_as_float(xo.z << 16) + a1[0] * scale; v1[1] = __uint_as_float(xo.z & 0xffff0000u) + a1[1] * scale; v1[2] = __uint_as_float(xo.w << 16) + a1[2] * scale; v1[3] = __uint_as_float(xo.w & 0xffff0000u) + a1[3] * scale;
                    ss += (v0[0] * v0[0] + v0[1] * v0[1]) + (v0[2] * v0[2] + v0[3] * v0[3]) + (v1[0] * v1[0] + v1[1] * v1[1]) + (v1[2] * v1[2] + v1[3] * v1[3]);
                    u32x4 w; w.x = cvt_pk_bf16(v0[0], v0[1]); w.y = cvt_pk_bf16(v0[2], v0[3]); w.z = cvt_pk_bf16(v1[0], v1[1]); w.w = cvt_pk_bf16(v1[2], v1[3]);
                    *(u32x4*)(rowb + bj * HALF) = w;
                    if (XB8) { int w0 = __builtin_amdgcn_cvt_pk_fp8_f32(v0[0], v0[1], 0, false); w0 = __builtin_amdgcn_cvt_pk_fp8_f32(v0[2], v0[3], w0, true);
                        int w1 = __builtin_amdgcn_cvt_pk_fp8_f32(v1[0], v1[1], 0, false); w1 = __builtin_amdgcn_cvt_pk_fp8_f32(v1[2], v1[3], w1, true);
                        u32x2 w8; w8.x = (unsigned)w0; w8.y = (unsigned)w1; *(u32x2*)(XB8 + (size_t)row * ldc + col0 + bj * HALF) = w8; } }
                ss += __shfl_xor(ss, 16); ss += __shfl_xor(ss, 32);
                if (fq == 0) red[(ai * HALF + wr * 64 + m * 16 + fr) * 4 + wc] = ss; }
            asm volatile("" ::: "memory"); }
        asm volatile("s_waitcnt lgkmcnt(0)" ::: "memory"); __builtin_amdgcn_s_barrier(); asm volatile("" ::: "memory");
        { const int t = (wr * 4 + wc) * 64 + fq * 16 + fr;
          if (t < nai * HALF) { const f32x4 q = *(const PG8_LAS f32x4*)(red + t * 4); rss_out[((size_t)u.pm * BM + (u.mh > 0 ? HALF : 0) + t) * 8 + u.pn] = (q[0] + q[1]) + (q[2] + q[3]); } }
    }
};
struct EpiStoreBf16 {
    static constexpr bool MID = false;
    static constexpr bool PERM = true, AFTER_DRAIN = false;
    static constexpr bool RSS = true;
    bf16_t* O; int ldc; const float* rss; const PG8_LAS float* rssl; float inv_n, eps; bf16_t* UG; int ucol0, ug_chunks, ug_ld;
    __device__ __forceinline__ void operator()(const f32x4 (&acc)[2][2][4][2], const Unit& u, int wr, int wc, int fr, int fq) const {
        const int nai = u.mh < 0 ? 2 : 1, row0 = u.pm * BM + (u.mh > 0 ? HALF : 0) + wr * 64 + fr, col0 = u.pn * BM + wc * 32 + 8 * fq; const bool isu = (u.pn * BM >= ucol0);
#pragma unroll
        for (int ai = 0; ai < 2; ++ai) if (ai < nai)
#pragma unroll
            for (int m = 0; m < 4; ++m) { const int row = row0 + ai * HALF + m * 16; const float r = row_rnorm_lds(rssl, ai * HALF + wr * 64 + m * 16 + fr, inv_n, eps);
#pragma unroll
                for (int bj = 0; bj < 2; ++bj) { const f32x4 v0 = acc[ai][bj][m][0] * r, v1 = acc[ai][bj][m][1] * r;
                    u32x4 w; w.x = cvt_pk_bf16(v0[0], v0[1]); w.y = cvt_pk_bf16(v0[2], v0[3]); w.z = cvt_pk_bf16(v1[0], v1[1]); w.w = cvt_pk_bf16(v1[2], v1[3]);
                    const int c = col0 + bj * HALF;
                    bf16_t* dst = isu ? UG + ((size_t)((c - ucol0) >> 4) * ug_chunks + (row >> 4)) * ug_ld + (row & 15) * 16 + (c & 15) : O + (size_t)row * ldc + c;
                    *(u32x4*)dst = w; } }
    }
};
struct EpiSloc {
    static constexpr bool MID = false;
    static constexpr bool RSS = false;
    static constexpr bool PERM = false, AFTER_DRAIN = false;
    float* S; int cpg, nchunk, ngrp;
    __device__ __forceinline__ void operator()(const f32x4 (&acc)[2][2][4][2], const Unit& u, int wr, int wc, int fr, int fq) const {
        const int nai = u.mh < 0 ? 2 : 1, R0 = u.pm * BM + (u.mh > 0 ? HALF : 0) + wr * 64 + fr, g = R0 / cpg, c0 = R0 - g * cpg, col0 = wc * 32 + 4 * fq;
#pragma unroll
        for (int ai = 0; ai < 2; ++ai) if (ai < nai)
#pragma unroll
            for (int m = 0; m < 4; ++m) { const int chunk = c0 + ai * HALF + m * 16; if (chunk < nchunk) { float* p = S + ((size_t)chunk * ngrp + g) * 128 + col0;
#pragma unroll
                for (int n = 0; n < 2; ++n) *(f32x4*)(p + n * 16) = acc[ai][0][m][n]; } }
    }
};
struct EpiYs {
    static constexpr bool MID = false;
    static constexpr bool RSS = false;
    static constexpr bool PERM = true, AFTER_DRAIN = false;
    bf16_t* Y; int ldy, cpg, nchunk;
    __device__ __forceinline__ void operator()(const f32x4 (&acc)[2][2][4][2], const Unit& u, int wr, int wc, int fr, int fq) const {
        const int nai = u.mh < 0 ? 2 : 1, R0 = u.pm * BM + (u.mh > 0 ? HALF : 0) + wr * 64 + fr, g = R0 / cpg, c0 = R0 - g * cpg, col0 = wc * 32 + 8 * fq;
#pragma unroll
        for (int ai = 0; ai < 2; ++ai) if (ai < nai)
#pragma unroll
            for (int m = 0; m < 4; ++m) { const int chunk = c0 + ai * HALF + m * 16; if (chunk < nchunk) {
#pragma unroll
                for (int bj = 0; bj < 2; ++bj) { const int c = col0 + bj * HALF; float o[8];
#pragma unroll
                    for (int n = 0; n < 2; ++n)
#pragma unroll
                        for (int j = 0; j < 4; ++j) { const float x = acc[ai][bj][m][n][j]; const float z = 0.7978845608028654f * (x + 0.044715f * x * x * x); o[4 * n + j] = x * fast_sigmoid(2.0f * z); }
                    u32x4 w; w.x = cvt_pk_bf16(o[0], o[1]); w.y = cvt_pk_bf16(o[2], o[3]); w.z = cvt_pk_bf16(o[4], o[5]); w.w = cvt_pk_bf16(o[6], o[7]);
                    *(u32x4*)(Y + ((size_t)chunk * 16 + (c >> 4)) * ldy + g * 16 + (c & 15)) = w; } } }
    }
};
struct EpiGlu {
    static constexpr bool MID = false;
    static constexpr bool RSS = false;
    static constexpr bool PERM = true, AFTER_DRAIN = false;
    const bf16_t* Y; int ldy; bf16_t* O; int ldo; float* rss_out; PG8_LAS float* red;
    __device__ __forceinline__ void operator()(const f32x4 (&acc)[2][2][4][2], const Unit& u, int wr, int wc, int fr, int fq) const {
        const int nai = u.mh < 0 ? 2 : 1, row0 = u.pm * BM + (u.mh > 0 ? HALF : 0) + wr * 64 + fr, col0 = u.pn * BM + wc * 32 + 8 * fq;
#pragma unroll
        for (int ai = 0; ai < 2; ++ai) if (ai < nai) {
            u32x4 yin[4][2];
#pragma unroll
            for (int m = 0; m < 4; ++m)
#pragma unroll
                for (int bj = 0; bj < 2; ++bj) yin[m][bj] = *(const u32x4*)(Y + (size_t)(row0 + ai * HALF + m * 16) * ldy + col0 + bj * HALF);
#pragma unroll
            for (int m = 0; m < 4; ++m) { const size_t r = (size_t)(row0 + ai * HALF + m * 16); float ss = 0.f;
#pragma unroll
                for (int bj = 0; bj < 2; ++bj) { const u32x4 yv = yin[m][bj]; const f32x4 z0 = acc[ai][bj][m][0], z1 = acc[ai][bj][m][1];
                    float o[8];
#pragma unroll
                    for (int q = 0; q < 4; ++q) { const unsigned w = yv[q]; const float ylo = __uint_as_float(w << 16), yhi = __uint_as_float(w & 0xffff0000u);
                        const float za = (q < 2) ? z0[2 * q] : z1[2 * q - 4], zb = (q < 2) ? z0[2 * q + 1] : z1[2 * q - 3];
                        o[2 * q] = ylo * fast_sigmoid(za); o[2 * q + 1] = yhi * fast_sigmoid(zb); ss += o[2 * q] * o[2 * q] + o[2 * q + 1] * o[2 * q + 1]; }
                    u32x4 w; w.x = cvt_pk_bf16(o[0], o[1]); w.y = cvt_pk_bf16(o[2], o[3]); w.z = cvt_pk_bf16(o[4], o[5]); w.w = cvt_pk_bf16(o[6], o[7]);
                    *(u32x4*)(O + r * ldo + col0 + bj * HALF) = w; }
                ss += __shfl_xor(ss, 16); ss += __shfl_xor(ss, 32);
                if (fq == 0) red[(ai * HALF + wr * 64 + m * 16 + fr) * 4 + wc] = ss; }
            asm volatile("" ::: "memory"); }
        asm volatile("s_waitcnt lgkmcnt(0)" ::: "memory"); __builtin_amdgcn_s_barrier(); asm volatile("" ::: "memory");
        { const int t = (wr * 4 + wc) * 64 + fq * 16 + fr;
          if (t < nai * HALF) { const f32x4 q = *(const PG8_LAS f32x4*)(red + t * 4); float* ro = rss_out + ((size_t)u.pm * BM + (u.mh > 0 ? HALF : 0) + t) * 8 + u.pn; ro[0] = (q[0] + q[1]) + (q[2] + q[3]); ro[4] = 0.f; } }
    }
};
struct EpiSwigluQ {
    static constexpr bool MID = false, RSS = false;
    static constexpr bool PERM = true, AFTER_DRAIN = false;
    const float* QF; unsigned char* H; const float* CSG; int ldc; const float* CSU; int f8; float oscale;
    __device__ __forceinline__ void operator()(const f32x4 (&acc)[2][2][4][2], const Unit& u, int wr, int wc, int fr, int fq) const {
        const int nai = u.mh < 0 ? 2 : 1, row0 = u.pm * BM + (u.mh > 0 ? HALF : 0) + wr * 64 + fr, col0 = u.pn * HALF + wc * 32 + 8 * fq;
        f32x4 cg[2], cu[2]; cg[0] = *(const f32x4*)(CSG + col0); cg[1] = *(const f32x4*)(CSG + col0 + 4); cu[0] = *(const f32x4*)(CSU + col0) * oscale; cu[1] = *(const f32x4*)(CSU + col0 + 4) * oscale;
        float qf[2][4];
#pragma unroll
        for (int ai = 0; ai < 2; ++ai)
#pragma unroll
            for (int m = 0; m < 4; ++m) qf[ai][m] = (ai < nai) ? QF[row0 + ai * HALF + m * 16] : 0.f;
#pragma unroll
        for (int ai = 0; ai < 2; ++ai) if (ai < nai)
#pragma unroll
            for (int m = 0; m < 4; ++m) { const int row = row0 + ai * HALF + m * 16;
                float o[8];
#pragma unroll
                for (int n = 0; n < 2; ++n)
#pragma unroll
                    for (int j = 0; j < 4; j += 2) { const f32x4 ag = acc[ai][0][m][n], au = acc[ai][1][m][n];
                        const float g0 = ag[j], g1 = ag[j + 1], u0 = au[j], u1 = au[j + 1];
                        const f32x2 g = ((f32x2){(float)__float_as_int(g0), (float)__float_as_int(g1)} * qf[ai][m]) * (f32x2){cg[n][j], cg[n][j + 1]};
                        const f32x2 up = ((f32x2){(float)__float_as_int(u0), (float)__float_as_int(u1)} * qf[ai][m]) * (f32x2){cu[n][j], cu[n][j + 1]};
                        f32x2 e = g * (-1.4426950408889634f); e.x = __builtin_amdgcn_exp2f(e.x); e.y = __builtin_amdgcn_exp2f(e.y); e = e + 1.0f;
                        f32x2 sgm; sgm.x = __builtin_amdgcn_rcpf(e.x); sgm.y = __builtin_amdgcn_rcpf(e.y);
                        const f32x2 ov = (g * up) * sgm; o[4 * n + j] = ov.x; o[4 * n + j + 1] = ov.y; }
                if (f8) {
                    int w0 = __builtin_amdgcn_cvt_pk_fp8_f32(o[0], o[1], 0, false); w0 = __builtin_amdgcn_cvt_pk_fp8_f32(o[2], o[3], w0, true);
                    int w1 = __builtin_amdgcn_cvt_pk_fp8_f32(o[4], o[5], 0, false); w1 = __builtin_amdgcn_cvt_pk_fp8_f32(o[6], o[7], w1, true);
                    u32x2 w; w.x = (unsigned)w0; w.y = (unsigned)w1; *(u32x2*)(H + (size_t)row * ldc + col0) = w;
                } else {
                    u32x4 w; w.x = cvt_pk_bf16(o[0], o[1]); w.y = cvt_pk_bf16(o[2], o[3]); w.z = cvt_pk_bf16(o[4], o[5]); w.w = cvt_pk_bf16(o[6], o[7]);
                    *(u32x4*)((bf16_t*)H + (size_t)row * ldc + col0) = w; } }
    }
};
template <class Epi, class Sched, bool ALIGN_EPI = false, bool SP2 = false, int FP8 = 0, bool HM = false>
__device__ __forceinline__ void gemm_phase(PG8_LAS unsigned char* lds, const Gemm g, const Sched& S, const Epi& E, const int tid_in) {   constexpr bool hm = HM;
    const int tid = tid_in, wid = __builtin_amdgcn_readfirstlane(tid >> 6), lane = tid & 63, wr = wid >> 2, wc = wid & 3, fr = lane & 15, fq = lane >> 4;
    const int K = g.K, nt = K / BK;
    unsigned voffA[2], voffB[2];
#pragma unroll
    for (int i = 0; i < 2; ++i) { int R, C; stage_rc(tid * 16 + i * 8192, R, C); const int Rb = Epi::PERM ? ((R & ~31) + perm32(R & 31)) : R;
        voffA[i] = (unsigned)(R * g.lda + C) * 2u; voffB[i] = (unsigned)(Rb * g.ldb + C) * 2u; }
    const size_t kstep = (size_t)(BK * 2);
    const size_t hstepA = (size_t)HALF * g.lda * 2, hstepB = (size_t)HALF * g.ldb * 2;
    const size_t tstepA = 2 * hstepA, tstepB = 2 * hstepB;
    const unsigned ldsw = (unsigned)wid * 1024u;
    const int aoff = lds_byte(wr * 64 + fr, fq * 8), boff = lds_byte(wc * 32 + fr, fq * 8);
#define PG8_SA(b, h) (((b) * 2 + (h)) * HTB)
#define PG8_SB(b, h) ((4 + (b) * 2 + (h)) * HTB)
#define PG8_STAGE(bufoff, gbase, voff) do { _Pragma("unroll") for (int _i = 0; _i < 2; ++_i) \
        __builtin_amdgcn_global_load_lds((const unsigned*)((const char*)(gbase) + (voff)[_i]), (PG8_LAS unsigned*)(lds + (bufoff) + ldsw + _i * 8192), 16, 0, 0); } while (0)
#define PG8_LDA(dst, b, h) do { if constexpr (FP8 == 1) { _Pragma("unroll") for (int m = 0; m < 4; ++m) { const i32x4 lo_ = *(const PG8_LAS i32x4*)(lds + PG8_SA(b, h) + aoff + m * 2048), hi_ = *(const PG8_LAS i32x4*)(lds + PG8_SA(b, h) + aoff + m * 2048 + 1024); \
            dst##8[m] = __builtin_shufflevector(lo_, hi_, 0, 1, 2, 3, 4, 5, 6, 7); } } \
        else { _Pragma("unroll") for (int m = 0; m < 4; ++m) _Pragma("unroll") for (int k = 0; k < 2; ++k) dst[m][k] = *(const PG8_LAS bf16x8*)(lds + PG8_SA(b, h) + aoff + m * 2048 + k * 1024); } } while (0)
#define PG8_LDB(dst, b, h) do { if constexpr (FP8 == 1) { _Pragma("unroll") for (int n = 0; n < 2; ++n) { const i32x4 lo_ = *(const PG8_LAS i32x4*)(lds + PG8_SB(b, h) + boff + n * 2048), hi_ = *(const PG8_LAS i32x4*)(lds + PG8_SB(b, h) + boff + n * 2048 + 1024); \
            dst##8[n] = __builtin_shufflevector(lo_, hi_, 0, 1, 2, 3, 4, 5, 6, 7); } } \
        else { _Pragma("unroll") for (int n = 0; n < 2; ++n) _Pragma("unroll") for (int k = 0; k < 2; ++k) dst[n][k] = *(const PG8_LAS bf16x8*)(lds + PG8_SB(b, h) + boff + n * 2048 + k * 1024); } } while (0)
#define PG8_MMA(ai, bj, At, Bt) do { __builtin_amdgcn_s_setprio(1); \
        if constexpr (FP8 == 1) { _Pragma("unroll") for (int m = 0; m < 4; ++m) _Pragma("unroll") for (int n = 0; n < 2; ++n) \
            asm volatile("v_mfma_scale_f32_16x16x128_f8f6f4 %0, %1, %2, %0, %3, %3 op_sel_hi:[0,0,0]" : "+v"(acc[ai][bj][m][n]) : "v"(Bt##8[n]), "v"(At##8[m]), "v"(one_scale)); } \
        else if constexpr (FP8 == 2) { _Pragma("unroll") for (int m = 0; m < 4; ++m) _Pragma("unroll") for (int n = 0; n < 2; ++n) _Pragma("unroll") for (int k = 0; k < 2; ++k) \
            acc[ai][bj][m][n] = __builtin_bit_cast(f32x4, __builtin_amdgcn_mfma_i32_16x16x64_i8(__builtin_bit_cast(i32x4, Bt[n][k]), __builtin_bit_cast(i32x4, At[m][k]), __builtin_bit_cast(i32x4, acc[ai][bj][m][n]), 0, 0, 0)); } \
        else { _Pragma("unroll") for (int m = 0; m < 4; ++m) _Pragma("unroll") for (int n = 0; n < 2; ++n) _Pragma("unroll") for (int k = 0; k < 2; ++k) \
            acc[ai][bj][m][n] = __builtin_amdgcn_mfma_f32_16x16x32_bf16(Bt[n][k], At[m][k], acc[ai][bj][m][n], 0, 0, 0); } \
        __builtin_amdgcn_s_setprio(0); } while (0)
#define PG8_RSS_DMA() do { if constexpr (Epi::RSS) { if (t == 0) __builtin_amdgcn_global_load_lds((const unsigned*)((const char*)E.rss + ((size_t)cur.pm * BM + (cur.mh > 0 ? HALF : 0)) * 32 + (size_t)tid * 16), \
        (PG8_LAS unsigned*)((PG8_LAS unsigned char*)E.rssl + ldsw), 16, 0, 0); } } while (0)
#define PG8_WAIT_V(n) asm volatile("s_waitcnt vmcnt(" #n ")" ::: "memory")
#define PG8_WAIT_L(n) asm volatile("s_waitcnt lgkmcnt(" #n ")" ::: "memory")
#define PG8_BAR __builtin_amdgcn_s_barrier()
#define PG8_SCHED __builtin_amdgcn_sched_barrier(0)
    Unit cur, nxt; int ui = 0;
    if (!S.next(0, cur)) return;
    f32x4 acc[2][2][4][2];
#pragma unroll
    for (int a = 0; a < 2; ++a)
#pragma unroll
        for (int b = 0; b < 2; ++b)
#pragma unroll
            for (int m = 0; m < 4; ++m)
#pragma unroll
                for (int n = 0; n < 2; ++n) acc[a][b][m][n] = (f32x4){0.f, 0.f, 0.f, 0.f};
    int one_scale = 0x7f7f7f7f; asm volatile("" : "+v"(one_scale));
    bf16x8 At[4][2], B0[2][2], B1[2][2]; i32x8 At8[4], B08[2], B18[2];
    const char* cA = (const char*)g.A + (size_t)cur.pm * tstepA + (cur.mh > 0 ? hstepA : (size_t)0); const char* cB = (const char*)g.Bt + (size_t)cur.pn * tstepB + (g.gpanels ? (size_t)(cur.pm / g.gpanels) * g.gstride : (size_t)0);
    S.a_ready(cur);
    if constexpr (SP2) {
        if constexpr (HM) {
        PG8_STAGE(PG8_SB(0, 0), cB, voffB); PG8_STAGE(PG8_SB(0, 1), cB + hstepB, voffB); PG8_STAGE(PG8_SA(0, 0), cA, voffA);
        if (wr == 1) PG8_BAR;
        PG8_WAIT_V(0); PG8_BAR;
        PG8_STAGE(PG8_SB(1, 0), cB + kstep, voffB); PG8_STAGE(PG8_SA(1, 0), cA + kstep, voffA); PG8_STAGE(PG8_SB(1, 1), cB + hstepB + kstep, voffB);
        PG8_BAR;
        } else {
        PG8_STAGE(PG8_SB(0, 0), cB, voffB); PG8_STAGE(PG8_SB(0, 1), cB + hstepB, voffB); PG8_STAGE(PG8_SA(0, 0), cA, voffA); PG8_STAGE(PG8_SA(0, 1), cA + hstepA, voffA);
        if (wr == 1) PG8_BAR;
        PG8_WAIT_V(2); PG8_BAR;
        PG8_STAGE(PG8_SB(1, 0), cB + kstep, voffB); PG8_STAGE(PG8_SA(1, 0), cA + kstep, voffA); PG8_STAGE(PG8_SB(1, 1), cB + hstepB + kstep, voffB);
        PG8_WAIT_V(6); PG8_BAR;
        }
    } else {
        PG8_STAGE(PG8_SB(0, 0), cB, voffB); PG8_STAGE(PG8_SA(0, 0), cA, voffA); PG8_STAGE(PG8_SB(0, 1), cB + hstepB, voffB); PG8_STAGE(PG8_SA(0, 1), cA + hstepA, voffA);
        if (wr == 1) PG8_BAR;
        PG8_WAIT_V(4); PG8_BAR;
        PG8_STAGE(PG8_SB(1, 0), cB + kstep, voffB); PG8_STAGE(PG8_SA(1, 0), cA + kstep, voffA); PG8_STAGE(PG8_SB(1, 1), cB + hstepB + kstep, voffB);
        PG8_WAIT_V(6); PG8_BAR;
    }
    for (;;) {
        const bool has_next = S.next(ui + 1, nxt);
        const char* nA = has_next ? (const char*)g.A + (size_t)nxt.pm * tstepA + (nxt.mh > 0 ? hstepA : (size_t)0) : cA; const char* nB = has_next ? (const char*)g.Bt + (size_t)nxt.pn * tstepB + (g.gpanels ? (size_t)(nxt.pm / g.gpanels) * g.gstride : (size_t)0) : cB;
#pragma nounroll
        for (int t = 0; t < nt; t += 2) {
            const bool last = (t == nt - 2);
            const char* a1 = cA + (size_t)(t + 1) * kstep;
            const char* a2 = last ? nA : cA + (size_t)(t + 2) * kstep; const char* b2 = last ? nB : cB + (size_t)(t + 2) * kstep;
            const char* a3 = a2 + kstep; const char* b3 = b2 + kstep;
            if (last && has_next) S.a_ready(nxt);
            if constexpr (Epi::MID) { if (t == (nt >> 1)) E.mid(acc, cur, wr, fr); }
            if constexpr (SP2) {
            if constexpr (HM) {
            PG8_LDB(B0, 0, 0); PG8_LDB(B1, 0, 1); PG8_SCHED; PG8_LDA(At, 0, 0);
            PG8_WAIT_L(0); PG8_BAR; PG8_RSS_DMA(); PG8_MMA(0, 0, At, B0); PG8_MMA(0, 1, At, B1); PG8_BAR; PG8_SCHED;
            PG8_STAGE(PG8_SB(0, 0), b2, voffB); PG8_STAGE(PG8_SB(0, 1), b2 + hstepB, voffB); PG8_STAGE(PG8_SA(0, 0), a2, voffA);
            PG8_WAIT_V(6); PG8_BAR; PG8_BAR; PG8_SCHED;
            PG8_LDB(B0, 1, 0); PG8_LDB(B1, 1, 1); PG8_SCHED; PG8_LDA(At, 1, 0);
            PG8_WAIT_L(0); PG8_BAR; PG8_MMA(0, 0, At, B0); PG8_MMA(0, 1, At, B1); PG8_BAR; PG8_SCHED;
            PG8_STAGE(PG8_SB(1, 0), b3, voffB); PG8_STAGE(PG8_SB(1, 1), b3 + hstepB, voffB); PG8_STAGE(PG8_SA(1, 0), a3, voffA);
            PG8_WAIT_V(6); PG8_BAR; PG8_BAR; PG8_SCHED;
            } else {
            PG8_LDB(B0, 0, 0); PG8_LDB(B1, 0, 1); PG8_SCHED; PG8_LDA(At, 0, 0); PG8_STAGE(PG8_SA(1, 1), a1 + hstepA, voffA);
            PG8_WAIT_V(8); PG8_WAIT_L(0); PG8_BAR; PG8_RSS_DMA(); PG8_MMA(0, 0, At, B0); PG8_MMA(0, 1, At, B1); PG8_BAR; PG8_SCHED;
            PG8_LDA(At, 0, 1); PG8_STAGE(PG8_SB(0, 0), b2, voffB); PG8_STAGE(PG8_SB(0, 1), b2 + hstepB, voffB); PG8_STAGE(PG8_SA(0, 0), a2, voffA);
            PG8_WAIT_V(8); PG8_WAIT_L(0); PG8_BAR; PG8_MMA(1, 0, At, B0); PG8_MMA(1, 1, At, B1); PG8_BAR; PG8_SCHED;
            PG8_LDB(B0, 1, 0); PG8_LDB(B1, 1, 1); PG8_SCHED; PG8_LDA(At, 1, 0); PG8_STAGE(PG8_SA(0, 1), a2 + hstepA, voffA);
            PG8_WAIT_V(8); PG8_WAIT_L(0); PG8_BAR; PG8_MMA(0, 0, At, B0); PG8_MMA(0, 1, At, B1); PG8_BAR; PG8_SCHED;
            PG8_LDA(At, 1, 1); PG8_STAGE(PG8_SB(1, 0), b3, voffB); PG8_STAGE(PG8_SB(1, 1), b3 + hstepB, voffB); PG8_STAGE(PG8_SA(1, 0), a3, voffA);
            PG8_WAIT_V(8); PG8_WAIT_L(0); PG8_BAR; PG8_MMA(1, 0, At, B0); PG8_MMA(1, 1, At, B1); PG8_BAR; PG8_SCHED;
            }
            } else {
            PG8_LDB(B0, 0, 0); PG8_SCHED; PG8_LDA(At, 0, 0); PG8_STAGE(PG8_SA(1, 1), a1 + hstepA, voffA);
            PG8_WAIT_L(8); PG8_BAR; PG8_WAIT_L(0); PG8_MMA(0, 0, At, B0); PG8_BAR; PG8_SCHED;
            PG8_LDB(B1, 0, 1); PG8_STAGE(PG8_SB(0, 0), b2, voffB);
            PG8_BAR; PG8_WAIT_L(0); PG8_MMA(0, 1, At, B1); PG8_BAR;
            PG8_LDA(At, 0, 1); PG8_STAGE(PG8_SA(0, 0), a2, voffA);
            PG8_BAR; PG8_WAIT_L(0); PG8_MMA(1, 0, At, B0); PG8_BAR; PG8_SCHED;
            PG8_STAGE(PG8_SB(0, 1), b2 + hstepB, voffB);
            PG8_WAIT_V(6); PG8_BAR; PG8_MMA(1, 1, At, B1); PG8_BAR;
            PG8_LDB(B0, 1, 0); PG8_SCHED; PG8_LDA(At, 1, 0); PG8_STAGE(PG8_SA(0, 1), a2 + hstepA, voffA);
            PG8_WAIT_L(8); PG8_BAR; PG8_WAIT_L(0); PG8_MMA(0, 0, At, B0); PG8_BAR; PG8_SCHED;
            PG8_LDB(B1, 1, 1); PG8_STAGE(PG8_SB(1, 0), b3, voffB);
            PG8_BAR; PG8_WAIT_L(0); PG8_MMA(0, 1, At, B1); PG8_BAR;
            PG8_LDA(At, 1, 1); PG8_STAGE(PG8_SA(1, 0), a3, voffA);
            PG8_BAR; PG8_WAIT_L(0); PG8_MMA(1, 0, At, B0); PG8_BAR; PG8_SCHED;
            PG8_STAGE(PG8_SB(1, 1), b3 + hstepB, voffB);
            PG8_WAIT_V(6); PG8_BAR; PG8_MMA(1, 1, At, B1); PG8_BAR;
            }
        }
        if constexpr (ALIGN_EPI) { if (wr == 0) PG8_BAR; }
        if constexpr (!Epi::AFTER_DRAIN) {
            if constexpr (FP8 == 1) asm volatile("s_nop 15\n\ts_nop 15" ::: "memory");
            int tz = tid; asm volatile("" : "+v"(tz)); const int lz = tz & 63, wz = __builtin_amdgcn_readfirstlane(tz >> 6);
            E(acc, cur, wz >> 2, wz & 3, lz & 15, lz >> 4); S.done(cur); }
        if (!has_next) break;
#pragma unroll
        for (int a = 0; a < 2; ++a)
#pragma unroll
            for (int b = 0; b < 2; ++b)
#pragma unroll
                for (int m = 0; m < 4; ++m)
#pragma unroll
                    for (int n = 0; n < 2; ++n) acc[a][b][m][n] = (f32x4){0.f, 0.f, 0.f, 0.f};
        cur = nxt; cA = nA; cB = nB; ++ui;
        if constexpr (ALIGN_EPI) { if (wr == 1) PG8_BAR; }
    }
    PG8_WAIT_V(0);
    if constexpr (!ALIGN_EPI) { if (wr == 0) PG8_BAR; }
    PG8_BAR;
    if constexpr (Epi::AFTER_DRAIN) { E.fused(acc, cur, wr, wc, fr, fq, lds, wid, lane); S.done(cur); }
#undef PG8_SA
#undef PG8_SB
#undef PG8_STAGE
#undef PG8_LDA
#undef PG8_LDB
#undef PG8_MMA
#undef PG8_WAIT_V
#undef PG8_RSS_DMA
#undef PG8_WAIT_L
#undef PG8_BAR
#undef PG8_SCHED
}
}
#define GAS __attribute__((address_space(1)))
#define LAS __attribute__((address_space(3)))
typedef unsigned short bf16;
typedef unsigned v4u __attribute__((ext_vector_type(4)));
typedef float f32x4 __attribute__((ext_vector_type(4)));
typedef short bf16x8 __attribute__((ext_vector_type(8)));
typedef GAS unsigned gu32;
typedef GAS unsigned long long gu64;
#define RLX_AGENT __ATOMIC_RELAXED, __HIP_MEMORY_SCOPE_AGENT
#define LDS_WAIT() asm volatile("s_waitcnt lgkmcnt(0)" ::: "memory")
#define VM_WAIT() asm volatile("s_waitcnt vmcnt(0)" ::: "memory")
__device__ __forceinline__ unsigned long long rt() { return __builtin_amdgcn_s_memrealtime(); }
__device__ __forceinline__ unsigned f2bf(float f) { unsigned u = __builtin_bit_cast(unsigned, f); return (u + 0x7fffu + ((u >> 16) & 1u)) >> 16; }
__device__ __forceinline__ unsigned pk2(float lo, float hi) { return f2bf(lo) | (f2bf(hi) << 16); }

#define XB_TMO      128
#define XB_XCNT(j)  (256  + 64 * (j))
#define XB_XSUB(j)  (1280 + 64 * (j))
#define XB_XGEN(j)  (2304 + 64 * (j))
#define XB_TOP      3328
#define XB_TOPGEN   3392
#define XCD_BAR_WORDS 3456
#define XB_SPIN_CAP (1u << 18)

__device__ __forceinline__ unsigned xb_ld(unsigned* p)              { return __hip_atomic_load(p, __ATOMIC_RELAXED, __HIP_MEMORY_SCOPE_AGENT); }
__device__ __forceinline__ unsigned xb_add(unsigned* p, unsigned v) { return __hip_atomic_fetch_add(p, v, __ATOMIC_RELAXED, __HIP_MEMORY_SCOPE_AGENT); }
__device__ __forceinline__ unsigned xb_xcc_id() { return (unsigned)__builtin_amdgcn_s_getreg((3 << 11) | 20) & 0xFu; }
#define XB_SPIN(cond, bar) do { unsigned _sp = 0; while (cond) { __builtin_amdgcn_s_sleep(1); \
    if ((++_sp & 255u) == 0u) { if (xb_ld(&(bar)[XB_TMO])) break; if (_sp > XB_SPIN_CAP) { atomicAdd(&(bar)[XB_TMO], 1u); break; } } } } while (0)

struct XcdBarrier {
    unsigned* bar; unsigned x;
    volatile LAS unsigned* st;
};

__device__ __forceinline__ XcdBarrier xcd_barrier_post(unsigned* bar, volatile LAS unsigned* st) {
    XcdBarrier b; b.bar = bar; b.x = xb_xcc_id(); b.st = st;
    if (threadIdx.x == 0) (void)xb_add(&bar[XB_XCNT(b.x)], 1u);
    return b;
}
__device__ __forceinline__ void xcd_barrier_complete(unsigned* bar, unsigned x, unsigned& nloc, unsigned& nx) {
    const unsigned G = gridDim.x * gridDim.y * gridDim.z;
    unsigned sum, cnt, mine, sp = 0u;
    for (;;) {
        sum = 0u; cnt = 0u; mine = 0u;
#pragma unroll
        for (unsigned j = 0; j < 16; ++j) { const unsigned c = xb_ld(&bar[XB_XCNT(j)]); sum += c; cnt += (c > 0u) ? 1u : 0u; mine = (j == x) ? c : mine; }
        if (sum == G) break;
        __builtin_amdgcn_s_sleep(1);
        if ((++sp & 255u) == 0u) { if (xb_ld(&bar[XB_TMO])) break; if (sp > XB_SPIN_CAP) { atomicAdd(&bar[XB_TMO], 1u); break; } }
    }
    nloc = mine > 0u ? mine : 1u; nx = cnt > 0u ? cnt : 1u;
}

__device__ __forceinline__ void xcd_barrier(const XcdBarrier& b) {
    asm volatile("s_waitcnt vmcnt(0)" ::: "memory");
    __syncthreads();
    if (threadIdx.x == 0) {
        unsigned* bar = b.bar;
        __builtin_amdgcn_s_waitcnt(0);
        unsigned nloc = b.st[0], nx = b.st[1];
        if (nloc == 0u) { xcd_barrier_complete(bar, b.x, nloc, nx); b.st[0] = nloc; b.st[1] = nx; }
        const unsigned old = xb_add(&bar[XB_XSUB(b.x)], 1u);
        const unsigned gen = old / nloc;
        if (old + 1u == (gen + 1u) * nloc) {
            __builtin_amdgcn_fence(__ATOMIC_RELEASE, "agent");
            asm volatile("s_waitcnt vmcnt(0)" ::: "memory");
            const unsigned og = xb_add(&bar[XB_TOP], 1u);
            const unsigned tg = og / nx;
            if (og + 1u == (tg + 1u) * nx) xb_add(&bar[XB_TOPGEN], 1u);
            else XB_SPIN(xb_ld(&bar[XB_TOPGEN]) == tg, bar);
            __builtin_amdgcn_fence(__ATOMIC_ACQUIRE, "agent");
            xb_add(&bar[XB_XGEN(b.x)], 1u);
            asm volatile("s_waitcnt vmcnt(0)" ::: "memory");
        } else {
            XB_SPIN(xb_ld(&bar[XB_XGEN(b.x)]) == gen, bar);
            __builtin_amdgcn_fence(__ATOMIC_ACQUIRE, "agent");
            asm volatile("s_waitcnt vmcnt(0)" ::: "memory");
        }
    }
    __syncthreads();
}
namespace mk {
typedef float f32x2 __attribute__((ext_vector_type(2)));
typedef unsigned u32x2 __attribute__((ext_vector_type(2)));
constexpr int NWAVES = 8;
constexpr int D = 2048, FF = 5632, DCV = 1024, DSS = 1024, DIN = 4096, NL = 4;
constexpr int SEQ = 16384, NMETA = 16, TP = SEQ + NMETA, NBP = 2, NBS = 8, TS = 32;
constexpr int MPROMPT = NBP * TP;
constexpr int MREAL = MPROMPT + NBS * TS;
constexpr int MPAD = 33280;
constexpr int NCHUNK = MPAD / 16;
constexpr int NCH_REAL = MREAL / 16;
constexpr int CH_PER_SEQ = TP / 16;
constexpr int NCT = NCHUNK / 16;
constexpr int SG = 64, SP = 64, SH = 16;
constexpr float EPS = 1e-6f;
constexpr int FP8_FROM_HL = 3;
constexpr int FP8_UP_FROM = 2 * NL;
constexpr int UPQ_FROM = 0;
constexpr float QALPHA_UNUSED = 5.5f;
constexpr float H8_SCALE = 4.0f, WD8_SCALE = 256.0f, WGU8_SCALE = 256.0f;
static_assert(MPAD % 256 == 0 && MPAD >= MREAL && MREAL % 16 == 0 && TP % 16 == 0 && TS % 4 == 0 && TP >= 8 && TS >= 8, "row geometry");

enum { I_XP = 0, I_XS, I_CACHE, I_SRE, I_SIM, I_META, I_F1N, I_F1G, I_F1U, I_F1D, I_MIXN, I_WIN, I_CONVW, I_CONVN, I_LRE, I_LIM, I_LDT, I_BRE, I_BIM, I_CRE, I_CIM, I_SD,
       I_GLU, I_SSMN, I_WOUT, I_F2N, I_F2G, I_F2U, I_F2D, I_FINN, N_IN };
constexpr size_t O_YP = 0, O_YS = O_YP + (size_t)NBP * SEQ * D, O_CVP = O_YS + (size_t)NBS * TS * D, O_REP = O_CVP + (size_t)NL * NBP * 2 * DCV,
                 O_IMP = O_REP + (size_t)NL * NBP * SG * SP, O_CVS = O_IMP + (size_t)NL * NBP * SG * SP, O_RES = O_CVS + (size_t)NL * NBS * 2 * DCV,
                 O_IMS = O_RES + (size_t)NL * NBS * SG * SP, O_END = O_IMS + (size_t)NL * NBS * SG * SP;
static_assert(O_END == 68042752, "output size");

constexpr size_t CTL_BYTES = 1u << 20;
constexpr int NRSS = 4 * NL + 1;
constexpr size_t ZERO_BYTES = CTL_BYTES;
constexpr size_t RSS_STRIDE = (size_t)MPAD * 8 + 2048;
constexpr size_t WS_RSS = CTL_BYTES;
constexpr size_t WS_XN = WS_RSS + (size_t)NRSS * RSS_STRIDE * 4;
constexpr size_t WS_W = WS_XN + (size_t)MPAD * D * 2;
constexpr size_t W_GU0 = 0;
constexpr size_t W_GU1 = W_GU0 + (size_t)2 * FF * D * 2;
constexpr size_t W_D0 = W_GU1 + (size_t)2 * FF * D * 2;
constexpr size_t W_D1 = W_D0 + (size_t)D * FF * 2;
constexpr size_t W_IN = W_D1 + (size_t)D * FF * 2;
constexpr size_t W_GLU = W_IN + (size_t)DIN * D * 2;
constexpr size_t W_OUT = W_GLU + (size_t)DSS * DSS * 2;
constexpr size_t W_SET = W_OUT + (size_t)D * D * 2;
constexpr size_t WS_WBT = WS_W + 2 * W_SET;
constexpr size_t WS_BMT = WS_WBT + (size_t)SG * 256 * 384 * 2;
constexpr size_t WS_APOW = WS_BMT + (size_t)SG * 256 * 256 * 2;
constexpr int NPOW = 18;
constexpr size_t WS_BBAR = WS_APOW + (size_t)NL * NPOW * SG * SP * 8;
constexpr size_t WS_R = WS_BBAR + (size_t)NL * SG * SP * SH * 8;
constexpr size_t WS_H = WS_R;
constexpr size_t WS_PROJ = WS_R;
constexpr size_t WS_MIXED = WS_PROJ + (size_t)MPAD * DIN * 2;
constexpr size_t WS_YS = WS_MIXED + (size_t)MPAD * D * 2;
constexpr size_t WS_SLOC = WS_YS + (size_t)MPAD * DSS * 2;
constexpr int CPG = 2304, UGLD = 384;
constexpr size_t WS_UG = WS_SLOC + (size_t)NCHUNK * SG * 128 * 4;
constexpr size_t WS_XB8 = WS_UG + (size_t)SG * CPG * UGLD * 2;
constexpr size_t WS_DUMMY_ = 0;
constexpr size_t WS_END_A = WS_H + (size_t)MPAD * FF * 2, WS_PMAXC = WS_XB8 + (size_t)MPAD * D;
constexpr size_t WS_CS = WS_PMAXC + (size_t)4 * 32 * FF * 4;
constexpr size_t WS_QF = WS_CS + (size_t)2 * 4 * FF * 4;
constexpr size_t WS_END_B = WS_QF + (size_t)MPAD * 4 + 256;
constexpr size_t WS_END = WS_END_A > WS_END_B ? WS_END_A : WS_END_B;
static_assert(WS_R % 256 == 0 && WS_SLOC % 256 == 0, "alignment");
constexpr int CW_BAR = 4096;

constexpr int RING_OFF = 0, RING_BYTES = 131072;
constexpr int LDSCTL_OFF = RING_BYTES, MISC_OFF = LDSCTL_OFF + 320;
constexpr int RED_OFF = RING_BYTES + 512, RSSB_OFF = RED_OFF + 4096;
constexpr int LDS_BYTES = 147456;
static_assert(RSSB_OFF + 8192 <= LDS_BYTES && RSSB_OFF % 16 == 0, "LDS map");

__device__ __forceinline__ float wave_sum(float v) {
#pragma unroll
    for (int o = 1; o < 64; o <<= 1) v += __shfl_xor(v, o);
    return v;
}
__device__ __forceinline__ unsigned pkbf(float lo, float hi) { return pg8::cvt_pk_bf16(lo, hi); }
__device__ __forceinline__ float bflo(unsigned w) { return __uint_as_float(w << 16); }
__device__ __forceinline__ float bfhi(unsigned w) { return __uint_as_float(w & 0xffff0000u); }

__device__ __forceinline__ void transpose_item(const float* W, int K, int N, bf16* WT, int mode, const float* gain, LAS float* scr, int item, int lane, float f8scale = 0.f, int gk0 = 0, const float* cs8 = nullptr) {
    const int nblk = N / 32, kb = item / nblk, nb = item % nblk, k0 = 64 * kb, n0 = 32 * nb;
    const int drow0 = (mode == 0) ? n0 : (256 * (n0 >> 7) + 128 * (mode - 1) + (n0 & 127));
    const int nq = lane & 7, kr = lane >> 3;
    f32x4 v[8];
#pragma unroll
    for (int i = 0; i < 8; ++i) v[i] = *(const f32x4*)(W + (size_t)(k0 + kr + 8 * i) * N + n0 + 4 * nq);
#pragma unroll
    for (int i = 0; i < 8; ++i) { const int kk_ = k0 + kr + 8 * i; const float gk = (gain && kk_ >= gk0) ? gain[kk_ - gk0] : 1.0f; LAS float* d = scr + (kr + 8 * i) * 33 + 4 * nq; d[0] = v[i].x * gk; d[1] = v[i].y * gk; d[2] = v[i].z * gk; d[3] = v[i].w * gk; }
    LDS_WAIT(); asm volatile("" ::: "memory");
    const int c = lane & 7;
#pragma unroll
    for (int j = 0; j < 4; ++j) { const int n = (lane >> 3) + 8 * j; const LAS float* s = scr + (8 * c) * 33 + n;
        if (cs8) {
            const float qs = 1.0f / cs8[n0 + n]; unsigned b[8];
#pragma unroll
            for (int e = 0; e < 8; ++e) { float t = s[e * 33] * qs; t = fminf(fmaxf(t, -127.f), 127.f); b[e] = (unsigned)__float2int_rn(t) & 0xffu; }
            u32x2 o; o.x = b[0] | (b[1] << 8) | (b[2] << 16) | (b[3] << 24); o.y = b[4] | (b[5] << 8) | (b[6] << 16) | (b[7] << 24);
            *(u32x2*)((unsigned char*)WT + (size_t)(drow0 + n) * K + k0 + 8 * c) = o;
        } else if (f8scale != 0.f) {
            int w0 = __builtin_amdgcn_cvt_pk_fp8_f32(s[0 * 33] * f8scale, s[1 * 33] * f8scale, 0, false); w0 = __builtin_amdgcn_cvt_pk_fp8_f32(s[2 * 33] * f8scale, s[3 * 33] * f8scale, w0, true);
            int w1 = __builtin_amdgcn_cvt_pk_fp8_f32(s[4 * 33] * f8scale, s[5 * 33] * f8scale, 0, false); w1 = __builtin_amdgcn_cvt_pk_fp8_f32(s[6 * 33] * f8scale, s[7 * 33] * f8scale, w1, true);
            u32x2 o; o.x = (unsigned)w0; o.y = (unsigned)w1; *(u32x2*)((unsigned char*)WT + (size_t)(drow0 + n) * K + k0 + 8 * c) = o;
        } else {
        v4u o; o.x = pkbf(s[0 * 33], s[1 * 33]); o.y = pkbf(s[2 * 33], s[3 * 33]); o.z = pkbf(s[4 * 33], s[5 * 33]); o.w = pkbf(s[6 * 33], s[7 * 33]);
        *(v4u*)(WT + (size_t)(drow0 + n) * K + k0 + 8 * c) = o; } }
    LDS_WAIT(); asm volatile("" ::: "memory");
}

__device__ __forceinline__ void pmaxc_item(const float* W, int N, const float* gain, float* pmc, int item, int lane) {
    const int nblk = N / 32, kb = item / nblk, nb = item % nblk, k0 = 64 * kb, n0 = 32 * nb; const int nq = lane & 7, kr = lane >> 3;
    f32x4 v[8];
#pragma unroll
    for (int i = 0; i < 8; ++i) v[i] = *(const f32x4*)(W + (size_t)(k0 + kr + 8 * i) * N + n0 + 4 * nq);
    f32x4 m = {0.f, 0.f, 0.f, 0.f};
#pragma unroll
    for (int i = 0; i < 8; ++i) { const float gk = fabsf(gain[k0 + kr + 8 * i]); m.x = fmaxf(m.x, fabsf(v[i].x) * gk); m.y = fmaxf(m.y, fabsf(v[i].y) * gk); m.z = fmaxf(m.z, fabsf(v[i].z) * gk); m.w = fmaxf(m.w, fabsf(v[i].w) * gk); }
#pragma unroll
    for (int o = 8; o < 64; o <<= 1) { m.x = fmaxf(m.x, __shfl_xor(m.x, o)); m.y = fmaxf(m.y, __shfl_xor(m.y, o)); m.z = fmaxf(m.z, __shfl_xor(m.z, o)); m.w = fmaxf(m.w, __shfl_xor(m.w, o)); }
    if (lane < 8) *(f32x4*)(pmc + (size_t)kb * N + n0 + 4 * nq) = m;
}
__device__ __forceinline__ void colstep_reduce(const float* pmc, float* cs, int c) {
    const int q = c / FF, n = c - q * FF; const float* p = pmc + (size_t)q * 32 * FF + n; float m = 1e-30f;
#pragma unroll 8
    for (int kb = 0; kb < 32; ++kb) m = fmaxf(m, p[(size_t)kb * FF]);
    cs[c] = m * (1.0f / 127.0f);
}
static_assert((D / 64) * (FF / 32) == 5632, "gate/up item count");
__device__ __forceinline__ void quant_rows2(const bf16* x0, const bf16* x1, const float* rss0, const float* rss1, unsigned char* q0, unsigned char* q1, float* qf0, float* qf1, bool has1, int lane) {
    v4u a[2][4];
#pragma unroll
    for (int c = 0; c < 2; ++c) { const v4u* p0 = (const v4u*)(x0 + c * 1024 + 16 * lane); a[0][2 * c] = p0[0]; a[0][2 * c + 1] = p0[1]; const v4u* p1 = (const v4u*)(x1 + c * 1024 + 16 * lane); a[1][2 * c] = p1[0]; a[1][2 * c + 1] = p1[1]; }
    const float s0 = wave_sum(lane < 8 ? rss0[lane] : 0.f), s1 = wave_sum(lane < 8 ? rss1[lane] : 0.f);
    unsigned mx[2] = {0u, 0u};
#pragma unroll
    for (int w = 0; w < 2; ++w)
#pragma unroll
        for (int i = 0; i < 4; ++i)
#pragma unroll
            for (int d = 0; d < 4; ++d) { const unsigned u = a[w][i][d]; mx[w] = max(mx[w], max(u & 0x7fffu, (u >> 16) & 0x7fffu)); }
#pragma unroll
    for (int o = 1; o < 64; o <<= 1) { mx[0] = max(mx[0], (unsigned)__shfl_xor((int)mx[0], o)); mx[1] = max(mx[1], (unsigned)__shfl_xor((int)mx[1], o)); }
    const float am[2] = {fmaxf(__uint_as_float(mx[0] << 16), 1e-30f), fmaxf(__uint_as_float(mx[1] << 16), 1e-30f)};
    const float r[2] = {127.0f / am[0], 127.0f / am[1]};
    if (lane == 0) { qf0[0] = am[0] * (1.0f / 127.0f) * __builtin_amdgcn_rsqf(s0 * (1.0f / D) + EPS); if (has1) qf1[0] = am[1] * (1.0f / 127.0f) * __builtin_amdgcn_rsqf(s1 * (1.0f / D) + EPS); }
#pragma unroll
    for (int w = 0; w < 2; ++w) { if (w == 1 && !has1) break; unsigned char* q = w ? q1 : q0;
#pragma unroll
        for (int c = 0; c < 2; ++c) { v4u o;
#pragma unroll
            for (int d = 0; d < 4; ++d) {
                const unsigned w0 = a[w][2 * c + (d >> 1)][(2 * d) & 3], w1 = a[w][2 * c + (d >> 1)][(2 * d + 1) & 3];
                float t0 = bflo(w0) * r[w], t1 = bfhi(w0) * r[w], t2 = bflo(w1) * r[w], t3 = bfhi(w1) * r[w];
                t0 = fminf(fmaxf(t0, -127.f), 127.f); t1 = fminf(fmaxf(t1, -127.f), 127.f); t2 = fminf(fmaxf(t2, -127.f), 127.f); t3 = fminf(fmaxf(t3, -127.f), 127.f);
                o[d] = ((unsigned)__float2int_rn(t0) & 0xffu) | (((unsigned)__float2int_rn(t1) & 0xffu) << 8) | (((unsigned)__float2int_rn(t2) & 0xffu) << 16) | (((unsigned)__float2int_rn(t3) & 0xffu) << 24); }
            *(v4u*)(q + c * 1024 + 16 * lane) = o; } }
}
__device__ __forceinline__ void build_rows2(const float* src0, const float* src1, bf16* xb0, bf16* xb1, float* rss0, float* rss1, bool has1, int lane) {
    f32x4 v0[8], v1[8]; float s0 = 0.f, s1 = 0.f;
#pragma unroll
    for (int j = 0; j < 8; ++j) { v0[j] = src0 ? ((const f32x4*)src0 + lane)[64 * j] : (f32x4){0.f, 0.f, 0.f, 0.f}; v1[j] = src1 ? ((const f32x4*)src1 + lane)[64 * j] : (f32x4){0.f, 0.f, 0.f, 0.f}; }
#pragma unroll
    for (int j = 0; j < 8; ++j) { s0 += (v0[j].x * v0[j].x + v0[j].y * v0[j].y) + (v0[j].z * v0[j].z + v0[j].w * v0[j].w); s1 += (v1[j].x * v1[j].x + v1[j].y * v1[j].y) + (v1[j].z * v1[j].z + v1[j].w * v1[j].w); }
    u32x2* o0 = (u32x2*)xb0 + lane; u32x2* o1 = (u32x2*)xb1 + lane;
#pragma unroll
    for (int j = 0; j < 8; ++j) { u32x2 w; w.x = pkbf(v0[j].x, v0[j].y); w.y = pkbf(v0[j].z, v0[j].w); o0[64 * j] = w; if (has1) { u32x2 w1; w1.x = pkbf(v1[j].x, v1[j].y); w1.y = pkbf(v1[j].z, v1[j].w); o1[64 * j] = w1; } }
    s0 = wave_sum(s0); s1 = wave_sum(s1);
    if (lane < 8) { rss0[lane] = (lane == 0) ? s0 : 0.f; if (has1) rss1[lane] = (lane == 0) ? s1 : 0.f; }
}
__device__ __forceinline__ void final_rows2(const bf16* src0, const bf16* src1, const float* gain, float* dst0, float* dst1, const float* rss0, const float* rss1, int lane) {
    u32x2 w0[8], w1[8];
#pragma unroll
    for (int j = 0; j < 8; ++j) { w0[j] = ((const u32x2*)src0 + lane)[64 * j]; w1[j] = dst1 ? ((const u32x2*)src1 + lane)[64 * j] : (u32x2){0u, 0u}; }
    const float q0 = lane < 8 ? rss0[lane] : 0.f, q1 = (dst1 && lane < 8) ? rss1[lane] : 0.f;
    const float r0 = 1.0f / sqrtf(wave_sum(q0) * (1.0f / D) + EPS), r1 = 1.0f / sqrtf(wave_sum(q1) * (1.0f / D) + EPS);
    const f32x4* gr = (const f32x4*)gain + lane; f32x4* o0 = (f32x4*)dst0 + lane; f32x4* o1 = (f32x4*)dst1 + lane;
#pragma unroll
    for (int j = 0; j < 8; ++j) { const f32x4 g = gr[64 * j]; o0[64 * j] = (f32x4){bflo(w0[j].x) * r0 * g.x, bfhi(w0[j].x) * r0 * g.y, bflo(w0[j].y) * r0 * g.z, bfhi(w0[j].y) * r0 * g.w};
        if (dst1) o1[64 * j] = (f32x4){bflo(w1[j].x) * r1 * g.x, bfhi(w1[j].x) * r1 * g.y, bflo(w1[j].y) * r1 * g.z, bfhi(w1[j].y) * r1 * g.w}; }
}
__device__ __forceinline__ const float* input_row(int r, const float* xp, const float* xs, const float* meta) {
    if (r < MPROMPT) { const int b = r / TP, pos = r - b * TP; return pos < NMETA ? meta + (size_t)pos * D : xp + ((size_t)b * SEQ + (pos - NMETA)) * D; }
    if (r < MREAL) return xs + (size_t)(r - MPROMPT) * D;
    return nullptr;
}

__device__ __forceinline__ void ssm_tables(int t, const float* lre_, const float* lim_, const float* ldt, const float* bre, const float* bim, f32x2* apow, f32x2* bbar) {
    const int l = t / (SG * SP), gp = t % (SG * SP), g = gp / SP;
    const double dtd = exp((double)ldt[l * SG + g]);
    const float lre = lre_[t], lim = lim_[t];
    const double xr = (double)lre * dtd, th = (double)lim * dtd;
    float c1 = 1.f, s1 = 0.f;
    for (int k = 0; k < NPOW; ++k) {
        const double kk = (k <= 16) ? (double)k : 16.0 * 65.0;
        const double ang = th * kk; const double n = rint(ang * 0.15915494309189535); const float r = (float)(ang - n * 6.283185307179586);
        const float mag = expf((float)(xr * kk)); const float cs = cosf(r), sn = sinf(r);
        apow[((size_t)(l * NPOW + k)) * (SG * SP) + gp] = (f32x2){mag * cs, mag * sn};
        if (k == 1) { c1 = cs; s1 = sn; }
    }
    const float em1 = expm1f((float)xr);
    const float hv = 0.5f * (1.0f - c1);
    const float are = em1 * c1 - 2.0f * hv, aim = (1.0f + em1) * s1;
    const float den = 1.0f / (lre * lre + lim * lim);
    const float qre = (are * lre + aim * lim) * den, qim = (aim * lre - are * lim) * den;
    const float* br = bre + (size_t)t * SH; const float* bi = bim + (size_t)t * SH; f32x2* bo = bbar + (size_t)t * SH;
#pragma unroll 4
    for (int h = 0; h < SH; ++h) { const float x = br[h], y = bi[h]; bo[h] = (f32x2){qre * x - qim * y, qre * y + qim * x}; }
}
__device__ __forceinline__ void ssm_matrices(int l, size_t t0, size_t tstride, const f32x2* apow, const f32x2* bbar, const float* cre, const float* cim, const float* dsk, bf16* WBT, bf16* BMT) {
    const f32x2* ap = apow + (size_t)l * NPOW * SG * SP; const f32x2* bb = bbar + (size_t)l * SG * SP * SH;
    const float* cr = cre + (size_t)l * SG * SH * SP; const float* ci = cim + (size_t)l * SG * SH * SP; const float* dd = dsk + (size_t)l * SG * SH;
    constexpr size_t NA = (size_t)SG * 16 * 256, NB = (size_t)SG * 256 * SP, NC = (size_t)SG * SP * 256;
    for (size_t t = t0; t < NA + NB + NC; t += tstride) {
        if (t < NA) {
            const int g = (int)(t / 4096), k = (int)(t / 256) % 16, h = (int)(t / 16) % 16, hp = (int)t % 16;
            float s = 0.f;
            for (int p = 0; p < SP; ++p) { const f32x2 a = ap[((size_t)k * SG + g) * SP + p], b = bb[((size_t)g * SP + p) * SH + hp]; const float x = cr[((size_t)g * SH + h) * SP + p], y = ci[((size_t)g * SH + h) * SP + p];
                const float abr = a.x * b.x - a.y * b.y, abi = a.x * b.y + a.y * b.x; s += x * abr - y * abi; }
            if (k == 0 && h == hp) s += dd[g * SH + h];
            const unsigned short sv = (unsigned short)(pkbf(s, 0.f) & 0xffffu);
            for (int m = 0; m + k < 16; ++m) { WBT[((size_t)g * 256 + (size_t)(k + m) * 16 + h) * 384 + m * 16 + hp] = sv;
                if (k > 0) WBT[((size_t)g * 256 + (size_t)m * 16 + h) * 384 + (k + m) * 16 + hp] = 0; }
        } else if (t < NA + NB) {
            const size_t u = t - NA; const int g = (int)(u / 16384), i = (int)(u / 1024) % 16, h = (int)(u / 64) % 16, p = (int)u % 64;
            const f32x2 a = ap[((size_t)(i + 1) * SG + g) * SP + p]; const float x = cr[((size_t)g * SH + h) * SP + p], y = ci[((size_t)g * SH + h) * SP + p];
            const size_t o = ((size_t)g * 256 + i * 16 + h) * 384 + 256 + p;
            WBT[o] = (unsigned short)(pkbf(x * a.x - y * a.y, 0.f) & 0xffffu); WBT[o + 64] = (unsigned short)(pkbf(-(x * a.y + y * a.x), 0.f) & 0xffffu);
        } else {
            const size_t u = t - NA - NB; const int g = (int)(u / 16384), p = (int)(u / 256) % 64, j = (int)(u / 16) % 16, hp = (int)u % 16;
            const f32x2 a = ap[((size_t)(15 - j) * SG + g) * SP + p], b = bb[((size_t)g * SP + p) * SH + hp];
            const size_t o = ((size_t)g * 256 + p) * 256 + j * 16 + hp;
            BMT[o] = (unsigned short)(pkbf(a.x * b.x - a.y * b.y, 0.f) & 0xffffu); BMT[o + (size_t)64 * 256] = (unsigned short)(pkbf(a.x * b.y + a.y * b.x, 0.f) & 0xffffu);
        }
    }
}

__device__ __forceinline__ float gelu_tanh(float x) { const float z = 0.7978845608028654f * (x + 0.044715f * x * x * x); return x * __builtin_amdgcn_rcpf(1.0f + __expf(-2.0f * z)); }

__device__ __forceinline__ void conv_rows4(int r0, int l, const bf16* PROJ, bf16* MIXED, const float* cache, const float* convw, const float* cgain, float* out, int lane) {
    if (r0 >= MREAL) {
#pragma unroll
        for (int q = 0; q < 4; ++q) { v4u* mo = (v4u*)(MIXED + (size_t)(r0 + q) * D); mo[lane] = (v4u){0u, 0u, 0u, 0u}; mo[64 + lane] = (v4u){0u, 0u, 0u, 0u}; }
        return; }
    int pos0, T; const float* cb = nullptr; float* ob;
    if (r0 < MPROMPT) { const int b = r0 / TP; pos0 = r0 - b * TP; T = TP; ob = out + O_CVP + (size_t)(l * NBP + b) * 2 * DCV; }
    else { const int s = (r0 - MPROMPT) / TS; pos0 = (r0 - MPROMPT) - s * TS; T = TS; cb = cache + (size_t)(l * NBS + s) * 2 * DCV; ob = out + O_CVS + (size_t)(l * NBS + s) * 2 * DCV; }
    float ss[4] = {0.f, 0.f, 0.f, 0.f}; float y[4][16];
#pragma unroll
    for (int hf = 0; hf < 2; ++hf) {
        const int c0 = hf * 512 + lane * 8;
        const bf16* pr = PROJ + (size_t)r0 * DIN + c0;
        v4u cg[6], hg[6], bg[4];
#pragma unroll
        for (int j = 0; j < 6; ++j) { if (j >= 2 || pos0 >= 2 - j) { cg[j] = *(const v4u*)(pr + (ptrdiff_t)(j - 2) * DIN + DCV); hg[j] = *(const v4u*)(pr + (ptrdiff_t)(j - 2) * DIN + 2 * DCV); } else { cg[j] = (v4u){0u, 0u, 0u, 0u}; hg[j] = cg[j]; } }
#pragma unroll
        for (int q = 0; q < 4; ++q) bg[q] = *(const v4u*)(pr + (size_t)q * DIN);
        float cbv[2][8];
#pragma unroll
        for (int e = 0; e < 8; ++e) { cbv[0][e] = (cb && pos0 < 2) ? cb[c0 + e] : 0.f; cbv[1][e] = (cb && pos0 < 1) ? cb[DCV + c0 + e] : 0.f; }
        const float* w = convw + (size_t)l * 3 * DCV + c0;
        float w0[8], w1[8], w2[8];
#pragma unroll
        for (int e = 0; e < 8; ++e) { w0[e] = w[e]; w1[e] = w[DCV + e]; w2[e] = w[2 * DCV + e]; }
        float v[6][8];
#pragma unroll
        for (int j = 0; j < 6; ++j)
#pragma unroll
            for (int qq = 0; qq < 4; ++qq) { v[j][2 * qq] = bflo(cg[j][qq]) * bflo(hg[j][qq]); v[j][2 * qq + 1] = bfhi(cg[j][qq]) * bfhi(hg[j][qq]); }
        if (pos0 == 0) {
#pragma unroll
            for (int e = 0; e < 8; ++e) { v[0][e] = cbv[0][e]; v[1][e] = cbv[1][e]; } }
#pragma unroll
        for (int q = 0; q < 4; ++q)
#pragma unroll
            for (int e = 0; e < 8; ++e) { const float bgv = (e & 1) ? bfhi(bg[q][e >> 1]) : bflo(bg[q][e >> 1]);
                const float yy = bgv * (w0[e] * v[q][e] + w1[e] * v[q + 1][e] + w2[e] * v[q + 2][e]); y[q][hf * 8 + e] = yy; ss[q] += yy * yy; }
        if (pos0 + 4 == T) {
#pragma unroll
            for (int e = 0; e < 8; ++e) { ob[c0 + e] = v[4][e]; ob[DCV + c0 + e] = v[5][e]; } }
    }
#pragma unroll
    for (int q = 0; q < 4; ++q) { const float rn = 1.0f / sqrtf(wave_sum(ss[q]) * (1.0f / DCV) + EPS); v4u* mo = (v4u*)(MIXED + (size_t)(r0 + q) * D);
#pragma unroll
        for (int hf = 0; hf < 2; ++hf) { const float* g = cgain + (size_t)l * DCV + hf * 512 + lane * 8; v4u wv;
#pragma unroll
            for (int qq = 0; qq < 4; ++qq) wv[qq] = pkbf(y[q][hf * 8 + 2 * qq] * rn * g[2 * qq], y[q][hf * 8 + 2 * qq + 1] * rn * g[2 * qq + 1]);
            mo[hf * 64 + lane] = wv; } }
}
__device__ __forceinline__ void norm_s_row(int r, bf16* MIXED, const float* gain, int lane) {
    v4u* p = (v4u*)(MIXED + (size_t)r * D + DCV); const v4u a = p[lane], b = p[64 + lane]; float v[16]; float ss = 0.f;
#pragma unroll
    for (int q = 0; q < 4; ++q) { v[2 * q] = bflo(a[q]); v[2 * q + 1] = bfhi(a[q]); v[8 + 2 * q] = bflo(b[q]); v[8 + 2 * q + 1] = bfhi(b[q]); }
#pragma unroll
    for (int e = 0; e < 16; ++e) ss += v[e] * v[e];
    const float rn = 1.0f / sqrtf(wave_sum(ss) * (1.0f / DSS) + EPS);
    v4u wa, wb; const float* g0 = gain + lane * 8; const float* g1 = gain + 512 + lane * 8;
#pragma unroll
    for (int q = 0; q < 4; ++q) { wa[q] = pkbf(v[2 * q] * rn * g0[2 * q], v[2 * q + 1] * rn * g0[2 * q + 1]); wb[q] = pkbf(v[8 + 2 * q] * rn * g1[2 * q], v[8 + 2 * q + 1] * rn * g1[2 * q + 1]); }
    p[lane] = wa; p[64 + lane] = wb;
}

template <bool WRITE> __device__ __forceinline__ void carry_run(const float* sl, bf16* so, int nc, const f32x2 a, float& sr, float& si) {
    constexpr size_t CS = (size_t)SG * 128, CO = (size_t)UGLD; constexpr int NB = 16;
#define CARRY_LOAD(LR, LI, c0) do { _Pragma("unroll") for (int q = 0; q < NB; ++q) { LR[q] = sl[(size_t)((c0) + q) * CS]; LI[q] = sl[(size_t)((c0) + q) * CS + 64]; } } while (0)
#define CARRY_STEP(LR, LI, c0) do { _Pragma("unroll") for (int q = 0; q < NB; ++q) { \
        if (WRITE) { so[(size_t)((c0) + q) * CO] = (unsigned short)(pkbf(sr, 0.f) & 0xffffu); so[(size_t)((c0) + q) * CO + 64] = (unsigned short)(pkbf(si, 0.f) & 0xffffu); } \
        const float nr = a.x * sr - a.y * si + LR[q], ni = a.x * si + a.y * sr + LI[q]; sr = nr; si = ni; } } while (0)
    float ar[NB], ai[NB], br[NB], bi[NB];
    int c = 0;
    if (nc >= NB) CARRY_LOAD(ar, ai, 0);
    while (c + NB <= nc) {
        if (c + 2 * NB <= nc) CARRY_LOAD(br, bi, c + NB);
        CARRY_STEP(ar, ai, c); c += NB;
        if (c + NB > nc) break;
        if (c + 2 * NB <= nc) CARRY_LOAD(ar, ai, c + NB);
        CARRY_STEP(br, bi, c); c += NB;
    }
#undef CARRY_LOAD
#undef CARRY_STEP
    for (; c < nc; ++c) { const float lr = sl[(size_t)c * CS], li = sl[(size_t)c * CS + 64];
        if (WRITE) { so[(size_t)c * CO] = (unsigned short)(pkbf(sr, 0.f) & 0xffffu); so[(size_t)c * CO + 64] = (unsigned short)(pkbf(si, 0.f) & 0xffffu); }
        const float nr = a.x * sr - a.y * si + lr, ni = a.x * si + a.y * sr + li; sr = nr; si = ni; }
}
constexpr int CSEG = 65, NSEG = 16;
static_assert(NSEG * CSEG >= CH_PER_SEQ && (NSEG - 1) * CSEG < CH_PER_SEQ, "carry segments");
__device__ __forceinline__ void carry_totals2(const float* sa, int na, const float* sb, int nb, const f32x2 a, float& ar, float& ai, float& br, float& bi) {
    constexpr size_t CS = (size_t)SG * 128; constexpr int NB = 8;
    const int nmin = na < nb ? na : nb; int c = 0;
    for (; c + NB <= nmin; c += NB) { float xr[NB], xi[NB], yr[NB], yi[NB];
#pragma unroll
        for (int q = 0; q < NB; ++q) { xr[q] = sa[(size_t)(c + q) * CS]; xi[q] = sa[(size_t)(c + q) * CS + 64]; yr[q] = sb[(size_t)(c + q) * CS]; yi[q] = sb[(size_t)(c + q) * CS + 64]; }
#pragma unroll
        for (int q = 0; q < NB; ++q) { const float n0 = a.x * ar - a.y * ai + xr[q], n1 = a.x * ai + a.y * ar + xi[q]; ar = n0; ai = n1; const float m0 = a.x * br - a.y * bi + yr[q], m1 = a.x * bi + a.y * br + yi[q]; br = m0; bi = m1; } }
    for (int k = c; k < na; ++k) { const float x0 = sa[(size_t)k * CS], x1 = sa[(size_t)k * CS + 64]; const float n0 = a.x * ar - a.y * ai + x0, n1 = a.x * ai + a.y * ar + x1; ar = n0; ai = n1; }
    for (int k = c; k < nb; ++k) { const float y0 = sb[(size_t)k * CS], y1 = sb[(size_t)k * CS + 64]; const float m0 = a.x * br - a.y * bi + y0, m1 = a.x * bi + a.y * br + y1; br = m0; bi = m1; }
}
__device__ __forceinline__ void ssm_carry_prompt(int b, int g, int hb, int l, const f32x2* apow, const float* SLOC, bf16* UG, float* out, LAS float* sh, int wave, int lane) {
    const f32x2 a = apow[((size_t)(l * NPOW + 16) * SG + g) * SP + lane], aseg = apow[((size_t)(l * NPOW + 17) * SG + g) * SP + lane];
    const int seg = 8 * hb + wave, cs = seg * CSEG, len = (CH_PER_SEQ - cs) < CSEG ? (CH_PER_SEQ - cs) : CSEG, c0 = b * CH_PER_SEQ + cs;
    const float* sl = SLOC + ((size_t)c0 * SG + g) * 128 + lane; bf16* so = UG + ((size_t)g * CPG + c0) * UGLD + 256 + lane;
    float tr = 0.f, ti = 0.f, pr = 0.f, pi = 0.f;
    if (hb) { const float* sp = SLOC + ((size_t)(b * CH_PER_SEQ + wave * CSEG) * SG + g) * 128 + lane; carry_totals2(sp, CSEG, sl, len, a, pr, pi, tr, ti);
        sh[(wave * 2) * 64 + lane] = pr; sh[(wave * 2 + 1) * 64 + lane] = pi; }
    else carry_run<false>(sl, so, len, a, tr, ti);
    sh[(seg * 2) * 64 + lane] = tr; sh[(seg * 2 + 1) * 64 + lane] = ti;
    LDS_WAIT(); __syncthreads();
    float sr = 0.f, si = 0.f;
    for (int w = 0; w < seg; ++w) { const float xr = sh[(w * 2) * 64 + lane], xi = sh[(w * 2 + 1) * 64 + lane]; const float nr = aseg.x * sr - aseg.y * si + xr, ni = aseg.x * si + aseg.y * sr + xi; sr = nr; si = ni; }
    carry_run<true>(sl, so, len, a, sr, si);
    if (seg == NSEG - 1) { out[O_REP + ((size_t)(l * NBP + b) * SG + g) * SP + lane] = sr; out[O_IMP + ((size_t)(l * NBP + b) * SG + g) * SP + lane] = si; }
    __syncthreads();
}
__device__ __forceinline__ void ssm_carry_small(int w, int l, const f32x2* apow, const float* SLOC, bf16* UG, const float* sre, const float* sim, float* out, int lane) {
    if (w >= NBS * SG) { const int u = w - NBS * SG; const int c = NCH_REAL + u / SG, g = u % SG; if (c >= NCHUNK) return;
        ((unsigned*)(UG + ((size_t)g * CPG + c) * UGLD + 256))[lane] = 0u; return; }
    const int s = w / SG, g = w % SG, c0 = NBP * CH_PER_SEQ + s * (TS / 16); const size_t o = ((size_t)(l * NBS + s) * SG + g) * SP + lane;
    float sr = sre[o], si = sim[o];
    const f32x2 a = apow[((size_t)(l * NPOW + 16) * SG + g) * SP + lane];
    carry_run<true>(SLOC + ((size_t)c0 * SG + g) * 128 + lane, UG + ((size_t)g * CPG + c0) * UGLD + 256 + lane, TS / 16, a, sr, si);
    out[O_RES + o] = sr; out[O_IMS + o] = si;
}
struct Args { const float* in[N_IN]; float* out; unsigned char* ws; };
static_assert(sizeof(Args) == 8 * (N_IN + 2), "no padding in Args");
typedef const __attribute__((address_space(4))) Args* ArgsP;
#ifdef PROBE_REP
#define PROBE_N(w) ((PROBE_WHICH == (w) || (PROBE_WHICH == 99 && (w) != 6)) ? PROBE_REP : 1)
#define PROBE_SET_REP(S) do { if (PROBE_WHICH == 1 || PROBE_WHICH == 99) (S).rep = PROBE_REP; } while (0)
#define PROBE_SET_REP3(S) do { if (PROBE_WHICH == 3 || PROBE_WHICH == 99) (S).rep = PROBE_REP; } while (0)
#define PROBE_SET_REP_R(S, E) do { if (PROBE_WHICH == 2 || PROBE_WHICH == 99) { (S).rep = PROBE_REP; (E).scale *= 1.0f / PROBE_REP; } } while (0)
#else
#define PROBE_N(w) 1
#define PROBE_SET_REP(S) do {} while (0)
#define PROBE_SET_REP3(S) do {} while (0)
#define PROBE_SET_REP_R(S, E) do {} while (0)
#endif

#define PHASE_BEGIN() \
    int tid = threadIdx.x; asm volatile("" : "+v"(tid)); \
    ArgsP A = (ArgsP)__builtin_amdgcn_kernarg_segment_ptr(); asm volatile("" : "+s"(A)); \
    const int lane = tid & 63, wave = __builtin_amdgcn_readfirstlane(tid >> 6); \
    const int gw = vcu * NWAVES + wave, NGW = G * NWAVES; \
    unsigned char* ws = A->ws; (void)lane; (void)gw; (void)NGW; (void)ws;

__device__ __forceinline__ void convert_layer(int l, ArgsP A, unsigned char* ws, LAS float* scr, int gw, int NGW, int lane, int part = 0, int nparts = 1) {
    unsigned char* wset = ws + WS_W + (size_t)(l & 1) * W_SET;
    constexpr int I_GU = (D / 64) * (FF / 32), I_DN = (FF / 64) * (D / 32), I_IN = (D / 64) * (DIN / 32), I_GL = (DSS / 64) * (DSS / 32), I_OUT = (D / 64) * (D / 32);
    constexpr int NITEMS = 4 * I_GU + 2 * I_DN + I_IN + I_GL + I_OUT;
    const bool q8 = (2 * l >= UPQ_FROM);
    int it0 = (int)((long)NITEMS * part / nparts), it1 = (int)((long)NITEMS * (part + 1) / nparts);
    if (q8) { if (part == 0) { it0 = 0; it1 = NITEMS; } else { it0 = 0; it1 = 4 * I_GU; } }
    for (int it = it0 + gw; it < it1; it += NGW) {
        int r = it;
        if (r < 4 * I_GU) { const int q = r / I_GU; r -= q * I_GU;
            const float* W = A->in[q == 0 ? I_F1G : q == 1 ? I_F1U : q == 2 ? I_F2G : I_F2U] + (size_t)l * D * FF;
            if (q8 && part == 0) { pmaxc_item(W, FF, A->in[q < 2 ? I_F1N : I_F2N] + (size_t)l * D, (float*)(ws + WS_PMAXC) + (size_t)q * 32 * FF, r, lane); continue; }
            transpose_item(W, D, FF, (bf16*)(wset + (q < 2 ? W_GU0 : W_GU1)), 1 + (q & 1), A->in[q < 2 ? I_F1N : I_F2N] + (size_t)l * D, scr, r, lane, 0.f, 0, q8 ? (const float*)(ws + WS_CS) + (size_t)((l & 1) * 4 + q) * FF : nullptr); continue; }
        r -= 4 * I_GU;
        if (r < 2 * I_DN) { const int q = r / I_DN; r -= q * I_DN;
            transpose_item(A->in[q ? I_F2D : I_F1D] + (size_t)l * FF * D, FF, D, (bf16*)(wset + (q ? W_D1 : W_D0)), 0, nullptr, scr, r, lane, (2 * l + q >= FP8_FROM_HL) ? WD8_SCALE : 0.f); continue; }
        r -= 2 * I_DN;
        if (r < I_IN) { transpose_item(A->in[I_WIN] + (size_t)l * D * DIN, D, DIN, (bf16*)(wset + W_IN), 0, A->in[I_MIXN] + (size_t)l * D, scr, r, lane); continue; }
        r -= I_IN;
        if (r < I_GL) { transpose_item(A->in[I_GLU] + (size_t)l * DSS * DSS, DSS, DSS, (bf16*)(wset + W_GLU), 0, nullptr, scr, r, lane); continue; }
        r -= I_GL;
        transpose_item(A->in[I_WOUT] + (size_t)l * D * D, D, D, (bf16*)(wset + W_OUT), 0, A->in[I_SSMN] + (size_t)l * DSS, scr, r, lane, 0.f, DCV);
    }
}

__global__ void __launch_bounds__(NWAVES * 64, 2) hymba_fwd(Args args_unused) {
    extern __shared__ __attribute__((aligned(16))) unsigned char lds_raw[];
    LAS unsigned char* lds = (LAS unsigned char*)lds_raw;
    const int G = gridDim.x; const int bx = blockIdx.x; const int vcu = (G % 8 == 0) ? (bx % 8) * (G / 8) + bx / 8 : bx;
    XcdBarrier bar;
    {
        PHASE_BEGIN();
        for (int u = tid; u < (LDS_BYTES - LDSCTL_OFF) / 4; u += NWAVES * 64) ((LAS unsigned*)(lds + LDSCTL_OFF))[u] = 0u;
        __syncthreads();
        bar = xcd_barrier_post((unsigned*)(ws) + CW_BAR, (volatile LAS unsigned*)(lds + MISC_OFF) + 8);
    }
#define GRID_BAR() do { for (int prep_ = 0; prep_ < PROBE_N(6); ++prep_) xcd_barrier(bar); } while (0)
    {
        PHASE_BEGIN();
        for (int prep = 0; prep < PROBE_N(7); ++prep)
        for (int t = bx * (NWAVES * 64) + tid; t < NL * SG * SP; t += G * NWAVES * 64)
            ssm_tables(t, A->in[I_LRE], A->in[I_LIM], A->in[I_LDT], A->in[I_BRE], A->in[I_BIM], (f32x2*)(ws + WS_APOW), (f32x2*)(ws + WS_BBAR));
    }
    {
        PHASE_BEGIN();
        for (int prep = 0; prep < PROBE_N(7); ++prep) convert_layer(0, A, ws, (LAS float*)(lds + RING_OFF + wave * 16384), gw, NGW, lane, 0, UPQ_FROM == 0 ? 2 : 1);
    }
    {
        PHASE_BEGIN();
        v4u* z = (v4u*)(ws + WS_BMT);
        for (int i = bx * (NWAVES * 64) + tid; i < SG * 128 * 256 * 2 / 16; i += G * NWAVES * 64) { const int g = i / (128 * 256 * 2 / 16), o = i % (128 * 256 * 2 / 16); z[(size_t)g * (256 * 256 * 2 / 16) + (128 * 256 * 2 / 16) + o] = (v4u){0u, 0u, 0u, 0u}; }
    }
    {
        PHASE_BEGIN();
        bf16* XB = (bf16*)(ws + WS_XN); float* rss = (float*)(ws + WS_RSS);
        const float* xp = A->in[I_XP]; const float* xs = A->in[I_XS]; const float* meta = A->in[I_META];
        for (int prep = 0; prep < PROBE_N(7); ++prep)
        for (int r = gw; r < MPAD; r += 2 * NGW) { const int r1 = r + NGW; const bool h1 = r1 < MPAD; const int rr = h1 ? r1 : r;
            build_rows2(input_row(r, xp, xs, meta), h1 ? input_row(r1, xp, xs, meta) : nullptr, XB + (size_t)r * D, XB + (size_t)rr * D, rss + (size_t)r * 8, rss + (size_t)rr * 8, h1, lane); }
    }
    GRID_BAR();
    if (UPQ_FROM == 0) {
        {
            PHASE_BEGIN();
            for (int c = bx * (NWAVES * 64) + tid; c < 4 * FF; c += G * NWAVES * 64) colstep_reduce((const float*)(ws + WS_PMAXC), (float*)(ws + WS_CS), c);
            const bf16* XB = (const bf16*)(ws + WS_XN); unsigned char* XQ = ws + WS_XB8; const float* rss = (const float*)(ws + WS_RSS);
            for (int r = gw; r < MPAD; r += 2 * NGW) { const int r1 = r + NGW; const bool h1 = r1 < MPAD; const int rr = h1 ? r1 : r;
                quant_rows2(XB + (size_t)r * D, XB + (size_t)rr * D, rss + (size_t)r * 8, rss + (size_t)rr * 8, XQ + (size_t)r * D, XQ + (size_t)rr * D, (float*)(ws + WS_QF) + r, (float*)(ws + WS_QF) + rr, h1, lane); }
        }
        GRID_BAR();
        {
            PHASE_BEGIN();
            convert_layer(0, A, ws, (LAS float*)(lds + RING_OFF + wave * 16384), gw, NGW, lane, 1, 2);
        }
        GRID_BAR();
    }
    for (int hl = 0; hl < 2 * NL; ++hl) {
        const int l = hl >> 1, second = hl & 1;
        if (hl >= UPQ_FROM && hl > 0) {
            PHASE_BEGIN();
            const bf16* XB = (const bf16*)(ws + WS_XN); unsigned char* XQ = ws + WS_XB8; const float* rss = (const float*)(ws + WS_RSS) + (size_t)(3 * l + (second ? 2 : 0)) * RSS_STRIDE;
            for (int r = gw; r < MPAD; r += 2 * NGW) { const int r1 = r + NGW; const bool h1 = r1 < MPAD; const int rr = h1 ? r1 : r;
                quant_rows2(XB + (size_t)r * D, XB + (size_t)rr * D, rss + (size_t)r * 8, rss + (size_t)rr * 8, XQ + (size_t)r * D, XQ + (size_t)rr * D, (float*)(ws + WS_QF) + r, (float*)(ws + WS_QF) + rr, h1, lane); }
        }
        if (hl >= UPQ_FROM && hl > 0) GRID_BAR();
        if (hl >= UPQ_FROM) {
            PHASE_BEGIN();
            const float* cs = (const float*)(ws + WS_CS) + (size_t)((l & 1) * 4 + 2 * second) * FF;
            pg8::Gemm g{(const bf16*)(ws + WS_XB8), (const bf16*)(ws + WS_W + (size_t)(l & 1) * W_SET + (second ? W_GU1 : W_GU0)), MPAD, 2 * FF, D / 2, D / 2, D / 2, 0, 0};   pg8::StaticOrder S; S.init(MPAD, 2 * FF, G, bx); PROBE_SET_REP(S);
            pg8::EpiSwigluQ E{(const float*)(ws + WS_QF), (unsigned char*)(ws + WS_H), cs, FF, cs + FF, (hl >= FP8_FROM_HL) ? 1 : 0, (hl >= FP8_FROM_HL) ? H8_SCALE : 1.0f};
            S.split = 1;
            S.pass = 0; pg8::gemm_phase<pg8::EpiSwigluQ, pg8::StaticOrder, true, true, 2, false>(lds + RING_OFF, g, S, E, tid); S.pass = 1; pg8::gemm_phase<pg8::EpiSwigluQ, pg8::StaticOrder, true, true, 2, true>(lds + RING_OFF, g, S, E, tid);
        } else
#ifdef PROBE_SPLIT
        for (int part = 0; part < 2; ++part)
#endif
        {
            PHASE_BEGIN();
            pg8::Gemm g{(const bf16*)(ws + WS_XN), (const bf16*)(ws + WS_W + (size_t)(l & 1) * W_SET + (second ? W_GU1 : W_GU0)), MPAD, 2 * FF, D, D, D, 0, 0}; pg8::StaticOrder S; S.init(MPAD, 2 * FF, G, bx); PROBE_SET_REP(S);
#ifdef PROBE_SPLIT
            if (part == 0) S.r1 = 11; else S.r0 = 11;
#endif
            pg8::EpiSwiglu E{(unsigned char*)(ws + WS_H), FF, (const float*)(ws + WS_RSS) + (size_t)(3 * l + (second ? 2 : 0)) * RSS_STRIDE, (const LAS float*)(lds + RSSB_OFF), 1.0f / D, EPS, (hl >= FP8_FROM_HL) ? H8_SCALE : 1.0f, 1.0f, (hl >= FP8_FROM_HL) ? 1 : 0};
            S.split = 1;
            S.pass = 0; pg8::gemm_phase<pg8::EpiSwiglu, pg8::StaticOrder, true, true, false, false>(lds + RING_OFF, g, S, E, tid); S.pass = 1; pg8::gemm_phase<pg8::EpiSwiglu, pg8::StaticOrder, true, true, false, true>(lds + RING_OFF, g, S, E, tid);
#ifdef PROBE_SPLIT
            if (part == 0) GRID_BAR();
#endif
        }
        GRID_BAR();
        if (hl >= FP8_FROM_HL) {
            PHASE_BEGIN();
            pg8::Gemm g{(const bf16*)(ws + WS_H), (const bf16*)(ws + WS_W + (size_t)(l & 1) * W_SET + (second ? W_D1 : W_D0)), MPAD, D, FF / 2, FF / 2, FF / 2, 0, 0};   pg8::StaticOrder S; S.init(MPAD, D, G, bx);
            pg8::EpiResidNorm<false> E{(bf16*)(ws + WS_XN), D, 0.5f / (H8_SCALE * WD8_SCALE), (float*)(ws + WS_RSS) + (size_t)(second ? 3 * (l + 1) : 3 * l + 1) * RSS_STRIDE, (second && hl + 1 >= FP8_UP_FROM && hl + 1 < 2 * NL) ? (unsigned char*)(ws + WS_XB8) : nullptr, (LAS float*)(lds + RED_OFF), nullptr, nullptr, 0.f, 0.f};
            PROBE_SET_REP_R(S, E);
            S.split = 1;
            S.pass = 0; pg8::gemm_phase<pg8::EpiResidNorm<false>, pg8::StaticOrder, true, true, true, false>(lds + RING_OFF, g, S, E, tid); S.pass = 1; pg8::gemm_phase<pg8::EpiResidNorm<false>, pg8::StaticOrder, true, true, true, true>(lds + RING_OFF, g, S, E, tid);
        } else {
            PHASE_BEGIN();
            pg8::Gemm g{(const bf16*)(ws + WS_H), (const bf16*)(ws + WS_W + (size_t)(l & 1) * W_SET + (second ? W_D1 : W_D0)), MPAD, D, FF, FF, FF, 0, 0}; pg8::StaticOrder S; S.init(MPAD, D, G, bx);
            pg8::EpiResidNorm<false> E{(bf16*)(ws + WS_XN), D, 0.5f, (float*)(ws + WS_RSS) + (size_t)(second ? 3 * (l + 1) : 3 * l + 1) * RSS_STRIDE, (second && hl + 1 >= FP8_UP_FROM && hl + 1 < 2 * NL) ? (unsigned char*)(ws + WS_XB8) : nullptr, (LAS float*)(lds + RED_OFF), nullptr, nullptr, 0.f, 0.f};
            PROBE_SET_REP_R(S, E);
            S.split = 1;
            S.pass = 0; pg8::gemm_phase<pg8::EpiResidNorm<false>, pg8::StaticOrder, true, true, false, false>(lds + RING_OFF, g, S, E, tid); S.pass = 1; pg8::gemm_phase<pg8::EpiResidNorm<false>, pg8::StaticOrder, true, true, false, true>(lds + RING_OFF, g, S, E, tid);
        }
        if (l + 1 < NL) {
            PHASE_BEGIN();
            constexpr int NTAIL = 2 * (((MPAD / 256) * (D / 256)) % 256);
            if (G > 2 * NTAIL) { if (bx >= NTAIL) for (int prep = 0; prep < PROBE_N(4); ++prep) convert_layer(l + 1, A, ws, (LAS float*)(lds + RING_OFF + wave * 16384), (bx - NTAIL) * NWAVES + wave, (G - NTAIL) * NWAVES, lane, second, 2); }
            else convert_layer(l + 1, A, ws, (LAS float*)(lds + RING_OFF + wave * 16384), gw, NGW, lane, second, 2);
        }
        GRID_BAR();
        if (second) continue;
        {
            PHASE_BEGIN();
            pg8::Gemm g{(const bf16*)(ws + WS_XN), (const bf16*)(ws + WS_W + (size_t)(l & 1) * W_SET + W_IN), MPAD, DIN, D, D, D, 0, 0}; pg8::StaticOrder S; S.init(MPAD, DIN, G, bx); PROBE_SET_REP(S);
            pg8::EpiStoreBf16 E{(bf16*)(ws + WS_PROJ), DIN, (const float*)(ws + WS_RSS) + (size_t)(3 * l + 1) * RSS_STRIDE, (const LAS float*)(lds + RSSB_OFF), 1.0f / D, EPS, (bf16*)(ws + WS_UG), 3 * DCV, CPG, UGLD};
            S.split = 1;
            S.pass = 0; pg8::gemm_phase<pg8::EpiStoreBf16, pg8::StaticOrder, true, true, false, false>(lds + RING_OFF, g, S, E, tid); S.pass = 1; pg8::gemm_phase<pg8::EpiStoreBf16, pg8::StaticOrder, true, true, false, true>(lds + RING_OFF, g, S, E, tid);
        }
        {
            PHASE_BEGIN();
            for (int prep = 0; prep < PROBE_N(5); ++prep)
            ssm_matrices(l, (size_t)bx * (NWAVES * 64) + tid, (size_t)G * NWAVES * 64, (const f32x2*)(ws + WS_APOW), (const f32x2*)(ws + WS_BBAR), A->in[I_CRE], A->in[I_CIM], A->in[I_SD],
                         (bf16*)(ws + WS_WBT), (bf16*)(ws + WS_BMT));
        }
        GRID_BAR();
        {
            PHASE_BEGIN();
            const bf16* PROJ = (const bf16*)(ws + WS_PROJ);
            for (int prep = 0; prep < PROBE_N(3); ++prep) {
            { bf16* MIXED = (bf16*)(ws + WS_MIXED); const float* cache = A->in[I_CACHE]; const float* convw = A->in[I_CONVW]; const float* cgain = A->in[I_CONVN]; float* out = A->out;
              for (int r = 4 * gw; r < MPAD; r += 4 * NGW) conv_rows4(r, l, PROJ, MIXED, cache, convw, cgain, out, lane); }
            }
        }
        {
            PHASE_BEGIN();
            pg8::Gemm g{(const bf16*)(ws + WS_UG), (const bf16*)(ws + WS_BMT), SG * CPG, 256, 256, UGLD, 256, CPG / 256, (size_t)256 * 256 * 2}; pg8::StaticOrder S; S.init(SG * CPG, 256, G, bx);
            pg8::EpiSloc E{(float*)(ws + WS_SLOC), CPG, NCHUNK, SG};
            PROBE_SET_REP3(S);
            S.split = 1;
            S.pass = 0; pg8::gemm_phase<pg8::EpiSloc, pg8::StaticOrder, true, true, false, false>(lds + RING_OFF, g, S, E, tid); S.pass = 1; pg8::gemm_phase<pg8::EpiSloc, pg8::StaticOrder, true, true, false, true>(lds + RING_OFF, g, S, E, tid);
        }
        GRID_BAR();
        {
            PHASE_BEGIN();
            const f32x2* apow = (const f32x2*)(ws + WS_APOW); const float* SLOC = (const float*)(ws + WS_SLOC); bf16* UG = (bf16*)(ws + WS_UG);
            for (int prep = 0; prep < PROBE_N(3); ++prep) {
            for (int pi = vcu; pi < 2 * NBP * SG; pi += G) ssm_carry_prompt((pi >> 1) / SG, (pi >> 1) % SG, pi & 1, l, apow, SLOC, UG, A->out, (LAS float*)(lds + RING_OFF), wave, lane);
            for (int w = gw; w < NBS * SG + (NCHUNK - NCH_REAL) * SG; w += NGW) ssm_carry_small(w, l, apow, SLOC, UG, A->in[I_SRE], A->in[I_SIM], A->out, lane);
            }
        }
        GRID_BAR();
        {
            PHASE_BEGIN();
            pg8::Gemm g{(const bf16*)(ws + WS_UG), (const bf16*)(ws + WS_WBT), SG * CPG, 256, UGLD, UGLD, UGLD, CPG / 256, (size_t)256 * UGLD * 2}; pg8::StaticOrder S; S.init(SG * CPG, 256, G, bx);
            pg8::EpiYs E{(bf16*)(ws + WS_YS), DSS, CPG, NCHUNK};
            PROBE_SET_REP3(S);
            S.split = 1;
            S.pass = 0; pg8::gemm_phase<pg8::EpiYs, pg8::StaticOrder, true, true, false, false>(lds + RING_OFF, g, S, E, tid); S.pass = 1; pg8::gemm_phase<pg8::EpiYs, pg8::StaticOrder, true, true, false, true>(lds + RING_OFF, g, S, E, tid);
        }
        GRID_BAR();
        {
            PHASE_BEGIN();
            pg8::Gemm g{(const bf16*)(ws + WS_YS), (const bf16*)(ws + WS_W + (size_t)(l & 1) * W_SET + W_GLU), MPAD, DSS, DSS, DSS, DSS, 0, 0}; pg8::StaticOrder S; S.init(MPAD, DSS, G, bx); PROBE_SET_REP(S);
            pg8::EpiGlu E{(const bf16*)(ws + WS_YS), DSS, (bf16*)(ws + WS_MIXED) + DCV, D, (float*)(ws + WS_RSS) + (size_t)(3 * NL + 1 + l) * RSS_STRIDE, (LAS float*)(lds + RED_OFF)};
            S.split = 1;
            S.pass = 0; pg8::gemm_phase<pg8::EpiGlu, pg8::StaticOrder, true, true, false, false>(lds + RING_OFF, g, S, E, tid); S.pass = 1; pg8::gemm_phase<pg8::EpiGlu, pg8::StaticOrder, true, true, false, true>(lds + RING_OFF, g, S, E, tid);
        }
        GRID_BAR();
        {
            PHASE_BEGIN();
            pg8::Gemm g{(const bf16*)(ws + WS_MIXED), (const bf16*)(ws + WS_W + (size_t)(l & 1) * W_SET + W_OUT), MPAD, D, D, D, D, 0, 0}; pg8::StaticOrder S; S.init(MPAD, D, G, bx);
            pg8::EpiResidNorm<true> E{(bf16*)(ws + WS_XN), D, 1.0f, (float*)(ws + WS_RSS) + (size_t)(3 * l + 2) * RSS_STRIDE, (hl + 1 >= FP8_UP_FROM) ? (unsigned char*)(ws + WS_XB8) : nullptr, (LAS float*)(lds + RED_OFF), (const float*)(ws + WS_RSS) + (size_t)(3 * NL + 1 + l) * RSS_STRIDE, (const LAS float*)(lds + RSSB_OFF), 1.0f / DSS, EPS};
            PROBE_SET_REP_R(S, E);
            S.split = 1;
            S.pass = 0; pg8::gemm_phase<pg8::EpiResidNorm<true>, pg8::StaticOrder, true, true, false, false>(lds + RING_OFF, g, S, E, tid); S.pass = 1; pg8::gemm_phase<pg8::EpiResidNorm<true>, pg8::StaticOrder, true, true, false, true>(lds + RING_OFF, g, S, E, tid);
        }
        if (l + 1 < NL && 2 * (l + 1) >= UPQ_FROM) {
            PHASE_BEGIN();
            for (int c = bx * (NWAVES * 64) + tid; c < 4 * FF; c += G * NWAVES * 64) colstep_reduce((const float*)(ws + WS_PMAXC), (float*)(ws + WS_CS) + (size_t)((l + 1) & 1) * 4 * FF, c);
        }
        GRID_BAR();
    }
    {
        PHASE_BEGIN();
        const bf16* X = (const bf16*)(ws + WS_XN); float* out = A->out; const float* gain = A->in[I_FINN]; const float* rss = (const float*)(ws + WS_RSS) + (size_t)(3 * NL) * RSS_STRIDE;
        for (int prep = 0; prep < PROBE_N(7); ++prep)
#define OUT_ROW(r) ((r) < MPROMPT ? (((r) % TP) < NMETA ? (float*)nullptr : out + O_YP + ((size_t)((r) / TP) * SEQ + (((r) % TP) - NMETA)) * D) : out + O_YS + (size_t)((r) - MPROMPT) * D)
        for (int r = gw; r < MREAL; r += 2 * NGW) { const int r1 = r + NGW;
            float* d0 = OUT_ROW(r); float* d1 = (r1 < MREAL) ? OUT_ROW(r1) : (float*)nullptr; int ra = r, rb = r1;
            if (!d0) { d0 = d1; d1 = nullptr; ra = r1; }
            if (d0) final_rows2(X + (size_t)ra * D, X + (size_t)(d1 ? rb : ra) * D, gain, d0, d1, rss + (size_t)ra * 8, rss + (size_t)(d1 ? rb : ra) * 8, lane); }
#undef OUT_ROW
    }
}
}

extern "C" void kernel_launch(void* const* d_in, const int* in_sizes, int n_in, void* d_out, int out_size, void* d_ws, size_t ws_size, hipStream_t stream) {
    using namespace mk;
    static int grid = 0;
    if (grid == 0) {
        if (n_in != N_IN || (size_t)out_size != O_END || ws_size < WS_END) { fprintf(stderr, "kernel_launch: unexpected shapes (n_in %d, out %d, ws %zu, need %zu)\n", n_in, out_size, ws_size, (size_t)WS_END); grid = -1; return; }
        int dev = 0, cus = 0, per_cu = 0;
        if (hipGetDevice(&dev) != hipSuccess || hipDeviceGetAttribute(&cus, hipDeviceAttributeMultiprocessorCount, dev) != hipSuccess) { grid = -1; return; }
        if (hipFuncSetAttribute((const void*)hymba_fwd, hipFuncAttributeMaxDynamicSharedMemorySize, LDS_BYTES) != hipSuccess) { fprintf(stderr, "kernel_launch: hipFuncSetAttribute failed\n"); grid = -1; return; }
        if (hipOccupancyMaxActiveBlocksPerMultiprocessor(&per_cu, (const void*)hymba_fwd, NWAVES * 64, LDS_BYTES) != hipSuccess || per_cu < 1) { fprintf(stderr, "kernel_launch: occupancy query says %d\n", per_cu); }
        (void)hipGetLastError();
        grid = cus;
    }
    if (grid < 0) return;
    if (hipMemsetAsync(d_ws, 0, ZERO_BYTES, stream) != hipSuccess) return;
    Args a{};
    for (int i = 0; i < N_IN; ++i) a.in[i] = (const float*)d_in[i];
    a.out = (float*)d_out; a.ws = (unsigned char*)d_ws;
    hipLaunchKernelGGL(hymba_fwd, dim3(grid), dim3(NWAVES * 64), LDS_BYTES, stream, a);
}
```

```cpp
#include <hip/hip_runtime.h>
#include <cstdio>
#include <cstdint>
namespace pg8 {
#define PG8_LAS __attribute__((address_space(3)))
typedef unsigned short bf16_t;
typedef short bf16x8 __attribute__((ext_vector_type(8)));
typedef float f32x4 __attribute__((ext_vector_type(4)));
typedef unsigned u32x4 __attribute__((ext_vector_type(4)));
typedef int i32x4 __attribute__((ext_vector_type(4)));
typedef int i32x8 __attribute__((ext_vector_type(8)));
typedef unsigned u32x2 __attribute__((ext_vector_type(2)));
constexpr int BM = 256, BK = 64, HALF = 128, HTB = HALF * BK * 2  , STAGE_BYTES = 8 * HTB, NXCD = 8, WGM = 8;

__host__ __device__ __forceinline__ int lds_byte(int r, int c) { const int st = (r >> 4) * 2 + (c >> 5), rr = r & 15, cc = c & 31, ob = rr * 64 + cc * 2; return st * 1024 + (ob ^ (((ob >> 9) & 1) << 5)); }
__host__ __device__ __forceinline__ void stage_rc(int b, int& R, int& C) { const int st = b / 1024, sb = b % 1024, swz = sb ^ (((sb >> 9) & 1) << 5); R = (st >> 1) * 16 + swz / 64; C = (st & 1) * 32 + (swz % 64) / 2; }
__host__ __device__ __forceinline__ int perm32(int rho) { const int n = rho >> 4, i = rho & 15; return 8 * (i >> 2) + 4 * n + (i & 3); }

struct Unit { int pm, pn, mh; };
struct Gemm { const bf16_t* A; const bf16_t* Bt; int M, N, K; int lda, ldb; int gpanels; size_t gstride; };

struct StaticOrder {
    int nM, nN, nwg, G, c, split, pass;
#ifdef PROBE_SPLIT
    int r0, r1;
#endif
#ifdef PROBE_REP
    int rep;
#else
    static constexpr int rep = 1;
#endif
    __host__ __device__ void init(int M, int N, int G_, int c_) { nM = M / BM; nN = N / BM; nwg = nM * nN; G = G_; c = c_; split = 0; pass = 0;
#ifdef PROBE_SPLIT
        r0 = 0; r1 = 1 << 30;
#endif
#ifdef PROBE_REP
        rep = 1;
#endif
    }
    __host__ __device__ bool next(int i, Unit& u) const {
        const int nfull = split ? (nwg / G) * G : nwg;
        long L; u.mh = -1;
        if (pass == 0) { L = (long)(i / rep) * G + c; if (L >= nfull) return false; }
        else { const long hq = (long)i * G + c; if (hq >= 2 * (long)(nwg - nfull)) return false; L = nfull + (hq >> 1); u.mh = (int)(hq & 1); }
        int wgid = (int)L; { const int q = nwg / NXCD, r = nwg % NXCD, xcd = wgid % NXCD, off = wgid / NXCD; wgid = (xcd < r ? xcd * (q + 1) : r * (q + 1) + (xcd - r) * q) + off; }
        const int nig = WGM * nN, gid = wgid / nig, fm = gid * WGM, gsz = (nM - fm) < WGM ? (nM - fm) : WGM;
        u.pm = fm + ((wgid % nig) % gsz); u.pn = (wgid % nig) / gsz; return true;
    }
    __device__ __forceinline__ void a_ready(const Unit&) const {}
    __device__ __forceinline__ void done(const Unit&) const {}
};
__device__ __forceinline__ unsigned cvt_pk_bf16(float lo, float hi) { unsigned r; asm volatile("v_cvt_pk_bf16_f32 %0, %1, %2" : "=v"(r) : "v"(lo), "v"(hi)); return r; }
typedef float f32x2 __attribute__((ext_vector_type(2)));
__device__ __forceinline__ float fast_sigmoid(float z) { return __builtin_amdgcn_rcpf(1.0f + __expf(-z)); }
__device__ __forceinline__ float row_rnorm_lds(const PG8_LAS float* rssl, int lr, float inv_n, float eps) {
    const PG8_LAS f32x4* p = (const PG8_LAS f32x4*)(rssl + lr * 8); const f32x4 a = p[0], b = p[1];
    const float s = ((a[0] + a[1]) + (a[2] + a[3])) + ((b[0] + b[1]) + (b[2] + b[3]));
    return __builtin_amdgcn_rsqf(s * inv_n + eps); }
struct EpiSwiglu {
    static constexpr bool MID = false;
    static constexpr bool PERM = true, AFTER_DRAIN = false, QPRE = false;
    static constexpr bool RSS = true;
    unsigned char* H; int ldc; const float* rss; const PG8_LAS float* rssl; float inv_n, eps, oscale, iscale; int f8;
    __device__ __forceinline__ void operator()(const f32x4 (&acc)[2][2][4][2], const Unit& u, int wr, int wc, int fr, int fq) const {
        const int nai = u.mh < 0 ? 2 : 1, row0 = u.pm * BM + (u.mh > 0 ? HALF : 0) + wr * 64 + fr, col0 = u.pn * HALF + wc * 32 + 8 * fq;
#pragma unroll
        for (int ai = 0; ai < 2; ++ai) if (ai < nai)
#pragma unroll
            for (int m = 0; m < 4; ++m) { const int row = row0 + ai * HALF + m * 16; const float r = row_rnorm_lds(rssl, ai * HALF + wr * 64 + m * 16 + fr, inv_n, eps) * iscale;
                float o[8]; const float ru = r * oscale;
#pragma unroll
                for (int n = 0; n < 2; ++n)
#pragma unroll
                    for (int j = 0; j < 4; j += 2) {
                        const f32x2 g = (f32x2){acc[ai][0][m][n][j], acc[ai][0][m][n][j + 1]} * r, up = (f32x2){acc[ai][1][m][n][j], acc[ai][1][m][n][j + 1]} * ru;
                        f32x2 e = g * (-1.4426950408889634f); e.x = __builtin_amdgcn_exp2f(e.x); e.y = __builtin_amdgcn_exp2f(e.y); e = e + 1.0f;
                        f32x2 sg; sg.x = __builtin_amdgcn_rcpf(e.x); sg.y = __builtin_amdgcn_rcpf(e.y);
                        const f32x2 ov = (g * up) * sg; o[4 * n + j] = ov.x; o[4 * n + j + 1] = ov.y; }
                if (f8) {
                    int w0 = __builtin_amdgcn_cvt_pk_fp8_f32(o[0], o[1], 0, false); w0 = __builtin_amdgcn_cvt_pk_fp8_f32(o[2], o[3], w0, true);
                    int w1 = __builtin_amdgcn_cvt_pk_fp8_f32(o[4], o[5], 0, false); w1 = __builtin_amdgcn_cvt_pk_fp8_f32(o[6], o[7], w1, true);
                    u32x2 w; w.x = (unsigned)w0; w.y = (unsigned)w1; *(u32x2*)(H + (size_t)row * ldc + col0) = w;
                } else {
                    u32x4 w; w.x = cvt_pk_bf16(o[0], o[1]); w.y = cvt_pk_bf16(o[2], o[3]); w.z = cvt_pk_bf16(o[4], o[5]); w.w = cvt_pk_bf16(o[6], o[7]);
                    *(u32x4*)((bf16_t*)H + (size_t)row * ldc + col0) = w; } }
    }
};
template <bool MIDS> struct EpiResidNorm {
    static constexpr bool PERM = true, AFTER_DRAIN = false, QPRE = false;
    static constexpr bool RSS = MIDS, MID = MIDS;
    bf16_t* XB; int ldc; float scale; float* rss_out; unsigned char* XB8; PG8_LAS float* red; const float* rss; const PG8_LAS float* rssl; float inv_n, eps;
    __device__ __forceinline__ void mid(f32x4 (&acc)[2][2][4][2], const Unit& u, int wr, int fr) const {
        const int nai = u.mh < 0 ? 2 : 1;
#pragma unroll
        for (int ai = 0; ai < 2; ++ai) if (ai < nai)
#pragma unroll
            for (int m = 0; m < 4; ++m) { const PG8_LAS f32x4* p = (const PG8_LAS f32x4*)(rssl + (ai * HALF + wr * 64 + m * 16 + fr) * 8); const f32x4 a = p[0], b = p[1];
                const float c = __builtin_amdgcn_sqrtf((((a[0] + a[1]) + (a[2] + a[3])) + ((b[0] + b[1]) + (b[2] + b[3]))) * inv_n + eps);
#pragma unroll
                for (int bj = 0; bj < 2; ++bj)
#pragma unroll
                    for (int n = 0; n < 2; ++n) acc[ai][bj][m][n] = acc[ai][bj][m][n] * c; }
    }
    __device__ __forceinline__ void operator()(const f32x4 (&acc)[2][2][4][2], const Unit& u, int wr, int wc, int fr, int fq) const {
        const int nai = u.mh < 0 ? 2 : 1, row0 = u.pm * BM + (u.mh > 0 ? HALF : 0) + wr * 64 + fr, col0 = u.pn * BM + wc * 32 + 8 * fq;
#pragma unroll
        for (int ai = 0; ai < 2; ++ai) if (ai < nai) {
            u32x4 xin[4][2];
#pragma unroll
            for (int m = 0; m < 4; ++m)
#pragma unroll
                for (int bj = 0; bj < 2; ++bj) xin[m][bj] = *(const u32x4*)(XB + (size_t)(row0 + ai * HALF + m * 16) * ldc + col0 + bj * HALF);
#pragma unroll
            for (int m = 0; m < 4; ++m) { const int row = row0 + ai * HALF + m * 16; bf16_t* rowb = XB + (size_t)row * ldc + col0; float ss = 0.f;
                const float scale = MIDS ? this->scale * row_rnorm_lds(rssl, ai * HALF + wr * 64 + m * 16 + fr, inv_n, eps) : this->scale;
#pragma unroll
                for (int bj = 0; bj < 2; ++bj) { const u32x4 xo = xin[m][bj]; const f32x4 a0 = acc[ai][bj][m][0], a1 = acc[ai][bj][m][1];
                    f32x4 v0, v1;
                    v0[0] = __uint_as_float(xo.x << 16) + a0[0] * scale; v0[1] = __uint_as_float(xo.x & 0xffff0000u) + a0[1] * scale; v0[2] = __uint_as_float(xo.y << 16) + a0[2] * scale; v0[3] = __uint_as_float(xo.y & 0xffff0000u) + a0[3] * scale;
                    v1[0] = __uint_as_float(xo.z << 16) + a1[0] * scale; v1[1] = __uint_as_float(xo.z & 0xffff0000u) + a1[1] * scale; v1[2] = __uint_as_float(xo.w << 16) + a1[2] * scale; v1[3] = __uint_as_float(xo.w & 0xffff0000u) + a1[3] * scale;
                    ss += (v0[0] * v0[0] + v0[1] * v0[1]) + (v0[2] * v0[2] + v0[3] * v0[3]) + (v1[0] * v1[0] + v1[1] * v1[1]) + (v1[2] * v1[2] + v1[3] * v1[3]);
                    u32x4 w; w.x = cvt_pk_bf16(v0[0], v0[1]); w.y = cvt_pk_bf16(v0[2], v0[3]); w.z = cvt_pk_bf16(v1[0], v1[1]); w.w = cvt_pk_bf16(v1[2], v1[3]);
                    *(u32x4*)(rowb + bj * HALF) = w;
                    if (XB8) { int w0 = __builtin_amdgcn_cvt_pk_fp8_f32(v0[0], v0[1], 0, false); w0 = __builtin_amdgcn_cvt_pk_fp8_f32(v0[2], v0[3], w0, true);
                        int w1 = __builtin_amdgcn_cvt_pk_fp8_f32(v1[0], v1[1], 0, false); w1 = __builtin_amdgcn_cvt_pk_fp8_f32(v1[2], v1[3], w1, true);
                        u32x2 w8; w8.x = (unsigned)w0; w8.y = (unsigned)w1; *(u32x2*)(XB8 + (size_t)row * ldc + col0 + bj * HALF) = w8; } }
                ss += __shfl_xor(ss, 16); ss += __shfl_xor(ss, 32);
                if (fq == 0) red[(ai * HALF + wr * 64 + m * 16 + fr) * 4 + wc] = ss; }
            asm volatile("" ::: "memory"); }
        asm volatile("s_waitcnt lgkmcnt(0)" ::: "memory"); __builtin_amdgcn_s_barrier(); asm volatile("" ::: "memory");
        { const int t = (wr * 4 + wc) * 64 + fq * 16 + fr;
          if (t < nai * HALF) { const f32x4 q = *(const PG8_LAS f32x4*)(red + t * 4); rss_out[((size_t)u.pm * BM + (u.mh > 0 ? HALF : 0) + t) * 8 + u.pn] = (q[0] + q[1]) + (q[2] + q[3]); } }
    }
};
struct EpiStoreBf16 {
    static constexpr bool MID = false;
    static constexpr bool PERM = true, AFTER_DRAIN = false, QPRE = false;
    static constexpr bool RSS = true;
    bf16_t* O; int ldc; const float* rss; const PG8_LAS float* rssl; float inv_n, eps; bf16_t* UG; int ucol0, ug_chunks, ug_ld;
    __device__ __forceinline__ void operator()(const f32x4 (&acc)[2][2][4][2], const Unit& u, int wr, int wc, int fr, int fq) const {
        const int nai = u.mh < 0 ? 2 : 1, row0 = u.pm * BM + (u.mh > 0 ? HALF : 0) + wr * 64 + fr, col0 = u.pn * BM + wc * 32 + 8 * fq; const bool isu = (u.pn * BM >= ucol0);
#pragma unroll
        for (int ai = 0; ai < 2; ++ai) if (ai < nai)
#pragma unroll
            for (int m = 0; m < 4; ++m) { const int row = row0 + ai * HALF + m * 16; const float r = row_rnorm_lds(rssl, ai * HALF + wr * 64 + m * 16 + fr, inv_n, eps);
#pragma unroll
                for (int bj = 0; bj < 2; ++bj) { const f32x4 v0 = acc[ai][bj][m][0] * r, v1 = acc[ai][bj][m][1] * r;
                    u32x4 w; w.x = cvt_pk_bf16(v0[0], v0[1]); w.y = cvt_pk_bf16(v0[2], v0[3]); w.z = cvt_pk_bf16(v1[0], v1[1]); w.w = cvt_pk_bf16(v1[2], v1[3]);
                    const int c = col0 + bj * HALF;
                    bf16_t* dst = isu ? UG + ((size_t)((c - ucol0) >> 4) * ug_chunks + (row >> 4)) * ug_ld + (row & 15) * 16 + (c & 15) : O + (size_t)row * ldc + c;
                    *(u32x4*)dst = w; } }
    }
};
struct EpiSloc {
    static constexpr bool MID = false;
    static constexpr bool RSS = false;
    static constexpr bool PERM = false, AFTER_DRAIN = false, QPRE = false;
    float* S; int cpg, nchunk, ngrp;
    __device__ __forceinline__ void operator()(const f32x4 (&acc)[2][2][4][2], const Unit& u, int wr, int wc, int fr, int fq) const {
        const int nai = u.mh < 0 ? 2 : 1, R0 = u.pm * BM + (u.mh > 0 ? HALF : 0) + wr * 64 + fr, g = R0 / cpg, c0 = R0 - g * cpg, col0 = wc * 32 + 4 * fq;
#pragma unroll
        for (int ai = 0; ai < 2; ++ai) if (ai < nai)
#pragma unroll
            for (int m = 0; m < 4; ++m) { const int chunk = c0 + ai * HALF + m * 16; if (chunk < nchunk) { float* p = S + ((size_t)chunk * ngrp + g) * 128 + col0;
#pragma unroll
                for (int n = 0; n < 2; ++n) *(f32x4*)(p + n * 16) = acc[ai][0][m][n]; } }
    }
};
struct EpiYs {
    static constexpr bool MID = false;
    static constexpr bool RSS = false;
    static constexpr bool PERM = true, AFTER_DRAIN = false, QPRE = false;
    bf16_t* Y; int ldy, cpg, nchunk;
    __device__ __forceinline__ void operator()(const f32x4 (&acc)[2][2][4][2], const Unit& u, int wr, int wc, int fr, int fq) const {
        const int nai = u.mh < 0 ? 2 : 1, R0 = u.pm * BM + (u.mh > 0 ? HALF : 0) + wr * 64 + fr, g = R0 / cpg, c0 = R0 - g * cpg, col0 = wc * 32 + 8 * fq;
#pragma unroll
        for (int ai = 0; ai < 2; ++ai) if (ai < nai)
#pragma unroll
            for (int m = 0; m < 4; ++m) { const int chunk = c0 + ai * HALF + m * 16; if (chunk < nchunk) {
#pragma unroll
                for (int bj = 0; bj < 2; ++bj) { const int c = col0 + bj * HALF; float o[8];
#pragma unroll
                    for (int n = 0; n < 2; ++n)
#pragma unroll
                        for (int j = 0; j < 4; ++j) { const float x = acc[ai][bj][m][n][j]; const float z = 0.7978845608028654f * (x + 0.044715f * x * x * x); o[4 * n + j] = x * fast_sigmoid(2.0f * z); }
                    u32x4 w; w.x = cvt_pk_bf16(o[0], o[1]); w.y = cvt_pk_bf16(o[2], o[3]); w.z = cvt_pk_bf16(o[4], o[5]); w.w = cvt_pk_bf16(o[6], o[7]);
                    *(u32x4*)(Y + ((size_t)chunk * 16 + (c >> 4)) * ldy + g * 16 + (c & 15)) = w; } } }
    }
};
struct EpiGlu {
    static constexpr bool MID = false;
    static constexpr bool RSS = false;
    static constexpr bool PERM = true, AFTER_DRAIN = false, QPRE = false;
    const bf16_t* Y; int ldy; bf16_t* O; int ldo; float* rss_out; PG8_LAS float* red;
    __device__ __forceinline__ void operator()(const f32x4 (&acc)[2][2][4][2], const Unit& u, int wr, int wc, int fr, int fq) const {
        const int nai = u.mh < 0 ? 2 : 1, row0 = u.pm * BM + (u.mh > 0 ? HALF : 0) + wr * 64 + fr, col0 = u.pn * BM + wc * 32 + 8 * fq;
#pragma unroll
        for (int ai = 0; ai < 2; ++ai) if (ai < nai) {
            u32x4 yin[4][2];
#pragma unroll
            for (int m = 0; m < 4; ++m)
#pragma unroll
                for (int bj = 0; bj < 2; ++bj) yin[m][bj] = *(const u32x4*)(Y + (size_t)(row0 + ai * HALF + m * 16) * ldy + col0 + bj * HALF);
#pragma unroll
            for (int m = 0; m < 4; ++m) { const size_t r = (size_t)(row0 + ai * HALF + m * 16); float ss = 0.f;
#pragma unroll
                for (int bj = 0; bj < 2; ++bj) { const u32x4 yv = yin[m][bj]; const f32x4 z0 = acc[ai][bj][m][0], z1 = acc[ai][bj][m][1];
                    float o[8];
#pragma unroll
                    for (int q = 0; q < 4; ++q) { const unsigned w = yv[q]; const float ylo = __uint_as_float(w << 16), yhi = __uint_as_float(w & 0xffff0000u);
                        const float za = (q < 2) ? z0[2 * q] : z1[2 * q - 4], zb = (q < 2) ? z0[2 * q + 1] : z1[2 * q - 3];
                        o[2 * q] = ylo * fast_sigmoid(za); o[2 * q + 1] = yhi * fast_sigmoid(zb); ss += o[2 * q] * o[2 * q] + o[2 * q + 1] * o[2 * q + 1]; }
                    u32x4 w; w.x = cvt_pk_bf16(o[0], o[1]); w.y = cvt_pk_bf16(o[2], o[3]); w.z = cvt_pk_bf16(o[4], o[5]); w.w = cvt_pk_bf16(o[6], o[7]);
                    *(u32x4*)(O + r * ldo + col0 + bj * HALF) = w; }
                ss += __shfl_xor(ss, 16); ss += __shfl_xor(ss, 32);
                if (fq == 0) red[(ai * HALF + wr * 64 + m * 16 + fr) * 4 + wc] = ss; }
            asm volatile("" ::: "memory"); }
        asm volatile("s_waitcnt lgkmcnt(0)" ::: "memory"); __builtin_amdgcn_s_barrier(); asm volatile("" ::: "memory");
        { const int t = (wr * 4 + wc) * 64 + fq * 16 + fr;
          if (t < nai * HALF) { const f32x4 q = *(const PG8_LAS f32x4*)(red + t * 4); float* ro = rss_out + ((size_t)u.pm * BM + (u.mh > 0 ? HALF : 0) + t) * 8 + u.pn; ro[0] = (q[0] + q[1]) + (q[2] + q[3]); ro[4] = 0.f; } }
    }
};
struct EpiSwigluQ {
    static constexpr bool MID = false, RSS = true;
    static constexpr bool PERM = true, AFTER_DRAIN = false, QPRE = true;
    const float* QF; unsigned char* H; const float* CSG; int ldc; const float* CSU; int f8; float oscale; const PG8_LAS float* rssl;
    __device__ __forceinline__ const void* pre_src(const Unit& u, int wid, int lane) const {
        return wid == 0 ? (const void*)(QF + (size_t)u.pm * BM + (u.mh > 0 ? HALF : 0) + lane * 4) : (const void*)((lane < 32 ? CSG : CSU) + u.pn * HALF + (lane & 31) * 4); }
    __device__ __forceinline__ void operator()(const f32x4 (&acc)[2][2][4][2], const Unit& u, int wr, int wc, int fr, int fq) const {
        const int nai = u.mh < 0 ? 2 : 1, row0 = u.pm * BM + (u.mh > 0 ? HALF : 0) + wr * 64 + fr, col0 = u.pn * HALF + wc * 32 + 8 * fq;
        f32x4 cg[2], cu[2]; const PG8_LAS f32x4* cp = (const PG8_LAS f32x4*)(rssl + 256 + wc * 32 + 8 * fq); cg[0] = cp[0]; cg[1] = cp[1]; cu[0] = cp[32] * oscale; cu[1] = cp[33] * oscale;
        float qf[2][4];
#pragma unroll
        for (int ai = 0; ai < 2; ++ai)
#pragma unroll
            for (int m = 0; m < 4; ++m) qf[ai][m] = (ai < nai) ? rssl[ai * HALF + wr * 64 + m * 16 + fr] : 0.f;
#pragma unroll
        for (int ai = 0; ai < 2; ++ai) if (ai < nai)
#pragma unroll
            for (int m = 0; m < 4; ++m) { const int row = row0 + ai * HALF + m * 16;
                float o[8];
#pragma unroll
                for (int n = 0; n < 2; ++n)
#pragma unroll
                    for (int j = 0; j < 4; j += 2) { const f32x4 ag = acc[ai][0][m][n], au = acc[ai][1][m][n];
                        const float g0 = ag[j], g1 = ag[j + 1], u0 = au[j], u1 = au[j + 1];
                        const f32x2 g = ((f32x2){(float)__float_as_int(g0), (float)__float_as_int(g1)} * qf[ai][m]) * (f32x2){cg[n][j], cg[n][j + 1]};
                        const f32x2 up = ((f32x2){(float)__float_as_int(u0), (float)__float_as_int(u1)} * qf[ai][m]) * (f32x2){cu[n][j], cu[n][j + 1]};
                        f32x2 e = g * (-1.4426950408889634f); e.x = __builtin_amdgcn_exp2f(e.x); e.y = __builtin_amdgcn_exp2f(e.y); e = e + 1.0f;
                        f32x2 sgm; sgm.x = __builtin_amdgcn_rcpf(e.x); sgm.y = __builtin_amdgcn_rcpf(e.y);
                        const f32x2 ov = (g * up) * sgm; o[4 * n + j] = ov.x; o[4 * n + j + 1] = ov.y; }
                if (f8) {
                    int w0 = __builtin_amdgcn_cvt_pk_fp8_f32(o[0], o[1], 0, false); w0 = __builtin_amdgcn_cvt_pk_fp8_f32(o[2], o[3], w0, true);
                    int w1 = __builtin_amdgcn_cvt_pk_fp8_f32(o[4], o[5], 0, false); w1 = __builtin_amdgcn_cvt_pk_fp8_f32(o[6], o[7], w1, true);
                    u32x2 w; w.x = (unsigned)w0; w.y = (unsigned)w1; *(u32x2*)(H + (size_t)row * ldc + col0) = w;
                } else {
                    u32x4 w; w.x = cvt_pk_bf16(o[0], o[1]); w.y = cvt_pk_bf16(o[2], o[3]); w.z = cvt_pk_bf16(o[4], o[5]); w.w = cvt_pk_bf16(o[6], o[7]);
                    *(u32x4*)((bf16_t*)H + (size_t)row * ldc + col0) = w; } }
    }
};
template <class Epi, class Sched, bool ALIGN_EPI = false, bool SP2 = false, int FP8 = 0, bool HM = false>
__device__ __forceinline__ void gemm_phase(PG8_LAS unsigned char* lds, const Gemm g, const Sched& S, const Epi& E, const int tid_in) {   constexpr bool hm = HM;
    const int tid = tid_in, wid = __builtin_amdgcn_readfirstlane(tid >> 6), lane = tid & 63, wr = wid >> 2, wc = wid & 3, fr = lane & 15, fq = lane >> 4;
    const int K = g.K, nt = K / BK;
    unsigned voffA[2], voffB[2];
#pragma unroll
    for (int i = 0; i < 2; ++i) { int R, C; stage_rc(tid * 16 + i * 8192, R, C); const int Rb = Epi::PERM ? ((R & ~31) + perm32(R & 31)) : R;
        voffA[i] = (unsigned)(R * g.lda + C) * 2u; voffB[i] = (unsigned)(Rb * g.ldb + C) * 2u; }
    const size_t kstep = (size_t)(BK * 2);
    const size_t hstepA = (size_t)HALF * g.lda * 2, hstepB = (size_t)HALF * g.ldb * 2;
    const size_t tstepA = 2 * hstepA, tstepB = 2 * hstepB;
    const unsigned ldsw = (unsigned)wid * 1024u;
    const int aoff = lds_byte(wr * 64 + fr, fq * 8), boff = lds_byte(wc * 32 + fr, fq * 8);
#define PG8_SA(b, h) (((b) * 2 + (h)) * HTB)
#define PG8_SB(b, h) ((4 + (b) * 2 + (h)) * HTB)
#define PG8_STAGE(bufoff, gbase, voff) do { _Pragma("unroll") for (int _i = 0; _i < 2; ++_i) \
        __builtin_amdgcn_global_load_lds((const unsigned*)((const char*)(gbase) + (voff)[_i]), (PG8_LAS unsigned*)(lds + (bufoff) + ldsw + _i * 8192), 16, 0, 0); } while (0)
#define PG8_LDA(dst, b, h) do { if constexpr (FP8 == 1) { _Pragma("unroll") for (int m = 0; m < 4; ++m) { const i32x4 lo_ = *(const PG8_LAS i32x4*)(lds + PG8_SA(b, h) + aoff + m * 2048), hi_ = *(const PG8_LAS i32x4*)(lds + PG8_SA(b, h) + aoff + m * 2048 + 1024); \
            dst##8[m] = __builtin_shufflevector(lo_, hi_, 0, 1, 2, 3, 4, 5, 6, 7); } } \
        else { _Pragma("unroll") for (int m = 0; m < 4; ++m) _Pragma("unroll") for (int k = 0; k < 2; ++k) dst[m][k] = *(const PG8_LAS bf16x8*)(lds + PG8_SA(b, h) + aoff + m * 2048 + k * 1024); } } while (0)
#define PG8_LDB(dst, b, h) do { if constexpr (FP8 == 1) { _Pragma("unroll") for (int n = 0; n < 2; ++n) { const i32x4 lo_ = *(const PG8_LAS i32x4*)(lds + PG8_SB(b, h) + boff + n * 2048), hi_ = *(const PG8_LAS i32x4*)(lds + PG8_SB(b, h) + boff + n * 2048 + 1024); \
            dst##8[n] = __builtin_shufflevector(lo_, hi_, 0, 1, 2, 3, 4, 5, 6, 7); } } \
        else { _Pragma("unroll") for (int n = 0; n < 2; ++n) _Pragma("unroll") for (int k = 0; k < 2; ++k) dst[n][k] = *(const PG8_LAS bf16x8*)(lds + PG8_SB(b, h) + boff + n * 2048 + k * 1024); } } while (0)
#define PG8_MMA(ai, bj, At, Bt) do { __builtin_amdgcn_s_setprio(1); \
        if constexpr (FP8 == 1) { _Pragma("unroll") for (int m = 0; m < 4; ++m) _Pragma("unroll") for (int n = 0; n < 2; ++n) \
            asm volatile("v_mfma_scale_f32_16x16x128_f8f6f4 %0, %1, %2, %0, %3, %3 op_sel_hi:[0,0,0]" : "+v"(acc[ai][bj][m][n]) : "v"(Bt##8[n]), "v"(At##8[m]), "v"(one_scale)); } \
        else if constexpr (FP8 == 2) { _Pragma("unroll") for (int m = 0; m < 4; ++m) _Pragma("unroll") for (int n = 0; n < 2; ++n) _Pragma("unroll") for (int k = 0; k < 2; ++k) \
            acc[ai][bj][m][n] = __builtin_bit_cast(f32x4, __builtin_amdgcn_mfma_i32_16x16x64_i8(__builtin_bit_cast(i32x4, Bt[n][k]), __builtin_bit_cast(i32x4, At[m][k]), __builtin_bit_cast(i32x4, acc[ai][bj][m][n]), 0, 0, 0)); } \
        else { _Pragma("unroll") for (int m = 0; m < 4; ++m) _Pragma("unroll") for (int n = 0; n < 2; ++n) _Pragma("unroll") for (int k = 0; k < 2; ++k) \
            acc[ai][bj][m][n] = __builtin_amdgcn_mfma_f32_16x16x32_bf16(Bt[n][k], At[m][k], acc[ai][bj][m][n], 0, 0, 0); } \
        __builtin_amdgcn_s_setprio(0); } while (0)
#define PG8_RSS_DMA() do { if constexpr (Epi::RSS) { if (t == 0) { if constexpr (Epi::QPRE) { if (wid < 2) __builtin_amdgcn_global_load_lds((const unsigned*)E.pre_src(cur, wid, lane), (PG8_LAS unsigned*)((PG8_LAS unsigned char*)E.rssl + ldsw), 16, 0, 0); } \
        else __builtin_amdgcn_global_load_lds((const unsigned*)((const char*)E.rss + ((size_t)cur.pm * BM + (cur.mh > 0 ? HALF : 0)) * 32 + (size_t)tid * 16), \
        (PG8_LAS unsigned*)((PG8_LAS unsigned char*)E.rssl + ldsw), 16, 0, 0); } } } while (0)
#define PG8_WAIT_V(n) asm volatile("s_waitcnt vmcnt(" #n ")" ::: "memory")
#define PG8_WAIT_L(n) asm volatile("s_waitcnt lgkmcnt(" #n ")" ::: "memory")
#define PG8_BAR __builtin_amdgcn_s_barrier()
#define PG8_SCHED __builtin_amdgcn_sched_barrier(0)
    Unit cur, nxt; int ui = 0;
    if (!S.next(0, cur)) return;
    f32x4 acc[2][2][4][2];
#pragma unroll
    for (int a = 0; a < 2; ++a)
#pragma unroll
        for (int b = 0; b < 2; ++b)
#pragma unroll
            for (int m = 0; m < 4; ++m)
#pragma unroll
                for (int n = 0; n < 2; ++n) acc[a][b][m][n] = (f32x4){0.f, 0.f, 0.f, 0.f};
    int one_scale = 0x7f7f7f7f; asm volatile("" : "+v"(one_scale));
    bf16x8 At[4][2], B0[2][2], B1[2][2]; i32x8 At8[4], B08[2], B18[2];
    const char* cA = (const char*)g.A + (size_t)cur.pm * tstepA + (cur.mh > 0 ? hstepA : (size_t)0); const char* cB = (const char*)g.Bt + (size_t)cur.pn * tstepB + (g.gpanels ? (size_t)(cur.pm / g.gpanels) * g.gstride : (size_t)0);
    S.a_ready(cur);
    if constexpr (SP2) {
        if constexpr (HM) {
        PG8_STAGE(PG8_SB(0, 0), cB, voffB); PG8_STAGE(PG8_SB(0, 1), cB + hstepB, voffB); PG8_STAGE(PG8_SA(0, 0), cA, voffA);
        if (wr == 1) PG8_BAR;
        PG8_WAIT_V(0); PG8_BAR;
        PG8_STAGE(PG8_SB(1, 0), cB + kstep, voffB); PG8_STAGE(PG8_SA(1, 0), cA + kstep, voffA); PG8_STAGE(PG8_SB(1, 1), cB + hstepB + kstep, voffB);
        PG8_BAR;
        } else {
        PG8_STAGE(PG8_SB(0, 0), cB, voffB); PG8_STAGE(PG8_SB(0, 1), cB + hstepB, voffB); PG8_STAGE(PG8_SA(0, 0), cA, voffA); PG8_STAGE(PG8_SA(0, 1), cA + hstepA, voffA);
        if (wr == 1) PG8_BAR;
        PG8_WAIT_V(2); PG8_BAR;
        PG8_STAGE(PG8_SB(1, 0), cB + kstep, voffB); PG8_STAGE(PG8_SA(1, 0), cA + kstep, voffA); PG8_STAGE(PG8_SB(1, 1), cB + hstepB + kstep, voffB);
        PG8_WAIT_V(6); PG8_BAR;
        }
    } else {
        PG8_STAGE(PG8_SB(0, 0), cB, voffB); PG8_STAGE(PG8_SA(0, 0), cA, voffA); PG8_STAGE(PG8_SB(0, 1), cB + hstepB, voffB); PG8_STAGE(PG8_SA(0, 1), cA + hstepA, voffA);
        if (wr == 1) PG8_BAR;
        PG8_WAIT_V(4); PG8_BAR;
        PG8_STAGE(PG8_SB(1, 0), cB + kstep, voffB); PG8_STAGE(PG8_SA(1, 0), cA + kstep, voffA); PG8_STAGE(PG8_SB(1, 1), cB + hstepB + kstep, voffB);
        PG8_WAIT_V(6); PG8_BAR;
    }
    for (;;) {
        const bool has_next = S.next(ui + 1, nxt);
        const char* nA = has_next ? (const char*)g.A + (size_t)nxt.pm * tstepA + (nxt.mh > 0 ? hstepA : (size_t)0) : cA; const char* nB = has_next ? (const char*)g.Bt + (size_t)nxt.pn * tstepB + (g.gpanels ? (size_t)(nxt.pm / g.gpanels) * g.gstride : (size_t)0) : cB;
#pragma nounroll
        for (int t = 0; t < nt; t += 2) {
            const bool last = (t == nt - 2);
            const char* a1 = cA + (size_t)(t + 1) * kstep;
            const char* a2 = last ? nA : cA + (size_t)(t + 2) * kstep; const char* b2 = last ? nB : cB + (size_t)(t + 2) * kstep;
            const char* a3 = a2 + kstep; const char* b3 = b2 + kstep;
            if (last && has_next) S.a_ready(nxt);
            if constexpr (Epi::MID) { if (t == (nt >> 1)) E.mid(acc, cur, wr, fr); }
            if constexpr (SP2) {
            if constexpr (HM) {
            PG8_LDB(B0, 0, 0); PG8_LDB(B1, 0, 1); PG8_SCHED; PG8_LDA(At, 0, 0);
            PG8_WAIT_L(0); PG8_BAR; PG8_RSS_DMA(); PG8_MMA(0, 0, At, B0); PG8_MMA(0, 1, At, B1); PG8_BAR; PG8_SCHED;
            PG8_STAGE(PG8_SB(0, 0), b2, voffB); PG8_STAGE(PG8_SB(0, 1), b2 + hstepB, voffB); PG8_STAGE(PG8_SA(0, 0), a2, voffA);
            PG8_WAIT_V(6); PG8_BAR; PG8_BAR; PG8_SCHED;
            PG8_LDB(B0, 1, 0); PG8_LDB(B1, 1, 1); PG8_SCHED; PG8_LDA(At, 1, 0);
            PG8_WAIT_L(0); PG8_BAR; PG8_MMA(0, 0, At, B0); PG8_MMA(0, 1, At, B1); PG8_BAR; PG8_SCHED;
            PG8_STAGE(PG8_SB(1, 0), b3, voffB); PG8_STAGE(PG8_SB(1, 1), b3 + hstepB, voffB); PG8_STAGE(PG8_SA(1, 0), a3, voffA);
            PG8_WAIT_V(6); PG8_BAR; PG8_BAR; PG8_SCHED;
            } else {
            PG8_LDB(B0, 0, 0); PG8_LDB(B1, 0, 1); PG8_SCHED; PG8_LDA(At, 0, 0); PG8_STAGE(PG8_SA(1, 1), a1 + hstepA, voffA);
            PG8_WAIT_V(8); PG8_WAIT_L(0); PG8_BAR; PG8_RSS_DMA(); PG8_MMA(0, 0, At, B0); PG8_MMA(0, 1, At, B1); PG8_BAR; PG8_SCHED;
            PG8_LDA(At, 0, 1); PG8_STAGE(PG8_SB(0, 0), b2, voffB); PG8_STAGE(PG8_SB(0, 1), b2 + hstepB, voffB); PG8_STAGE(PG8_SA(0, 0), a2, voffA);
            PG8_WAIT_V(8); PG8_WAIT_L(0); PG8_BAR; PG8_MMA(1, 0, At, B0); PG8_MMA(1, 1, At, B1); PG8_BAR; PG8_SCHED;
            PG8_LDB(B0, 1, 0); PG8_LDB(B1, 1, 1); PG8_SCHED; PG8_LDA(At, 1, 0); PG8_STAGE(PG8_SA(0, 1), a2 + hstepA, voffA);
            PG8_WAIT_V(8); PG8_WAIT_L(0); PG8_BAR; PG8_MMA(0, 0, At, B0); PG8_MMA(0, 1, At, B1); PG8_BAR; PG8_SCHED;
            PG8_LDA(At, 1, 1); PG8_STAGE(PG8_SB(1, 0), b3, voffB); PG8_STAGE(PG8_SB(1, 1), b3 + hstepB, voffB); PG8_STAGE(PG8_SA(1, 0), a3, voffA);
            PG8_WAIT_V(8); PG8_WAIT_L(0); PG8_BAR; PG8_MMA(1, 0, At, B0); PG8_MMA(1, 1, At, B1); PG8_BAR; PG8_SCHED;
            }
            } else {
            PG8_LDB(B0, 0, 0); PG8_SCHED; PG8_LDA(At, 0, 0); PG8_STAGE(PG8_SA(1, 1), a1 + hstepA, voffA);
            PG8_WAIT_L(8); PG8_BAR; PG8_WAIT_L(0); PG8_MMA(0, 0, At, B0); PG8_BAR; PG8_SCHED;
            PG8_LDB(B1, 0, 1); PG8_STAGE(PG8_SB(0, 0), b2, voffB);
            PG8_BAR; PG8_WAIT_L(0); PG8_MMA(0, 1, At, B1); PG8_BAR;
            PG8_LDA(At, 0, 1); PG8_STAGE(PG8_SA(0, 0), a2, voffA);
            PG8_BAR; PG8_WAIT_L(0); PG8_MMA(1, 0, At, B0); PG8_BAR; PG8_SCHED;
            PG8_STAGE(PG8_SB(0, 1), b2 + hstepB, voffB);
            PG8_WAIT_V(6); PG8_BAR; PG8_MMA(1, 1, At, B1); PG8_BAR;
            PG8_LDB(B0, 1, 0); PG8_SCHED; PG8_LDA(At, 1, 0); PG8_STAGE(PG8_SA(0, 1), a2 + hstepA, voffA);
            PG8_WAIT_L(8); PG8_BAR; PG8_WAIT_L(0); PG8_MMA(0, 0, At, B0); PG8_BAR; PG8_SCHED;
            PG8_LDB(B1, 1, 1); PG8_STAGE(PG8_SB(1, 0), b3, voffB);
            PG8_BAR; PG8_WAIT_L(0); PG8_MMA(0, 1, At, B1); PG8_BAR;
            PG8_LDA(At, 1, 1); PG8_STAGE(PG8_SA(1, 0), a3, voffA);
            PG8_BAR; PG8_WAIT_L(0); PG8_MMA(1, 0, At, B0); PG8_BAR; PG8_SCHED;
            PG8_STAGE(PG8_SB(1, 1), b3 + hstepB, voffB);
            PG8_WAIT_V(6); PG8_BAR; PG8_MMA(1, 1, At, B1); PG8_BAR;
            }
        }
        if constexpr (ALIGN_EPI) { if (wr == 0) PG8_BAR; }
        if constexpr (!Epi::AFTER_DRAIN) {
            if constexpr (FP8 == 1) asm volatile("s_nop 15\n\ts_nop 15" ::: "memory");
            int tz = tid; asm volatile("" : "+v"(tz)); const int lz = tz & 63, wz = __builtin_amdgcn_readfirstlane(tz >> 6);
            E(acc, cur, wz >> 2, wz & 3, lz & 15, lz >> 4); S.done(cur); }
        if (!has_next) break;
#pragma unroll
        for (int a = 0; a < 2; ++a)
#pragma unroll
            for (int b = 0; b < 2; ++b)
#pragma unroll
                for (int m = 0; m < 4; ++m)
#pragma unroll
                    for (int n = 0; n < 2; ++n) acc[a][b][m][n] = (f32x4){0.f, 0.f, 0.f, 0.f};
        cur = nxt; cA = nA; cB = nB; ++ui;
        if constexpr (ALIGN_EPI) { if (wr == 1) PG8_BAR; }
    }
    PG8_WAIT_V(0);
    if constexpr (!ALIGN_EPI) { if (wr == 0) PG8_BAR; }
    PG8_BAR;
    if constexpr (Epi::AFTER_DRAIN) { E.fused(acc, cur, wr, wc, fr, fq, lds, wid, lane); S.done(cur); }
#undef PG8_SA
#undef PG8_SB
#undef PG8_STAGE
#undef PG8_LDA
#undef PG8_LDB
#undef PG8_MMA
#undef PG8_WAIT_V
#undef PG8_RSS_DMA
#undef PG8_WAIT_L
#undef PG8_BAR
#undef PG8_SCHED
}
}
#define GAS __attribute__((address_space(1)))
#define LAS __attribute__((address_space(3)))
typedef unsigned short bf16;
typedef unsigned v4u __attribute__((ext_vector_type(4)));
typedef float f32x4 __attribute__((ext_vector_type(4)));
typedef short bf16x8 __attribute__((ext_vector_type(8)));
typedef GAS unsigned gu32;
typedef GAS unsigned long long gu64;
#define RLX_AGENT __ATOMIC_RELAXED, __HIP_MEMORY_SCOPE_AGENT
#define LDS_WAIT() asm volatile("s_waitcnt lgkmcnt(0)" ::: "memory")
#define VM_WAIT() asm volatile("s_waitcnt vmcnt(0)" ::: "memory")
__device__ __forceinline__ unsigned long long rt() { return __builtin_amdgcn_s_memrealtime(); }
__device__ __forceinline__ unsigned f2bf(float f) { unsigned u = __builtin_bit_cast(unsigned, f); return (u + 0x7fffu + ((u >> 16) & 1u)) >> 16; }
__device__ __forceinline__ unsigned pk2(float lo, float hi) { return f2bf(lo) | (f2bf(hi) << 16); }

#define XB_TMO      128
#define XB_XCNT(j)  (256  + 64 * (j))
#define XB_XSUB(j)  (1280 + 64 * (j))
#define XB_XGEN(j)  (2304 + 64 * (j))
#define XB_TOP      3328
#define XB_TOPGEN   3392
#define XCD_BAR_WORDS 3456
#define XB_SPIN_CAP (1u << 18)

__device__ __forceinline__ unsigned xb_ld(unsigned* p)              { return __hip_atomic_load(p, __ATOMIC_RELAXED, __HIP_MEMORY_SCOPE_AGENT); }
__device__ __forceinline__ unsigned xb_add(unsigned* p, unsigned v) { return __hip_atomic_fetch_add(p, v, __ATOMIC_RELAXED, __HIP_MEMORY_SCOPE_AGENT); }
__device__ __forceinline__ unsigned xb_xcc_id() { return (unsigned)__builtin_amdgcn_s_getreg((3 << 11) | 20) & 0xFu; }
#define XB_SPIN(cond, bar) do { unsigned _sp = 0; while (cond) { __builtin_amdgcn_s_sleep(1); \
    if ((++_sp & 255u) == 0u) { if (xb_ld(&(bar)[XB_TMO])) break; if (_sp > XB_SPIN_CAP) { atomicAdd(&(bar)[XB_TMO], 1u); break; } } } } while (0)

struct XcdBarrier {
    unsigned* bar; unsigned x;
    volatile LAS unsigned* st;
};

__device__ __forceinline__ XcdBarrier xcd_barrier_post(unsigned* bar, volatile LAS unsigned* st) {
    XcdBarrier b; b.bar = bar; b.x = xb_xcc_id(); b.st = st;
    if (threadIdx.x == 0) (void)xb_add(&bar[XB_XCNT(b.x)], 1u);
    return b;
}
__device__ __forceinline__ void xcd_barrier_complete(unsigned* bar, unsigned x, unsigned& nloc, unsigned& nx) {
    const unsigned G = gridDim.x * gridDim.y * gridDim.z;
    unsigned sum, cnt, mine, sp = 0u;
    for (;;) {
        sum = 0u; cnt = 0u; mine = 0u;
#pragma unroll
        for (unsigned j = 0; j < 16; ++j) { const unsigned c = xb_ld(&bar[XB_XCNT(j)]); sum += c; cnt += (c > 0u) ? 1u : 0u; mine = (j == x) ? c : mine; }
        if (sum == G) break;
        __builtin_amdgcn_s_sleep(1);
        if ((++sp & 255u) == 0u) { if (xb_ld(&bar[XB_TMO])) break; if (sp > XB_SPIN_CAP) { atomicAdd(&bar[XB_TMO], 1u); break; } }
    }
    nloc = mine > 0u ? mine : 1u; nx = cnt > 0u ? cnt : 1u;
}

__device__ __forceinline__ void xcd_barrier(const XcdBarrier& b) {
    asm volatile("s_waitcnt vmcnt(0)" ::: "memory");
    __syncthreads();
    if (threadIdx.x == 0) {
        unsigned* bar = b.bar;
        __builtin_amdgcn_s_waitcnt(0);
        unsigned nloc = b.st[0], nx = b.st[1];
        if (nloc == 0u) { xcd_barrier_complete(bar, b.x, nloc, nx); b.st[0] = nloc; b.st[1] = nx; }
        const unsigned old = xb_add(&bar[XB_XSUB(b.x)], 1u);
        const unsigned gen = old / nloc;
        if (old + 1u == (gen + 1u) * nloc) {
            __builtin_amdgcn_fence(__ATOMIC_RELEASE, "agent");
            asm volatile("s_waitcnt vmcnt(0)" ::: "memory");
            const unsigned og = xb_add(&bar[XB_TOP], 1u);
            const unsigned tg = og / nx;
            if (og + 1u == (tg + 1u) * nx) xb_add(&bar[XB_TOPGEN], 1u);
            else XB_SPIN(xb_ld(&bar[XB_TOPGEN]) == tg, bar);
            __builtin_amdgcn_fence(__ATOMIC_ACQUIRE, "agent");
            xb_add(&bar[XB_XGEN(b.x)], 1u);
            asm volatile("s_waitcnt vmcnt(0)" ::: "memory");
        } else {
            XB_SPIN(xb_ld(&bar[XB_XGEN(b.x)]) == gen, bar);
            __builtin_amdgcn_fence(__ATOMIC_ACQUIRE, "agent");
            asm volatile("s_waitcnt vmcnt(0)" ::: "memory");
        }
    }
    __syncthreads();
}
namespace mk {
typedef float f32x2 __attribute__((ext_vector_type(2)));
typedef unsigned u32x2 __attribute__((ext_vector_type(2)));
constexpr int NWAVES = 8;
constexpr int D = 2048, FF = 5632, DCV = 1024, DSS = 1024, DIN = 4096, NL = 4;
constexpr int SEQ = 16384, NMETA = 16, TP = SEQ + NMETA, NBP = 2, NBS = 8, TS = 32;
constexpr int MPROMPT = NBP * TP;
constexpr int MREAL = MPROMPT + NBS * TS;
constexpr int MPAD = 33280;
constexpr int NCHUNK = MPAD / 16;
constexpr int NCH_REAL = MREAL / 16;
constexpr int CH_PER_SEQ = TP / 16;
constexpr int NCT = NCHUNK / 16;
constexpr int SG = 64, SP = 64, SH = 16;
constexpr float EPS = 1e-6f;
constexpr int FP8_FROM_HL = 3;
constexpr int FP8_UP_FROM = 2 * NL;
constexpr int UPQ_FROM = 0;
constexpr float QALPHA_UNUSED = 5.5f;
constexpr float H8_SCALE = 4.0f, WD8_SCALE = 256.0f, WGU8_SCALE = 256.0f;
static_assert(MPAD % 256 == 0 && MPAD >= MREAL && MREAL % 16 == 0 && TP % 16 == 0 && TS % 4 == 0 && TP >= 8 && TS >= 8, "row geometry");

enum { I_XP = 0, I_XS, I_CACHE, I_SRE, I_SIM, I_META, I_F1N, I_F1G, I_F1U, I_F1D, I_MIXN, I_WIN, I_CONVW, I_CONVN, I_LRE, I_LIM, I_LDT, I_BRE, I_BIM, I_CRE, I_CIM, I_SD,
       I_GLU, I_SSMN, I_WOUT, I_F2N, I_F2G, I_F2U, I_F2D, I_FINN, N_IN };
constexpr size_t O_YP = 0, O_YS = O_YP + (size_t)NBP * SEQ * D, O_CVP = O_YS + (size_t)NBS * TS * D, O_REP = O_CVP + (size_t)NL * NBP * 2 * DCV,
                 O_IMP = O_REP + (size_t)NL * NBP * SG * SP, O_CVS = O_IMP + (size_t)NL * NBP * SG * SP, O_RES = O_CVS + (size_t)NL * NBS * 2 * DCV,
                 O_IMS = O_RES + (size_t)NL * NBS * SG * SP, O_END = O_IMS + (size_t)NL * NBS * SG * SP;
static_assert(O_END == 68042752, "output size");

constexpr size_t CTL_BYTES = 1u << 20;
constexpr int NRSS = 4 * NL + 1;
constexpr size_t ZERO_BYTES = CTL_BYTES;
constexpr size_t RSS_STRIDE = (size_t)MPAD * 8 + 2048;
constexpr size_t WS_RSS = CTL_BYTES;
constexpr size_t WS_XN = WS_RSS + (size_t)NRSS * RSS_STRIDE * 4;
constexpr size_t WS_W = WS_XN + (size_t)MPAD * D * 2;
constexpr size_t W_GU0 = 0;
constexpr size_t W_GU1 = W_GU0 + (size_t)2 * FF * D * 2;
constexpr size_t W_D0 = W_GU1 + (size_t)2 * FF * D * 2;
constexpr size_t W_D1 = W_D0 + (size_t)D * FF * 2;
constexpr size_t W_IN = W_D1 + (size_t)D * FF * 2;
constexpr size_t W_GLU = W_IN + (size_t)DIN * D * 2;
constexpr size_t W_OUT = W_GLU + (size_t)DSS * DSS * 2;
constexpr size_t W_SET = W_OUT + (size_t)D * D * 2;
constexpr size_t WS_WBT = WS_W + 2 * W_SET;
constexpr size_t WS_BMT = WS_WBT + (size_t)SG * 256 * 384 * 2;
constexpr size_t WS_APOW = WS_BMT + (size_t)SG * 256 * 256 * 2;
constexpr int NPOW = 18;
constexpr size_t WS_BBAR = WS_APOW + (size_t)NL * NPOW * SG * SP * 8;
constexpr size_t WS_R = WS_BBAR + (size_t)NL * SG * SP * SH * 8;
constexpr size_t WS_H = WS_R;
constexpr size_t WS_PROJ = WS_R;
constexpr size_t WS_MIXED = WS_PROJ + (size_t)MPAD * DIN * 2;
constexpr size_t WS_YS = WS_MIXED + (size_t)MPAD * D * 2;
constexpr size_t WS_SLOC = WS_YS + (size_t)MPAD * DSS * 2;
constexpr int CPG = 2304, UGLD = 384;
constexpr size_t WS_UG = WS_SLOC + (size_t)NCHUNK * SG * 128 * 4;
constexpr size_t WS_XB8 = WS_UG + (size_t)SG * CPG * UGLD * 2;
constexpr size_t WS_DUMMY_ = 0;
constexpr size_t WS_END_A = WS_H + (size_t)MPAD * FF * 2, WS_CS = WS_XB8 + (size_t)MPAD * D;
constexpr size_t WS_QF = WS_CS + (size_t)2 * 4 * FF * 4;
constexpr size_t WS_END_B = WS_QF + (size_t)MPAD * 4 + 1024;
constexpr size_t WS_END = WS_END_A > WS_END_B ? WS_END_A : WS_END_B;
static_assert(WS_R % 256 == 0 && WS_SLOC % 256 == 0, "alignment");
constexpr int CW_BAR = 4096;

constexpr int RING_OFF = 0, RING_BYTES = 131072;
constexpr int LDSCTL_OFF = RING_BYTES, MISC_OFF = LDSCTL_OFF + 320;
constexpr int RED_OFF = RING_BYTES + 512, RSSB_OFF = RED_OFF + 4096;
constexpr int LDS_BYTES = 147456;
static_assert(RSSB_OFF + 8192 <= LDS_BYTES && RSSB_OFF % 16 == 0, "LDS map");

__device__ __forceinline__ float wave_sum(float v) {
#pragma unroll
    for (int o = 1; o < 64; o <<= 1) v += __shfl_xor(v, o);
    return v;
}
__device__ __forceinline__ unsigned pkbf(float lo, float hi) { return pg8::cvt_pk_bf16(lo, hi); }
__device__ __forceinline__ float bflo(unsigned w) { return __uint_as_float(w << 16); }
__device__ __forceinline__ float bfhi(unsigned w) { return __uint_as_float(w & 0xffff0000u); }

__device__ __forceinline__ void transpose_item(const float* W, int K, int N, bf16* WT, int mode, const float* gain, LAS float* scr, int item, int lane, float f8scale = 0.f, int gk0 = 0, const float* cs8 = nullptr) {
    const int nblk = N / 32, kb = item / nblk, nb = item % nblk, k0 = 64 * kb, n0 = 32 * nb;
    const int drow0 = (mode == 0) ? n0 : (256 * (n0 >> 7) + 128 * (mode - 1) + (n0 & 127));
    const int nq = lane & 7, kr = lane >> 3;
    f32x4 v[8]; float csv[4] = {1.f, 1.f, 1.f, 1.f};
    if (cs8) {
#pragma unroll
        for (int j = 0; j < 4; ++j) csv[j] = cs8[n0 + (lane >> 3) + 8 * j]; }
#pragma unroll
    for (int i = 0; i < 8; ++i) v[i] = *(const f32x4*)(W + (size_t)(k0 + kr + 8 * i) * N + n0 + 4 * nq);
#pragma unroll
    for (int i = 0; i < 8; ++i) { const int kk_ = k0 + kr + 8 * i; const float gk = (gain && kk_ >= gk0) ? gain[kk_ - gk0] : 1.0f; LAS float* d = scr + (kr + 8 * i) * 33 + 4 * nq; d[0] = v[i].x * gk; d[1] = v[i].y * gk; d[2] = v[i].z * gk; d[3] = v[i].w * gk; }
    LDS_WAIT(); asm volatile("" ::: "memory");
    const int c = lane & 7;
#pragma unroll
    for (int j = 0; j < 4; ++j) { const int n = (lane >> 3) + 8 * j; const LAS float* s = scr + (8 * c) * 33 + n;
        if (cs8) {
            const float qs = 1.0f / csv[j]; unsigned b[8];
#pragma unroll
            for (int e = 0; e < 8; ++e) { float t = s[e * 33] * qs; t = fminf(fmaxf(t, -127.f), 127.f); b[e] = (unsigned)__float2int_rn(t) & 0xffu; }
            u32x2 o; o.x = b[0] | (b[1] << 8) | (b[2] << 16) | (b[3] << 24); o.y = b[4] | (b[5] << 8) | (b[6] << 16) | (b[7] << 24);
            *(u32x2*)((unsigned char*)WT + (size_t)(drow0 + n) * K + k0 + 8 * c) = o;
        } else if (f8scale != 0.f) {
            int w0 = __builtin_amdgcn_cvt_pk_fp8_f32(s[0 * 33] * f8scale, s[1 * 33] * f8scale, 0, false); w0 = __builtin_amdgcn_cvt_pk_fp8_f32(s[2 * 33] * f8scale, s[3 * 33] * f8scale, w0, true);
            int w1 = __builtin_amdgcn_cvt_pk_fp8_f32(s[4 * 33] * f8scale, s[5 * 33] * f8scale, 0, false); w1 = __builtin_amdgcn_cvt_pk_fp8_f32(s[6 * 33] * f8scale, s[7 * 33] * f8scale, w1, true);
            u32x2 o; o.x = (unsigned)w0; o.y = (unsigned)w1; *(u32x2*)((unsigned char*)WT + (size_t)(drow0 + n) * K + k0 + 8 * c) = o;
        } else {
        v4u o; o.x = pkbf(s[0 * 33], s[1 * 33]); o.y = pkbf(s[2 * 33], s[3 * 33]); o.z = pkbf(s[4 * 33], s[5 * 33]); o.w = pkbf(s[6 * 33], s[7 * 33]);
        *(v4u*)(WT + (size_t)(drow0 + n) * K + k0 + 8 * c) = o; } }
    LDS_WAIT(); asm volatile("" ::: "memory");
}

__device__ __forceinline__ void pmaxc_item(const float* W, int N, const float* gain, float* pmc, int item, int lane) {
    const int nblk = N / 32, kb = item / nblk, nb = item % nblk, k0 = 64 * kb, n0 = 32 * nb; const int nq = lane & 7, kr = lane >> 3;
    f32x4 v[8];
#pragma unroll
    for (int i = 0; i < 8; ++i) v[i] = *(const f32x4*)(W + (size_t)(k0 + kr + 8 * i) * N + n0 + 4 * nq);
    f32x4 m = {0.f, 0.f, 0.f, 0.f};
#pragma unroll
    for (int i = 0; i < 8; ++i) { const float gk = fabsf(gain[k0 + kr + 8 * i]); m.x = fmaxf(m.x, fabsf(v[i].x) * gk); m.y = fmaxf(m.y, fabsf(v[i].y) * gk); m.z = fmaxf(m.z, fabsf(v[i].z) * gk); m.w = fmaxf(m.w, fabsf(v[i].w) * gk); }
#pragma unroll
    for (int o = 8; o < 64; o <<= 1) { m.x = fmaxf(m.x, __shfl_xor(m.x, o)); m.y = fmaxf(m.y, __shfl_xor(m.y, o)); m.z = fmaxf(m.z, __shfl_xor(m.z, o)); m.w = fmaxf(m.w, __shfl_xor(m.w, o)); }
    if (lane < 8) *(f32x4*)(pmc + (size_t)kb * N + n0 + 4 * nq) = m;
}
__device__ __forceinline__ void colstep_reduce(const float* pmc, float* cs, int c) {
    const int q = c / FF, n = c - q * FF; const float* p = pmc + (size_t)q * 32 * FF + n; float m = 1e-30f;
#pragma unroll 8
    for (int kb = 0; kb < 32; ++kb) m = fmaxf(m, p[(size_t)kb * FF]);
    cs[c] = m * (1.0f / 127.0f);
}
__device__ __forceinline__ void gu_task(const float* W, const float* gain, unsigned char* WT, int mode, float* cs, LAS float* scr, LAS float* xch, int nb, int wave, int lane) {
    const int n0 = 32 * nb, nq = lane & 7, kr = lane >> 3, kw = 256 * wave;
    const int drow0 = 256 * (n0 >> 7) + 128 * (mode - 1) + (n0 & 127);
    f32x4 v[32];
    const unsigned loff = (unsigned)(kr * FF + 4 * nq) * 4u;
#pragma unroll
    for (int i = 0; i < 32; ++i) v[i] = *(const f32x4*)((const char*)(W + (size_t)(kw + 8 * i) * FF + n0) + loff);
    LAS float* gl = scr + 2304;
    *(LAS f32x4*)(gl + 4 * lane) = *(const f32x4*)(gain + kw + 4 * lane);
    LDS_WAIT(); asm volatile("" ::: "memory");
    f32x4 m = {0.f, 0.f, 0.f, 0.f};
#pragma unroll
    for (int i = 0; i < 32; ++i) { const float gk = gl[kr + 8 * i]; v[i] = v[i] * gk; m.x = fmaxf(m.x, fabsf(v[i].x)); m.y = fmaxf(m.y, fabsf(v[i].y)); m.z = fmaxf(m.z, fabsf(v[i].z)); m.w = fmaxf(m.w, fabsf(v[i].w)); }
#pragma unroll
    for (int o = 8; o < 64; o <<= 1) { m.x = fmaxf(m.x, __shfl_xor(m.x, o)); m.y = fmaxf(m.y, __shfl_xor(m.y, o)); m.z = fmaxf(m.z, __shfl_xor(m.z, o)); m.w = fmaxf(m.w, __shfl_xor(m.w, o)); }
    if (lane < 8) *(LAS f32x4*)(xch + wave * 32 + 4 * nq) = m;
    __syncthreads();
    float qs[4];
#pragma unroll
    for (int j = 0; j < 4; ++j) { float cm = 1e-30f;
#pragma unroll
        for (int w = 0; w < 8; ++w) cm = fmaxf(cm, xch[w * 32 + (lane >> 3) + 8 * j]);
        qs[j] = 127.0f / cm; if (wave == 0 && (lane & 7) == 0) cs[n0 + (lane >> 3) + 8 * j] = cm * (1.0f / 127.0f); }
    const int c = lane & 7;
#pragma unroll
    for (int t = 0; t < 4; ++t) {
#pragma unroll
        for (int i = 0; i < 8; ++i) { LAS float* d = scr + (kr + 8 * i) * 33 + 4 * nq; d[0] = v[8 * t + i].x; d[1] = v[8 * t + i].y; d[2] = v[8 * t + i].z; d[3] = v[8 * t + i].w; }
        LDS_WAIT(); asm volatile("" ::: "memory");
#pragma unroll
        for (int j = 0; j < 4; ++j) { const int n = (lane >> 3) + 8 * j; const LAS float* s = scr + (8 * c) * 33 + n; unsigned b[8];
#pragma unroll
            for (int e = 0; e < 8; ++e) { float x = s[e * 33] * qs[j]; x = fminf(fmaxf(x, -127.f), 127.f); b[e] = (unsigned)__float2int_rn(x) & 0xffu; }
            u32x2 o; o.x = b[0] | (b[1] << 8) | (b[2] << 16) | (b[3] << 24); o.y = b[4] | (b[5] << 8) | (b[6] << 16) | (b[7] << 24);
            *(u32x2*)(WT + (size_t)(drow0 + n) * D + kw + 64 * t + 8 * c) = o; }
        LDS_WAIT(); asm volatile("" ::: "memory");
    }
    __syncthreads();
}
static_assert((D / 64) * (FF / 32) == 5632, "gate/up item count");
__device__ __forceinline__ void quant_rows2(const bf16* x0, const bf16* x1, const float* rss0, const float* rss1, unsigned char* q0, unsigned char* q1, float* qf0, float* qf1, bool has1, int lane) {
    v4u a[2][4];
#pragma unroll
    for (int c = 0; c < 2; ++c) { const v4u* p0 = (const v4u*)(x0 + c * 1024 + 16 * lane); a[0][2 * c] = p0[0]; a[0][2 * c + 1] = p0[1]; const v4u* p1 = (const v4u*)(x1 + c * 1024 + 16 * lane); a[1][2 * c] = p1[0]; a[1][2 * c + 1] = p1[1]; }
    const float s0 = wave_sum(lane < 8 ? rss0[lane] : 0.f), s1 = wave_sum(lane < 8 ? rss1[lane] : 0.f);
    unsigned mx[2] = {0u, 0u};
#pragma unroll
    for (int w = 0; w < 2; ++w)
#pragma unroll
        for (int i = 0; i < 4; ++i)
#pragma unroll
            for (int d = 0; d < 4; ++d) { const unsigned u = a[w][i][d]; mx[w] = max(mx[w], max(u & 0x7fffu, (u >> 16) & 0x7fffu)); }
#pragma unroll
    for (int o = 1; o < 64; o <<= 1) { mx[0] = max(mx[0], (unsigned)__shfl_xor((int)mx[0], o)); mx[1] = max(mx[1], (unsigned)__shfl_xor((int)mx[1], o)); }
    const float am[2] = {fmaxf(__uint_as_float(mx[0] << 16), 1e-30f), fmaxf(__uint_as_float(mx[1] << 16), 1e-30f)};
    const float r[2] = {127.0f / am[0], 127.0f / am[1]};
    if (lane == 0) { qf0[0] = am[0] * (1.0f / 127.0f) * __builtin_amdgcn_rsqf(s0 * (1.0f / D) + EPS); if (has1) qf1[0] = am[1] * (1.0f / 127.0f) * __builtin_amdgcn_rsqf(s1 * (1.0f / D) + EPS); }
#pragma unroll
    for (int w = 0; w < 2; ++w) { if (w == 1 && !has1) break; unsigned char* q = w ? q1 : q0;
#pragma unroll
        for (int c = 0; c < 2; ++c) { v4u o;
#pragma unroll
            for (int d = 0; d < 4; ++d) {
                const unsigned w0 = a[w][2 * c + (d >> 1)][(2 * d) & 3], w1 = a[w][2 * c + (d >> 1)][(2 * d + 1) & 3];
                float t0 = bflo(w0) * r[w], t1 = bfhi(w0) * r[w], t2 = bflo(w1) * r[w], t3 = bfhi(w1) * r[w];
                t0 = fminf(fmaxf(t0, -127.f), 127.f); t1 = fminf(fmaxf(t1, -127.f), 127.f); t2 = fminf(fmaxf(t2, -127.f), 127.f); t3 = fminf(fmaxf(t3, -127.f), 127.f);
                o[d] = ((unsigned)__float2int_rn(t0) & 0xffu) | (((unsigned)__float2int_rn(t1) & 0xffu) << 8) | (((unsigned)__float2int_rn(t2) & 0xffu) << 16) | (((unsigned)__float2int_rn(t3) & 0xffu) << 24); }
            *(v4u*)(q + c * 1024 + 16 * lane) = o; } }
}
__device__ __forceinline__ void build_rows2(const float* src0, const float* src1, bf16* xb0, bf16* xb1, float* rss0, float* rss1, bool has1, int lane, unsigned char* xq0, unsigned char* xq1, float* qf0, float* qf1) {
    f32x4 v0[8], v1[8]; float s0 = 0.f, s1 = 0.f;
#pragma unroll
    for (int j = 0; j < 8; ++j) { v0[j] = src0 ? ((const f32x4*)src0 + lane)[64 * j] : (f32x4){0.f, 0.f, 0.f, 0.f}; v1[j] = src1 ? ((const f32x4*)src1 + lane)[64 * j] : (f32x4){0.f, 0.f, 0.f, 0.f}; }
#pragma unroll
    for (int j = 0; j < 8; ++j) { s0 += (v0[j].x * v0[j].x + v0[j].y * v0[j].y) + (v0[j].z * v0[j].z + v0[j].w * v0[j].w); s1 += (v1[j].x * v1[j].x + v1[j].y * v1[j].y) + (v1[j].z * v1[j].z + v1[j].w * v1[j].w); }
    u32x2* o0 = (u32x2*)xb0 + lane; u32x2* o1 = (u32x2*)xb1 + lane;
#pragma unroll
    for (int j = 0; j < 8; ++j) { u32x2 w; w.x = pkbf(v0[j].x, v0[j].y); w.y = pkbf(v0[j].z, v0[j].w); o0[64 * j] = w; if (has1) { u32x2 w1; w1.x = pkbf(v1[j].x, v1[j].y); w1.y = pkbf(v1[j].z, v1[j].w); o1[64 * j] = w1; } }
    s0 = wave_sum(s0); s1 = wave_sum(s1);
    if (lane < 8) { rss0[lane] = (lane == 0) ? s0 : 0.f; if (has1) rss1[lane] = (lane == 0) ? s1 : 0.f; }
    float a0 = 0.f, a1 = 0.f;
#pragma unroll
    for (int j = 0; j < 8; ++j) { a0 = fmaxf(a0, fmaxf(fmaxf(fabsf(v0[j].x), fabsf(v0[j].y)), fmaxf(fabsf(v0[j].z), fabsf(v0[j].w)))); a1 = fmaxf(a1, fmaxf(fmaxf(fabsf(v1[j].x), fabsf(v1[j].y)), fmaxf(fabsf(v1[j].z), fabsf(v1[j].w)))); }
#pragma unroll
    for (int o = 1; o < 64; o <<= 1) { a0 = fmaxf(a0, __shfl_xor(a0, o)); a1 = fmaxf(a1, __shfl_xor(a1, o)); }
    a0 = fmaxf(a0, 1e-30f); a1 = fmaxf(a1, 1e-30f);
    const float q0 = 127.0f / a0, q1 = 127.0f / a1;
    if (lane == 0) { qf0[0] = a0 * (1.0f / 127.0f) * __builtin_amdgcn_rsqf(s0 * (1.0f / D) + EPS); if (has1) qf1[0] = a1 * (1.0f / 127.0f) * __builtin_amdgcn_rsqf(s1 * (1.0f / D) + EPS); }
#pragma unroll
    for (int j = 0; j < 8; ++j) {
        ((unsigned*)xq0)[lane + 64 * j] = ((unsigned)__float2int_rn(v0[j].x * q0) & 0xffu) | (((unsigned)__float2int_rn(v0[j].y * q0) & 0xffu) << 8) | (((unsigned)__float2int_rn(v0[j].z * q0) & 0xffu) << 16) | (((unsigned)__float2int_rn(v0[j].w * q0) & 0xffu) << 24);
        if (has1) ((unsigned*)xq1)[lane + 64 * j] = ((unsigned)__float2int_rn(v1[j].x * q1) & 0xffu) | (((unsigned)__float2int_rn(v1[j].y * q1) & 0xffu) << 8) | (((unsigned)__float2int_rn(v1[j].z * q1) & 0xffu) << 16) | (((unsigned)__float2int_rn(v1[j].w * q1) & 0xffu) << 24); }
}
__device__ __forceinline__ void final_rows2(const bf16* src0, const bf16* src1, const float* gain, float* dst0, float* dst1, const float* rss0, const float* rss1, int lane) {
    u32x2 w0[8], w1[8];
#pragma unroll
    for (int j = 0; j < 8; ++j) { w0[j] = ((const u32x2*)src0 + lane)[64 * j]; w1[j] = dst1 ? ((const u32x2*)src1 + lane)[64 * j] : (u32x2){0u, 0u}; }
    const float q0 = lane < 8 ? rss0[lane] : 0.f, q1 = (dst1 && lane < 8) ? rss1[lane] : 0.f;
    const float r0 = 1.0f / sqrtf(wave_sum(q0) * (1.0f / D) + EPS), r1 = 1.0f / sqrtf(wave_sum(q1) * (1.0f / D) + EPS);
    const f32x4* gr = (const f32x4*)gain + lane; f32x4* o0 = (f32x4*)dst0 + lane; f32x4* o1 = (f32x4*)dst1 + lane;
#pragma unroll
    for (int j = 0; j < 8; ++j) { const f32x4 g = gr[64 * j]; o0[64 * j] = (f32x4){bflo(w0[j].x) * r0 * g.x, bfhi(w0[j].x) * r0 * g.y, bflo(w0[j].y) * r0 * g.z, bfhi(w0[j].y) * r0 * g.w};
        if (dst1) o1[64 * j] = (f32x4){bflo(w1[j].x) * r1 * g.x, bfhi(w1[j].x) * r1 * g.y, bflo(w1[j].y) * r1 * g.z, bfhi(w1[j].y) * r1 * g.w}; }
}
__device__ __forceinline__ const float* input_row(int r, const float* xp, const float* xs, const float* meta) {
    if (r < MPROMPT) { const int b = r / TP, pos = r - b * TP; return pos < NMETA ? meta + (size_t)pos * D : xp + ((size_t)b * SEQ + (pos - NMETA)) * D; }
    if (r < MREAL) return xs + (size_t)(r - MPROMPT) * D;
    return nullptr;
}

__device__ __forceinline__ void ssm_tables(int t, const float* lre_, const float* lim_, const float* ldt, const float* bre, const float* bim, f32x2* apow, f32x2* bbar) {
    const int l = t / (SG * SP), gp = t % (SG * SP), g = gp / SP;
    const double dtd = exp((double)ldt[l * SG + g]);
    const float lre = lre_[t], lim = lim_[t];
    const double xr = (double)lre * dtd, th = (double)lim * dtd;
    float c1 = 1.f, s1 = 0.f;
    for (int k = 0; k < NPOW; ++k) {
        const double kk = (k <= 16) ? (double)k : 16.0 * 65.0;
        const double ang = th * kk; const double n = rint(ang * 0.15915494309189535); const float r = (float)(ang - n * 6.283185307179586);
        const float mag = expf((float)(xr * kk)); const float cs = cosf(r), sn = sinf(r);
        apow[((size_t)(l * NPOW + k)) * (SG * SP) + gp] = (f32x2){mag * cs, mag * sn};
        if (k == 1) { c1 = cs; s1 = sn; }
    }
    const float em1 = expm1f((float)xr);
    const float hv = 0.5f * (1.0f - c1);
    const float are = em1 * c1 - 2.0f * hv, aim = (1.0f + em1) * s1;
    const float den = 1.0f / (lre * lre + lim * lim);
    const float qre = (are * lre + aim * lim) * den, qim = (aim * lre - are * lim) * den;
    const float* br = bre + (size_t)t * SH; const float* bi = bim + (size_t)t * SH; f32x2* bo = bbar + (size_t)t * SH;
#pragma unroll 4
    for (int h = 0; h < SH; ++h) { const float x = br[h], y = bi[h]; bo[h] = (f32x2){qre * x - qim * y, qre * y + qim * x}; }
}
__device__ __forceinline__ void ssm_matrices(int l, size_t t0, size_t tstride, const f32x2* apow, const f32x2* bbar, const float* cre, const float* cim, const float* dsk, bf16* WBT, bf16* BMT) {
    const f32x2* ap = apow + (size_t)l * NPOW * SG * SP; const f32x2* bb = bbar + (size_t)l * SG * SP * SH;
    const float* cr = cre + (size_t)l * SG * SH * SP; const float* ci = cim + (size_t)l * SG * SH * SP; const float* dd = dsk + (size_t)l * SG * SH;
    constexpr size_t NA = (size_t)SG * 16 * 256, NB = (size_t)SG * 256 * SP, NC = (size_t)SG * SP * 256;
    for (size_t t = t0; t < NA + NB + NC; t += tstride) {
        if (t < NA) {
            const int g = (int)(t / 4096), k = (int)(t / 256) % 16, h = (int)(t / 16) % 16, hp = (int)t % 16;
            float s = 0.f;
            for (int p = 0; p < SP; ++p) { const f32x2 a = ap[((size_t)k * SG + g) * SP + p], b = bb[((size_t)g * SP + p) * SH + hp]; const float x = cr[((size_t)g * SH + h) * SP + p], y = ci[((size_t)g * SH + h) * SP + p];
                const float abr = a.x * b.x - a.y * b.y, abi = a.x * b.y + a.y * b.x; s += x * abr - y * abi; }
            if (k == 0 && h == hp) s += dd[g * SH + h];
            const unsigned short sv = (unsigned short)(pkbf(s, 0.f) & 0xffffu);
            for (int m = 0; m + k < 16; ++m) { WBT[((size_t)g * 256 + (size_t)(k + m) * 16 + h) * 384 + m * 16 + hp] = sv;
                if (k > 0) WBT[((size_t)g * 256 + (size_t)m * 16 + h) * 384 + (k + m) * 16 + hp] = 0; }
        } else if (t < NA + NB) {
            const size_t u = t - NA; const int g = (int)(u / 16384), i = (int)(u / 1024) % 16, h = (int)(u / 64) % 16, p = (int)u % 64;
            const f32x2 a = ap[((size_t)(i + 1) * SG + g) * SP + p]; const float x = cr[((size_t)g * SH + h) * SP + p], y = ci[((size_t)g * SH + h) * SP + p];
            const size_t o = ((size_t)g * 256 + i * 16 + h) * 384 + 256 + p;
            WBT[o] = (unsigned short)(pkbf(x * a.x - y * a.y, 0.f) & 0xffffu); WBT[o + 64] = (unsigned short)(pkbf(-(x * a.y + y * a.x), 0.f) & 0xffffu);
        } else {
            const size_t u = t - NA - NB; const int g = (int)(u / 16384), p = (int)(u / 256) % 64, j = (int)(u / 16) % 16, hp = (int)u % 16;
            const f32x2 a = ap[((size_t)(15 - j) * SG + g) * SP + p], b = bb[((size_t)g * SP + p) * SH + hp];
            const size_t o = ((size_t)g * 256 + p) * 256 + j * 16 + hp;
            BMT[o] = (unsigned short)(pkbf(a.x * b.x - a.y * b.y, 0.f) & 0xffffu); BMT[o + (size_t)64 * 256] = (unsigned short)(pkbf(a.x * b.y + a.y * b.x, 0.f) & 0xffffu);
        }
    }
}

__device__ __forceinline__ float gelu_tanh(float x) { const float z = 0.7978845608028654f * (x + 0.044715f * x * x * x); return x * __builtin_amdgcn_rcpf(1.0f + __expf(-2.0f * z)); }

__device__ __forceinline__ void conv_rows4(int r0, int l, const bf16* PROJ, bf16* MIXED, const float* cache, const float* convw, const float* cgain, float* out, int lane) {
    if (r0 >= MREAL) {
#pragma unroll
        for (int q = 0; q < 4; ++q) { v4u* mo = (v4u*)(MIXED + (size_t)(r0 + q) * D); mo[lane] = (v4u){0u, 0u, 0u, 0u}; mo[64 + lane] = (v4u){0u, 0u, 0u, 0u}; }
        return; }
    int pos0, T; const float* cb = nullptr; float* ob;
    if (r0 < MPROMPT) { const int b = r0 / TP; pos0 = r0 - b * TP; T = TP; ob = out + O_CVP + (size_t)(l * NBP + b) * 2 * DCV; }
    else { const int s = (r0 - MPROMPT) / TS; pos0 = (r0 - MPROMPT) - s * TS; T = TS; cb = cache + (size_t)(l * NBS + s) * 2 * DCV; ob = out + O_CVS + (size_t)(l * NBS + s) * 2 * DCV; }
    float ss[4] = {0.f, 0.f, 0.f, 0.f}; float y[4][16];
#pragma unroll
    for (int hf = 0; hf < 2; ++hf) {
        const int c0 = hf * 512 + lane * 8;
        const bf16* pr = PROJ + (size_t)r0 * DIN + c0;
        v4u cg[6], hg[6], bg[4];
#pragma unroll
        for (int j = 0; j < 6; ++j) { if (j >= 2 || pos0 >= 2 - j) { cg[j] = *(const v4u*)(pr + (ptrdiff_t)(j - 2) * DIN + DCV); hg[j] = *(const v4u*)(pr + (ptrdiff_t)(j - 2) * DIN + 2 * DCV); } else { cg[j] = (v4u){0u, 0u, 0u, 0u}; hg[j] = cg[j]; } }
#pragma unroll
        for (int q = 0; q < 4; ++q) bg[q] = *(const v4u*)(pr + (size_t)q * DIN);
        float cbv[2][8];
#pragma unroll
        for (int e = 0; e < 8; ++e) { cbv[0][e] = (cb && pos0 < 2) ? cb[c0 + e] : 0.f; cbv[1][e] = (cb && pos0 < 1) ? cb[DCV + c0 + e] : 0.f; }
        const float* w = convw + (size_t)l * 3 * DCV + c0;
        float w0[8], w1[8], w2[8];
#pragma unroll
        for (int e = 0; e < 8; ++e) { w0[e] = w[e]; w1[e] = w[DCV + e]; w2[e] = w[2 * DCV + e]; }
        float v[6][8];
#pragma unroll
        for (int j = 0; j < 6; ++j)
#pragma unroll
            for (int qq = 0; qq < 4; ++qq) { v[j][2 * qq] = bflo(cg[j][qq]) * bflo(hg[j][qq]); v[j][2 * qq + 1] = bfhi(cg[j][qq]) * bfhi(hg[j][qq]); }
        if (pos0 == 0) {
#pragma unroll
            for (int e = 0; e < 8; ++e) { v[0][e] = cbv[0][e]; v[1][e] = cbv[1][e]; } }
#pragma unroll
        for (int q = 0; q < 4; ++q)
#pragma unroll
            for (int e = 0; e < 8; ++e) { const float bgv = (e & 1) ? bfhi(bg[q][e >> 1]) : bflo(bg[q][e >> 1]);
                const float yy = bgv * (w0[e] * v[q][e] + w1[e] * v[q + 1][e] + w2[e] * v[q + 2][e]); y[q][hf * 8 + e] = yy; ss[q] += yy * yy; }
        if (pos0 + 4 == T) {
#pragma unroll
            for (int e = 0; e < 8; ++e) { ob[c0 + e] = v[4][e]; ob[DCV + c0 + e] = v[5][e]; } }
    }
#pragma unroll
    for (int q = 0; q < 4; ++q) { const float rn = 1.0f / sqrtf(wave_sum(ss[q]) * (1.0f / DCV) + EPS); v4u* mo = (v4u*)(MIXED + (size_t)(r0 + q) * D);
#pragma unroll
        for (int hf = 0; hf < 2; ++hf) { const float* g = cgain + (size_t)l * DCV + hf * 512 + lane * 8; v4u wv;
#pragma unroll
            for (int qq = 0; qq < 4; ++qq) wv[qq] = pkbf(y[q][hf * 8 + 2 * qq] * rn * g[2 * qq], y[q][hf * 8 + 2 * qq + 1] * rn * g[2 * qq + 1]);
            mo[hf * 64 + lane] = wv; } }
}
__device__ __forceinline__ void norm_s_row(int r, bf16* MIXED, const float* gain, int lane) {
    v4u* p = (v4u*)(MIXED + (size_t)r * D + DCV); const v4u a = p[lane], b = p[64 + lane]; float v[16]; float ss = 0.f;
#pragma unroll
    for (int q = 0; q < 4; ++q) { v[2 * q] = bflo(a[q]); v[2 * q + 1] = bfhi(a[q]); v[8 + 2 * q] = bflo(b[q]); v[8 + 2 * q + 1] = bfhi(b[q]); }
#pragma unroll
    for (int e = 0; e < 16; ++e) ss += v[e] * v[e];
    const float rn = 1.0f / sqrtf(wave_sum(ss) * (1.0f / DSS) + EPS);
    v4u wa, wb; const float* g0 = gain + lane * 8; const float* g1 = gain + 512 + lane * 8;
#pragma unroll
    for (int q = 0; q < 4; ++q) { wa[q] = pkbf(v[2 * q] * rn * g0[2 * q], v[2 * q + 1] * rn * g0[2 * q + 1]); wb[q] = pkbf(v[8 + 2 * q] * rn * g1[2 * q], v[8 + 2 * q + 1] * rn * g1[2 * q + 1]); }
    p[lane] = wa; p[64 + lane] = wb;
}

template <bool WRITE> __device__ __forceinline__ void carry_run(const float* sl, bf16* so, int nc, const f32x2 a, float& sr, float& si) {
    constexpr size_t CS = (size_t)SG * 128, CO = (size_t)UGLD; constexpr int NB = 16;
#define CARRY_LOAD(LR, LI, c0) do { _Pragma("unroll") for (int q = 0; q < NB; ++q) { LR[q] = sl[(size_t)((c0) + q) * CS]; LI[q] = sl[(size_t)((c0) + q) * CS + 64]; } } while (0)
#define CARRY_STEP(LR, LI, c0) do { _Pragma("unroll") for (int q = 0; q < NB; ++q) { \
        if (WRITE) { so[(size_t)((c0) + q) * CO] = (unsigned short)(pkbf(sr, 0.f) & 0xffffu); so[(size_t)((c0) + q) * CO + 64] = (unsigned short)(pkbf(si, 0.f) & 0xffffu); } \
        const float nr = a.x * sr - a.y * si + LR[q], ni = a.x * si + a.y * sr + LI[q]; sr = nr; si = ni; } } while (0)
    float ar[NB], ai[NB], br[NB], bi[NB];
    int c = 0;
    if (nc >= NB) CARRY_LOAD(ar, ai, 0);
    while (c + NB <= nc) {
        if (c + 2 * NB <= nc) CARRY_LOAD(br, bi, c + NB);
        CARRY_STEP(ar, ai, c); c += NB;
        if (c + NB > nc) break;
        if (c + 2 * NB <= nc) CARRY_LOAD(ar, ai, c + NB);
        CARRY_STEP(br, bi, c); c += NB;
    }
#undef CARRY_LOAD
#undef CARRY_STEP
    for (; c < nc; ++c) { const float lr = sl[(size_t)c * CS], li = sl[(size_t)c * CS + 64];
        if (WRITE) { so[(size_t)c * CO] = (unsigned short)(pkbf(sr, 0.f) & 0xffffu); so[(size_t)c * CO + 64] = (unsigned short)(pkbf(si, 0.f) & 0xffffu); }
        const float nr = a.x * sr - a.y * si + lr, ni = a.x * si + a.y * sr + li; sr = nr; si = ni; }
}
constexpr int CSEG = 65, NSEG = 16;
static_assert(NSEG * CSEG >= CH_PER_SEQ && (NSEG - 1) * CSEG < CH_PER_SEQ, "carry segments");
__device__ __forceinline__ void carry_totals2(const float* sa, int na, const float* sb, int nb, const f32x2 a, float& ar, float& ai, float& br, float& bi) {
    constexpr size_t CS = (size_t)SG * 128; constexpr int NB = 8;
    const int nmin = na < nb ? na : nb; int c = 0;
    for (; c + NB <= nmin; c += NB) { float xr[NB], xi[NB], yr[NB], yi[NB];
#pragma unroll
        for (int q = 0; q < NB; ++q) { xr[q] = sa[(size_t)(c + q) * CS]; xi[q] = sa[(size_t)(c + q) * CS + 64]; yr[q] = sb[(size_t)(c + q) * CS]; yi[q] = sb[(size_t)(c + q) * CS + 64]; }
#pragma unroll
        for (int q = 0; q < NB; ++q) { const float n0 = a.x * ar - a.y * ai + xr[q], n1 = a.x * ai + a.y * ar + xi[q]; ar = n0; ai = n1; const float m0 = a.x * br - a.y * bi + yr[q], m1 = a.x * bi + a.y * br + yi[q]; br = m0; bi = m1; } }
    for (int k = c; k < na; ++k) { const float x0 = sa[(size_t)k * CS], x1 = sa[(size_t)k * CS + 64]; const float n0 = a.x * ar - a.y * ai + x0, n1 = a.x * ai + a.y * ar + x1; ar = n0; ai = n1; }
    for (int k = c; k < nb; ++k) { const float y0 = sb[(size_t)k * CS], y1 = sb[(size_t)k * CS + 64]; const float m0 = a.x * br - a.y * bi + y0, m1 = a.x * bi + a.y * br + y1; br = m0; bi = m1; }
}
__device__ __forceinline__ void ssm_carry_prompt(int b, int g, int hb, int l, const f32x2* apow, const float* SLOC, bf16* UG, float* out, LAS float* sh, int wave, int lane) {
    const f32x2 a = apow[((size_t)(l * NPOW + 16) * SG + g) * SP + lane], aseg = apow[((size_t)(l * NPOW + 17) * SG + g) * SP + lane];
    const int seg = 8 * hb + wave, cs = seg * CSEG, len = (CH_PER_SEQ - cs) < CSEG ? (CH_PER_SEQ - cs) : CSEG, c0 = b * CH_PER_SEQ + cs;
    const float* sl = SLOC + ((size_t)c0 * SG + g) * 128 + lane; bf16* so = UG + ((size_t)g * CPG + c0) * UGLD + 256 + lane;
    float tr = 0.f, ti = 0.f, pr = 0.f, pi = 0.f;
    if (hb) { const float* sp = SLOC + ((size_t)(b * CH_PER_SEQ + wave * CSEG) * SG + g) * 128 + lane; carry_totals2(sp, CSEG, sl, len, a, pr, pi, tr, ti);
        sh[(wave * 2) * 64 + lane] = pr; sh[(wave * 2 + 1) * 64 + lane] = pi; }
    else carry_run<false>(sl, so, len, a, tr, ti);
    sh[(seg * 2) * 64 + lane] = tr; sh[(seg * 2 + 1) * 64 + lane] = ti;
    LDS_WAIT(); __syncthreads();
    float sr = 0.f, si = 0.f;
    for (int w = 0; w < seg; ++w) { const float xr = sh[(w * 2) * 64 + lane], xi = sh[(w * 2 + 1) * 64 + lane]; const float nr = aseg.x * sr - aseg.y * si + xr, ni = aseg.x * si + aseg.y * sr + xi; sr = nr; si = ni; }
    carry_run<true>(sl, so, len, a, sr, si);
    if (seg == NSEG - 1) { out[O_REP + ((size_t)(l * NBP + b) * SG + g) * SP + lane] = sr; out[O_IMP + ((size_t)(l * NBP + b) * SG + g) * SP + lane] = si; }
    __syncthreads();
}
__device__ __forceinline__ void ssm_carry_small(int w, int l, const f32x2* apow, const float* SLOC, bf16* UG, const float* sre, const float* sim, float* out, int lane) {
    if (w >= NBS * SG) { const int u = w - NBS * SG; const int c = NCH_REAL + u / SG, g = u % SG; if (c >= NCHUNK) return;
        ((unsigned*)(UG + ((size_t)g * CPG + c) * UGLD + 256))[lane] = 0u; return; }
    const int s = w / SG, g = w % SG, c0 = NBP * CH_PER_SEQ + s * (TS / 16); const size_t o = ((size_t)(l * NBS + s) * SG + g) * SP + lane;
    float sr = sre[o], si = sim[o];
    const f32x2 a = apow[((size_t)(l * NPOW + 16) * SG + g) * SP + lane];
    carry_run<true>(SLOC + ((size_t)c0 * SG + g) * 128 + lane, UG + ((size_t)g * CPG + c0) * UGLD + 256 + lane, TS / 16, a, sr, si);
    out[O_RES + o] = sr; out[O_IMS + o] = si;
}
struct Args { const float* in[N_IN]; float* out; unsigned char* ws; };
static_assert(sizeof(Args) == 8 * (N_IN + 2), "no padding in Args");
typedef const __attribute__((address_space(4))) Args* ArgsP;
#ifdef PROBE_REP
#define PROBE_N(w) ((PROBE_WHICH == (w) || (PROBE_WHICH == 99 && (w) != 6)) ? PROBE_REP : 1)
#define PROBE_SET_REP(S) do { if (PROBE_WHICH == 1 || PROBE_WHICH == 99) (S).rep = PROBE_REP; } while (0)
#define PROBE_SET_REP3(S) do { if (PROBE_WHICH == 3 || PROBE_WHICH == 99) (S).rep = PROBE_REP; } while (0)
#define PROBE_SET_REP_R(S, E) do { if (PROBE_WHICH == 2 || PROBE_WHICH == 99) { (S).rep = PROBE_REP; (E).scale *= 1.0f / PROBE_REP; } } while (0)
#else
#define PROBE_N(w) 1
#define PROBE_SET_REP(S) do {} while (0)
#define PROBE_SET_REP3(S) do {} while (0)
#define PROBE_SET_REP_R(S, E) do {} while (0)
#endif

#define PHASE_BEGIN() \
    int tid = threadIdx.x; asm volatile("" : "+v"(tid)); \
    ArgsP A = (ArgsP)__builtin_amdgcn_kernarg_segment_ptr(); asm volatile("" : "+s"(A)); \
    const int lane = tid & 63, wave = __builtin_amdgcn_readfirstlane(tid >> 6); \
    const int gw = vcu * NWAVES + wave, NGW = G * NWAVES; \
    unsigned char* ws = A->ws; (void)lane; (void)gw; (void)NGW; (void)ws;

__device__ __forceinline__ void convert_layer(int l, ArgsP A, unsigned char* ws, LAS float* scr, int gw, int NGW, int lane) {
    unsigned char* wset = ws + WS_W + (size_t)(l & 1) * W_SET;
    constexpr int I_DN = (FF / 64) * (D / 32), I_IN = (D / 64) * (DIN / 32), I_GL = (DSS / 64) * (DSS / 32), I_OUT = (D / 64) * (D / 32);
    constexpr int NITEMS = 2 * I_DN + I_IN + I_GL + I_OUT;
    for (int it = gw; it < NITEMS; it += NGW) {
        int r = it;
        if (r < 2 * I_DN) { const int q = r / I_DN; r -= q * I_DN;
            transpose_item(A->in[q ? I_F2D : I_F1D] + (size_t)l * FF * D, FF, D, (bf16*)(wset + (q ? W_D1 : W_D0)), 0, nullptr, scr, r, lane, (2 * l + q >= FP8_FROM_HL) ? WD8_SCALE : 0.f); continue; }
        r -= 2 * I_DN;
        if (r < I_IN) { transpose_item(A->in[I_WIN] + (size_t)l * D * DIN, D, DIN, (bf16*)(wset + W_IN), 0, A->in[I_MIXN] + (size_t)l * D, scr, r, lane); continue; }
        r -= I_IN;
        if (r < I_GL) { transpose_item(A->in[I_GLU] + (size_t)l * DSS * DSS, DSS, DSS, (bf16*)(wset + W_GLU), 0, nullptr, scr, r, lane); continue; }
        r -= I_GL;
        transpose_item(A->in[I_WOUT] + (size_t)l * D * D, D, D, (bf16*)(wset + W_OUT), 0, A->in[I_SSMN] + (size_t)l * DSS, scr, r, lane, 0.f, DCV);
    }
}
__device__ __forceinline__ void convert_gu(int l, ArgsP A, unsigned char* ws, LAS float* scr, LAS float* xch, int cu, int ncu, int wave, int lane) {
    unsigned char* wset = ws + WS_W + (size_t)(l & 1) * W_SET;
    for (int it = cu; it < 4 * (FF / 32); it += ncu) { const int q = it / (FF / 32), nb = it - q * (FF / 32);
        gu_task(A->in[q == 0 ? I_F1G : q == 1 ? I_F1U : q == 2 ? I_F2G : I_F2U] + (size_t)l * D * FF, A->in[q < 2 ? I_F1N : I_F2N] + (size_t)l * D, wset + (q < 2 ? W_GU0 : W_GU1), 1 + (q & 1),
                (float*)(ws + WS_CS) + (size_t)((l & 1) * 4 + q) * FF, scr, xch, nb, wave, lane); }
}

__global__ void __launch_bounds__(NWAVES * 64, 2) hymba_fwd(Args args_unused) {
    extern __shared__ __attribute__((aligned(16))) unsigned char lds_raw[];
    LAS unsigned char* lds = (LAS unsigned char*)lds_raw;
    const int G = gridDim.x; const int bx = blockIdx.x; const int vcu = (G % 8 == 0) ? (bx % 8) * (G / 8) + bx / 8 : bx;
    XcdBarrier bar;
    {
        PHASE_BEGIN();
        for (int u = tid; u < (LDS_BYTES - LDSCTL_OFF) / 4; u += NWAVES * 64) ((LAS unsigned*)(lds + LDSCTL_OFF))[u] = 0u;
        __syncthreads();
        bar = xcd_barrier_post((unsigned*)(ws) + CW_BAR, (volatile LAS unsigned*)(lds + MISC_OFF) + 8);
    }
#define GRID_BAR() do { for (int prep_ = 0; prep_ < PROBE_N(6); ++prep_) xcd_barrier(bar); } while (0)
    {
        PHASE_BEGIN();
        for (int prep = 0; prep < PROBE_N(7); ++prep)
        for (int t = bx * (NWAVES * 64) + tid; t < NL * SG * SP; t += G * NWAVES * 64)
            ssm_tables(t, A->in[I_LRE], A->in[I_LIM], A->in[I_LDT], A->in[I_BRE], A->in[I_BIM], (f32x2*)(ws + WS_APOW), (f32x2*)(ws + WS_BBAR));
    }
    {
        PHASE_BEGIN();
        convert_gu(0, A, ws, (LAS float*)(lds + RING_OFF + wave * 16384), (LAS float*)(lds + RING_OFF + 12288), vcu, G, wave, lane);
        convert_layer(0, A, ws, (LAS float*)(lds + RING_OFF + wave * 16384), gw, NGW, lane);
    }
    {
        PHASE_BEGIN();
        v4u* z = (v4u*)(ws + WS_BMT);
        for (int i = bx * (NWAVES * 64) + tid; i < SG * 128 * 256 * 2 / 16; i += G * NWAVES * 64) { const int g = i / (128 * 256 * 2 / 16), o = i % (128 * 256 * 2 / 16); z[(size_t)g * (256 * 256 * 2 / 16) + (128 * 256 * 2 / 16) + o] = (v4u){0u, 0u, 0u, 0u}; }
    }
    {
        PHASE_BEGIN();
        bf16* XB = (bf16*)(ws + WS_XN); float* rss = (float*)(ws + WS_RSS);
        const float* xp = A->in[I_XP]; const float* xs = A->in[I_XS]; const float* meta = A->in[I_META];
        for (int prep = 0; prep < PROBE_N(7); ++prep)
        for (int r = gw; r < MPAD; r += 2 * NGW) { const int r1 = r + NGW; const bool h1 = r1 < MPAD; const int rr = h1 ? r1 : r;
            build_rows2(input_row(r, xp, xs, meta), h1 ? input_row(r1, xp, xs, meta) : nullptr, XB + (size_t)r * D, XB + (size_t)rr * D, rss + (size_t)r * 8, rss + (size_t)rr * 8, h1, lane,
                        ws + WS_XB8 + (size_t)r * D, ws + WS_XB8 + (size_t)rr * D, (float*)(ws + WS_QF) + r, (float*)(ws + WS_QF) + rr); }
    }
    GRID_BAR();
    for (int hl = 0; hl < 2 * NL; ++hl) {
        const int l = hl >> 1, second = hl & 1;
        if (hl >= UPQ_FROM && hl > 0) {
            PHASE_BEGIN();
            const bf16* XB = (const bf16*)(ws + WS_XN); unsigned char* XQ = ws + WS_XB8; const float* rss = (const float*)(ws + WS_RSS) + (size_t)(3 * l + (second ? 2 : 0)) * RSS_STRIDE;
            for (int r = gw; r < MPAD; r += 2 * NGW) { const int r1 = r + NGW; const bool h1 = r1 < MPAD; const int rr = h1 ? r1 : r;
                quant_rows2(XB + (size_t)r * D, XB + (size_t)rr * D, rss + (size_t)r * 8, rss + (size_t)rr * 8, XQ + (size_t)r * D, XQ + (size_t)rr * D, (float*)(ws + WS_QF) + r, (float*)(ws + WS_QF) + rr, h1, lane); }
        }
        if (hl >= UPQ_FROM && hl > 0) GRID_BAR();
        if (hl >= UPQ_FROM) {
            PHASE_BEGIN();
            const float* cs = (const float*)(ws + WS_CS) + (size_t)((l & 1) * 4 + 2 * second) * FF;
            pg8::Gemm g{(const bf16*)(ws + WS_XB8), (const bf16*)(ws + WS_W + (size_t)(l & 1) * W_SET + (second ? W_GU1 : W_GU0)), MPAD, 2 * FF, D / 2, D / 2, D / 2, 0, 0};   pg8::StaticOrder S; S.init(MPAD, 2 * FF, G, bx); PROBE_SET_REP(S);
            pg8::EpiSwigluQ E{(const float*)(ws + WS_QF), (unsigned char*)(ws + WS_H), cs, FF, cs + FF, (hl >= FP8_FROM_HL) ? 1 : 0, (hl >= FP8_FROM_HL) ? H8_SCALE : 1.0f, (const LAS float*)(lds + RSSB_OFF)};
            S.split = 1;
            S.pass = 0; pg8::gemm_phase<pg8::EpiSwigluQ, pg8::StaticOrder, true, true, 2, false>(lds + RING_OFF, g, S, E, tid); S.pass = 1; pg8::gemm_phase<pg8::EpiSwigluQ, pg8::StaticOrder, true, true, 2, true>(lds + RING_OFF, g, S, E, tid);
        } else
#ifdef PROBE_SPLIT
        for (int part = 0; part < 2; ++part)
#endif
        {
            PHASE_BEGIN();
            pg8::Gemm g{(const bf16*)(ws + WS_XN), (const bf16*)(ws + WS_W + (size_t)(l & 1) * W_SET + (second ? W_GU1 : W_GU0)), MPAD, 2 * FF, D, D, D, 0, 0}; pg8::StaticOrder S; S.init(MPAD, 2 * FF, G, bx); PROBE_SET_REP(S);
#ifdef PROBE_SPLIT
            if (part == 0) S.r1 = 11; else S.r0 = 11;
#endif
            pg8::EpiSwiglu E{(unsigned char*)(ws + WS_H), FF, (const float*)(ws + WS_RSS) + (size_t)(3 * l + (second ? 2 : 0)) * RSS_STRIDE, (const LAS float*)(lds + RSSB_OFF), 1.0f / D, EPS, (hl >= FP8_FROM_HL) ? H8_SCALE : 1.0f, 1.0f, (hl >= FP8_FROM_HL) ? 1 : 0};
            S.split = 1;
            S.pass = 0; pg8::gemm_phase<pg8::EpiSwiglu, pg8::StaticOrder, true, true, false, false>(lds + RING_OFF, g, S, E, tid); S.pass = 1; pg8::gemm_phase<pg8::EpiSwiglu, pg8::StaticOrder, true, true, false, true>(lds + RING_OFF, g, S, E, tid);
#ifdef PROBE_SPLIT
            if (part == 0) GRID_BAR();
#endif
        }
        GRID_BAR();
        if (hl >= FP8_FROM_HL) {
            PHASE_BEGIN();
            pg8::Gemm g{(const bf16*)(ws + WS_H), (const bf16*)(ws + WS_W + (size_t)(l & 1) * W_SET + (second ? W_D1 : W_D0)), MPAD, D, FF / 2, FF / 2, FF / 2, 0, 0};   pg8::StaticOrder S; S.init(MPAD, D, G, bx);
            pg8::EpiResidNorm<false> E{(bf16*)(ws + WS_XN), D, 0.5f / (H8_SCALE * WD8_SCALE), (float*)(ws + WS_RSS) + (size_t)(second ? 3 * (l + 1) : 3 * l + 1) * RSS_STRIDE, (second && hl + 1 >= FP8_UP_FROM && hl + 1 < 2 * NL) ? (unsigned char*)(ws + WS_XB8) : nullptr, (LAS float*)(lds + RED_OFF), nullptr, nullptr, 0.f, 0.f};
            PROBE_SET_REP_R(S, E);
            S.split = 1;
            S.pass = 0; pg8::gemm_phase<pg8::EpiResidNorm<false>, pg8::StaticOrder, true, true, true, false>(lds + RING_OFF, g, S, E, tid); S.pass = 1; pg8::gemm_phase<pg8::EpiResidNorm<false>, pg8::StaticOrder, true, true, true, true>(lds + RING_OFF, g, S, E, tid);
        } else {
            PHASE_BEGIN();
            pg8::Gemm g{(const bf16*)(ws + WS_H), (const bf16*)(ws + WS_W + (size_t)(l & 1) * W_SET + (second ? W_D1 : W_D0)), MPAD, D, FF, FF, FF, 0, 0}; pg8::StaticOrder S; S.init(MPAD, D, G, bx);
            pg8::EpiResidNorm<false> E{(bf16*)(ws + WS_XN), D, 0.5f, (float*)(ws + WS_RSS) + (size_t)(second ? 3 * (l + 1) : 3 * l + 1) * RSS_STRIDE, (second && hl + 1 >= FP8_UP_FROM && hl + 1 < 2 * NL) ? (unsigned char*)(ws + WS_XB8) : nullptr, (LAS float*)(lds + RED_OFF), nullptr, nullptr, 0.f, 0.f};
            PROBE_SET_REP_R(S, E);
            S.split = 1;
            S.pass = 0; pg8::gemm_phase<pg8::EpiResidNorm<false>, pg8::StaticOrder, true, true, false, false>(lds + RING_OFF, g, S, E, tid); S.pass = 1; pg8::gemm_phase<pg8::EpiResidNorm<false>, pg8::StaticOrder, true, true, false, true>(lds + RING_OFF, g, S, E, tid);
        }
        if (l + 1 < NL) {
            PHASE_BEGIN();
            constexpr int NTAIL = 2 * (((MPAD / 256) * (D / 256)) % 256);
            if (G > 2 * NTAIL) { if (bx >= NTAIL) { if (!second) convert_layer(l + 1, A, ws, (LAS float*)(lds + RING_OFF + wave * 16384), (bx - NTAIL) * NWAVES + wave, (G - NTAIL) * NWAVES, lane);
                                                     else convert_gu(l + 1, A, ws, (LAS float*)(lds + RING_OFF + wave * 16384), (LAS float*)(lds + RING_OFF + 12288), bx - NTAIL, G - NTAIL, wave, lane); } }
            else { if (!second) convert_layer(l + 1, A, ws, (LAS float*)(lds + RING_OFF + wave * 16384), gw, NGW, lane); else convert_gu(l + 1, A, ws, (LAS float*)(lds + RING_OFF + wave * 16384), (LAS float*)(lds + RING_OFF + 12288), bx, G, wave, lane); }
        }
        GRID_BAR();
        if (second) continue;
        {
            PHASE_BEGIN();
            pg8::Gemm g{(const bf16*)(ws + WS_XN), (const bf16*)(ws + WS_W + (size_t)(l & 1) * W_SET + W_IN), MPAD, DIN, D, D, D, 0, 0}; pg8::StaticOrder S; S.init(MPAD, DIN, G, bx); PROBE_SET_REP(S);
            pg8::EpiStoreBf16 E{(bf16*)(ws + WS_PROJ), DIN, (const float*)(ws + WS_RSS) + (size_t)(3 * l + 1) * RSS_STRIDE, (const LAS float*)(lds + RSSB_OFF), 1.0f / D, EPS, (bf16*)(ws + WS_UG), 3 * DCV, CPG, UGLD};
            S.split = 1;
            S.pass = 0; pg8::gemm_phase<pg8::EpiStoreBf16, pg8::StaticOrder, true, true, false, false>(lds + RING_OFF, g, S, E, tid); S.pass = 1; pg8::gemm_phase<pg8::EpiStoreBf16, pg8::StaticOrder, true, true, false, true>(lds + RING_OFF, g, S, E, tid);
        }
        {
            PHASE_BEGIN();
            for (int prep = 0; prep < PROBE_N(5); ++prep)
            ssm_matrices(l, (size_t)bx * (NWAVES * 64) + tid, (size_t)G * NWAVES * 64, (const f32x2*)(ws + WS_APOW), (const f32x2*)(ws + WS_BBAR), A->in[I_CRE], A->in[I_CIM], A->in[I_SD],
                         (bf16*)(ws + WS_WBT), (bf16*)(ws + WS_BMT));
        }
        GRID_BAR();
        {
            PHASE_BEGIN();
            const bf16* PROJ = (const bf16*)(ws + WS_PROJ);
            for (int prep = 0; prep < PROBE_N(3); ++prep) {
            { bf16* MIXED = (bf16*)(ws + WS_MIXED); const float* cache = A->in[I_CACHE]; const float* convw = A->in[I_CONVW]; const float* cgain = A->in[I_CONVN]; float* out = A->out;
              for (int r = 4 * gw; r < MPAD; r += 4 * NGW) conv_rows4(r, l, PROJ, MIXED, cache, convw, cgain, out, lane); }
            }
        }
        {
            PHASE_BEGIN();
            pg8::Gemm g{(const bf16*)(ws + WS_UG), (const bf16*)(ws + WS_BMT), SG * CPG, 256, 256, UGLD, 256, CPG / 256, (size_t)256 * 256 * 2}; pg8::StaticOrder S; S.init(SG * CPG, 256, G, bx);
            pg8::EpiSloc E{(float*)(ws + WS_SLOC), CPG, NCHUNK, SG};
            PROBE_SET_REP3(S);
            S.split = 1;
            S.pass = 0; pg8::gemm_phase<pg8::EpiSloc, pg8::StaticOrder, true, true, false, false>(lds + RING_OFF, g, S, E, tid); S.pass = 1; pg8::gemm_phase<pg8::EpiSloc, pg8::StaticOrder, true, true, false, true>(lds + RING_OFF, g, S, E, tid);
        }
        GRID_BAR();
        {
            PHASE_BEGIN();
            const f32x2* apow = (const f32x2*)(ws + WS_APOW); const float* SLOC = (const float*)(ws + WS_SLOC); bf16* UG = (bf16*)(ws + WS_UG);
            for (int prep = 0; prep < PROBE_N(3); ++prep) {
            for (int pi = vcu; pi < 2 * NBP * SG; pi += G) ssm_carry_prompt((pi >> 1) / SG, (pi >> 1) % SG, pi & 1, l, apow, SLOC, UG, A->out, (LAS float*)(lds + RING_OFF), wave, lane);
            for (int w = gw; w < NBS * SG + (NCHUNK - NCH_REAL) * SG; w += NGW) ssm_carry_small(w, l, apow, SLOC, UG, A->in[I_SRE], A->in[I_SIM], A->out, lane);
            }
        }
        GRID_BAR();
        {
            PHASE_BEGIN();
            pg8::Gemm g{(const bf16*)(ws + WS_UG), (const bf16*)(ws + WS_WBT), SG * CPG, 256, UGLD, UGLD, UGLD, CPG / 256, (size_t)256 * UGLD * 2}; pg8::StaticOrder S; S.init(SG * CPG, 256, G, bx);
            pg8::EpiYs E{(bf16*)(ws + WS_YS), DSS, CPG, NCHUNK};
            PROBE_SET_REP3(S);
            S.split = 1;
            S.pass = 0; pg8::gemm_phase<pg8::EpiYs, pg8::StaticOrder, true, true, false, false>(lds + RING_OFF, g, S, E, tid); S.pass = 1; pg8::gemm_phase<pg8::EpiYs, pg8::StaticOrder, true, true, false, true>(lds + RING_OFF, g, S, E, tid);
        }
        GRID_BAR();
        {
            PHASE_BEGIN();
            pg8::Gemm g{(const bf16*)(ws + WS_YS), (const bf16*)(ws + WS_W + (size_t)(l & 1) * W_SET + W_GLU), MPAD, DSS, DSS, DSS, DSS, 0, 0}; pg8::StaticOrder S; S.init(MPAD, DSS, G, bx); PROBE_SET_REP(S);
            pg8::EpiGlu E{(const bf16*)(ws + WS_YS), DSS, (bf16*)(ws + WS_MIXED) + DCV, D, (float*)(ws + WS_RSS) + (size_t)(3 * NL + 1 + l) * RSS_STRIDE, (LAS float*)(lds + RED_OFF)};
            S.split = 1;
            S.pass = 0; pg8::gemm_phase<pg8::EpiGlu, pg8::StaticOrder, true, true, false, false>(lds + RING_OFF, g, S, E, tid); S.pass = 1; pg8::gemm_phase<pg8::EpiGlu, pg8::StaticOrder, true, true, false, true>(lds + RING_OFF, g, S, E, tid);
        }
        GRID_BAR();
        {
            PHASE_BEGIN();
            pg8::Gemm g{(const bf16*)(ws + WS_MIXED), (const bf16*)(ws + WS_W + (size_t)(l & 1) * W_SET + W_OUT), MPAD, D, D, D, D, 0, 0}; pg8::StaticOrder S; S.init(MPAD, D, G, bx);
            pg8::EpiResidNorm<true> E{(bf16*)(ws + WS_XN), D, 1.0f, (float*)(ws + WS_RSS) + (size_t)(3 * l + 2) * RSS_STRIDE, (hl + 1 >= FP8_UP_FROM) ? (unsigned char*)(ws + WS_XB8) : nullptr, (LAS float*)(lds + RED_OFF), (const float*)(ws + WS_RSS) + (size_t)(3 * NL + 1 + l) * RSS_STRIDE, (const LAS float*)(lds + RSSB_OFF), 1.0f / DSS, EPS};
            PROBE_SET_REP_R(S, E);
            S.split = 1;
            S.pass = 0; pg8::gemm_phase<pg8::EpiResidNorm<true>, pg8::StaticOrder, true, true, false, false>(lds + RING_OFF, g, S, E, tid); S.pass = 1; pg8::gemm_phase<pg8::EpiResidNorm<true>, pg8::StaticOrder, true, true, false, true>(lds + RING_OFF, g, S, E, tid);
        }
        GRID_BAR();
    }
    {
        PHASE_BEGIN();
        const bf16* X = (const bf16*)(ws + WS_XN); float* out = A->out; const float* gain = A->in[I_FINN]; const float* rss = (const float*)(ws + WS_RSS) + (size_t)(3 * NL) * RSS_STRIDE;
        for (int prep = 0; prep < PROBE_N(7); ++prep)
#define OUT_ROW(r) ((r) < MPROMPT ? (((r) % TP) < NMETA ? (float*)nullptr : out + O_YP + ((size_t)((r) / TP) * SEQ + (((r) % TP) - NMETA)) * D) : out + O_YS + (size_t)((r) - MPROMPT) * D)
        for (int r = gw; r < MREAL; r += 2 * NGW) { const int r1 = r + NGW;
            float* d0 = OUT_ROW(r); float* d1 = (r1 < MREAL) ? OUT_ROW(r1) : (float*)nullptr; int ra = r, rb = r1;
            if (!d0) { d0 = d1; d1 = nullptr; ra = r1; }
            if (d0) final_rows2(X + (size_t)ra * D, X + (size_t)(d1 ? rb : ra) * D, gain, d0, d1, rss + (size_t)ra * 8, rss + (size_t)(d1 ? rb : ra) * 8, lane); }
#undef OUT_ROW
    }
}
}

extern "C" void kernel_launch(void* const* d_in, const int* in_sizes, int n_in, void* d_out, int out_size, void* d_ws, size_t ws_size, hipStream_t stream) {
    using namespace mk;
    static int grid = 0;
    if (grid == 0) {
        if (n_in != N_IN || (size_t)out_size != O_END || ws_size < WS_END) { fprintf(stderr, "kernel_launch: unexpected shapes (n_in %d, out %d, ws %zu, need %zu)\n", n_in, out_size, ws_size, (size_t)WS_END); grid = -1; return; }
        int dev = 0, cus = 0, per_cu = 0;
        if (hipGetDevice(&dev) != hipSuccess || hipDeviceGetAttribute(&cus, hipDeviceAttributeMultiprocessorCount, dev) != hipSuccess) { grid = -1; return; }
        if (hipFuncSetAttribute((const void*)hymba_fwd, hipFuncAttributeMaxDynamicSharedMemorySize, LDS_BYTES) != hipSuccess) { fprintf(stderr, "kernel_launch: hipFuncSetAttribute failed\n"); grid = -1; return; }
        if (hipOccupancyMaxActiveBlocksPerMultiprocessor(&per_cu, (const void*)hymba_fwd, NWAVES * 64, LDS_BYTES) != hipSuccess || per_cu < 1) { fprintf(stderr, "kernel_launch: occupancy query says %d\n", per_cu); }
        (void)hipGetLastError();
        grid = cus;
    }
    if (grid < 0) return;
    if (hipMemsetAsync(d_ws, 0, ZERO_BYTES, stream) != hipSuccess) return;
    Args a{};
    for (int i = 0; i < N_IN; ++i) a.in[i] = (const float*)d_in[i];
    a.out = (float*)d_out; a.ws = (unsigned char*)d_ws;
    hipLaunchKernelGGL(hymba_fwd, dim3(grid), dim3(NWAVES * 64), LDS_BYTES, stream, a);
}
```

```cpp
#include <hip/hip_runtime.h>
#include <cstdio>
#include <cstdint>
namespace pg8 {
#define PG8_LAS __attribute__((address_space(3)))
typedef unsigned short bf16_t;
typedef short bf16x8 __attribute__((ext_vector_type(8)));
typedef float f32x4 __attribute__((ext_vector_type(4)));
typedef unsigned u32x4 __attribute__((ext_vector_type(4)));
typedef int i32x4 __attribute__((ext_vector_type(4)));
typedef int i32x8 __attribute__((ext_vector_type(8)));
typedef unsigned u32x2 __attribute__((ext_vector_type(2)));
constexpr int BM = 256, BK = 64, HALF = 128, HTB = HALF * BK * 2  , STAGE_BYTES = 8 * HTB, NXCD = 8, WGM = 4;

__host__ __device__ __forceinline__ int lds_byte(int r, int c) { const int st = (r >> 4) * 2 + (c >> 5), rr = r & 15, cc = c & 31, ob = rr * 64 + cc * 2; return st * 1024 + (ob ^ (((ob >> 9) & 1) << 5)); }
__host__ __device__ __forceinline__ void stage_rc(int b, int& R, int& C) { const int st = b / 1024, sb = b % 1024, swz = sb ^ (((sb >> 9) & 1) << 5); R = (st >> 1) * 16 + swz / 64; C = (st & 1) * 32 + (swz % 64) / 2; }
__host__ __device__ __forceinline__ int perm32(int rho) { const int n = rho >> 4, i = rho & 15; return 8 * (i >> 2) + 4 * n + (i & 3); }

struct Unit { int pm, pn, mh; };
struct Gemm { const bf16_t* A; const bf16_t* Bt; int M, N, K; int lda, ldb; int gpanels; size_t gstride; };

struct StaticOrder {
    int nM, nN, nwg, G, c, split, pass;
#ifdef PROBE_SPLIT
    int r0, r1;
#endif
#ifdef PROBE_REP
    int rep;
#else
    static constexpr int rep = 1;
#endif
    __host__ __device__ void init(int M, int N, int G_, int c_) { nM = M / BM; nN = N / BM; nwg = nM * nN; G = G_; c = c_; split = 0; pass = 0;
#ifdef PROBE_SPLIT
        r0 = 0; r1 = 1 << 30;
#endif
#ifdef PROBE_REP
        rep = 1;
#endif
    }
    __host__ __device__ bool next(int i, Unit& u) const {
        const int nfull = split ? (nwg / G) * G : nwg;
        long L; u.mh = -1;
        if (pass == 0) { L = (long)(i / rep) * G + c; if (L >= nfull) return false; }
        else { const long hq = (long)i * G + c; if (hq >= 2 * (long)(nwg - nfull)) return false; L = nfull + (hq >> 1); u.mh = (int)(hq & 1); }
        int wgid = (int)L; { const int q = nwg / NXCD, r = nwg % NXCD, xcd = wgid % NXCD, off = wgid / NXCD; wgid = (xcd < r ? xcd * (q + 1) : r * (q + 1) + (xcd - r) * q) + off; }
        const int nig = WGM * nN, gid = wgid / nig, fm = gid * WGM, gsz = (nM - fm) < WGM ? (nM - fm) : WGM;
        u.pm = fm + ((wgid % nig) % gsz); u.pn = (wgid % nig) / gsz; return true;
    }
    __device__ __forceinline__ void a_ready(const Unit&) const {}
    __device__ __forceinline__ void done(const Unit&) const {}
};
__device__ __forceinline__ unsigned cvt_pk_bf16(float lo, float hi) { unsigned r; asm volatile("v_cvt_pk_bf16_f32 %0, %1, %2" : "=v"(r) : "v"(lo), "v"(hi)); return r; }
typedef float f32x2 __attribute__((ext_vector_type(2)));
__device__ __forceinline__ float fast_sigmoid(float z) { return __builtin_amdgcn_rcpf(1.0f + __expf(-z)); }
__device__ __forceinline__ float row_rnorm_lds(const PG8_LAS float* rssl, int lr, float inv_n, float eps) {
    const PG8_LAS f32x4* p = (const PG8_LAS f32x4*)(rssl + lr * 8); const f32x4 a = p[0], b = p[1];
    const float s = ((a[0] + a[1]) + (a[2] + a[3])) + ((b[0] + b[1]) + (b[2] + b[3]));
    return __builtin_amdgcn_rsqf(s * inv_n + eps); }
struct EpiSwiglu {
    static constexpr bool MID = false;
    static constexpr bool PERM = true, AFTER_DRAIN = false, QPRE = false;
    static constexpr bool RSS = true;
    unsigned char* H; int ldc; const float* rss; const PG8_LAS float* rssl; float inv_n, eps, oscale, iscale; int f8;
    __device__ __forceinline__ void operator()(const f32x4 (&acc)[2][2][4][2], const Unit& u, int wr, int wc, int fr, int fq) const {
        const int nai = u.mh < 0 ? 2 : 1, row0 = u.pm * BM + (u.mh > 0 ? HALF : 0) + wr * 64 + fr, col0 = u.pn * HALF + wc * 32 + 8 * fq;
#pragma unroll
        for (int ai = 0; ai < 2; ++ai) if (ai < nai)
#pragma unroll
            for (int m = 0; m < 4; ++m) { const int row = row0 + ai * HALF + m * 16; const float r = row_rnorm_lds(rssl, ai * HALF + wr * 64 + m * 16 + fr, inv_n, eps) * iscale;
                float o[8]; const float ru = r * oscale;
#pragma unroll
                for (int n = 0; n < 2; ++n)
#pragma unroll
                    for (int j = 0; j < 4; j += 2) {
                        const f32x2 g = (f32x2){acc[ai][0][m][n][j], acc[ai][0][m][n][j + 1]} * r, up = (f32x2){acc[ai][1][m][n][j], acc[ai][1][m][n][j + 1]} * ru;
                        f32x2 e = g * (-1.4426950408889634f); e.x = __builtin_amdgcn_exp2f(e.x); e.y = __builtin_amdgcn_exp2f(e.y); e = e + 1.0f;
                        f32x2 sg; sg.x = __builtin_amdgcn_rcpf(e.x); sg.y = __builtin_amdgcn_rcpf(e.y);
                        const f32x2 ov = (g * up) * sg; o[4 * n + j] = ov.x; o[4 * n + j + 1] = ov.y; }
                if (f8) {
                    int w0 = __builtin_amdgcn_cvt_pk_fp8_f32(o[0], o[1], 0, false); w0 = __builtin_amdgcn_cvt_pk_fp8_f32(o[2], o[3], w0, true);
                    int w1 = __builtin_amdgcn_cvt_pk_fp8_f32(o[4], o[5], 0, false); w1 = __builtin_amdgcn_cvt_pk_fp8_f32(o[6], o[7], w1, true);
                    u32x2 w; w.x = (unsigned)w0; w.y = (unsigned)w1; *(u32x2*)(H + (size_t)row * ldc + col0) = w;
                } else {
                    u32x4 w; w.x = cvt_pk_bf16(o[0], o[1]); w.y = cvt_pk_bf16(o[2], o[3]); w.z = cvt_pk_bf16(o[4], o[5]); w.w = cvt_pk_bf16(o[6], o[7]);
                    *(u32x4*)((bf16_t*)H + (size_t)row * ldc + col0) = w; } }
    }
};
template <bool MIDS> struct EpiResidNorm {
    static constexpr bool PERM = true, AFTER_DRAIN = false, QPRE = false;
    static constexpr bool RSS = MIDS, MID = MIDS;
    bf16_t* XB; int ldc; float scale; float* rss_out; unsigned char* XB8; PG8_LAS float* red; const float* rss; const PG8_LAS float* rssl; float inv_n, eps;
    __device__ __forceinline__ void mid(f32x4 (&acc)[2][2][4][2], const Unit& u, int wr, int fr) const {
        const int nai = u.mh < 0 ? 2 : 1;
#pragma unroll
        for (int ai = 0; ai < 2; ++ai) if (ai < nai)
#pragma unroll
            for (int m = 0; m < 4; ++m) { const PG8_LAS f32x4* p = (const PG8_LAS f32x4*)(rssl + (ai * HALF + wr * 64 + m * 16 + fr) * 8); const f32x4 a = p[0], b = p[1];
                const float c = __builtin_amdgcn_sqrtf((((a[0] + a[1]) + (a[2] + a[3])) + ((b[0] + b[1]) + (b[2] + b[3]))) * inv_n + eps);
#pragma unroll
                for (int bj = 0; bj < 2; ++bj)
#pragma unroll
                    for (int n = 0; n < 2; ++n) acc[ai][bj][m][n] = acc[ai][bj][m][n] * c; }
    }
    __device__ __forceinline__ void operator()(const f32x4 (&acc)[2][2][4][2], const Unit& u, int wr, int wc, int fr, int fq) const {
        const int nai = u.mh < 0 ? 2 : 1, row0 = u.pm * BM + (u.mh > 0 ? HALF : 0) + wr * 64 + fr, col0 = u.pn * BM + wc * 32 + 8 * fq;
#pragma unroll
        for (int ai = 0; ai < 2; ++ai) if (ai < nai) {
            u32x4 xin[4][2];
#pragma unroll
            for (int m = 0; m < 4; ++m)
#pragma unroll
                for (int bj = 0; bj < 2; ++bj) xin[m][bj] = *(const u32x4*)(XB + (size_t)(row0 + ai * HALF + m * 16) * ldc + col0 + bj * HALF);
#pragma unroll
            for (int m = 0; m < 4; ++m) { const int row = row0 + ai * HALF + m * 16; bf16_t* rowb = XB + (size_t)row * ldc + col0; float ss = 0.f;
                const float scale = MIDS ? this->scale * row_rnorm_lds(rssl, ai * HALF + wr * 64 + m * 16 + fr, inv_n, eps) : this->scale;
#pragma unroll
                for (int bj = 0; bj < 2; ++bj) { const u32x4 xo = xin[m][bj]; const f32x4 a0 = acc[ai][bj][m][0], a1 = acc[ai][bj][m][1];
                    f32x4 v0, v1;
                    v0[0] = __uint_as_float(xo.x << 16) + a0[0] * scale; v0[1] = __uint_as_float(xo.x & 0xffff0000u) + a0[1] * scale; v0[2] = __uint_as_float(xo.y << 16) + a0[2] * scale; v0[3] = __uint_as_float(xo.y & 0xffff0000u) + a0[3] * scale;
                    v1[0] = __uint_as_float(xo.z << 16) + a1[0] * scale; v1[1] = __uint_as_float(xo.z & 0xffff0000u) + a1[1] * scale; v1[2] = __uint_as_float(xo.w << 16) + a1[2] * scale; v1[3] = __uint_as_float(xo.w & 0xffff0000u) + a1[3] * scale;
                    ss += (v0[0] * v0[0] + v0[1] * v0[1]) + (v0[2] * v0[2] + v0[3] * v0[3]) + (v1[0] * v1[0] + v1[1] * v1[1]) + (v1[2] * v1[2] + v1[3] * v1[3]);
                    u32x4 w; w.x = cvt_pk_bf16(v0[0], v0[1]); w.y = cvt_pk_bf16(v0[2], v0[3]); w.z = cvt_pk_bf16(v1[0], v1[1]); w.w = cvt_pk_bf16(v1[2], v1[3]);
                    *(u32x4*)(rowb + bj * HALF) = w;
                    if (XB8) { int w0 = __builtin_amdgcn_cvt_pk_fp8_f32(v0[0], v0[1], 0, false); w0 = __builtin_amdgcn_cvt_pk_fp8_f32(v0[2], v0[3], w0, true);
                        int w1 = __builtin_amdgcn_cvt_pk_fp8_f32(v1[0], v1[1], 0, false); w1 = __builtin_amdgcn_cvt_pk_fp8_f32(v1[2], v1[3], w1, true);
                        u32x2 w8; w8.x = (unsigned)w0; w8.y = (unsigned)w1; *(u32x2*)(XB8 + (size_t)row * ldc + col0 + bj * HALF) = w8; } }
                ss += __shfl_xor(ss, 16); ss += __shfl_xor(ss, 32);
                if (fq == 0) red[(ai * HALF + wr * 64 + m * 16 + fr) * 4 + wc] = ss; }
            asm volatile("" ::: "memory"); }
        asm volatile("s_waitcnt lgkmcnt(0)" ::: "memory"); __builtin_amdgcn_s_barrier(); asm volatile("" ::: "memory");
        { const int t = (wr * 4 + wc) * 64 + fq * 16 + fr;
          if (t < nai * HALF) { const f32x4 q = *(const PG8_LAS f32x4*)(red + t * 4); rss_out[((size_t)u.pm * BM + (u.mh > 0 ? HALF : 0) + t) * 8 + u.pn] = (q[0] + q[1]) + (q[2] + q[3]); } }
    }
};
struct EpiStoreBf16 {
    static constexpr bool MID = false;
    static constexpr bool PERM = true, AFTER_DRAIN = false, QPRE = false;
    static constexpr bool RSS = true;
    bf16_t* O; int ldc; const float* rss; const PG8_LAS float* rssl; float inv_n, eps; bf16_t* UG; int ucol0, ug_chunks, ug_ld;
    __device__ __forceinline__ void operator()(const f32x4 (&acc)[2][2][4][2], const Unit& u, int wr, int wc, int fr, int fq) const {
        const int nai = u.mh < 0 ? 2 : 1, row0 = u.pm * BM + (u.mh > 0 ? HALF : 0) + wr * 64 + fr, col0 = u.pn * BM + wc * 32 + 8 * fq; const bool isu = (u.pn * BM >= ucol0);
#pragma unroll
        for (int ai = 0; ai < 2; ++ai) if (ai < nai)
#pragma unroll
            for (int m = 0; m < 4; ++m) { const int row = row0 + ai * HALF + m * 16; const float r = row_rnorm_lds(rssl, ai * HALF + wr * 64 + m * 16 + fr, inv_n, eps);
#pragma unroll
                for (int bj = 0; bj < 2; ++bj) { const f32x4 v0 = acc[ai][bj][m][0] * r, v1 = acc[ai][bj][m][1] * r;
                    u32x4 w; w.x = cvt_pk_bf16(v0[0], v0[1]); w.y = cvt_pk_bf16(v0[2], v0[3]); w.z = cvt_pk_bf16(v1[0], v1[1]); w.w = cvt_pk_bf16(v1[2], v1[3]);
                    const int c = col0 + bj * HALF;
                    bf16_t* dst = isu ? UG + ((size_t)((c - ucol0) >> 4) * ug_chunks + (row >> 4)) * ug_ld + (row & 15) * 16 + (c & 15) : O + (size_t)row * ldc + c;
                    *(u32x4*)dst = w; } }
    }
};
struct EpiSloc {
    static constexpr bool MID = false;
    static constexpr bool RSS = false;
    static constexpr bool PERM = false, AFTER_DRAIN = false, QPRE = false;
    float* S; int cpg, nchunk, ngrp;
    __device__ __forceinline__ void operator()(const f32x4 (&acc)[2][2][4][2], const Unit& u, int wr, int wc, int fr, int fq) const {
        const int nai = u.mh < 0 ? 2 : 1, R0 = u.pm * BM + (u.mh > 0 ? HALF : 0) + wr * 64 + fr, g = R0 / cpg, c0 = R0 - g * cpg, col0 = wc * 32 + 4 * fq;
#pragma unroll
        for (int ai = 0; ai < 2; ++ai) if (ai < nai)
#pragma unroll
            for (int m = 0; m < 4; ++m) { const int chunk = c0 + ai * HALF + m * 16; if (chunk < nchunk) { float* p = S + ((size_t)chunk * ngrp + g) * 128 + col0;
#pragma unroll
                for (int n = 0; n < 2; ++n) *(f32x4*)(p + n * 16) = acc[ai][0][m][n]; } }
    }
};
struct EpiYs {
    static constexpr bool MID = false;
    static constexpr bool RSS = false;
    static constexpr bool PERM = true, AFTER_DRAIN = false, QPRE = false;
    bf16_t* Y; int ldy, cpg, nchunk;
    __device__ __forceinline__ void operator()(const f32x4 (&acc)[2][2][4][2], const Unit& u, int wr, int wc, int fr, int fq) const {
        const int nai = u.mh < 0 ? 2 : 1, R0 = u.pm * BM + (u.mh > 0 ? HALF : 0) + wr * 64 + fr, g = R0 / cpg, c0 = R0 - g * cpg, col0 = wc * 32 + 8 * fq;
#pragma unroll
        for (int ai = 0; ai < 2; ++ai) if (ai < nai)
#pragma unroll
            for (int m = 0; m < 4; ++m) { const int chunk = c0 + ai * HALF + m * 16; if (chunk < nchunk) {
#pragma unroll
                for (int bj = 0; bj < 2; ++bj) { const int c = col0 + bj * HALF; float o[8];
#pragma unroll
                    for (int n = 0; n < 2; ++n)
#pragma unroll
                        for (int j = 0; j < 4; ++j) { const float x = acc[ai][bj][m][n][j]; const float z = 0.7978845608028654f * (x + 0.044715f * x * x * x); o[4 * n + j] = x * fast_sigmoid(2.0f * z); }
                    u32x4 w; w.x = cvt_pk_bf16(o[0], o[1]); w.y = cvt_pk_bf16(o[2], o[3]); w.z = cvt_pk_bf16(o[4], o[5]); w.w = cvt_pk_bf16(o[6], o[7]);
                    *(u32x4*)(Y + ((size_t)chunk * 16 + (c >> 4)) * ldy + g * 16 + (c & 15)) = w; } } }
    }
};
struct EpiGlu {
    static constexpr bool MID = false;
    static constexpr bool RSS = false;
    static constexpr bool PERM = true, AFTER_DRAIN = false, QPRE = false;
    const bf16_t* Y; int ldy; bf16_t* O; int ldo; float* rss_out; PG8_LAS float* red;
    __device__ __forceinline__ void operator()(const f32x4 (&acc)[2][2][4][2], const Unit& u, int wr, int wc, int fr, int fq) const {
        const int nai = u.mh < 0 ? 2 : 1, row0 = u.pm * BM + (u.mh > 0 ? HALF : 0) + wr * 64 + fr, col0 = u.pn * BM + wc * 32 + 8 * fq;
#pragma unroll
        for (int ai = 0; ai < 2; ++ai) if (ai < nai) {
            u32x4 yin[4][2];
#pragma unroll
            for (int m = 0; m < 4; ++m)
#pragma unroll
                for (int bj = 0; bj < 2; ++bj) yin[m][bj] = *(const u32x4*)(Y + (size_t)(row0 + ai * HALF + m * 16) * ldy + col0 + bj * HALF);
#pragma unroll
            for (int m = 0; m < 4; ++m) { const size_t r = (size_t)(row0 + ai * HALF + m * 16); float ss = 0.f;
#pragma unroll
                for (int bj = 0; bj < 2; ++bj) { const u32x4 yv = yin[m][bj]; const f32x4 z0 = acc[ai][bj][m][0], z1 = acc[ai][bj][m][1];
                    float o[8];
#pragma unroll
                    for (int q = 0; q < 4; ++q) { const unsigned w = yv[q]; const float ylo = __uint_as_float(w << 16), yhi = __uint_as_float(w & 0xffff0000u);
                        const float za = (q < 2) ? z0[2 * q] : z1[2 * q - 4], zb = (q < 2) ? z0[2 * q + 1] : z1[2 * q - 3];
                        o[2 * q] = ylo * fast_sigmoid(za); o[2 * q + 1] = yhi * fast_sigmoid(zb); ss += o[2 * q] * o[2 * q] + o[2 * q + 1] * o[2 * q + 1]; }
                    u32x4 w; w.x = cvt_pk_bf16(o[0], o[1]); w.y = cvt_pk_bf16(o[2], o[3]); w.z = cvt_pk_bf16(o[4], o[5]); w.w = cvt_pk_bf16(o[6], o[7]);
                    *(u32x4*)(O + r * ldo + col0 + bj * HALF) = w; }
                ss += __shfl_xor(ss, 16); ss += __shfl_xor(ss, 32);
                if (fq == 0) red[(ai * HALF + wr * 64 + m * 16 + fr) * 4 + wc] = ss; }
            asm volatile("" ::: "memory"); }
        asm volatile("s_waitcnt lgkmcnt(0)" ::: "memory"); __builtin_amdgcn_s_barrier(); asm volatile("" ::: "memory");
        { const int t = (wr * 4 + wc) * 64 + fq * 16 + fr;
          if (t < nai * HALF) { const f32x4 q = *(const PG8_LAS f32x4*)(red + t * 4); float* ro = rss_out + ((size_t)u.pm * BM + (u.mh > 0 ? HALF : 0) + t) * 8 + u.pn; ro[0] = (q[0] + q[1]) + (q[2] + q[3]); ro[4] = 0.f; } }
    }
};
struct EpiSwigluQ {
    static constexpr bool MID = false, RSS = true;
    static constexpr bool PERM = true, AFTER_DRAIN = false, QPRE = true;
    const float* QF; unsigned char* H; const float* CSG; int ldc; const float* CSU; int f8; float oscale; const PG8_LAS float* rssl;
    __device__ __forceinline__ const void* pre_src(const Unit& u, int wid, int lane) const {
        return wid == 0 ? (const void*)(QF + (size_t)u.pm * BM + (u.mh > 0 ? HALF : 0) + lane * 4) : (const void*)((lane < 32 ? CSG : CSU) + u.pn * HALF + (lane & 31) * 4); }
    __device__ __forceinline__ void operator()(const f32x4 (&acc)[2][2][4][2], const Unit& u, int wr, int wc, int fr, int fq) const {
        const int nai = u.mh < 0 ? 2 : 1, row0 = u.pm * BM + (u.mh > 0 ? HALF : 0) + wr * 64 + fr, col0 = u.pn * HALF + wc * 32 + 8 * fq;
        f32x4 cg[2], cu[2]; const PG8_LAS f32x4* cp = (const PG8_LAS f32x4*)(rssl + 256 + wc * 32 + 8 * fq); cg[0] = cp[0]; cg[1] = cp[1]; cu[0] = cp[32] * oscale; cu[1] = cp[33] * oscale;
        float qf[2][4];
#pragma unroll
        for (int ai = 0; ai < 2; ++ai)
#pragma unroll
            for (int m = 0; m < 4; ++m) qf[ai][m] = (ai < nai) ? rssl[ai * HALF + wr * 64 + m * 16 + fr] : 0.f;
#pragma unroll
        for (int ai = 0; ai < 2; ++ai) if (ai < nai)
#pragma unroll
            for (int m = 0; m < 4; ++m) { const int row = row0 + ai * HALF + m * 16;
                float o[8];
#pragma unroll
                for (int n = 0; n < 2; ++n)
#pragma unroll
                    for (int j = 0; j < 4; j += 2) { const f32x4 ag = acc[ai][0][m][n], au = acc[ai][1][m][n];
                        const float g0 = ag[j], g1 = ag[j + 1], u0 = au[j], u1 = au[j + 1];
                        const f32x2 g = ((f32x2){(float)__float_as_int(g0), (float)__float_as_int(g1)} * qf[ai][m]) * (f32x2){cg[n][j], cg[n][j + 1]};
                        const f32x2 up = ((f32x2){(float)__float_as_int(u0), (float)__float_as_int(u1)} * qf[ai][m]) * (f32x2){cu[n][j], cu[n][j + 1]};
                        f32x2 e = g * (-1.4426950408889634f); e.x = __builtin_amdgcn_exp2f(e.x); e.y = __builtin_amdgcn_exp2f(e.y); e = e + 1.0f;
                        f32x2 sgm; sgm.x = __builtin_amdgcn_rcpf(e.x); sgm.y = __builtin_amdgcn_rcpf(e.y);
                        const f32x2 ov = (g * up) * sgm; o[4 * n + j] = ov.x; o[4 * n + j + 1] = ov.y; }
                if (f8) {
                    int w0 = __builtin_amdgcn_cvt_pk_fp8_f32(o[0], o[1], 0, false); w0 = __builtin_amdgcn_cvt_pk_fp8_f32(o[2], o[3], w0, true);
                    int w1 = __builtin_amdgcn_cvt_pk_fp8_f32(o[4], o[5], 0, false); w1 = __builtin_amdgcn_cvt_pk_fp8_f32(o[6], o[7], w1, true);
                    u32x2 w; w.x = (unsigned)w0; w.y = (unsigned)w1; *(u32x2*)(H + (size_t)row * ldc + col0) = w;
                } else {
                    u32x4 w; w.x = cvt_pk_bf16(o[0], o[1]); w.y = cvt_pk_bf16(o[2], o[3]); w.z = cvt_pk_bf16(o[4], o[5]); w.w = cvt_pk_bf16(o[6], o[7]);
                    *(u32x4*)((bf16_t*)H + (size_t)row * ldc + col0) = w; } }
    }
};
template <class Epi, class Sched, bool ALIGN_EPI = false, bool SP2 = false, int FP8 = 0, bool HM = false>
__device__ __forceinline__ void gemm_phase(PG8_LAS unsigned char* lds, const Gemm g, const Sched& S, const Epi& E, const int tid_in) {   constexpr bool hm = HM;
    const int tid = tid_in, wid = __builtin_amdgcn_readfirstlane(tid >> 6), lane = tid & 63, wr = wid >> 2, wc = wid & 3, fr = lane & 15, fq = lane >> 4;
    const int K = g.K, nt = K / BK;
    unsigned voffA[2], voffB[2];
#pragma unroll
    for (int i = 0; i < 2; ++i) { int R, C; stage_rc(tid * 16 + i * 8192, R, C); const int Rb = Epi::PERM ? ((R & ~31) + perm32(R & 31)) : R;
        voffA[i] = (unsigned)(R * g.lda + C) * 2u; voffB[i] = (unsigned)(Rb * g.ldb + C) * 2u; }
    const size_t kstep = (size_t)(BK * 2);
    const size_t hstepA = (size_t)HALF * g.lda * 2, hstepB = (size_t)HALF * g.ldb * 2;
    const size_t tstepA = 2 * hstepA, tstepB = 2 * hstepB;
    const unsigned ldsw = (unsigned)wid * 1024u;
    const int aoff = lds_byte(wr * 64 + fr, fq * 8), boff = lds_byte(wc * 32 + fr, fq * 8);
#define PG8_SA(b, h) (((b) * 2 + (h)) * HTB)
#define PG8_SB(b, h) ((4 + (b) * 2 + (h)) * HTB)
#define PG8_STAGE(bufoff, gbase, voff) do { _Pragma("unroll") for (int _i = 0; _i < 2; ++_i) \
        __builtin_amdgcn_global_load_lds((const unsigned*)((const char*)(gbase) + (voff)[_i]), (PG8_LAS unsigned*)(lds + (bufoff) + ldsw + _i * 8192), 16, 0, 0); } while (0)
#define PG8_LDA(dst, b, h) do { if constexpr (FP8 == 1) { _Pragma("unroll") for (int m = 0; m < 4; ++m) { const i32x4 lo_ = *(const PG8_LAS i32x4*)(lds + PG8_SA(b, h) + aoff + m * 2048), hi_ = *(const PG8_LAS i32x4*)(lds + PG8_SA(b, h) + aoff + m * 2048 + 1024); \
            dst##8[m] = __builtin_shufflevector(lo_, hi_, 0, 1, 2, 3, 4, 5, 6, 7); } } \
        else { _Pragma("unroll") for (int m = 0; m < 4; ++m) _Pragma("unroll") for (int k = 0; k < 2; ++k) dst[m][k] = *(const PG8_LAS bf16x8*)(lds + PG8_SA(b, h) + aoff + m * 2048 + k * 1024); } } while (0)
#define PG8_LDB(dst, b, h) do { if constexpr (FP8 == 1) { _Pragma("unroll") for (int n = 0; n < 2; ++n) { const i32x4 lo_ = *(const PG8_LAS i32x4*)(lds + PG8_SB(b, h) + boff + n * 2048), hi_ = *(const PG8_LAS i32x4*)(lds + PG8_SB(b, h) + boff + n * 2048 + 1024); \
            dst##8[n] = __builtin_shufflevector(lo_, hi_, 0, 1, 2, 3, 4, 5, 6, 7); } } \
        else { _Pragma("unroll") for (int n = 0; n < 2; ++n) _Pragma("unroll") for (int k = 0; k < 2; ++k) dst[n][k] = *(const PG8_LAS bf16x8*)(lds + PG8_SB(b, h) + boff + n * 2048 + k * 1024); } } while (0)
#define PG8_MMA(ai, bj, At, Bt) do { __builtin_amdgcn_s_setprio(1); \
        if constexpr (FP8 == 1) { _Pragma("unroll") for (int m = 0; m < 4; ++m) _Pragma("unroll") for (int n = 0; n < 2; ++n) \
            asm volatile("v_mfma_scale_f32_16x16x128_f8f6f4 %0, %1, %2, %0, %3, %3 op_sel_hi:[0,0,0]" : "+v"(acc[ai][bj][m][n]) : "v"(Bt##8[n]), "v"(At##8[m]), "v"(one_scale)); } \
        else if constexpr (FP8 == 2) { _Pragma("unroll") for (int m = 0; m < 4; ++m) _Pragma("unroll") for (int n = 0; n < 2; ++n) _Pragma("unroll") for (int k = 0; k < 2; ++k) \
            acc[ai][bj][m][n] = __builtin_bit_cast(f32x4, __builtin_amdgcn_mfma_i32_16x16x64_i8(__builtin_bit_cast(i32x4, Bt[n][k]), __builtin_bit_cast(i32x4, At[m][k]), __builtin_bit_cast(i32x4, acc[ai][bj][m][n]), 0, 0, 0)); } \
        else { _Pragma("unroll") for (int m = 0; m < 4; ++m) _Pragma("unroll") for (int n = 0; n < 2; ++n) _Pragma("unroll") for (int k = 0; k < 2; ++k) \
            acc[ai][bj][m][n] = __builtin_amdgcn_mfma_f32_16x16x32_bf16(Bt[n][k], At[m][k], acc[ai][bj][m][n], 0, 0, 0); } \
        __builtin_amdgcn_s_setprio(0); } while (0)
#define PG8_RSS_DMA() do { if constexpr (Epi::RSS) { if (t == 0) { if constexpr (Epi::QPRE) { if (wid < 2) __builtin_amdgcn_global_load_lds((const unsigned*)E.pre_src(cur, wid, lane), (PG8_LAS unsigned*)((PG8_LAS unsigned char*)E.rssl + ldsw), 16, 0, 0); } \
        else __builtin_amdgcn_global_load_lds((const unsigned*)((const char*)E.rss + ((size_t)cur.pm * BM + (cur.mh > 0 ? HALF : 0)) * 32 + (size_t)tid * 16), \
        (PG8_LAS unsigned*)((PG8_LAS unsigned char*)E.rssl + ldsw), 16, 0, 0); } } } while (0)
#define PG8_WAIT_V(n) asm volatile("s_waitcnt vmcnt(" #n ")" ::: "memory")
#define PG8_WAIT_L(n) asm volatile("s_waitcnt lgkmcnt(" #n ")" ::: "memory")
#define PG8_BAR __builtin_amdgcn_s_barrier()
#define PG8_SCHED __builtin_amdgcn_sched_barrier(0)
    Unit cur, nxt; int ui = 0;
    if (!S.next(0, cur)) return;
    f32x4 acc[2][2][4][2];
#pragma unroll
    for (int a = 0; a < 2; ++a)
#pragma unroll
        for (int b = 0; b < 2; ++b)
#pragma unroll
            for (int m = 0; m < 4; ++m)
#pragma unroll
                for (int n = 0; n < 2; ++n) acc[a][b][m][n] = (f32x4){0.f, 0.f, 0.f, 0.f};
    int one_scale = 0x7f7f7f7f; asm volatile("" : "+v"(one_scale));
    bf16x8 At[4][2], B0[2][2], B1[2][2]; i32x8 At8[4], B08[2], B18[2];
    const char* cA = (const char*)g.A + (size_t)cur.pm * tstepA + (cur.mh > 0 ? hstepA : (size_t)0); const char* cB = (const char*)g.Bt + (size_t)cur.pn * tstepB + (g.gpanels ? (size_t)(cur.pm / g.gpanels) * g.gstride : (size_t)0);
    S.a_ready(cur);
    if constexpr (SP2) {
        if constexpr (HM) {
        PG8_STAGE(PG8_SB(0, 0), cB, voffB); PG8_STAGE(PG8_SB(0, 1), cB + hstepB, voffB); PG8_STAGE(PG8_SA(0, 0), cA, voffA);
        if (wr == 1) PG8_BAR;
        PG8_WAIT_V(0); PG8_BAR;
        PG8_STAGE(PG8_SB(1, 0), cB + kstep, voffB); PG8_STAGE(PG8_SA(1, 0), cA + kstep, voffA); PG8_STAGE(PG8_SB(1, 1), cB + hstepB + kstep, voffB);
        PG8_BAR;
        } else {
        PG8_STAGE(PG8_SB(0, 0), cB, voffB); PG8_STAGE(PG8_SB(0, 1), cB + hstepB, voffB); PG8_STAGE(PG8_SA(0, 0), cA, voffA); PG8_STAGE(PG8_SA(0, 1), cA + hstepA, voffA);
        if (wr == 1) PG8_BAR;
        PG8_WAIT_V(2); PG8_BAR;
        PG8_STAGE(PG8_SB(1, 0), cB + kstep, voffB); PG8_STAGE(PG8_SA(1, 0), cA + kstep, voffA); PG8_STAGE(PG8_SB(1, 1), cB + hstepB + kstep, voffB);
        PG8_WAIT_V(6); PG8_BAR;
        }
    } else {
        PG8_STAGE(PG8_SB(0, 0), cB, voffB); PG8_STAGE(PG8_SA(0, 0), cA, voffA); PG8_STAGE(PG8_SB(0, 1), cB + hstepB, voffB); PG8_STAGE(PG8_SA(0, 1), cA + hstepA, voffA);
        if (wr == 1) PG8_BAR;
        PG8_WAIT_V(4); PG8_BAR;
        PG8_STAGE(PG8_SB(1, 0), cB + kstep, voffB); PG8_STAGE(PG8_SA(1, 0), cA + kstep, voffA); PG8_STAGE(PG8_SB(1, 1), cB + hstepB + kstep, voffB);
        PG8_WAIT_V(6); PG8_BAR;
    }
    for (;;) {
        const bool has_next = S.next(ui + 1, nxt);
        const char* nA = has_next ? (const char*)g.A + (size_t)nxt.pm * tstepA + (nxt.mh > 0 ? hstepA : (size_t)0) : cA; const char* nB = has_next ? (const char*)g.Bt + (size_t)nxt.pn * tstepB + (g.gpanels ? (size_t)(nxt.pm / g.gpanels) * g.gstride : (size_t)0) : cB;
#pragma nounroll
        for (int t = 0; t < nt; t += 2) {
            const bool last = (t == nt - 2);
            const char* a1 = cA + (size_t)(t + 1) * kstep;
            const char* a2 = last ? nA : cA + (size_t)(t + 2) * kstep; const char* b2 = last ? nB : cB + (size_t)(t + 2) * kstep;
            const char* a3 = a2 + kstep; const char* b3 = b2 + kstep;
            if (last && has_next) S.a_ready(nxt);
            if constexpr (Epi::MID) { if (t == (nt >> 1)) E.mid(acc, cur, wr, fr); }
            if constexpr (SP2) {
            if constexpr (HM) {
            PG8_LDB(B0, 0, 0); PG8_LDB(B1, 0, 1); PG8_SCHED; PG8_LDA(At, 0, 0);
            PG8_WAIT_L(0); PG8_BAR; PG8_RSS_DMA(); PG8_MMA(0, 0, At, B0); PG8_MMA(0, 1, At, B1); PG8_BAR; PG8_SCHED;
            PG8_STAGE(PG8_SB(0, 0), b2, voffB); PG8_STAGE(PG8_SB(0, 1), b2 + hstepB, voffB); PG8_STAGE(PG8_SA(0, 0), a2, voffA);
            PG8_WAIT_V(6); PG8_BAR; PG8_BAR; PG8_SCHED;
            PG8_LDB(B0, 1, 0); PG8_LDB(B1, 1, 1); PG8_SCHED; PG8_LDA(At, 1, 0);
            PG8_WAIT_L(0); PG8_BAR; PG8_MMA(0, 0, At, B0); PG8_MMA(0, 1, At, B1); PG8_BAR; PG8_SCHED;
            PG8_STAGE(PG8_SB(1, 0), b3, voffB); PG8_STAGE(PG8_SB(1, 1), b3 + hstepB, voffB); PG8_STAGE(PG8_SA(1, 0), a3, voffA);
            PG8_WAIT_V(6); PG8_BAR; PG8_BAR; PG8_SCHED;
            } else {
            PG8_LDB(B0, 0, 0); PG8_LDB(B1, 0, 1); PG8_SCHED; PG8_LDA(At, 0, 0); PG8_STAGE(PG8_SA(1, 1), a1 + hstepA, voffA);
            PG8_WAIT_V(8); PG8_WAIT_L(0); PG8_BAR; PG8_RSS_DMA(); PG8_MMA(0, 0, At, B0); PG8_MMA(0, 1, At, B1); PG8_BAR; PG8_SCHED;
            PG8_LDA(At, 0, 1); PG8_STAGE(PG8_SB(0, 0), b2, voffB); PG8_STAGE(PG8_SB(0, 1), b2 + hstepB, voffB); PG8_STAGE(PG8_SA(0, 0), a2, voffA);
            PG8_WAIT_V(8); PG8_WAIT_L(0); PG8_BAR; PG8_MMA(1, 0, At, B0); PG8_MMA(1, 1, At, B1); PG8_BAR; PG8_SCHED;
            PG8_LDB(B0, 1, 0); PG8_LDB(B1, 1, 1); PG8_SCHED; PG8_LDA(At, 1, 0); PG8_STAGE(PG8_SA(0, 1), a2 + hstepA, voffA);
            PG8_WAIT_V(8); PG8_WAIT_L(0); PG8_BAR; PG8_MMA(0, 0, At, B0); PG8_MMA(0, 1, At, B1); PG8_BAR; PG8_SCHED;
            PG8_LDA(At, 1, 1); PG8_STAGE(PG8_SB(1, 0), b3, voffB); PG8_STAGE(PG8_SB(1, 1), b3 + hstepB, voffB); PG8_STAGE(PG8_SA(1, 0), a3, voffA);
            PG8_WAIT_V(8); PG8_WAIT_L(0); PG8_BAR; PG8_MMA(1, 0, At, B0); PG8_MMA(1, 1, At, B1); PG8_BAR; PG8_SCHED;
            }
            } else {
            PG8_LDB(B0, 0, 0); PG8_SCHED; PG8_LDA(At, 0, 0); PG8_STAGE(PG8_SA(1, 1), a1 + hstepA, voffA);
            PG8_WAIT_L(8); PG8_BAR; PG8_WAIT_L(0); PG8_MMA(0, 0, At, B0); PG8_BAR; PG8_SCHED;
            PG8_LDB(B1, 0, 1); PG8_STAGE(PG8_SB(0, 0), b2, voffB);
            PG8_BAR; PG8_WAIT_L(0); PG8_MMA(0, 1, At, B1); PG8_BAR;
            PG8_LDA(At, 0, 1); PG8_STAGE(PG8_SA(0, 0), a2, voffA);
            PG8_BAR; PG8_WAIT_L(0); PG8_MMA(1, 0, At, B0); PG8_BAR; PG8_SCHED;
            PG8_STAGE(PG8_SB(0, 1), b2 + hstepB, voffB);
            PG8_WAIT_V(6); PG8_BAR; PG8_MMA(1, 1, At, B1); PG8_BAR;
            PG8_LDB(B0, 1, 0); PG8_SCHED; PG8_LDA(At, 1, 0); PG8_STAGE(PG8_SA(0, 1), a2 + hstepA, voffA);
            PG8_WAIT_L(8); PG8_BAR; PG8_WAIT_L(0); PG8_MMA(0, 0, At, B0); PG8_BAR; PG8_SCHED;
            PG8_LDB(B1, 1, 1); PG8_STAGE(PG8_SB(1, 0), b3, voffB);
            PG8_BAR; PG8_WAIT_L(0); PG8_MMA(0, 1, At, B1); PG8_BAR;
            PG8_LDA(At, 1, 1); PG8_STAGE(PG8_SA(1, 0), a3, voffA);
            PG8_BAR; PG8_WAIT_L(0); PG8_MMA(1, 0, At, B0); PG8_BAR; PG8_SCHED;
            PG8_STAGE(PG8_SB(1, 1), b3 + hstepB, voffB);
            PG8_WAIT_V(6); PG8_BAR; PG8_MMA(1, 1, At, B1); PG8_BAR;
            }
        }
        if constexpr (ALIGN_EPI) { if (wr == 0) PG8_BAR; }
        if constexpr (!Epi::AFTER_DRAIN) {
            if constexpr (FP8 == 1) asm volatile("s_nop 15\n\ts_nop 15" ::: "memory");
            int tz = tid; asm volatile("" : "+v"(tz)); const int lz = tz & 63, wz = __builtin_amdgcn_readfirstlane(tz >> 6);
            E(acc, cur, wz >> 2, wz & 3, lz & 15, lz >> 4); S.done(cur); }
        if (!has_next) break;
#pragma unroll
        for (int a = 0; a < 2; ++a)
#pragma unroll
            for (int b = 0; b < 2; ++b)
#pragma unroll
                for (int m = 0; m < 4; ++m)
#pragma unroll
                    for (int n = 0; n < 2; ++n) acc[a][b][m][n] = (f32x4){0.f, 0.f, 0.f, 0.f};
        cur = nxt; cA = nA; cB = nB; ++ui;
        if constexpr (ALIGN_EPI) { if (wr == 1) PG8_BAR; }
    }
    PG8_WAIT_V(0);
    if constexpr (!ALIGN_EPI) { if (wr == 0) PG8_BAR; }
    PG8_BAR;
    if constexpr (Epi::AFTER_DRAIN) { E.fused(acc, cur, wr, wc, fr, fq, lds, wid, lane); S.done(cur); }
#undef PG8_SA
#undef PG8_SB
#undef PG8_STAGE
#undef PG8_LDA
#undef PG8_LDB
#undef PG8_MMA
#undef PG8_WAIT_V
#undef PG8_RSS_DMA
#undef PG8_WAIT_L
#undef PG8_BAR
#undef PG8_SCHED
}
}
#define GAS __attribute__((address_space(1)))
#define LAS __attribute__((address_space(3)))
typedef unsigned short bf16;
typedef unsigned v4u __attribute__((ext_vector_type(4)));
typedef float f32x4 __attribute__((ext_vector_type(4)));
typedef short bf16x8 __attribute__((ext_vector_type(8)));
typedef GAS unsigned gu32;
typedef GAS unsigned long long gu64;
#define RLX_AGENT __ATOMIC_RELAXED, __HIP_MEMORY_SCOPE_AGENT
#define LDS_WAIT() asm volatile("s_waitcnt lgkmcnt(0)" ::: "memory")
#define VM_WAIT() asm volatile("s_waitcnt vmcnt(0)" ::: "memory")
__device__ __forceinline__ unsigned long long rt() { return __builtin_amdgcn_s_memrealtime(); }
__device__ __forceinline__ unsigned f2bf(float f) { unsigned u = __builtin_bit_cast(unsigned, f); return (u + 0x7fffu + ((u >> 16) & 1u)) >> 16; }
__device__ __forceinline__ unsigned pk2(float lo, float hi) { return f2bf(lo) | (f2bf(hi) << 16); }

#define XB_TMO      128
#define XB_XCNT(j)  (256  + 64 * (j))
#define XB_XSUB(j)  (1280 + 64 * (j))
#define XB_XGEN(j)  (2304 + 64 * (j))
#define XB_TOP      3328
#define XB_TOPGEN   3392
#define XCD_BAR_WORDS 3456
#define XB_SPIN_CAP (1u << 18)

__device__ __forceinline__ unsigned xb_ld(unsigned* p)              { return __hip_atomic_load(p, __ATOMIC_RELAXED, __HIP_MEMORY_SCOPE_AGENT); }
__device__ __forceinline__ unsigned xb_add(unsigned* p, unsigned v) { return __hip_atomic_fetch_add(p, v, __ATOMIC_RELAXED, __HIP_MEMORY_SCOPE_AGENT); }
__device__ __forceinline__ unsigned xb_xcc_id() { return (unsigned)__builtin_amdgcn_s_getreg((3 << 11) | 20) & 0xFu; }
#define XB_SPIN(cond, bar) do { unsigned _sp = 0; while (cond) { __builtin_amdgcn_s_sleep(1); \
    if ((++_sp & 255u) == 0u) { if (xb_ld(&(bar)[XB_TMO])) break; if (_sp > XB_SPIN_CAP) { atomicAdd(&(bar)[XB_TMO], 1u); break; } } } } while (0)

struct XcdBarrier {
    unsigned* bar; unsigned x;
    volatile LAS unsigned* st;
};

__device__ __forceinline__ XcdBarrier xcd_barrier_post(unsigned* bar, volatile LAS unsigned* st) {
    XcdBarrier b; b.bar = bar; b.x = xb_xcc_id(); b.st = st;
    if (threadIdx.x == 0) (void)xb_add(&bar[XB_XCNT(b.x)], 1u);
    return b;
}
__device__ __forceinline__ void xcd_barrier_complete(unsigned* bar, unsigned x, unsigned& nloc, unsigned& nx) {
    const unsigned G = gridDim.x * gridDim.y * gridDim.z;
    unsigned sum, cnt, mine, sp = 0u;
    for (;;) {
        sum = 0u; cnt = 0u; mine = 0u;
#pragma unroll
        for (unsigned j = 0; j < 16; ++j) { const unsigned c = xb_ld(&bar[XB_XCNT(j)]); sum += c; cnt += (c > 0u) ? 1u : 0u; mine = (j == x) ? c : mine; }
        if (sum == G) break;
        __builtin_amdgcn_s_sleep(1);
        if ((++sp & 255u) == 0u) { if (xb_ld(&bar[XB_TMO])) break; if (sp > XB_SPIN_CAP) { atomicAdd(&bar[XB_TMO], 1u); break; } }
    }
    nloc = mine > 0u ? mine : 1u; nx = cnt > 0u ? cnt : 1u;
}

__device__ __forceinline__ void xcd_barrier(const XcdBarrier& b) {
    asm volatile("s_waitcnt vmcnt(0)" ::: "memory");
    __syncthreads();
    if (threadIdx.x == 0) {
        unsigned* bar = b.bar;
        __builtin_amdgcn_s_waitcnt(0);
        unsigned nloc = b.st[0], nx = b.st[1];
        if (nloc == 0u) { xcd_barrier_complete(bar, b.x, nloc, nx); b.st[0] = nloc; b.st[1] = nx; }
        const unsigned old = xb_add(&bar[XB_XSUB(b.x)], 1u);
        const unsigned gen = old / nloc;
        if (old + 1u == (gen + 1u) * nloc) {
            __builtin_amdgcn_fence(__ATOMIC_RELEASE, "agent");
            asm volatile("s_waitcnt vmcnt(0)" ::: "memory");
            const unsigned og = xb_add(&bar[XB_TOP], 1u);
            const unsigned tg = og / nx;
            if (og + 1u == (tg + 1u) * nx) xb_add(&bar[XB_TOPGEN], 1u);
            else XB_SPIN(xb_ld(&bar[XB_TOPGEN]) == tg, bar);
            __builtin_amdgcn_fence(__ATOMIC_ACQUIRE, "agent");
            xb_add(&bar[XB_XGEN(b.x)], 1u);
            asm volatile("s_waitcnt vmcnt(0)" ::: "memory");
        } else {
            XB_SPIN(xb_ld(&bar[XB_XGEN(b.x)]) == gen, bar);
            __builtin_amdgcn_fence(__ATOMIC_ACQUIRE, "agent");
            asm volatile("s_waitcnt vmcnt(0)" ::: "memory");
        }
    }
    __syncthreads();
}
namespace mk {
typedef float f32x2 __attribute__((ext_vector_type(2)));
typedef unsigned u32x2 __attribute__((ext_vector_type(2)));
constexpr int NWAVES = 8;
constexpr int D = 2048, FF = 5632, DCV = 1024, DSS = 1024, DIN = 4096, NL = 4;
constexpr int SEQ = 16384, NMETA = 16, TP = SEQ + NMETA, NBP = 2, NBS = 8, TS = 32;
constexpr int MPROMPT = NBP * TP;
constexpr int MREAL = MPROMPT + NBS * TS;
constexpr int MPAD = 33280;
constexpr int NCHUNK = MPAD / 16;
constexpr int NCH_REAL = MREAL / 16;
constexpr int CH_PER_SEQ = TP / 16;
constexpr int NCT = NCHUNK / 16;
constexpr int SG = 64, SP = 64, SH = 16;
constexpr float EPS = 1e-6f;
constexpr int FP8_FROM_HL = 3;
constexpr int FP8_UP_FROM = 2 * NL;
constexpr int UPQ_FROM = 0;
constexpr float QALPHA_UNUSED = 5.5f;
constexpr float H8_SCALE = 4.0f, WD8_SCALE = 256.0f, WGU8_SCALE = 256.0f;
static_assert(MPAD % 256 == 0 && MPAD >= MREAL && MREAL % 16 == 0 && TP % 16 == 0 && TS % 4 == 0 && TP >= 8 && TS >= 8, "row geometry");

enum { I_XP = 0, I_XS, I_CACHE, I_SRE, I_SIM, I_META, I_F1N, I_F1G, I_F1U, I_F1D, I_MIXN, I_WIN, I_CONVW, I_CONVN, I_LRE, I_LIM, I_LDT, I_BRE, I_BIM, I_CRE, I_CIM, I_SD,
       I_GLU, I_SSMN, I_WOUT, I_F2N, I_F2G, I_F2U, I_F2D, I_FINN, N_IN };
constexpr size_t O_YP = 0, O_YS = O_YP + (size_t)NBP * SEQ * D, O_CVP = O_YS + (size_t)NBS * TS * D, O_REP = O_CVP + (size_t)NL * NBP * 2 * DCV,
                 O_IMP = O_REP + (size_t)NL * NBP * SG * SP, O_CVS = O_IMP + (size_t)NL * NBP * SG * SP, O_RES = O_CVS + (size_t)NL * NBS * 2 * DCV,
                 O_IMS = O_RES + (size_t)NL * NBS * SG * SP, O_END = O_IMS + (size_t)NL * NBS * SG * SP;
static_assert(O_END == 68042752, "output size");

constexpr size_t CTL_BYTES = 1u << 20;
constexpr int NRSS = 4 * NL + 1;
constexpr size_t ZERO_BYTES = CTL_BYTES;
constexpr size_t RSS_STRIDE = (size_t)MPAD * 8 + 2048;
constexpr size_t WS_RSS = CTL_BYTES;
constexpr size_t WS_XN = WS_RSS + (size_t)NRSS * RSS_STRIDE * 4;
constexpr size_t WS_W = WS_XN + (size_t)MPAD * D * 2;
constexpr size_t W_GU0 = 0;
constexpr size_t W_GU1 = W_GU0 + (size_t)2 * FF * D * 2;
constexpr size_t W_D0 = W_GU1 + (size_t)2 * FF * D * 2;
constexpr size_t W_D1 = W_D0 + (size_t)D * FF * 2;
constexpr size_t W_IN = W_D1 + (size_t)D * FF * 2;
constexpr size_t W_GLU = W_IN + (size_t)DIN * D * 2;
constexpr size_t W_OUT = W_GLU + (size_t)DSS * DSS * 2;
constexpr size_t W_SET = W_OUT + (size_t)D * D * 2;
constexpr size_t WS_WBT = WS_W + 2 * W_SET;
constexpr size_t WS_BMT = WS_WBT + (size_t)SG * 256 * 384 * 2;
constexpr size_t WS_APOW = WS_BMT + (size_t)SG * 256 * 256 * 2;
constexpr int NPOW = 18;
constexpr size_t WS_BBAR = WS_APOW + (size_t)NL * NPOW * SG * SP * 8;
constexpr size_t WS_R = WS_BBAR + (size_t)NL * SG * SP * SH * 8;
constexpr size_t WS_H = WS_R;
constexpr size_t WS_PROJ = WS_R;
constexpr size_t WS_MIXED = WS_PROJ + (size_t)MPAD * DIN * 2;
constexpr size_t WS_YS = WS_MIXED + (size_t)MPAD * D * 2;
constexpr size_t WS_SLOC = WS_YS + (size_t)MPAD * DSS * 2;
constexpr int CPG = 2304, UGLD = 384;
constexpr size_t WS_UG = WS_SLOC + (size_t)NCHUNK * SG * 128 * 4;
constexpr size_t WS_XB8 = WS_UG + (size_t)SG * CPG * UGLD * 2;
constexpr size_t WS_DUMMY_ = 0;
constexpr size_t WS_END_A = WS_H + (size_t)MPAD * FF * 2, WS_CS = WS_XB8 + (size_t)MPAD * D;
constexpr size_t WS_QF = WS_CS + (size_t)2 * 4 * FF * 4;
constexpr size_t WS_END_B = WS_QF + (size_t)MPAD * 4 + 1024;
constexpr size_t WS_END = WS_END_A > WS_END_B ? WS_END_A : WS_END_B;
static_assert(WS_R % 256 == 0 && WS_SLOC % 256 == 0, "alignment");
constexpr int CW_BAR = 4096;

constexpr int RING_OFF = 0, RING_BYTES = 131072;
constexpr int LDSCTL_OFF = RING_BYTES, MISC_OFF = LDSCTL_OFF + 320;
constexpr int RED_OFF = RING_BYTES + 512, RSSB_OFF = RED_OFF + 4096;
constexpr int LDS_BYTES = 147456;
static_assert(RSSB_OFF + 8192 <= LDS_BYTES && RSSB_OFF % 16 == 0, "LDS map");

__device__ __forceinline__ float wave_sum(float v) {
#pragma unroll
    for (int o = 1; o < 64; o <<= 1) v += __shfl_xor(v, o);
    return v;
}
__device__ __forceinline__ unsigned pkbf(float lo, float hi) { return pg8::cvt_pk_bf16(lo, hi); }
__device__ __forceinline__ float bflo(unsigned w) { return __uint_as_float(w << 16); }
__device__ __forceinline__ float bfhi(unsigned w) { return __uint_as_float(w & 0xffff0000u); }

__device__ __forceinline__ void transpose_item(const float* W, int K, int N, bf16* WT, int mode, const float* gain, LAS float* scr, int item, int lane, float f8scale = 0.f, int gk0 = 0, const float* cs8 = nullptr) {
    const int nblk = N / 32, kb = item / nblk, nb = item % nblk, k0 = 64 * kb, n0 = 32 * nb;
    const int drow0 = (mode == 0) ? n0 : (256 * (n0 >> 7) + 128 * (mode - 1) + (n0 & 127));
    const int nq = lane & 7, kr = lane >> 3;
    f32x4 v[8]; float csv[4] = {1.f, 1.f, 1.f, 1.f};
    if (cs8) {
#pragma unroll
        for (int j = 0; j < 4; ++j) csv[j] = cs8[n0 + (lane >> 3) + 8 * j]; }
#pragma unroll
    for (int i = 0; i < 8; ++i) v[i] = *(const f32x4*)(W + (size_t)(k0 + kr + 8 * i) * N + n0 + 4 * nq);
#pragma unroll
    for (int i = 0; i < 8; ++i) { const int kk_ = k0 + kr + 8 * i; const float gk = (gain && kk_ >= gk0) ? gain[kk_ - gk0] : 1.0f; LAS float* d = scr + (kr + 8 * i) * 33 + 4 * nq; d[0] = v[i].x * gk; d[1] = v[i].y * gk; d[2] = v[i].z * gk; d[3] = v[i].w * gk; }
    LDS_WAIT(); asm volatile("" ::: "memory");
    const int c = lane & 7;
#pragma unroll
    for (int j = 0; j < 4; ++j) { const int n = (lane >> 3) + 8 * j; const LAS float* s = scr + (8 * c) * 33 + n;
        if (cs8) {
            const float qs = 1.0f / csv[j]; unsigned b[8];
#pragma unroll
            for (int e = 0; e < 8; ++e) { float t = s[e * 33] * qs; t = fminf(fmaxf(t, -127.f), 127.f); b[e] = (unsigned)__float2int_rn(t) & 0xffu; }
            u32x2 o; o.x = b[0] | (b[1] << 8) | (b[2] << 16) | (b[3] << 24); o.y = b[4] | (b[5] << 8) | (b[6] << 16) | (b[7] << 24);
            *(u32x2*)((unsigned char*)WT + (size_t)(drow0 + n) * K + k0 + 8 * c) = o;
        } else if (f8scale != 0.f) {
            int w0 = __builtin_amdgcn_cvt_pk_fp8_f32(s[0 * 33] * f8scale, s[1 * 33] * f8scale, 0, false); w0 = __builtin_amdgcn_cvt_pk_fp8_f32(s[2 * 33] * f8scale, s[3 * 33] * f8scale, w0, true);
            int w1 = __builtin_amdgcn_cvt_pk_fp8_f32(s[4 * 33] * f8scale, s[5 * 33] * f8scale, 0, false); w1 = __builtin_amdgcn_cvt_pk_fp8_f32(s[6 * 33] * f8scale, s[7 * 33] * f8scale, w1, true);
            u32x2 o; o.x = (unsigned)w0; o.y = (unsigned)w1; *(u32x2*)((unsigned char*)WT + (size_t)(drow0 + n) * K + k0 + 8 * c) = o;
        } else {
        v4u o; o.x = pkbf(s[0 * 33], s[1 * 33]); o.y = pkbf(s[2 * 33], s[3 * 33]); o.z = pkbf(s[4 * 33], s[5 * 33]); o.w = pkbf(s[6 * 33], s[7 * 33]);
        *(v4u*)(WT + (size_t)(drow0 + n) * K + k0 + 8 * c) = o; } }
    LDS_WAIT(); asm volatile("" ::: "memory");
}

__device__ __forceinline__ void pmaxc_item(const float* W, int N, const float* gain, float* pmc, int item, int lane) {
    const int nblk = N / 32, kb = item / nblk, nb = item % nblk, k0 = 64 * kb, n0 = 32 * nb; const int nq = lane & 7, kr = lane >> 3;
    f32x4 v[8];
#pragma unroll
    for (int i = 0; i < 8; ++i) v[i] = *(const f32x4*)(W + (size_t)(k0 + kr + 8 * i) * N + n0 + 4 * nq);
    f32x4 m = {0.f, 0.f, 0.f, 0.f};
#pragma unroll
    for (int i = 0; i < 8; ++i) { const float gk = fabsf(gain[k0 + kr + 8 * i]); m.x = fmaxf(m.x, fabsf(v[i].x) * gk); m.y = fmaxf(m.y, fabsf(v[i].y) * gk); m.z = fmaxf(m.z, fabsf(v[i].z) * gk); m.w = fmaxf(m.w, fabsf(v[i].w) * gk); }
#pragma unroll
    for (int o = 8; o < 64; o <<= 1) { m.x = fmaxf(m.x, __shfl_xor(m.x, o)); m.y = fmaxf(m.y, __shfl_xor(m.y, o)); m.z = fmaxf(m.z, __shfl_xor(m.z, o)); m.w = fmaxf(m.w, __shfl_xor(m.w, o)); }
    if (lane < 8) *(f32x4*)(pmc + (size_t)kb * N + n0 + 4 * nq) = m;
}
__device__ __forceinline__ void colstep_reduce(const float* pmc, float* cs, int c) {
    const int q = c / FF, n = c - q * FF; const float* p = pmc + (size_t)q * 32 * FF + n; float m = 1e-30f;
#pragma unroll 8
    for (int kb = 0; kb < 32; ++kb) m = fmaxf(m, p[(size_t)kb * FF]);
    cs[c] = m * (1.0f / 127.0f);
}
__device__ __forceinline__ void gu_task(const float* W, const float* gain, unsigned char* WT, int mode, float* cs, LAS float* scr, LAS float* xch, int nb, int wave, int lane) {
    const int n0 = 32 * nb, nq = lane & 7, kr = lane >> 3, kw = 256 * wave;
    const int drow0 = 256 * (n0 >> 7) + 128 * (mode - 1) + (n0 & 127);
    f32x4 v[32];
    const unsigned loff = (unsigned)(kr * FF + 4 * nq) * 4u;
#pragma unroll
    for (int i = 0; i < 32; ++i) v[i] = *(const f32x4*)((const char*)(W + (size_t)(kw + 8 * i) * FF + n0) + loff);
    LAS float* gl = scr + 2304;
    *(LAS f32x4*)(gl + 4 * lane) = *(const f32x4*)(gain + kw + 4 * lane);
    LDS_WAIT(); asm volatile("" ::: "memory");
    f32x4 m = {0.f, 0.f, 0.f, 0.f};
#pragma unroll
    for (int i = 0; i < 32; ++i) { const float gk = gl[kr + 8 * i]; v[i] = v[i] * gk; m.x = fmaxf(m.x, fabsf(v[i].x)); m.y = fmaxf(m.y, fabsf(v[i].y)); m.z = fmaxf(m.z, fabsf(v[i].z)); m.w = fmaxf(m.w, fabsf(v[i].w)); }
#pragma unroll
    for (int o = 8; o < 64; o <<= 1) { m.x = fmaxf(m.x, __shfl_xor(m.x, o)); m.y = fmaxf(m.y, __shfl_xor(m.y, o)); m.z = fmaxf(m.z, __shfl_xor(m.z, o)); m.w = fmaxf(m.w, __shfl_xor(m.w, o)); }
    if (lane < 8) *(LAS f32x4*)(xch + wave * 32 + 4 * nq) = m;
    __syncthreads();
    float qs[4];
#pragma unroll
    for (int j = 0; j < 4; ++j) { float cm = 1e-30f;
#pragma unroll
        for (int w = 0; w < 8; ++w) cm = fmaxf(cm, xch[w * 32 + (lane >> 3) + 8 * j]);
        qs[j] = 127.0f / cm; if (wave == 0 && (lane & 7) == 0) cs[n0 + (lane >> 3) + 8 * j] = cm * (1.0f / 127.0f); }
    const int c = lane & 7;
#pragma unroll
    for (int t = 0; t < 4; ++t) {
#pragma unroll
        for (int i = 0; i < 8; ++i) { LAS float* d = scr + (kr + 8 * i) * 33 + 4 * nq; d[0] = v[8 * t + i].x; d[1] = v[8 * t + i].y; d[2] = v[8 * t + i].z; d[3] = v[8 * t + i].w; }
        LDS_WAIT(); asm volatile("" ::: "memory");
#pragma unroll
        for (int j = 0; j < 4; ++j) { const int n = (lane >> 3) + 8 * j; const LAS float* s = scr + (8 * c) * 33 + n; unsigned b[8];
#pragma unroll
            for (int e = 0; e < 8; ++e) { float x = s[e * 33] * qs[j]; x = fminf(fmaxf(x, -127.f), 127.f); b[e] = (unsigned)__float2int_rn(x) & 0xffu; }
            u32x2 o; o.x = b[0] | (b[1] << 8) | (b[2] << 16) | (b[3] << 24); o.y = b[4] | (b[5] << 8) | (b[6] << 16) | (b[7] << 24);
            *(u32x2*)(WT + (size_t)(drow0 + n) * D + kw + 64 * t + 8 * c) = o; }
        LDS_WAIT(); asm volatile("" ::: "memory");
    }
    __syncthreads();
}
static_assert((D / 64) * (FF / 32) == 5632, "gate/up item count");
__device__ __forceinline__ void quant_rows2(const bf16* x0, const bf16* x1, const float* rss0, const float* rss1, unsigned char* q0, unsigned char* q1, float* qf0, float* qf1, bool has1, int lane) {
    v4u a[2][4];
#pragma unroll
    for (int c = 0; c < 2; ++c) { const v4u* p0 = (const v4u*)(x0 + c * 1024 + 16 * lane); a[0][2 * c] = p0[0]; a[0][2 * c + 1] = p0[1]; const v4u* p1 = (const v4u*)(x1 + c * 1024 + 16 * lane); a[1][2 * c] = p1[0]; a[1][2 * c + 1] = p1[1]; }
    const float s0 = wave_sum(lane < 8 ? rss0[lane] : 0.f), s1 = wave_sum(lane < 8 ? rss1[lane] : 0.f);
    unsigned mx[2] = {0u, 0u};
#pragma unroll
    for (int w = 0; w < 2; ++w)
#pragma unroll
        for (int i = 0; i < 4; ++i)
#pragma unroll
            for (int d = 0; d < 4; ++d) { const unsigned u = a[w][i][d]; mx[w] = max(mx[w], max(u & 0x7fffu, (u >> 16) & 0x7fffu)); }
#pragma unroll
    for (int o = 1; o < 64; o <<= 1) { mx[0] = max(mx[0], (unsigned)__shfl_xor((int)mx[0], o)); mx[1] = max(mx[1], (unsigned)__shfl_xor((int)mx[1], o)); }
    const float am[2] = {fmaxf(__uint_as_float(mx[0] << 16), 1e-30f), fmaxf(__uint_as_float(mx[1] << 16), 1e-30f)};
    const float r[2] = {127.0f / am[0], 127.0f / am[1]};
    if (lane == 0) { qf0[0] = am[0] * (1.0f / 127.0f) * __builtin_amdgcn_rsqf(s0 * (1.0f / D) + EPS); if (has1) qf1[0] = am[1] * (1.0f / 127.0f) * __builtin_amdgcn_rsqf(s1 * (1.0f / D) + EPS); }
#pragma unroll
    for (int w = 0; w < 2; ++w) { if (w == 1 && !has1) break; unsigned char* q = w ? q1 : q0;
#pragma unroll
        for (int c = 0; c < 2; ++c) { v4u o;
#pragma unroll
            for (int d = 0; d < 4; ++d) {
                const unsigned w0 = a[w][2 * c + (d >> 1)][(2 * d) & 3], w1 = a[w][2 * c + (d >> 1)][(2 * d + 1) & 3];
                float t0 = bflo(w0) * r[w], t1 = bfhi(w0) * r[w], t2 = bflo(w1) * r[w], t3 = bfhi(w1) * r[w];
                t0 = fminf(fmaxf(t0, -127.f), 127.f); t1 = fminf(fmaxf(t1, -127.f), 127.f); t2 = fminf(fmaxf(t2, -127.f), 127.f); t3 = fminf(fmaxf(t3, -127.f), 127.f);
                o[d] = ((unsigned)__float2int_rn(t0) & 0xffu) | (((unsigned)__float2int_rn(t1) & 0xffu) << 8) | (((unsigned)__float2int_rn(t2) & 0xffu) << 16) | (((unsigned)__float2int_rn(t3) & 0xffu) << 24); }
            *(v4u*)(q + c * 1024 + 16 * lane) = o; } }
}
__device__ __forceinline__ void build_rows2(const float* src0, const float* src1, bf16* xb0, bf16* xb1, float* rss0, float* rss1, bool has1, int lane, unsigned char* xq0, unsigned char* xq1, float* qf0, float* qf1) {
    f32x4 v0[8], v1[8]; float s0 = 0.f, s1 = 0.f;
#pragma unroll
    for (int j = 0; j < 8; ++j) { v0[j] = src0 ? ((const f32x4*)src0 + lane)[64 * j] : (f32x4){0.f, 0.f, 0.f, 0.f}; v1[j] = src1 ? ((const f32x4*)src1 + lane)[64 * j] : (f32x4){0.f, 0.f, 0.f, 0.f}; }
#pragma unroll
    for (int j = 0; j < 8; ++j) { s0 += (v0[j].x * v0[j].x + v0[j].y * v0[j].y) + (v0[j].z * v0[j].z + v0[j].w * v0[j].w); s1 += (v1[j].x * v1[j].x + v1[j].y * v1[j].y) + (v1[j].z * v1[j].z + v1[j].w * v1[j].w); }
    u32x2* o0 = (u32x2*)xb0 + lane; u32x2* o1 = (u32x2*)xb1 + lane;
#pragma unroll
    for (int j = 0; j < 8; ++j) { u32x2 w; w.x = pkbf(v0[j].x, v0[j].y); w.y = pkbf(v0[j].z, v0[j].w); o0[64 * j] = w; if (has1) { u32x2 w1; w1.x = pkbf(v1[j].x, v1[j].y); w1.y = pkbf(v1[j].z, v1[j].w); o1[64 * j] = w1; } }
    s0 = wave_sum(s0); s1 = wave_sum(s1);
    if (lane < 8) { rss0[lane] = (lane == 0) ? s0 : 0.f; if (has1) rss1[lane] = (lane == 0) ? s1 : 0.f; }
    float a0 = 0.f, a1 = 0.f;
#pragma unroll
    for (int j = 0; j < 8; ++j) { a0 = fmaxf(a0, fmaxf(fmaxf(fabsf(v0[j].x), fabsf(v0[j].y)), fmaxf(fabsf(v0[j].z), fabsf(v0[j].w)))); a1 = fmaxf(a1, fmaxf(fmaxf(fabsf(v1[j].x), fabsf(v1[j].y)), fmaxf(fabsf(v1[j].z), fabsf(v1[j].w)))); }
#pragma unroll
    for (int o = 1; o < 64; o <<= 1) { a0 = fmaxf(a0, __shfl_xor(a0, o)); a1 = fmaxf(a1, __shfl_xor(a1, o)); }
    a0 = fmaxf(a0, 1e-30f); a1 = fmaxf(a1, 1e-30f);
    const float q0 = 127.0f / a0, q1 = 127.0f / a1;
    if (lane == 0) { qf0[0] = a0 * (1.0f / 127.0f) * __builtin_amdgcn_rsqf(s0 * (1.0f / D) + EPS); if (has1) qf1[0] = a1 * (1.0f / 127.0f) * __builtin_amdgcn_rsqf(s1 * (1.0f / D) + EPS); }
#pragma unroll
    for (int j = 0; j < 8; ++j) {
        ((unsigned*)xq0)[lane + 64 * j] = ((unsigned)__float2int_rn(v0[j].x * q0) & 0xffu) | (((unsigned)__float2int_rn(v0[j].y * q0) & 0xffu) << 8) | (((unsigned)__float2int_rn(v0[j].z * q0) & 0xffu) << 16) | (((unsigned)__float2int_rn(v0[j].w * q0) & 0xffu) << 24);
        if (has1) ((unsigned*)xq1)[lane + 64 * j] = ((unsigned)__float2int_rn(v1[j].x * q1) & 0xffu) | (((unsigned)__float2int_rn(v1[j].y * q1) & 0xffu) << 8) | (((unsigned)__float2int_rn(v1[j].z * q1) & 0xffu) << 16) | (((unsigned)__float2int_rn(v1[j].w * q1) & 0xffu) << 24); }
}
__device__ __forceinline__ void final_rows2(const bf16* src0, const bf16* src1, const float* gain, float* dst0, float* dst1, const float* rss0, const float* rss1, int lane) {
    u32x2 w0[8], w1[8];
#pragma unroll
    for (int j = 0; j < 8; ++j) { w0[j] = ((const u32x2*)src0 + lane)[64 * j]; w1[j] = dst1 ? ((const u32x2*)src1 + lane)[64 * j] : (u32x2){0u, 0u}; }
    const float q0 = lane < 8 ? rss0[lane] : 0.f, q1 = (dst1 && lane < 8) ? rss1[lane] : 0.f;
    const float r0 = 1.0f / sqrtf(wave_sum(q0) * (1.0f / D) + EPS), r1 = 1.0f / sqrtf(wave_sum(q1) * (1.0f / D) + EPS);
    const f32x4* gr = (const f32x4*)gain + lane; f32x4* o0 = (f32x4*)dst0 + lane; f32x4* o1 = (f32x4*)dst1 + lane;
#pragma unroll
    for (int j = 0; j < 8; ++j) { const f32x4 g = gr[64 * j]; o0[64 * j] = (f32x4){bflo(w0[j].x) * r0 * g.x, bfhi(w0[j].x) * r0 * g.y, bflo(w0[j].y) * r0 * g.z, bfhi(w0[j].y) * r0 * g.w};
        if (dst1) o1[64 * j] = (f32x4){bflo(w1[j].x) * r1 * g.x, bfhi(w1[j].x) * r1 * g.y, bflo(w1[j].y) * r1 * g.z, bfhi(w1[j].y) * r1 * g.w}; }
}
__device__ __forceinline__ const float* input_row(int r, const float* xp, const float* xs, const float* meta) {
    if (r < MPROMPT) { const int b = r / TP, pos = r - b * TP; return pos < NMETA ? meta + (size_t)pos * D : xp + ((size_t)b * SEQ + (pos - NMETA)) * D; }
    if (r < MREAL) return xs + (size_t)(r - MPROMPT) * D;
    return nullptr;
}

__device__ __forceinline__ void ssm_tables(int t, const float* lre_, const float* lim_, const float* ldt, const float* bre, const float* bim, f32x2* apow, f32x2* bbar) {
    const int l = t / (SG * SP), gp = t % (SG * SP), g = gp / SP;
    const double dtd = exp((double)ldt[l * SG + g]);
    const float lre = lre_[t], lim = lim_[t];
    const double xr = (double)lre * dtd, th = (double)lim * dtd;
    float c1 = 1.f, s1 = 0.f;
    for (int k = 0; k < NPOW; ++k) {
        const double kk = (k <= 16) ? (double)k : 16.0 * 65.0;
        const double ang = th * kk; const double n = rint(ang * 0.15915494309189535); const float r = (float)(ang - n * 6.283185307179586);
        const float mag = expf((float)(xr * kk)); const float cs = cosf(r), sn = sinf(r);
        apow[((size_t)(l * NPOW + k)) * (SG * SP) + gp] = (f32x2){mag * cs, mag * sn};
        if (k == 1) { c1 = cs; s1 = sn; }
    }
    const float em1 = expm1f((float)xr);
    const float hv = 0.5f * (1.0f - c1);
    const float are = em1 * c1 - 2.0f * hv, aim = (1.0f + em1) * s1;
    const float den = 1.0f / (lre * lre + lim * lim);
    const float qre = (are * lre + aim * lim) * den, qim = (aim * lre - are * lim) * den;
    const float* br = bre + (size_t)t * SH; const float* bi = bim + (size_t)t * SH; f32x2* bo = bbar + (size_t)t * SH;
#pragma unroll 4
    for (int h = 0; h < SH; ++h) { const float x = br[h], y = bi[h]; bo[h] = (f32x2){qre * x - qim * y, qre * y + qim * x}; }
}
__device__ __forceinline__ void ssm_matrices(int l, size_t t0, size_t tstride, const f32x2* apow, const f32x2* bbar, const float* cre, const float* cim, const float* dsk, bf16* WBT, bf16* BMT) {
    const f32x2* ap = apow + (size_t)l * NPOW * SG * SP; const f32x2* bb = bbar + (size_t)l * SG * SP * SH;
    const float* cr = cre + (size_t)l * SG * SH * SP; const float* ci = cim + (size_t)l * SG * SH * SP; const float* dd = dsk + (size_t)l * SG * SH;
    constexpr size_t NA = (size_t)SG * 16 * 256, NB = (size_t)SG * 256 * SP, NC = (size_t)SG * SP * 256;
    for (size_t t = t0; t < NA + NB + NC; t += tstride) {
        if (t < NA) {
            const int g = (int)(t / 4096), k = (int)(t / 256) % 16, h = (int)(t / 16) % 16, hp = (int)t % 16;
            float s = 0.f;
            for (int p = 0; p < SP; ++p) { const f32x2 a = ap[((size_t)k * SG + g) * SP + p], b = bb[((size_t)g * SP + p) * SH + hp]; const float x = cr[((size_t)g * SH + h) * SP + p], y = ci[((size_t)g * SH + h) * SP + p];
                const float abr = a.x * b.x - a.y * b.y, abi = a.x * b.y + a.y * b.x; s += x * abr - y * abi; }
            if (k == 0 && h == hp) s += dd[g * SH + h];
            const unsigned short sv = (unsigned short)(pkbf(s, 0.f) & 0xffffu);
            for (int m = 0; m + k < 16; ++m) { WBT[((size_t)g * 256 + (size_t)(k + m) * 16 + h) * 384 + m * 16 + hp] = sv;
                if (k > 0) WBT[((size_t)g * 256 + (size_t)m * 16 + h) * 384 + (k + m) * 16 + hp] = 0; }
        } else if (t < NA + NB) {
            const size_t u = t - NA; const int g = (int)(u / 16384), i = (int)(u / 1024) % 16, h = (int)(u / 64) % 16, p = (int)u % 64;
            const f32x2 a = ap[((size_t)(i + 1) * SG + g) * SP + p]; const float x = cr[((size_t)g * SH + h) * SP + p], y = ci[((size_t)g * SH + h) * SP + p];
            const size_t o = ((size_t)g * 256 + i * 16 + h) * 384 + 256 + p;
            WBT[o] = (unsigned short)(pkbf(x * a.x - y * a.y, 0.f) & 0xffffu); WBT[o + 64] = (unsigned short)(pkbf(-(x * a.y + y * a.x), 0.f) & 0xffffu);
        } else {
            const size_t u = t - NA - NB; const int g = (int)(u / 16384), p = (int)(u / 256) % 64, j = (int)(u / 16) % 16, hp = (int)u % 16;
            const f32x2 a = ap[((size_t)(15 - j) * SG + g) * SP + p], b = bb[((size_t)g * SP + p) * SH + hp];
            const size_t o = ((size_t)g * 256 + p) * 256 + j * 16 + hp;
            BMT[o] = (unsigned short)(pkbf(a.x * b.x - a.y * b.y, 0.f) & 0xffffu); BMT[o + (size_t)64 * 256] = (unsigned short)(pkbf(a.x * b.y + a.y * b.x, 0.f) & 0xffffu);
        }
    }
}

__device__ __forceinline__ float gelu_tanh(float x) { const float z = 0.7978845608028654f * (x + 0.044715f * x * x * x); return x * __builtin_amdgcn_rcpf(1.0f + __expf(-2.0f * z)); }

__device__ __forceinline__ void conv_rows4(int r0, int l, const bf16* PROJ, bf16* MIXED, const float* cache, const float* convw, const float* cgain, float* out, int lane) {
    if (r0 >= MREAL) {
#pragma unroll
        for (int q = 0; q < 4; ++q) { v4u* mo = (v4u*)(MIXED + (size_t)(r0 + q) * D); mo[lane] = (v4u){0u, 0u, 0u, 0u}; mo[64 + lane] = (v4u){0u, 0u, 0u, 0u}; }
        return; }
    int pos0, T; const float* cb = nullptr; float* ob;
    if (r0 < MPROMPT) { const int b = r0 / TP; pos0 = r0 - b * TP; T = TP; ob = out + O_CVP + (size_t)(l * NBP + b) * 2 * DCV; }
    else { const int s = (r0 - MPROMPT) / TS; pos0 = (r0 - MPROMPT) - s * TS; T = TS; cb = cache + (size_t)(l * NBS + s) * 2 * DCV; ob = out + O_CVS + (size_t)(l * NBS + s) * 2 * DCV; }
    float ss[4] = {0.f, 0.f, 0.f, 0.f}; float y[4][16];
#pragma unroll
    for (int hf = 0; hf < 2; ++hf) {
        const int c0 = hf * 512 + lane * 8;
        const bf16* pr = PROJ + (size_t)r0 * DIN + c0;
        v4u cg[6], hg[6], bg[4];
#pragma unroll
        for (int j = 0; j < 6; ++j) { if (j >= 2 || pos0 >= 2 - j) { cg[j] = *(const v4u*)(pr + (ptrdiff_t)(j - 2) * DIN + DCV); hg[j] = *(const v4u*)(pr + (ptrdiff_t)(j - 2) * DIN + 2 * DCV); } else { cg[j] = (v4u){0u, 0u, 0u, 0u}; hg[j] = cg[j]; } }
#pragma unroll
        for (int q = 0; q < 4; ++q) bg[q] = *(const v4u*)(pr + (size_t)q * DIN);
        float cbv[2][8];
#pragma unroll
        for (int e = 0; e < 8; ++e) { cbv[0][e] = (cb && pos0 < 2) ? cb[c0 + e] : 0.f; cbv[1][e] = (cb && pos0 < 1) ? cb[DCV + c0 + e] : 0.f; }
        const float* w = convw + (size_t)l * 3 * DCV + c0;
        float w0[8], w1[8], w2[8];
#pragma unroll
        for (int e = 0; e < 8; ++e) { w0[e] = w[e]; w1[e] = w[DCV + e]; w2[e] = w[2 * DCV + e]; }
        float v[6][8];
#pragma unroll
        for (int j = 0; j < 6; ++j)
#pragma unroll
            for (int qq = 0; qq < 4; ++qq) { v[j][2 * qq] = bflo(cg[j][qq]) * bflo(hg[j][qq]); v[j][2 * qq + 1] = bfhi(cg[j][qq]) * bfhi(hg[j][qq]); }
        if (pos0 == 0) {
#pragma unroll
            for (int e = 0; e < 8; ++e) { v[0][e] = cbv[0][e]; v[1][e] = cbv[1][e]; } }
#pragma unroll
        for (int q = 0; q < 4; ++q)
#pragma unroll
            for (int e = 0; e < 8; ++e) { const float bgv = (e & 1) ? bfhi(bg[q][e >> 1]) : bflo(bg[q][e >> 1]);
                const float yy = bgv * (w0[e] * v[q][e] + w1[e] * v[q + 1][e] + w2[e] * v[q + 2][e]); y[q][hf * 8 + e] = yy; ss[q] += yy * yy; }
        if (pos0 + 4 == T) {
#pragma unroll
            for (int e = 0; e < 8; ++e) { ob[c0 + e] = v[4][e]; ob[DCV + c0 + e] = v[5][e]; } }
    }
#pragma unroll
    for (int q = 0; q < 4; ++q) { const float rn = 1.0f / sqrtf(wave_sum(ss[q]) * (1.0f / DCV) + EPS); v4u* mo = (v4u*)(MIXED + (size_t)(r0 + q) * D);
#pragma unroll
        for (int hf = 0; hf < 2; ++hf) { const float* g = cgain + (size_t)l * DCV + hf * 512 + lane * 8; v4u wv;
#pragma unroll
            for (int qq = 0; qq < 4; ++qq) wv[qq] = pkbf(y[q][hf * 8 + 2 * qq] * rn * g[2 * qq], y[q][hf * 8 + 2 * qq + 1] * rn * g[2 * qq + 1]);
            mo[hf * 64 + lane] = wv; } }
}
__device__ __forceinline__ void norm_s_row(int r, bf16* MIXED, const float* gain, int lane) {
    v4u* p = (v4u*)(MIXED + (size_t)r * D + DCV); const v4u a = p[lane], b = p[64 + lane]; float v[16]; float ss = 0.f;
#pragma unroll
    for (int q = 0; q < 4; ++q) { v[2 * q] = bflo(a[q]); v[2 * q + 1] = bfhi(a[q]); v[8 + 2 * q] = bflo(b[q]); v[8 + 2 * q + 1] = bfhi(b[q]); }
#pragma unroll
    for (int e = 0; e < 16; ++e) ss += v[e] * v[e];
    const float rn = 1.0f / sqrtf(wave_sum(ss) * (1.0f / DSS) + EPS);
    v4u wa, wb; const float* g0 = gain + lane * 8; const float* g1 = gain + 512 + lane * 8;
#pragma unroll
    for (int q = 0; q < 4; ++q) { wa[q] = pkbf(v[2 * q] * rn * g0[2 * q], v[2 * q + 1] * rn * g0[2 * q + 1]); wb[q] = pkbf(v[8 + 2 * q] * rn * g1[2 * q], v[8 + 2 * q + 1] * rn * g1[2 * q + 1]); }
    p[lane] = wa; p[64 + lane] = wb;
}

template <bool WRITE> __device__ __forceinline__ void carry_run(const float* sl, bf16* so, int nc, const f32x2 a, float& sr, float& si) {
    constexpr size_t CS = (size_t)SG * 128, CO = (size_t)UGLD; constexpr int NB = 16;
#define CARRY_LOAD(LR, LI, c0) do { _Pragma("unroll") for (int q = 0; q < NB; ++q) { LR[q] = sl[(size_t)((c0) + q) * CS]; LI[q] = sl[(size_t)((c0) + q) * CS + 64]; } } while (0)
#define CARRY_STEP(LR, LI, c0) do { _Pragma("unroll") for (int q = 0; q < NB; ++q) { \
        if (WRITE) { so[(size_t)((c0) + q) * CO] = (unsigned short)(pkbf(sr, 0.f) & 0xffffu); so[(size_t)((c0) + q) * CO + 64] = (unsigned short)(pkbf(si, 0.f) & 0xffffu); } \
        const float nr = a.x * sr - a.y * si + LR[q], ni = a.x * si + a.y * sr + LI[q]; sr = nr; si = ni; } } while (0)
    float ar[NB], ai[NB], br[NB], bi[NB];
    int c = 0;
    if (nc >= NB) CARRY_LOAD(ar, ai, 0);
    while (c + NB <= nc) {
        if (c + 2 * NB <= nc) CARRY_LOAD(br, bi, c + NB);
        CARRY_STEP(ar, ai, c); c += NB;
        if (c + NB > nc) break;
        if (c + 2 * NB <= nc) CARRY_LOAD(ar, ai, c + NB);
        CARRY_STEP(br, bi, c); c += NB;
    }
#undef CARRY_LOAD
#undef CARRY_STEP
    for (; c < nc; ++c) { const float lr = sl[(size_t)c * CS], li = sl[(size_t)c * CS + 64];
        if (WRITE) { so[(size_t)c * CO] = (unsigned short)(pkbf(sr, 0.f) & 0xffffu); so[(size_t)c * CO + 64] = (unsigned short)(pkbf(si, 0.f) & 0xffffu); }
        const float nr = a.x * sr - a.y * si + lr, ni = a.x * si + a.y * sr + li; sr = nr; si = ni; }
}
constexpr int CSEG = 65, NSEG = 16;
static_assert(NSEG * CSEG >= CH_PER_SEQ && (NSEG - 1) * CSEG < CH_PER_SEQ, "carry segments");
__device__ __forceinline__ void carry_totals2(const float* sa, int na, const float* sb, int nb, const f32x2 a, float& ar, float& ai, float& br, float& bi) {
    constexpr size_t CS = (size_t)SG * 128; constexpr int NB = 8;
    const int nmin = na < nb ? na : nb; int c = 0;
    for (; c + NB <= nmin; c += NB) { float xr[NB], xi[NB], yr[NB], yi[NB];
#pragma unroll
        for (int q = 0; q < NB; ++q) { xr[q] = sa[(size_t)(c + q) * CS]; xi[q] = sa[(size_t)(c + q) * CS + 64]; yr[q] = sb[(size_t)(c + q) * CS]; yi[q] = sb[(size_t)(c + q) * CS + 64]; }
#pragma unroll
        for (int q = 0; q < NB; ++q) { const float n0 = a.x * ar - a.y * ai + xr[q], n1 = a.x * ai + a.y * ar + xi[q]; ar = n0; ai = n1; const float m0 = a.x * br - a.y * bi + yr[q], m1 = a.x * bi + a.y * br + yi[q]; br = m0; bi = m1; } }
    for (int k = c; k < na; ++k) { const float x0 = sa[(size_t)k * CS], x1 = sa[(size_t)k * CS + 64]; const float n0 = a.x * ar - a.y * ai + x0, n1 = a.x * ai + a.y * ar + x1; ar = n0; ai = n1; }
    for (int k = c; k < nb; ++k) { const float y0 = sb[(size_t)k * CS], y1 = sb[(size_t)k * CS + 64]; const float m0 = a.x * br - a.y * bi + y0, m1 = a.x * bi + a.y * br + y1; br = m0; bi = m1; }
}
__device__ __forceinline__ void ssm_carry_prompt(int b, int g, int hb, int l, const f32x2* apow, const float* SLOC, bf16* UG, float* out, LAS float* sh, int wave, int lane) {
    const f32x2 a = apow[((size_t)(l * NPOW + 16) * SG + g) * SP + lane], aseg = apow[((size_t)(l * NPOW + 17) * SG + g) * SP + lane];
    const int seg = 8 * hb + wave, cs = seg * CSEG, len = (CH_PER_SEQ - cs) < CSEG ? (CH_PER_SEQ - cs) : CSEG, c0 = b * CH_PER_SEQ + cs;
    const float* sl = SLOC + ((size_t)c0 * SG + g) * 128 + lane; bf16* so = UG + ((size_t)g * CPG + c0) * UGLD + 256 + lane;
    float tr = 0.f, ti = 0.f, pr = 0.f, pi = 0.f;
    if (hb) { const float* sp = SLOC + ((size_t)(b * CH_PER_SEQ + wave * CSEG) * SG + g) * 128 + lane; carry_totals2(sp, CSEG, sl, len, a, pr, pi, tr, ti);
        sh[(wave * 2) * 64 + lane] = pr; sh[(wave * 2 + 1) * 64 + lane] = pi; }
    else carry_run<false>(sl, so, len, a, tr, ti);
    sh[(seg * 2) * 64 + lane] = tr; sh[(seg * 2 + 1) * 64 + lane] = ti;
    LDS_WAIT(); __syncthreads();
    float sr = 0.f, si = 0.f;
    for (int w = 0; w < seg; ++w) { const float xr = sh[(w * 2) * 64 + lane], xi = sh[(w * 2 + 1) * 64 + lane]; const float nr = aseg.x * sr - aseg.y * si + xr, ni = aseg.x * si + aseg.y * sr + xi; sr = nr; si = ni; }
    carry_run<true>(sl, so, len, a, sr, si);
    if (seg == NSEG - 1) { out[O_REP + ((size_t)(l * NBP + b) * SG + g) * SP + lane] = sr; out[O_IMP + ((size_t)(l * NBP + b) * SG + g) * SP + lane] = si; }
    __syncthreads();
}
__device__ __forceinline__ void ssm_carry_small(int w, int l, const f32x2* apow, const float* SLOC, bf16* UG, const float* sre, const float* sim, float* out, int lane) {
    if (w >= NBS * SG) { const int u = w - NBS * SG; const int c = NCH_REAL + u / SG, g = u % SG; if (c >= NCHUNK) return;
        ((unsigned*)(UG + ((size_t)g * CPG + c) * UGLD + 256))[lane] = 0u; return; }
    const int s = w / SG, g = w % SG, c0 = NBP * CH_PER_SEQ + s * (TS / 16); const size_t o = ((size_t)(l * NBS + s) * SG + g) * SP + lane;
    float sr = sre[o], si = sim[o];
    const f32x2 a = apow[((size_t)(l * NPOW + 16) * SG + g) * SP + lane];
    carry_run<true>(SLOC + ((size_t)c0 * SG + g) * 128 + lane, UG + ((size_t)g * CPG + c0) * UGLD + 256 + lane, TS / 16, a, sr, si);
    out[O_RES + o] = sr; out[O_IMS + o] = si;
}
struct Args { const float* in[N_IN]; float* out; unsigned char* ws; };
static_assert(sizeof(Args) == 8 * (N_IN + 2), "no padding in Args");
typedef const __attribute__((address_space(4))) Args* ArgsP;
#ifdef PROBE_REP
#define PROBE_N(w) ((PROBE_WHICH == (w) || (PROBE_WHICH == 99 && (w) != 6)) ? PROBE_REP : 1)
#define PROBE_SET_REP(S) do { if (PROBE_WHICH == 1 || PROBE_WHICH == 99) (S).rep = PROBE_REP; } while (0)
#define PROBE_SET_REP3(S) do { if (PROBE_WHICH == 3 || PROBE_WHICH == 99) (S).rep = PROBE_REP; } while (0)
#define PROBE_SET_REP_R(S, E) do { if (PROBE_WHICH == 2 || PROBE_WHICH == 99) { (S).rep = PROBE_REP; (E).scale *= 1.0f / PROBE_REP; } } while (0)
#else
#define PROBE_N(w) 1
#define PROBE_SET_REP(S) do {} while (0)
#define PROBE_SET_REP3(S) do {} while (0)
#define PROBE_SET_REP_R(S, E) do {} while (0)
#endif

#define PHASE_BEGIN() \
    int tid = threadIdx.x; asm volatile("" : "+v"(tid)); \
    ArgsP A = (ArgsP)__builtin_amdgcn_kernarg_segment_ptr(); asm volatile("" : "+s"(A)); \
    const int lane = tid & 63, wave = __builtin_amdgcn_readfirstlane(tid >> 6); \
    const int gw = vcu * NWAVES + wave, NGW = G * NWAVES; \
    unsigned char* ws = A->ws; (void)lane; (void)gw; (void)NGW; (void)ws;

__device__ __forceinline__ void convert_layer(int l, ArgsP A, unsigned char* ws, LAS float* scr, int gw, int NGW, int lane) {
    unsigned char* wset = ws + WS_W + (size_t)(l & 1) * W_SET;
    constexpr int I_DN = (FF / 64) * (D / 32), I_IN = (D / 64) * (DIN / 32), I_GL = (DSS / 64) * (DSS / 32), I_OUT = (D / 64) * (D / 32);
    constexpr int NITEMS = 2 * I_DN + I_IN + I_GL + I_OUT;
    for (int it = gw; it < NITEMS; it += NGW) {
        int r = it;
        if (r < 2 * I_DN) { const int q = r / I_DN; r -= q * I_DN;
            transpose_item(A->in[q ? I_F2D : I_F1D] + (size_t)l * FF * D, FF, D, (bf16*)(wset + (q ? W_D1 : W_D0)), 0, nullptr, scr, r, lane, (2 * l + q >= FP8_FROM_HL) ? WD8_SCALE : 0.f); continue; }
        r -= 2 * I_DN;
        if (r < I_IN) { transpose_item(A->in[I_WIN] + (size_t)l * D * DIN, D, DIN, (bf16*)(wset + W_IN), 0, A->in[I_MIXN] + (size_t)l * D, scr, r, lane); continue; }
        r -= I_IN;
        if (r < I_GL) { transpose_item(A->in[I_GLU] + (size_t)l * DSS * DSS, DSS, DSS, (bf16*)(wset + W_GLU), 0, nullptr, scr, r, lane); continue; }
        r -= I_GL;
        transpose_item(A->in[I_WOUT] + (size_t)l * D * D, D, D, (bf16*)(wset + W_OUT), 0, A->in[I_SSMN] + (size_t)l * DSS, scr, r, lane, 0.f, DCV);
    }
}
__device__ __forceinline__ void convert_gu(int l, ArgsP A, unsigned char* ws, LAS float* scr, LAS float* xch, int cu, int ncu, int wave, int lane) {
    unsigned char* wset = ws + WS_W + (size_t)(l & 1) * W_SET;
    for (int it = cu; it < 4 * (FF / 32); it += ncu) { const int q = it / (FF / 32), nb = it - q * (FF / 32);
        gu_task(A->in[q == 0 ? I_F1G : q == 1 ? I_F1U : q == 2 ? I_F2G : I_F2U] + (size_t)l * D * FF, A->in[q < 2 ? I_F1N : I_F2N] + (size_t)l * D, wset + (q < 2 ? W_GU0 : W_GU1), 1 + (q & 1),
                (float*)(ws + WS_CS) + (size_t)((l & 1) * 4 + q) * FF, scr, xch, nb, wave, lane); }
}

__global__ void __launch_bounds__(NWAVES * 64, 2) hymba_fwd(Args args_unused) {
    extern __shared__ __attribute__((aligned(16))) unsigned char lds_raw[];
    LAS unsigned char* lds = (LAS unsigned char*)lds_raw;
    const int G = gridDim.x; const int bx = blockIdx.x; const int vcu = (G % 8 == 0) ? (bx % 8) * (G / 8) + bx / 8 : bx;
    XcdBarrier bar;
    {
        PHASE_BEGIN();
        for (int u = tid; u < (LDS_BYTES - LDSCTL_OFF) / 4; u += NWAVES * 64) ((LAS unsigned*)(lds + LDSCTL_OFF))[u] = 0u;
        __syncthreads();
        bar = xcd_barrier_post((unsigned*)(ws) + CW_BAR, (volatile LAS unsigned*)(lds + MISC_OFF) + 8);
    }
#define GRID_BAR() do { for (int prep_ = 0; prep_ < PROBE_N(6); ++prep_) xcd_barrier(bar); } while (0)
    {
        PHASE_BEGIN();
        for (int prep = 0; prep < PROBE_N(7); ++prep)
        for (int t = bx * (NWAVES * 64) + tid; t < NL * SG * SP; t += G * NWAVES * 64)
            ssm_tables(t, A->in[I_LRE], A->in[I_LIM], A->in[I_LDT], A->in[I_BRE], A->in[I_BIM], (f32x2*)(ws + WS_APOW), (f32x2*)(ws + WS_BBAR));
    }
    {
        PHASE_BEGIN();
        convert_gu(0, A, ws, (LAS float*)(lds + RING_OFF + wave * 16384), (LAS float*)(lds + RING_OFF + 12288), vcu, G, wave, lane);
        convert_layer(0, A, ws, (LAS float*)(lds + RING_OFF + wave * 16384), gw, NGW, lane);
    }
    {
        PHASE_BEGIN();
        v4u* z = (v4u*)(ws + WS_BMT);
        for (int i = bx * (NWAVES * 64) + tid; i < SG * 128 * 256 * 2 / 16; i += G * NWAVES * 64) { const int g = i / (128 * 256 * 2 / 16), o = i % (128 * 256 * 2 / 16); z[(size_t)g * (256 * 256 * 2 / 16) + (128 * 256 * 2 / 16) + o] = (v4u){0u, 0u, 0u, 0u}; }
    }
    {
        PHASE_BEGIN();
        bf16* XB = (bf16*)(ws + WS_XN); float* rss = (float*)(ws + WS_RSS);
        const float* xp = A->in[I_XP]; const float* xs = A->in[I_XS]; const float* meta = A->in[I_META];
        for (int prep = 0; prep < PROBE_N(7); ++prep)
        for (int r = gw; r < MPAD; r += 2 * NGW) { const int r1 = r + NGW; const bool h1 = r1 < MPAD; const int rr = h1 ? r1 : r;
            build_rows2(input_row(r, xp, xs, meta), h1 ? input_row(r1, xp, xs, meta) : nullptr, XB + (size_t)r * D, XB + (size_t)rr * D, rss + (size_t)r * 8, rss + (size_t)rr * 8, h1, lane,
                        ws + WS_XB8 + (size_t)r * D, ws + WS_XB8 + (size_t)rr * D, (float*)(ws + WS_QF) + r, (float*)(ws + WS_QF) + rr); }
    }
    GRID_BAR();
    for (int hl = 0; hl < 2 * NL; ++hl) {
        const int l = hl >> 1, second = hl & 1;
        if (hl >= UPQ_FROM && hl > 0) {
            PHASE_BEGIN();
            const bf16* XB = (const bf16*)(ws + WS_XN); unsigned char* XQ = ws + WS_XB8; const float* rss = (const float*)(ws + WS_RSS) + (size_t)(3 * l + (second ? 2 : 0)) * RSS_STRIDE;
            for (int r = gw; r < MPAD; r += 2 * NGW) { const int r1 = r + NGW; const bool h1 = r1 < MPAD; const int rr = h1 ? r1 : r;
                quant_rows2(XB + (size_t)r * D, XB + (size_t)rr * D, rss + (size_t)r * 8, rss + (size_t)rr * 8, XQ + (size_t)r * D, XQ + (size_t)rr * D, (float*)(ws + WS_QF) + r, (float*)(ws + WS_QF) + rr, h1, lane); }
        }
        if (hl >= UPQ_FROM && hl > 0) GRID_BAR();
        if (hl >= UPQ_FROM) {
            PHASE_BEGIN();
            const float* cs = (const float*)(ws + WS_CS) + (size_t)((l & 1) * 4 + 2 * second) * FF;
            pg8::Gemm g{(const bf16*)(ws + WS_XB8), (const bf16*)(ws + WS_W + (size_t)(l & 1) * W_SET + (second ? W_GU1 : W_GU0)), MPAD, 2 * FF, D / 2, D / 2, D / 2, 0, 0};   pg8::StaticOrder S; S.init(MPAD, 2 * FF, G, bx); PROBE_SET_REP(S);
            pg8::EpiSwigluQ E{(const float*)(ws + WS_QF), (unsigned char*)(ws + WS_H), cs, FF, cs + FF, (hl >= FP8_FROM_HL) ? 1 : 0, (hl >= FP8_FROM_HL) ? H8_SCALE : 1.0f, (const LAS float*)(lds + RSSB_OFF)};
            S.split = 1;
            S.pass = 0; pg8::gemm_phase<pg8::EpiSwigluQ, pg8::StaticOrder, true, true, 2, false>(lds + RING_OFF, g, S, E, tid); S.pass = 1; pg8::gemm_phase<pg8::EpiSwigluQ, pg8::StaticOrder, true, true, 2, true>(lds + RING_OFF, g, S, E, tid);
        } else
#ifdef PROBE_SPLIT
        for (int part = 0; part < 2; ++part)
#endif
        {
            PHASE_BEGIN();
            pg8::Gemm g{(const bf16*)(ws + WS_XN), (const bf16*)(ws + WS_W + (size_t)(l & 1) * W_SET + (second ? W_GU1 : W_GU0)), MPAD, 2 * FF, D, D, D, 0, 0}; pg8::StaticOrder S; S.init(MPAD, 2 * FF, G, bx); PROBE_SET_REP(S);
#ifdef PROBE_SPLIT
            if (part == 0) S.r1 = 11; else S.r0 = 11;
#endif
            pg8::EpiSwiglu E{(unsigned char*)(ws + WS_H), FF, (const float*)(ws + WS_RSS) + (size_t)(3 * l + (second ? 2 : 0)) * RSS_STRIDE, (const LAS float*)(lds + RSSB_OFF), 1.0f / D, EPS, (hl >= FP8_FROM_HL) ? H8_SCALE : 1.0f, 1.0f, (hl >= FP8_FROM_HL) ? 1 : 0};
            S.split = 1;
            S.pass = 0; pg8::gemm_phase<pg8::EpiSwiglu, pg8::StaticOrder, true, true, false, false>(lds + RING_OFF, g, S, E, tid); S.pass = 1; pg8::gemm_phase<pg8::EpiSwiglu, pg8::StaticOrder, true, true, false, true>(lds + RING_OFF, g, S, E, tid);
#ifdef PROBE_SPLIT
            if (part == 0) GRID_BAR();
#endif
        }
        GRID_BAR();
        if (hl >= FP8_FROM_HL) {
            PHASE_BEGIN();
            pg8::Gemm g{(const bf16*)(ws + WS_H), (const bf16*)(ws + WS_W + (size_t)(l & 1) * W_SET + (second ? W_D1 : W_D0)), MPAD, D, FF / 2, FF / 2, FF / 2, 0, 0};   pg8::StaticOrder S; S.init(MPAD, D, G, bx);
            pg8::EpiResidNorm<false> E{(bf16*)(ws + WS_XN), D, 0.5f / (H8_SCALE * WD8_SCALE), (float*)(ws + WS_RSS) + (size_t)(second ? 3 * (l + 1) : 3 * l + 1) * RSS_STRIDE, (second && hl + 1 >= FP8_UP_FROM && hl + 1 < 2 * NL) ? (unsigned char*)(ws + WS_XB8) : nullptr, (LAS float*)(lds + RED_OFF), nullptr, nullptr, 0.f, 0.f};
            PROBE_SET_REP_R(S, E);
            S.split = 1;
            S.pass = 0; pg8::gemm_phase<pg8::EpiResidNorm<false>, pg8::StaticOrder, true, true, true, false>(lds + RING_OFF, g, S, E, tid); S.pass = 1; pg8::gemm_phase<pg8::EpiResidNorm<false>, pg8::StaticOrder, true, true, true, true>(lds + RING_OFF, g, S, E, tid);
        } else {
            PHASE_BEGIN();
            pg8::Gemm g{(const bf16*)(ws + WS_H), (const bf16*)(ws + WS_W + (size_t)(l & 1) * W_SET + (second ? W_D1 : W_D0)), MPAD, D, FF, FF, FF, 0, 0}; pg8::StaticOrder S; S.init(MPAD, D, G, bx);
            pg8::EpiResidNorm<false> E{(bf16*)(ws + WS_XN), D, 0.5f, (float*)(ws + WS_RSS) + (size_t)(second ? 3 * (l + 1) : 3 * l + 1) * RSS_STRIDE, (second && hl + 1 >= FP8_UP_FROM && hl + 1 < 2 * NL) ? (unsigned char*)(ws + WS_XB8) : nullptr, (LAS float*)(lds + RED_OFF), nullptr, nullptr, 0.f, 0.f};
            PROBE_SET_REP_R(S, E);
            S.split = 1;
            S.pass = 0; pg8::gemm_phase<pg8::EpiResidNorm<false>, pg8::StaticOrder, true, true, false, false>(lds + RING_OFF, g, S, E, tid); S.pass = 1; pg8::gemm_phase<pg8::EpiResidNorm<false>, pg8::StaticOrder, true, true, false, true>(lds + RING_OFF, g, S, E, tid);
        }
        if (l + 1 < NL) {
            PHASE_BEGIN();
            constexpr int NTAIL = 2 * (((MPAD / 256) * (D / 256)) % 256);
            if (G > 2 * NTAIL) { if (bx >= NTAIL) { if (!second) convert_layer(l + 1, A, ws, (LAS float*)(lds + RING_OFF + wave * 16384), (bx - NTAIL) * NWAVES + wave, (G - NTAIL) * NWAVES, lane);
                                                     else convert_gu(l + 1, A, ws, (LAS float*)(lds + RING_OFF + wave * 16384), (LAS float*)(lds + RING_OFF + 12288), bx - NTAIL, G - NTAIL, wave, lane); } }
            else { if (!second) convert_layer(l + 1, A, ws, (LAS float*)(lds + RING_OFF + wave * 16384), gw, NGW, lane); else convert_gu(l + 1, A, ws, (LAS float*)(lds + RING_OFF + wave * 16384), (LAS float*)(lds + RING_OFF + 12288), bx, G, wave, lane); }
        }
        GRID_BAR();
        if (second) continue;
        {
            PHASE_BEGIN();
            pg8::Gemm g{(const bf16*)(ws + WS_XN), (const bf16*)(ws + WS_W + (size_t)(l & 1) * W_SET + W_IN), MPAD, DIN, D, D, D, 0, 0}; pg8::StaticOrder S; S.init(MPAD, DIN, G, bx); PROBE_SET_REP(S);
            pg8::EpiStoreBf16 E{(bf16*)(ws + WS_PROJ), DIN, (const float*)(ws + WS_RSS) + (size_t)(3 * l + 1) * RSS_STRIDE, (const LAS float*)(lds + RSSB_OFF), 1.0f / D, EPS, (bf16*)(ws + WS_UG), 3 * DCV, CPG, UGLD};
            S.split = 1;
            S.pass = 0; pg8::gemm_phase<pg8::EpiStoreBf16, pg8::StaticOrder, true, true, false, false>(lds + RING_OFF, g, S, E, tid); S.pass = 1; pg8::gemm_phase<pg8::EpiStoreBf16, pg8::StaticOrder, true, true, false, true>(lds + RING_OFF, g, S, E, tid);
        }
        {
            PHASE_BEGIN();
            for (int prep = 0; prep < PROBE_N(5); ++prep)
            ssm_matrices(l, (size_t)bx * (NWAVES * 64) + tid, (size_t)G * NWAVES * 64, (const f32x2*)(ws + WS_APOW), (const f32x2*)(ws + WS_BBAR), A->in[I_CRE], A->in[I_CIM], A->in[I_SD],
                         (bf16*)(ws + WS_WBT), (bf16*)(ws + WS_BMT));
        }
        GRID_BAR();
        {
            PHASE_BEGIN();
            const bf16* PROJ = (const bf16*)(ws + WS_PROJ);
            for (int prep = 0; prep < PROBE_N(3); ++prep) {
            { bf16* MIXED = (bf16*)(ws + WS_MIXED); const float* cache = A->in[I_CACHE]; const float* convw = A->in[I_CONVW]; const float* cgain = A->in[I_CONVN]; float* out = A->out;
              for (int r = 4 * gw; r < MPAD; r += 4 * NGW) conv_rows4(r, l, PROJ, MIXED, cache, convw, cgain, out, lane); }
            }
        }
        {
            PHASE_BEGIN();
            pg8::Gemm g{(const bf16*)(ws + WS_UG), (const bf16*)(ws + WS_BMT), SG * CPG, 256, 256, UGLD, 256, CPG / 256, (size_t)256 * 256 * 2}; pg8::StaticOrder S; S.init(SG * CPG, 256, G, bx);
            pg8::EpiSloc E{(float*)(ws + WS_SLOC), CPG, NCHUNK, SG};
            PROBE_SET_REP3(S);
            S.split = 1;
            S.pass = 0; pg8::gemm_phase<pg8::EpiSloc, pg8::StaticOrder, true, true, false, false>(lds + RING_OFF, g, S, E, tid); S.pass = 1; pg8::gemm_phase<pg8::EpiSloc, pg8::StaticOrder, true, true, false, true>(lds + RING_OFF, g, S, E, tid);
        }
        GRID_BAR();
        {
            PHASE_BEGIN();
            const f32x2* apow = (const f32x2*)(ws + WS_APOW); const float* SLOC = (const float*)(ws + WS_SLOC); bf16* UG = (bf16*)(ws + WS_UG);
            for (int prep = 0; prep < PROBE_N(3); ++prep) {
            for (int pi = vcu; pi < 2 * NBP * SG; pi += G) ssm_carry_prompt((pi >> 1) / SG, (pi >> 1) % SG, pi & 1, l, apow, SLOC, UG, A->out, (LAS float*)(lds + RING_OFF), wave, lane);
            for (int w = gw; w < NBS * SG + (NCHUNK - NCH_REAL) * SG; w += NGW) ssm_carry_small(w, l, apow, SLOC, UG, A->in[I_SRE], A->in[I_SIM], A->out, lane);
            }
        }
        GRID_BAR();
        {
            PHASE_BEGIN();
            pg8::Gemm g{(const bf16*)(ws + WS_UG), (const bf16*)(ws + WS_WBT), SG * CPG, 256, UGLD, UGLD, UGLD, CPG / 256, (size_t)256 * UGLD * 2}; pg8::StaticOrder S; S.init(SG * CPG, 256, G, bx);
            pg8::EpiYs E{(bf16*)(ws + WS_YS), DSS, CPG, NCHUNK};
            PROBE_SET_REP3(S);
            S.split = 1;
            S.pass = 0; pg8::gemm_phase<pg8::EpiYs, pg8::StaticOrder, true, true, false, false>(lds + RING_OFF, g, S, E, tid); S.pass = 1; pg8::gemm_phase<pg8::EpiYs, pg8::StaticOrder, true, true, false, true>(lds + RING_OFF, g, S, E, tid);
        }
        GRID_BAR();
        {
            PHASE_BEGIN();
            pg8::Gemm g{(const bf16*)(ws + WS_YS), (const bf16*)(ws + WS_W + (size_t)(l & 1) * W_SET + W_GLU), MPAD, DSS, DSS, DSS, DSS, 0, 0}; pg8::StaticOrder S; S.init(MPAD, DSS, G, bx); PROBE_SET_REP(S);
            pg8::EpiGlu E{(const bf16*)(ws + WS_YS), DSS, (bf16*)(ws + WS_MIXED) + DCV, D, (float*)(ws + WS_RSS) + (size_t)(3 * NL + 1 + l) * RSS_STRIDE, (LAS float*)(lds + RED_OFF)};
            S.split = 1;
            S.pass = 0; pg8::gemm_phase<pg8::EpiGlu, pg8::StaticOrder, true, true, false, false>(lds + RING_OFF, g, S, E, tid); S.pass = 1; pg8::gemm_phase<pg8::EpiGlu, pg8::StaticOrder, true, true, false, true>(lds + RING_OFF, g, S, E, tid);
        }
        GRID_BAR();
        {
            PHASE_BEGIN();
            pg8::Gemm g{(const bf16*)(ws + WS_MIXED), (const bf16*)(ws + WS_W + (size_t)(l & 1) * W_SET + W_OUT), MPAD, D, D, D, D, 0, 0}; pg8::StaticOrder S; S.init(MPAD, D, G, bx);
            pg8::EpiResidNorm<true> E{(bf16*)(ws + WS_XN), D, 1.0f, (float*)(ws + WS_RSS) + (size_t)(3 * l + 2) * RSS_STRIDE, (hl + 1 >= FP8_UP_FROM) ? (unsigned char*)(ws + WS_XB8) : nullptr, (LAS float*)(lds + RED_OFF), (const float*)(ws + WS_RSS) + (size_t)(3 * NL + 1 + l) * RSS_STRIDE, (const LAS float*)(lds + RSSB_OFF), 1.0f / DSS, EPS};
            PROBE_SET_REP_R(S, E);
            S.split = 1;
            S.pass = 0; pg8::gemm_phase<pg8::EpiResidNorm<true>, pg8::StaticOrder, true, true, false, false>(lds + RING_OFF, g, S, E, tid); S.pass = 1; pg8::gemm_phase<pg8::EpiResidNorm<true>, pg8::StaticOrder, true, true, false, true>(lds + RING_OFF, g, S, E, tid);
        }
        GRID_BAR();
    }
    {
        PHASE_BEGIN();
        const bf16* X = (const bf16*)(ws + WS_XN); float* out = A->out; const float* gain = A->in[I_FINN]; const float* rss = (const float*)(ws + WS_RSS) + (size_t)(3 * NL) * RSS_STRIDE;
        for (int prep = 0; prep < PROBE_N(7); ++prep)
#define OUT_ROW(r) ((r) < MPROMPT ? (((r) % TP) < NMETA ? (float*)nullptr : out + O_YP + ((size_t)((r) / TP) * SEQ + (((r) % TP) - NMETA)) * D) : out + O_YS + (size_t)((r) - MPROMPT) * D)
        for (int r = gw; r < MREAL; r += 2 * NGW) { const int r1 = r + NGW;
            float* d0 = OUT_ROW(r); float* d1 = (r1 < MREAL) ? OUT_ROW(r1) : (float*)nullptr; int ra = r, rb = r1;
            if (!d0) { d0 = d1; d1 = nullptr; ra = r1; }
            if (d0) final_rows2(X + (size_t)ra * D, X + (size_t)(d1 ? rb : ra) * D, gain, d0, d1, rss + (size_t)ra * 8, rss + (size_t)(d1 ? rb : ra) * 8, lane); }
#undef OUT_ROW
    }
}
}

extern "C" void kernel_launch(void* const* d_in, const int* in_sizes, int n_in, void* d_out, int out_size, void* d_ws, size_t ws_size, hipStream_t stream) {
    using namespace mk;
    static int grid = 0;
    if (grid == 0) {
        if (n_in != N_IN || (size_t)out_size != O_END || ws_size < WS_END) { fprintf(stderr, "kernel_launch: unexpected shapes (n_in %d, out %d, ws %zu, need %zu)\n", n_in, out_size, ws_size, (size_t)WS_END); grid = -1; return; }
        int dev = 0, cus = 0, per_cu = 0;
        if (hipGetDevice(&dev) != hipSuccess || hipDeviceGetAttribute(&cus, hipDeviceAttributeMultiprocessorCount, dev) != hipSuccess) { grid = -1; return; }
        if (hipFuncSetAttribute((const void*)hymba_fwd, hipFuncAttributeMaxDynamicSharedMemorySize, LDS_BYTES) != hipSuccess) { fprintf(stderr, "kernel_launch: hipFuncSetAttribute failed\n"); grid = -1; return; }
        if (hipOccupancyMaxActiveBlocksPerMultiprocessor(&per_cu, (const void*)hymba_fwd, NWAVES * 64, LDS_BYTES) != hipSuccess || per_cu < 1) { fprintf(stderr, "kernel_launch: occupancy query says %d\n", per_cu); }
        (void)hipGetLastError();
        grid = cus;
    }
    if (grid < 0) return;
    if (hipMemsetAsync(d_ws, 0, ZERO_BYTES, stream) != hipSuccess) return;
    Args a{};
    for (int i = 0; i < N_IN; ++i) a.in[i] = (const float*)d_in[i];
    a.out = (float*)d_out; a.ws = (unsigned char*)d_ws;
    hipLaunchKernelGGL(hymba_fwd, dim3(grid), dim3(NWAVES * 64), LDS_BYTES, stream, a);
}
```

```cpp
#include <hip/hip_runtime.h>
#include <cstdio>
#include <cstdint>
namespace pg8 {
#define PG8_LAS __attribute__((address_space(3)))
typedef unsigned short bf16_t;
typedef short bf16x8 __attribute__((ext_vector_type(8)));
typedef float f32x4 __attribute__((ext_vector_type(4)));
typedef unsigned u32x4 __attribute__((ext_vector_type(4)));
typedef int i32x4 __attribute__((ext_vector_type(4)));
typedef int i32x8 __attribute__((ext_vector_type(8)));
typedef unsigned u32x2 __attribute__((ext_vector_type(2)));
constexpr int BM = 256, BK = 64, HALF = 128, HTB = HALF * BK * 2  , STAGE_BYTES = 8 * HTB, NXCD = 8, WGM = 4;

__host__ __device__ __forceinline__ int lds_byte(int r, int c) { const int st = (r >> 4) * 2 + (c >> 5), rr = r & 15, cc = c & 31, ob = rr * 64 + cc * 2; return st * 1024 + (ob ^ (((ob >> 9) & 1) << 5)); }
__host__ __device__ __forceinline__ void stage_rc(int b, int& R, int& C) { const int st = b / 1024, sb = b % 1024, swz = sb ^ (((sb >> 9) & 1) << 5); R = (st >> 1) * 16 + swz / 64; C = (st & 1) * 32 + (swz % 64) / 2; }
__host__ __device__ __forceinline__ int perm32(int rho) { const int n = rho >> 4, i = rho & 15; return 8 * (i >> 2) + 4 * n + (i & 3); }

struct Unit { int pm, pn, mh; };
struct Gemm { const bf16_t* A; const bf16_t* Bt; int M, N, K; int lda, ldb; int gpanels; size_t gstride; };

struct StaticOrder {
    int nM, nN, nwg, G, c, split, pass;
#ifdef PROBE_SPLIT
    int r0, r1;
#endif
#ifdef PROBE_REP
    int rep;
#else
    static constexpr int rep = 1;
#endif
    __host__ __device__ void init(int M, int N, int G_, int c_) { nM = M / BM; nN = N / BM; nwg = nM * nN; G = G_; c = c_; split = 0; pass = 0;
#ifdef PROBE_SPLIT
        r0 = 0; r1 = 1 << 30;
#endif
#ifdef PROBE_REP
        rep = 1;
#endif
    }
    __host__ __device__ bool next(int i, Unit& u) const {
        const int nfull = split ? (nwg / G) * G : nwg;
        long L; u.mh = -1;
        if (pass == 0) { L = (long)(i / rep) * G + c; if (L >= nfull) return false; }
        else { const long hq = (long)i * G + c; if (hq >= 2 * (long)(nwg - nfull)) return false; L = nfull + (hq >> 1); u.mh = (int)(hq & 1); }
        int wgid = (int)L; { const int q = nwg / NXCD, r = nwg % NXCD, xcd = wgid % NXCD, off = wgid / NXCD; wgid = (xcd < r ? xcd * (q + 1) : r * (q + 1) + (xcd - r) * q) + off; }
        const int nig = WGM * nN, gid = wgid / nig, fm = gid * WGM, gsz = (nM - fm) < WGM ? (nM - fm) : WGM;
        u.pm = fm + ((wgid % nig) % gsz); u.pn = (wgid % nig) / gsz; return true;
    }
    __device__ __forceinline__ void a_ready(const Unit&) const {}
    __device__ __forceinline__ void done(const Unit&) const {}
};
__device__ __forceinline__ unsigned cvt_pk_bf16(float lo, float hi) { unsigned r; asm volatile("v_cvt_pk_bf16_f32 %0, %1, %2" : "=v"(r) : "v"(lo), "v"(hi)); return r; }
typedef float f32x2 __attribute__((ext_vector_type(2)));
__device__ __forceinline__ float fast_sigmoid(float z) { return __builtin_amdgcn_rcpf(1.0f + __expf(-z)); }
__device__ __forceinline__ float row_rnorm_lds(const PG8_LAS float* rssl, int lr, float inv_n, float eps) {
    const PG8_LAS f32x4* p = (const PG8_LAS f32x4*)(rssl + lr * 8); const f32x4 a = p[0], b = p[1];
    const float s = ((a[0] + a[1]) + (a[2] + a[3])) + ((b[0] + b[1]) + (b[2] + b[3]));
    return __builtin_amdgcn_rsqf(s * inv_n + eps); }
struct EpiSwiglu {
    static constexpr bool MID = false;
    static constexpr bool PERM = true, AFTER_DRAIN = false, QPRE = false;
    static constexpr bool RSS = true;
    unsigned char* H; int ldc; const float* rss; const PG8_LAS float* rssl; float inv_n, eps, oscale, iscale; int f8;
    __device__ __forceinline__ void operator()(const f32x4 (&acc)[2][2][4][2], const Unit& u, int wr, int wc, int fr, int fq) const {
        const int nai = u.mh < 0 ? 2 : 1, row0 = u.pm * BM + (u.mh > 0 ? HALF : 0) + wr * 64 + fr, col0 = u.pn * HALF + wc * 32 + 8 * fq;
#pragma unroll
        for (int ai = 0; ai < 2; ++ai) if (ai < nai)
#pragma unroll
            for (int m = 0; m < 4; ++m) { const int row = row0 + ai * HALF + m * 16; const float r = row_rnorm_lds(rssl, ai * HALF + wr * 64 + m * 16 + fr, inv_n, eps) * iscale;
                float o[8]; const float ru = r * oscale;
#pragma unroll
                for (int n = 0; n < 2; ++n)
#pragma unroll
                    for (int j = 0; j < 4; j += 2) {
                        const f32x2 g = (f32x2){acc[ai][0][m][n][j], acc[ai][0][m][n][j + 1]} * r, up = (f32x2){acc[ai][1][m][n][j], acc[ai][1][m][n][j + 1]} * ru;
                        f32x2 e = g * (-1.4426950408889634f); e.x = __builtin_amdgcn_exp2f(e.x); e.y = __builtin_amdgcn_exp2f(e.y); e = e + 1.0f;
                        f32x2 sg; sg.x = __builtin_amdgcn_rcpf(e.x); sg.y = __builtin_amdgcn_rcpf(e.y);
                        const f32x2 ov = (g * up) * sg; o[4 * n + j] = ov.x; o[4 * n + j + 1] = ov.y; }
                if (f8) {
                    int w0 = __builtin_amdgcn_cvt_pk_fp8_f32(o[0], o[1], 0, false); w0 = __builtin_amdgcn_cvt_pk_fp8_f32(o[2], o[3], w0, true);
                    int w1 = __builtin_amdgcn_cvt_pk_fp8_f32(o[4], o[5], 0, false); w1 = __builtin_amdgcn_cvt_pk_fp8_f32(o[6], o[7], w1, true);
                    u32x2 w; w.x = (unsigned)w0; w.y = (unsigned)w1; *(u32x2*)(H + (size_t)row * ldc + col0) = w;
                } else {
                    u32x4 w; w.x = cvt_pk_bf16(o[0], o[1]); w.y = cvt_pk_bf16(o[2], o[3]); w.z = cvt_pk_bf16(o[4], o[5]); w.w = cvt_pk_bf16(o[6], o[7]);
                    *(u32x4*)((bf16_t*)H + (size_t)row * ldc + col0) = w; } }
    }
};
template <bool MIDS> struct EpiResidNorm {
    static constexpr bool PERM = true, AFTER_DRAIN = false, QPRE = false;
    static constexpr bool RSS = MIDS, MID = MIDS;
    bf16_t* XB; int ldc; float scale; float* rss_out; unsigned char* XB8; PG8_LAS float* red; const float* rss; const PG8_LAS float* rssl; float inv_n, eps;
    __device__ __forceinline__ void mid(f32x4 (&acc)[2][2][4][2], const Unit& u, int wr, int fr) const {
        const int nai = u.mh < 0 ? 2 : 1;
#pragma unroll
        for (int ai = 0; ai < 2; ++ai) if (ai < nai)
#pragma unroll
            for (int m = 0; m < 4; ++m) { const PG8_LAS f32x4* p = (const PG8_LAS f32x4*)(rssl + (ai * HALF + wr * 64 + m * 16 + fr) * 8); const f32x4 a = p[0], b = p[1];
                const float c = __builtin_amdgcn_sqrtf((((a[0] + a[1]) + (a[2] + a[3])) + ((b[0] + b[1]) + (b[2] + b[3]))) * inv_n + eps);
#pragma unroll
                for (int bj = 0; bj < 2; ++bj)
#pragma unroll
                    for (int n = 0; n < 2; ++n) acc[ai][bj][m][n] = acc[ai][bj][m][n] * c; }
    }
    __device__ __forceinline__ void operator()(const f32x4 (&acc)[2][2][4][2], const Unit& u, int wr, int wc, int fr, int fq) const {
        const int nai = u.mh < 0 ? 2 : 1, row0 = u.pm * BM + (u.mh > 0 ? HALF : 0) + wr * 64 + fr, col0 = u.pn * BM + wc * 32 + 8 * fq;
#pragma unroll
        for (int ai = 0; ai < 2; ++ai) if (ai < nai) {
            u32x4 xin[4][2];
#pragma unroll
            for (int m = 0; m < 4; ++m)
#pragma unroll
                for (int bj = 0; bj < 2; ++bj) xin[m][bj] = *(const u32x4*)(XB + (size_t)(row0 + ai * HALF + m * 16) * ldc + col0 + bj * HALF);
#pragma unroll
            for (int m = 0; m < 4; ++m) { const int row = row0 + ai * HALF + m * 16; bf16_t* rowb = XB + (size_t)row * ldc + col0; float ss = 0.f;
                const float scale = MIDS ? this->scale * row_rnorm_lds(rssl, ai * HALF + wr * 64 + m * 16 + fr, inv_n, eps) : this->scale;
#pragma unroll
                for (int bj = 0; bj < 2; ++bj) { const u32x4 xo = xin[m][bj]; const f32x4 a0 = acc[ai][bj][m][0], a1 = acc[ai][bj][m][1];
                    f32x4 v0, v1;
                    v0[0] = __uint_as_float(xo.x << 16) + a0[0] * scale; v0[1] = __uint_as_float(xo.x & 0xffff0000u) + a0[1] * scale; v0[2] = __uint_as_float(xo.y << 16) + a0[2] * scale; v0[3] = __uint_as_float(xo.y & 0xffff0000u) + a0[3] * scale;
                    v1[0] = __uint_as_float(xo.z << 16) + a1[0] * scale; v1[1] = __uint_as_float(xo.z & 0xffff0000u) + a1[1] * scale; v1[2] = __uint_as_float(xo.w << 16) + a1[2] * scale; v1[3] = __uint_as_float(xo.w & 0xffff0000u) + a1[3] * scale;
                    ss += (v0[0] * v0[0] + v0[1] * v0[1]) + (v0[2] * v0[2] + v0[3] * v0[3]) + (v1[0] * v1[0] + v1[1] * v1[1]) + (v1[2] * v1[2] + v1[3] * v1[3]);
                    u32x4 w; w.x = cvt_pk_bf16(v0[0], v0[1]); w.y = cvt_pk_bf16(v0[2], v0[3]); w.z = cvt_pk_bf16(v1[0], v1[1]); w.w = cvt_pk_bf16(v1[2], v1[3]);
                    *(u32x4*)(rowb + bj * HALF) = w;
                    if (XB8) { int w0 = __builtin_amdgcn_cvt_pk_fp8_f32(v0[0], v0[1], 0, false); w0 = __builtin_amdgcn_cvt_pk_fp8_f32(v0[2], v0[3], w0, true);
                        int w1 = __builtin_amdgcn_cvt_pk_fp8_f32(v1[0], v1[1], 0, false); w1 = __builtin_amdgcn_cvt_pk_fp8_f32(v1[2], v1[3], w1, true);
                        u32x2 w8; w8.x = (unsigned)w0; w8.y = (unsigned)w1; *(u32x2*)(XB8 + (size_t)row * ldc + col0 + bj * HALF) = w8; } }
                ss += __shfl_xor(ss, 16); ss += __shfl_xor(ss, 32);
                if (fq == 0) red[(ai * HALF + wr * 64 + m * 16 + fr) * 4 + wc] = ss; }
            asm volatile("" ::: "memory"); }
        asm volatile("s_waitcnt lgkmcnt(0)" ::: "memory"); __builtin_amdgcn_s_barrier(); asm volatile("" ::: "memory");
        { const int t = (wr * 4 + wc) * 64 + fq * 16 + fr;
          if (t < nai * HALF) { const f32x4 q = *(const PG8_LAS f32x4*)(red + t * 4); rss_out[((size_t)u.pm * BM + (u.mh > 0 ? HALF : 0) + t) * 8 + u.pn] = (q[0] + q[1]) + (q[2] + q[3]); } }
    }
};
struct EpiStoreBf16 {
    static constexpr bool MID = false;
    static constexpr bool PERM = true, AFTER_DRAIN = false, QPRE = false;
    static constexpr bool RSS = true;
    bf16_t* O; int ldc; const float* rss; const PG8_LAS float* rssl; float inv_n, eps; bf16_t* UG; int ucol0, ug_chunks, ug_ld;
    __device__ __forceinline__ void operator()(const f32x4 (&acc)[2][2][4][2], const Unit& u, int wr, int wc, int fr, int fq) const {
        const int nai = u.mh < 0 ? 2 : 1, row0 = u.pm * BM + (u.mh > 0 ? HALF : 0) + wr * 64 + fr, col0 = u.pn * BM + wc * 32 + 8 * fq; const bool isu = (u.pn * BM >= ucol0);
#pragma unroll
        for (int ai = 0; ai < 2; ++ai) if (ai < nai)
#pragma unroll
            for (int m = 0; m < 4; ++m) { const int row = row0 + ai * HALF + m * 16; const float r = row_rnorm_lds(rssl, ai * HALF + wr * 64 + m * 16 + fr, inv_n, eps);
#pragma unroll
                for (int bj = 0; bj < 2; ++bj) { const f32x4 v0 = acc[ai][bj][m][0] * r, v1 = acc[ai][bj][m][1] * r;
                    u32x4 w; w.x = cvt_pk_bf16(v0[0], v0[1]); w.y = cvt_pk_bf16(v0[2], v0[3]); w.z = cvt_pk_bf16(v1[0], v1[1]); w.w = cvt_pk_bf16(v1[2], v1[3]);
                    const int c = col0 + bj * HALF;
                    bf16_t* dst = isu ? UG + ((size_t)((c - ucol0) >> 4) * ug_chunks + (row >> 4)) * ug_ld + (row & 15) * 16 + (c & 15) : O + (size_t)row * ldc + c;
                    *(u32x4*)dst = w; } }
    }
};
struct EpiSloc {
    static constexpr bool MID = false;
    static constexpr bool RSS = false;
    static constexpr bool PERM = false, AFTER_DRAIN = false, QPRE = false;
    float* S; int cpg, nchunk, ngrp;
    __device__ __forceinline__ void operator()(const f32x4 (&acc)[2][2][4][2], const Unit& u, int wr, int wc, int fr, int fq) const {
        const int nai = u.mh < 0 ? 2 : 1, R0 = u.pm * BM + (u.mh > 0 ? HALF : 0) + wr * 64 + fr, g = R0 / cpg, c0 = R0 - g * cpg, col0 = wc * 32 + 4 * fq;
#pragma unroll
        for (int ai = 0; ai < 2; ++ai) if (ai < nai)
#pragma unroll
            for (int m = 0; m < 4; ++m) { const int chunk = c0 + ai * HALF + m * 16; if (chunk < nchunk) { float* p = S + ((size_t)chunk * ngrp + g) * 128 + col0;
#pragma unroll
                for (int n = 0; n < 2; ++n) *(f32x4*)(p + n * 16) = acc[ai][0][m][n]; } }
    }
};
struct EpiYs {
    static constexpr bool MID = false;
    static constexpr bool RSS = false;
    static constexpr bool PERM = true, AFTER_DRAIN = false, QPRE = false;
    bf16_t* Y; int ldy, cpg, nchunk;
    __device__ __forceinline__ void operator()(const f32x4 (&acc)[2][2][4][2], const Unit& u, int wr, int wc, int fr, int fq) const {
        const int nai = u.mh < 0 ? 2 : 1, R0 = u.pm * BM + (u.mh > 0 ? HALF : 0) + wr * 64 + fr, g = R0 / cpg, c0 = R0 - g * cpg, col0 = wc * 32 + 8 * fq;
#pragma unroll
        for (int ai = 0; ai < 2; ++ai) if (ai < nai)
#pragma unroll
            for (int m = 0; m < 4; ++m) { const int chunk = c0 + ai * HALF + m * 16; if (chunk < nchunk) {
#pragma unroll
                for (int bj = 0; bj < 2; ++bj) { const int c = col0 + bj * HALF; float o[8];
#pragma unroll
                    for (int n = 0; n < 2; ++n)
#pragma unroll
                        for (int j = 0; j < 4; ++j) { const float x = acc[ai][bj][m][n][j]; const float z = 0.7978845608028654f * (x + 0.044715f * x * x * x); o[4 * n + j] = x * fast_sigmoid(2.0f * z); }
                    u32x4 w; w.x = cvt_pk_bf16(o[0], o[1]); w.y = cvt_pk_bf16(o[2], o[3]); w.z = cvt_pk_bf16(o[4], o[5]); w.w = cvt_pk_bf16(o[6], o[7]);
                    *(u32x4*)(Y + ((size_t)chunk * 16 + (c >> 4)) * ldy + g * 16 + (c & 15)) = w; } } }
    }
};
struct EpiGlu {
    static constexpr bool MID = false;
    static constexpr bool RSS = false;
    static constexpr bool PERM = true, AFTER_DRAIN = false, QPRE = false;
    const bf16_t* Y; int ldy; bf16_t* O; int ldo; float* rss_out; PG8_LAS float* red;
    __device__ __forceinline__ void operator()(const f32x4 (&acc)[2][2][4][2], const Unit& u, int wr, int wc, int fr, int fq) const {
        const int nai = u.mh < 0 ? 2 : 1, row0 = u.pm * BM + (u.mh > 0 ? HALF : 0) + wr * 64 + fr, col0 = u.pn * BM + wc * 32 + 8 * fq;
#pragma unroll
        for (int ai = 0; ai < 2; ++ai) if (ai < nai) {
            u32x4 yin[4][2];
#pragma unroll
            for (int m = 0; m < 4; ++m)
#pragma unroll
                for (int bj = 0; bj < 2; ++bj) yin[m][bj] = *(const u32x4*)(Y + (size_t)(row0 + ai * HALF + m * 16) * ldy + col0 + bj * HALF);
#pragma unroll
            for (int m = 0; m < 4; ++m) { const size_t r = (size_t)(row0 + ai * HALF + m * 16); float ss = 0.f;
#pragma unroll
                for (int bj = 0; bj < 2; ++bj) { const u32x4 yv = yin[m][bj]; const f32x4 z0 = acc[ai][bj][m][0], z1 = acc[ai][bj][m][1];
                    float o[8];
#pragma unroll
                    for (int q = 0; q < 4; ++q) { const unsigned w = yv[q]; const float ylo = __uint_as_float(w << 16), yhi = __uint_as_float(w & 0xffff0000u);
                        const float za = (q < 2) ? z0[2 * q] : z1[2 * q - 4], zb = (q < 2) ? z0[2 * q + 1] : z1[2 * q - 3];
                        o[2 * q] = ylo * fast_sigmoid(za); o[2 * q + 1] = yhi * fast_sigmoid(zb); ss += o[2 * q] * o[2 * q] + o[2 * q + 1] * o[2 * q + 1]; }
                    u32x4 w; w.x = cvt_pk_bf16(o[0], o[1]); w.y = cvt_pk_bf16(o[2], o[3]); w.z = cvt_pk_bf16(o[4], o[5]); w.w = cvt_pk_bf16(o[6], o[7]);
                    *(u32x4*)(O + r * ldo + col0 + bj * HALF) = w; }
                ss += __shfl_xor(ss, 16); ss += __shfl_xor(ss, 32);
                if (fq == 0) red[(ai * HALF + wr * 64 + m * 16 + fr) * 4 + wc] = ss; }
            asm volatile("" ::: "memory"); }
        asm volatile("s_waitcnt lgkmcnt(0)" ::: "memory"); __builtin_amdgcn_s_barrier(); asm volatile("" ::: "memory");
        { const int t = (wr * 4 + wc) * 64 + fq * 16 + fr;
          if (t < nai * HALF) { const f32x4 q = *(const PG8_LAS f32x4*)(red + t * 4); float* ro = rss_out + ((size_t)u.pm * BM + (u.mh > 0 ? HALF : 0) + t) * 8 + u.pn; ro[0] = (q[0] + q[1]) + (q[2] + q[3]); ro[4] = 0.f; } }
    }
};
struct EpiSwigluQ {
    static constexpr bool MID = false, RSS = true;
    static constexpr bool PERM = true, AFTER_DRAIN = false, QPRE = true;
    const float* QF; unsigned char* H; const float* CSG; int ldc; const float* CSU; int f8; float oscale; const PG8_LAS float* rssl;
    __device__ __forceinline__ const void* pre_src(const Unit& u, int wid, int lane) const {
        return wid == 0 ? (const void*)(QF + (size_t)u.pm * BM + (u.mh > 0 ? HALF : 0) + lane * 4) : (const void*)((lane < 32 ? CSG : CSU) + u.pn * HALF + (lane & 31) * 4); }
    __device__ __forceinline__ void operator()(const f32x4 (&acc)[2][2][4][2], const Unit& u, int wr, int wc, int fr, int fq) const {
        const int nai = u.mh < 0 ? 2 : 1, row0 = u.pm * BM + (u.mh > 0 ? HALF : 0) + wr * 64 + fr, col0 = u.pn * HALF + wc * 32 + 8 * fq;
        f32x4 cg[2], cu[2]; const PG8_LAS f32x4* cp = (const PG8_LAS f32x4*)(rssl + 256 + wc * 32 + 8 * fq); cg[0] = cp[0]; cg[1] = cp[1]; cu[0] = cp[32] * oscale; cu[1] = cp[33] * oscale;
        float qf[2][4];
#pragma unroll
        for (int ai = 0; ai < 2; ++ai)
#pragma unroll
            for (int m = 0; m < 4; ++m) qf[ai][m] = (ai < nai) ? rssl[ai * HALF + wr * 64 + m * 16 + fr] : 0.f;
        f32x2 cl[2][2], cpr[2][2];
#pragma unroll
        for (int n = 0; n < 2; ++n)
#pragma unroll
            for (int h = 0; h < 2; ++h) { const f32x2 g2 = (f32x2){cg[n][2 * h], cg[n][2 * h + 1]}, u2 = (f32x2){cu[n][2 * h], cu[n][2 * h + 1]}; cl[n][h] = g2 * (-1.4426950408889634f); cpr[n][h] = g2 * u2; }
#pragma unroll
        for (int ai = 0; ai < 2; ++ai) if (ai < nai)
#pragma unroll
            for (int m = 0; m < 4; ++m) { const int row = row0 + ai * HALF + m * 16;
                float o[8]; const float q1 = qf[ai][m], q2 = q1 * q1;
#pragma unroll
                for (int n = 0; n < 2; ++n)
#pragma unroll
                    for (int j = 0; j < 4; j += 2) { const f32x4 ag = acc[ai][0][m][n], au = acc[ai][1][m][n];
                        const float g0 = ag[j], g1 = ag[j + 1], u0 = au[j], u1 = au[j + 1];
                        const f32x2 gi = (f32x2){(float)__float_as_int(g0), (float)__float_as_int(g1)}, ui = (f32x2){(float)__float_as_int(u0), (float)__float_as_int(u1)};
                        f32x2 e = gi * (cl[n][j >> 1] * q1); e.x = __builtin_amdgcn_exp2f(e.x); e.y = __builtin_amdgcn_exp2f(e.y); e = e + 1.0f;
                        f32x2 sgm; sgm.x = __builtin_amdgcn_rcpf(e.x); sgm.y = __builtin_amdgcn_rcpf(e.y);
                        const f32x2 ov = ((gi * ui) * (cpr[n][j >> 1] * q2)) * sgm; o[4 * n + j] = ov.x; o[4 * n + j + 1] = ov.y; }
                if (f8) {
                    int w0 = __builtin_amdgcn_cvt_pk_fp8_f32(o[0], o[1], 0, false); w0 = __builtin_amdgcn_cvt_pk_fp8_f32(o[2], o[3], w0, true);
                    int w1 = __builtin_amdgcn_cvt_pk_fp8_f32(o[4], o[5], 0, false); w1 = __builtin_amdgcn_cvt_pk_fp8_f32(o[6], o[7], w1, true);
                    u32x2 w; w.x = (unsigned)w0; w.y = (unsigned)w1; *(u32x2*)(H + (size_t)row * ldc + col0) = w;
                } else {
                    u32x4 w; w.x = cvt_pk_bf16(o[0], o[1]); w.y = cvt_pk_bf16(o[2], o[3]); w.z = cvt_pk_bf16(o[4], o[5]); w.w = cvt_pk_bf16(o[6], o[7]);
                    *(u32x4*)((bf16_t*)H + (size_t)row * ldc + col0) = w; } }
    }
};
template <class Epi, class Sched, bool ALIGN_EPI = false, bool SP2 = false, int FP8 = 0, bool HM = false>
__device__ __forceinline__ void gemm_phase(PG8_LAS unsigned char* lds, const Gemm g, const Sched& S, const Epi& E, const int tid_in) {   constexpr bool hm = HM;
    const int tid = tid_in, wid = __builtin_amdgcn_readfirstlane(tid >> 6), lane = tid & 63, wr = wid >> 2, wc = wid & 3, fr = lane & 15, fq = lane >> 4;
    const int K = g.K, nt = K / BK;
    unsigned voffA[2], voffB[2];
#pragma unroll
    for (int i = 0; i < 2; ++i) { int R, C; stage_rc(tid * 16 + i * 8192, R, C); const int Rb = Epi::PERM ? ((R & ~31) + perm32(R & 31)) : R;
        voffA[i] = (unsigned)(R * g.lda + C) * 2u; voffB[i] = (unsigned)(Rb * g.ldb + C) * 2u; }
    const size_t kstep = (size_t)(BK * 2);
    const size_t hstepA = (size_t)HALF * g.lda * 2, hstepB = (size_t)HALF * g.ldb * 2;
    const size_t tstepA = 2 * hstepA, tstepB = 2 * hstepB;
    const unsigned ldsw = (unsigned)wid * 1024u;
    const int aoff = lds_byte(wr * 64 + fr, fq * 8), boff = lds_byte(wc * 32 + fr, fq * 8);
#define PG8_SA(b, h) (((b) * 2 + (h)) * HTB)
#define PG8_SB(b, h) ((4 + (b) * 2 + (h)) * HTB)
#define PG8_STAGE(bufoff, gbase, voff) do { _Pragma("unroll") for (int _i = 0; _i < 2; ++_i) \
        __builtin_amdgcn_global_load_lds((const unsigned*)((const char*)(gbase) + (voff)[_i]), (PG8_LAS unsigned*)(lds + (bufoff) + ldsw + _i * 8192), 16, 0, 0); } while (0)
#define PG8_LDA(dst, b, h) do { if constexpr (FP8 == 1) { _Pragma("unroll") for (int m = 0; m < 4; ++m) { const i32x4 lo_ = *(const PG8_LAS i32x4*)(lds + PG8_SA(b, h) + aoff + m * 2048), hi_ = *(const PG8_LAS i32x4*)(lds + PG8_SA(b, h) + aoff + m * 2048 + 1024); \
            dst##8[m] = __builtin_shufflevector(lo_, hi_, 0, 1, 2, 3, 4, 5, 6, 7); } } \
        else { _Pragma("unroll") for (int m = 0; m < 4; ++m) _Pragma("unroll") for (int k = 0; k < 2; ++k) dst[m][k] = *(const PG8_LAS bf16x8*)(lds + PG8_SA(b, h) + aoff + m * 2048 + k * 1024); } } while (0)
#define PG8_LDB(dst, b, h) do { if constexpr (FP8 == 1) { _Pragma("unroll") for (int n = 0; n < 2; ++n) { const i32x4 lo_ = *(const PG8_LAS i32x4*)(lds + PG8_SB(b, h) + boff + n * 2048), hi_ = *(const PG8_LAS i32x4*)(lds + PG8_SB(b, h) + boff + n * 2048 + 1024); \
            dst##8[n] = __builtin_shufflevector(lo_, hi_, 0, 1, 2, 3, 4, 5, 6, 7); } } \
        else { _Pragma("unroll") for (int n = 0; n < 2; ++n) _Pragma("unroll") for (int k = 0; k < 2; ++k) dst[n][k] = *(const PG8_LAS bf16x8*)(lds + PG8_SB(b, h) + boff + n * 2048 + k * 1024); } } while (0)
#define PG8_MMA(ai, bj, At, Bt) do { __builtin_amdgcn_s_setprio(1); \
        if constexpr (FP8 == 1) { _Pragma("unroll") for (int m = 0; m < 4; ++m) _Pragma("unroll") for (int n = 0; n < 2; ++n) \
            asm volatile("v_mfma_scale_f32_16x16x128_f8f6f4 %0, %1, %2, %0, %3, %3 op_sel_hi:[0,0,0]" : "+v"(acc[ai][bj][m][n]) : "v"(Bt##8[n]), "v"(At##8[m]), "v"(one_scale)); } \
        else if constexpr (FP8 == 2) { _Pragma("unroll") for (int m = 0; m < 4; ++m) _Pragma("unroll") for (int n = 0; n < 2; ++n) _Pragma("unroll") for (int k = 0; k < 2; ++k) \
            acc[ai][bj][m][n] = __builtin_bit_cast(f32x4, __builtin_amdgcn_mfma_i32_16x16x64_i8(__builtin_bit_cast(i32x4, Bt[n][k]), __builtin_bit_cast(i32x4, At[m][k]), __builtin_bit_cast(i32x4, acc[ai][bj][m][n]), 0, 0, 0)); } \
        else { _Pragma("unroll") for (int m = 0; m < 4; ++m) _Pragma("unroll") for (int n = 0; n < 2; ++n) _Pragma("unroll") for (int k = 0; k < 2; ++k) \
            acc[ai][bj][m][n] = __builtin_amdgcn_mfma_f32_16x16x32_bf16(Bt[n][k], At[m][k], acc[ai][bj][m][n], 0, 0, 0); } \
        __builtin_amdgcn_s_setprio(0); } while (0)
#define PG8_RSS_DMA() do { if constexpr (Epi::RSS) { if (t == 0) { if constexpr (Epi::QPRE) { if (wid < 2) __builtin_amdgcn_global_load_lds((const unsigned*)E.pre_src(cur, wid, lane), (PG8_LAS unsigned*)((PG8_LAS unsigned char*)E.rssl + ldsw), 16, 0, 0); } \
        else __builtin_amdgcn_global_load_lds((const unsigned*)((const char*)E.rss + ((size_t)cur.pm * BM + (cur.mh > 0 ? HALF : 0)) * 32 + (size_t)tid * 16), \
        (PG8_LAS unsigned*)((PG8_LAS unsigned char*)E.rssl + ldsw), 16, 0, 0); } } } while (0)
#define PG8_WAIT_V(n) asm volatile("s_waitcnt vmcnt(" #n ")" ::: "memory")
#define PG8_WAIT_L(n) asm volatile("s_waitcnt lgkmcnt(" #n ")" ::: "memory")
#define PG8_BAR __builtin_amdgcn_s_barrier()
#define PG8_SCHED __builtin_amdgcn_sched_barrier(0)
    Unit cur, nxt; int ui = 0;
    if (!S.next(0, cur)) return;
    f32x4 acc[2][2][4][2];
#pragma unroll
    for (int a = 0; a < 2; ++a)
#pragma unroll
        for (int b = 0; b < 2; ++b)
#pragma unroll
            for (int m = 0; m < 4; ++m)
#pragma unroll
                for (int n = 0; n < 2; ++n) acc[a][b][m][n] = (f32x4){0.f, 0.f, 0.f, 0.f};
    int one_scale = 0x7f7f7f7f; asm volatile("" : "+v"(one_scale));
    bf16x8 At[4][2], B0[2][2], B1[2][2]; i32x8 At8[4], B08[2], B18[2];
    const char* cA = (const char*)g.A + (size_t)cur.pm * tstepA + (cur.mh > 0 ? hstepA : (size_t)0); const char* cB = (const char*)g.Bt + (size_t)cur.pn * tstepB + (g.gpanels ? (size_t)(cur.pm / g.gpanels) * g.gstride : (size_t)0);
    S.a_ready(cur);
    if constexpr (SP2) {
        if constexpr (HM) {
        PG8_STAGE(PG8_SB(0, 0), cB, voffB); PG8_STAGE(PG8_SB(0, 1), cB + hstepB, voffB); PG8_STAGE(PG8_SA(0, 0), cA, voffA);
        if (wr == 1) PG8_BAR;
        PG8_WAIT_V(0); PG8_BAR;
        PG8_STAGE(PG8_SB(1, 0), cB + kstep, voffB); PG8_STAGE(PG8_SA(1, 0), cA + kstep, voffA); PG8_STAGE(PG8_SB(1, 1), cB + hstepB + kstep, voffB);
        PG8_BAR;
        } else {
        PG8_STAGE(PG8_SB(0, 0), cB, voffB); PG8_STAGE(PG8_SB(0, 1), cB + hstepB, voffB); PG8_STAGE(PG8_SA(0, 0), cA, voffA); PG8_STAGE(PG8_SA(0, 1), cA + hstepA, voffA);
        if (wr == 1) PG8_BAR;
        PG8_WAIT_V(2); PG8_BAR;
        PG8_STAGE(PG8_SB(1, 0), cB + kstep, voffB); PG8_STAGE(PG8_SA(1, 0), cA + kstep, voffA); PG8_STAGE(PG8_SB(1, 1), cB + hstepB + kstep, voffB);
        PG8_WAIT_V(6); PG8_BAR;
        }
    } else {
        PG8_STAGE(PG8_SB(0, 0), cB, voffB); PG8_STAGE(PG8_SA(0, 0), cA, voffA); PG8_STAGE(PG8_SB(0, 1), cB + hstepB, voffB); PG8_STAGE(PG8_SA(0, 1), cA + hstepA, voffA);
        if (wr == 1) PG8_BAR;
        PG8_WAIT_V(4); PG8_BAR;
        PG8_STAGE(PG8_SB(1, 0), cB + kstep, voffB); PG8_STAGE(PG8_SA(1, 0), cA + kstep, voffA); PG8_STAGE(PG8_SB(1, 1), cB + hstepB + kstep, voffB);
        PG8_WAIT_V(6); PG8_BAR;
    }
    for (;;) {
        const bool has_next = S.next(ui + 1, nxt);
        const char* nA = has_next ? (const char*)g.A + (size_t)nxt.pm * tstepA + (nxt.mh > 0 ? hstepA : (size_t)0) : cA; const char* nB = has_next ? (const char*)g.Bt + (size_t)nxt.pn * tstepB + (g.gpanels ? (size_t)(nxt.pm / g.gpanels) * g.gstride : (size_t)0) : cB;
#pragma nounroll
        for (int t = 0; t < nt; t += 2) {
            const bool last = (t == nt - 2);
            const char* a1 = cA + (size_t)(t + 1) * kstep;
            const char* a2 = last ? nA : cA + (size_t)(t + 2) * kstep; const char* b2 = last ? nB : cB + (size_t)(t + 2) * kstep;
            const char* a3 = a2 + kstep; const char* b3 = b2 + kstep;
            if (last && has_next) S.a_ready(nxt);
            if constexpr (Epi::MID) { if (t == (nt >> 1)) E.mid(acc, cur, wr, fr); }
            if constexpr (SP2) {
            if constexpr (HM) {
            PG8_LDB(B0, 0, 0); PG8_LDB(B1, 0, 1); PG8_SCHED; PG8_LDA(At, 0, 0);
            PG8_WAIT_L(0); PG8_BAR; PG8_RSS_DMA(); PG8_MMA(0, 0, At, B0); PG8_MMA(0, 1, At, B1); PG8_BAR; PG8_SCHED;
            PG8_STAGE(PG8_SB(0, 0), b2, voffB); PG8_STAGE(PG8_SB(0, 1), b2 + hstepB, voffB); PG8_STAGE(PG8_SA(0, 0), a2, voffA);
            PG8_WAIT_V(6); PG8_BAR; PG8_BAR; PG8_SCHED;
            PG8_LDB(B0, 1, 0); PG8_LDB(B1, 1, 1); PG8_SCHED; PG8_LDA(At, 1, 0);
            PG8_WAIT_L(0); PG8_BAR; PG8_MMA(0, 0, At, B0); PG8_MMA(0, 1, At, B1); PG8_BAR; PG8_SCHED;
            PG8_STAGE(PG8_SB(1, 0), b3, voffB); PG8_STAGE(PG8_SB(1, 1), b3 + hstepB, voffB); PG8_STAGE(PG8_SA(1, 0), a3, voffA);
            PG8_WAIT_V(6); PG8_BAR; PG8_BAR; PG8_SCHED;
            } else {
            PG8_LDB(B0, 0, 0); PG8_LDB(B1, 0, 1); PG8_SCHED; PG8_LDA(At, 0, 0); PG8_STAGE(PG8_SA(1, 1), a1 + hstepA, voffA);
            PG8_WAIT_V(8); PG8_WAIT_L(0); PG8_BAR; PG8_RSS_DMA(); PG8_MMA(0, 0, At, B0); PG8_MMA(0, 1, At, B1); PG8_BAR; PG8_SCHED;
            PG8_LDA(At, 0, 1); PG8_STAGE(PG8_SB(0, 0), b2, voffB); PG8_STAGE(PG8_SB(0, 1), b2 + hstepB, voffB); PG8_STAGE(PG8_SA(0, 0), a2, voffA);
            PG8_WAIT_V(8); PG8_WAIT_L(0); PG8_BAR; PG8_MMA(1, 0, At, B0); PG8_MMA(1, 1, At, B1); PG8_BAR; PG8_SCHED;
            PG8_LDB(B0, 1, 0); PG8_LDB(B1, 1, 1); PG8_SCHED; PG8_LDA(At, 1, 0); PG8_STAGE(PG8_SA(0, 1), a2 + hstepA, voffA);
            PG8_WAIT_V(8); PG8_WAIT_L(0); PG8_BAR; PG8_MMA(0, 0, At, B0); PG8_MMA(0, 1, At, B1); PG8_BAR; PG8_SCHED;
            PG8_LDA(At, 1, 1); PG8_STAGE(PG8_SB(1, 0), b3, voffB); PG8_STAGE(PG8_SB(1, 1), b3 + hstepB, voffB); PG8_STAGE(PG8_SA(1, 0), a3, voffA);
            PG8_WAIT_V(8); PG8_WAIT_L(0); PG8_BAR; PG8_MMA(1, 0, At, B0); PG8_MMA(1, 1, At, B1); PG8_BAR; PG8_SCHED;
            }
            } else {
            PG8_LDB(B0, 0, 0); PG8_SCHED; PG8_LDA(At, 0, 0); PG8_STAGE(PG8_SA(1, 1), a1 + hstepA, voffA);
            PG8_WAIT_L(8); PG8_BAR; PG8_WAIT_L(0); PG8_MMA(0, 0, At, B0); PG8_BAR; PG8_SCHED;
            PG8_LDB(B1, 0, 1); PG8_STAGE(PG8_SB(0, 0), b2, voffB);
            PG8_BAR; PG8_WAIT_L(0); PG8_MMA(0, 1, At, B1); PG8_BAR;
            PG8_LDA(At, 0, 1); PG8_STAGE(PG8_SA(0, 0), a2, voffA);
            PG8_BAR; PG8_WAIT_L(0); PG8_MMA(1, 0, At, B0); PG8_BAR; PG8_SCHED;
            PG8_STAGE(PG8_SB(0, 1), b2 + hstepB, voffB);
            PG8_WAIT_V(6); PG8_BAR; PG8_MMA(1, 1, At, B1); PG8_BAR;
            PG8_LDB(B0, 1, 0); PG8_SCHED; PG8_LDA(At, 1, 0); PG8_STAGE(PG8_SA(0, 1), a2 + hstepA, voffA);
            PG8_WAIT_L(8); PG8_BAR; PG8_WAIT_L(0); PG8_MMA(0, 0, At, B0); PG8_BAR; PG8_SCHED;
            PG8_LDB(B1, 1, 1); PG8_STAGE(PG8_SB(1, 0), b3, voffB);
            PG8_BAR; PG8_WAIT_L(0); PG8_MMA(0, 1, At, B1); PG8_BAR;
            PG8_LDA(At, 1, 1); PG8_STAGE(PG8_SA(1, 0), a3, voffA);
            PG8_BAR; PG8_WAIT_L(0); PG8_MMA(1, 0, At, B0); PG8_BAR; PG8_SCHED;
            PG8_STAGE(PG8_SB(1, 1), b3 + hstepB, voffB);
            PG8_WAIT_V(6); PG8_BAR; PG8_MMA(1, 1, At, B1); PG8_BAR;
            }
        }
        if constexpr (ALIGN_EPI) { if (wr == 0) PG8_BAR; }
        if constexpr (!Epi::AFTER_DRAIN) {
            if constexpr (FP8 == 1) asm volatile("s_nop 15\n\ts_nop 15" ::: "memory");
            int tz = tid; asm volatile("" : "+v"(tz)); const int lz = tz & 63, wz = __builtin_amdgcn_readfirstlane(tz >> 6);
            E(acc, cur, wz >> 2, wz & 3, lz & 15, lz >> 4); S.done(cur); }
        if (!has_next) break;
#pragma unroll
        for (int a = 0; a < 2; ++a)
#pragma unroll
            for (int b = 0; b < 2; ++b)
#pragma unroll
                for (int m = 0; m < 4; ++m)
#pragma unroll
                    for (int n = 0; n < 2; ++n) acc[a][b][m][n] = (f32x4){0.f, 0.f, 0.f, 0.f};
        cur = nxt; cA = nA; cB = nB; ++ui;
        if constexpr (ALIGN_EPI) { if (wr == 1) PG8_BAR; }
    }
    PG8_WAIT_V(0);
    if constexpr (!ALIGN_EPI) { if (wr == 0) PG8_BAR; }
    PG8_BAR;
    if constexpr (Epi::AFTER_DRAIN) { E.fused(acc, cur, wr, wc, fr, fq, lds, wid, lane); S.done(cur); }
#undef PG8_SA
#undef PG8_SB
#undef PG8_STAGE
#undef PG8_LDA
#undef PG8_LDB
#undef PG8_MMA
#undef PG8_WAIT_V
#undef PG8_RSS_DMA
#undef PG8_WAIT_L
#undef PG8_BAR
#undef PG8_SCHED
}
}
#define GAS __attribute__((address_space(1)))
#define LAS __attribute__((address_space(3)))
typedef unsigned short bf16;
typedef unsigned v4u __attribute__((ext_vector_type(4)));
typedef float f32x4 __attribute__((ext_vector_type(4)));
typedef short bf16x8 __attribute__((ext_vector_type(8)));
typedef GAS unsigned gu32;
typedef GAS unsigned long long gu64;
#define RLX_AGENT __ATOMIC_RELAXED, __HIP_MEMORY_SCOPE_AGENT
#define LDS_WAIT() asm volatile("s_waitcnt lgkmcnt(0)" ::: "memory")
#define VM_WAIT() asm volatile("s_waitcnt vmcnt(0)" ::: "memory")
__device__ __forceinline__ unsigned long long rt() { return __builtin_amdgcn_s_memrealtime(); }
__device__ __forceinline__ unsigned f2bf(float f) { unsigned u = __builtin_bit_cast(unsigned, f); return (u + 0x7fffu + ((u >> 16) & 1u)) >> 16; }
__device__ __forceinline__ unsigned pk2(float lo, float hi) { return f2bf(lo) | (f2bf(hi) << 16); }

#define XB_TMO      128
#define XB_XCNT(j)  (256  + 64 * (j))
#define XB_XSUB(j)  (1280 + 64 * (j))
#define XB_XGEN(j)  (2304 + 64 * (j))
#define XB_TOP      3328
#define XB_TOPGEN   3392
#define XCD_BAR_WORDS 3456
#define XB_SPIN_CAP (1u << 18)

__device__ __forceinline__ unsigned xb_ld(unsigned* p)              { return __hip_atomic_load(p, __ATOMIC_RELAXED, __HIP_MEMORY_SCOPE_AGENT); }
__device__ __forceinline__ unsigned xb_add(unsigned* p, unsigned v) { return __hip_atomic_fetch_add(p, v, __ATOMIC_RELAXED, __HIP_MEMORY_SCOPE_AGENT); }
__device__ __forceinline__ unsigned xb_xcc_id() { return (unsigned)__builtin_amdgcn_s_getreg((3 << 11) | 20) & 0xFu; }
#define XB_SPIN(cond, bar) do { unsigned _sp = 0; while (cond) { __builtin_amdgcn_s_sleep(1); \
    if ((++_sp & 255u) == 0u) { if (xb_ld(&(bar)[XB_TMO])) break; if (_sp > XB_SPIN_CAP) { atomicAdd(&(bar)[XB_TMO], 1u); break; } } } } while (0)

struct XcdBarrier {
    unsigned* bar; unsigned x;
    volatile LAS unsigned* st;
};

__device__ __forceinline__ XcdBarrier xcd_barrier_post(unsigned* bar, volatile LAS unsigned* st) {
    XcdBarrier b; b.bar = bar; b.x = xb_xcc_id(); b.st = st;
    if (threadIdx.x == 0) (void)xb_add(&bar[XB_XCNT(b.x)], 1u);
    return b;
}
__device__ __forceinline__ void xcd_barrier_complete(unsigned* bar, unsigned x, unsigned& nloc, unsigned& nx) {
    const unsigned G = gridDim.x * gridDim.y * gridDim.z;
    unsigned sum, cnt, mine, sp = 0u;
    for (;;) {
        sum = 0u; cnt = 0u; mine = 0u;
#pragma unroll
        for (unsigned j = 0; j < 16; ++j) { const unsigned c = xb_ld(&bar[XB_XCNT(j)]); sum += c; cnt += (c > 0u) ? 1u : 0u; mine = (j == x) ? c : mine; }
        if (sum == G) break;
        __builtin_amdgcn_s_sleep(1);
        if ((++sp & 255u) == 0u) { if (xb_ld(&bar[XB_TMO])) break; if (sp > XB_SPIN_CAP) { atomicAdd(&bar[XB_TMO], 1u); break; } }
    }
    nloc = mine > 0u ? mine : 1u; nx = cnt > 0u ? cnt : 1u;
}

__device__ __forceinline__ void xcd_barrier(const XcdBarrier& b) {
    asm volatile("s_waitcnt vmcnt(0)" ::: "memory");
    __syncthreads();
    if (threadIdx.x == 0) {
        unsigned* bar = b.bar;
        __builtin_amdgcn_s_waitcnt(0);
        unsigned nloc = b.st[0], nx = b.st[1];
        if (nloc == 0u) { xcd_barrier_complete(bar, b.x, nloc, nx); b.st[0] = nloc; b.st[1] = nx; }
        const unsigned old = xb_add(&bar[XB_XSUB(b.x)], 1u);
        const unsigned gen = old / nloc;
        if (old + 1u == (gen + 1u) * nloc) {
            __builtin_amdgcn_fence(__ATOMIC_RELEASE, "agent");
            asm volatile("s_waitcnt vmcnt(0)" ::: "memory");
            const unsigned og = xb_add(&bar[XB_TOP], 1u);
            const unsigned tg = og / nx;
            if (og + 1u == (tg + 1u) * nx) xb_add(&bar[XB_TOPGEN], 1u);
            else XB_SPIN(xb_ld(&bar[XB_TOPGEN]) == tg, bar);
            __builtin_amdgcn_fence(__ATOMIC_ACQUIRE, "agent");
            xb_add(&bar[XB_XGEN(b.x)], 1u);
            asm volatile("s_waitcnt vmcnt(0)" ::: "memory");
        } else {
            XB_SPIN(xb_ld(&bar[XB_XGEN(b.x)]) == gen, bar);
            __builtin_amdgcn_fence(__ATOMIC_ACQUIRE, "agent");
            asm volatile("s_waitcnt vmcnt(0)" ::: "memory");
        }
    }
    __syncthreads();
}
namespace mk {
typedef float f32x2 __attribute__((ext_vector_type(2)));
typedef unsigned u32x2 __attribute__((ext_vector_type(2)));
constexpr int NWAVES = 8;
constexpr int D = 2048, FF = 5632, DCV = 1024, DSS = 1024, DIN = 4096, NL = 4;
constexpr int SEQ = 16384, NMETA = 16, TP = SEQ + NMETA, NBP = 2, NBS = 8, TS = 32;
constexpr int MPROMPT = NBP * TP;
constexpr int MREAL = MPROMPT + NBS * TS;
constexpr int MPAD = 33280;
constexpr int NCHUNK = MPAD / 16;
constexpr int NCH_REAL = MREAL / 16;
constexpr int CH_PER_SEQ = TP / 16;
constexpr int NCT = NCHUNK / 16;
constexpr int SG = 64, SP = 64, SH = 16;
constexpr float EPS = 1e-6f;
constexpr int FP8_FROM_HL = 3;
constexpr int FP8_UP_FROM = 2 * NL;
constexpr int UPQ_FROM = 0;
constexpr float QALPHA_UNUSED = 5.5f;
constexpr float H8_SCALE = 4.0f, WD8_SCALE = 256.0f, WGU8_SCALE = 256.0f;
static_assert(MPAD % 256 == 0 && MPAD >= MREAL && MREAL % 16 == 0 && TP % 16 == 0 && TS % 4 == 0 && TP >= 8 && TS >= 8, "row geometry");

enum { I_XP = 0, I_XS, I_CACHE, I_SRE, I_SIM, I_META, I_F1N, I_F1G, I_F1U, I_F1D, I_MIXN, I_WIN, I_CONVW, I_CONVN, I_LRE, I_LIM, I_LDT, I_BRE, I_BIM, I_CRE, I_CIM, I_SD,
       I_GLU, I_SSMN, I_WOUT, I_F2N, I_F2G, I_F2U, I_F2D, I_FINN, N_IN };
constexpr size_t O_YP = 0, O_YS = O_YP + (size_t)NBP * SEQ * D, O_CVP = O_YS + (size_t)NBS * TS * D, O_REP = O_CVP + (size_t)NL * NBP * 2 * DCV,
                 O_IMP = O_REP + (size_t)NL * NBP * SG * SP, O_CVS = O_IMP + (size_t)NL * NBP * SG * SP, O_RES = O_CVS + (size_t)NL * NBS * 2 * DCV,
                 O_IMS = O_RES + (size_t)NL * NBS * SG * SP, O_END = O_IMS + (size_t)NL * NBS * SG * SP;
static_assert(O_END == 68042752, "output size");

constexpr size_t CTL_BYTES = 1u << 20;
constexpr int NRSS = 4 * NL + 1;
constexpr size_t ZERO_BYTES = CTL_BYTES;
constexpr size_t RSS_STRIDE = (size_t)MPAD * 8 + 2048;
constexpr size_t WS_RSS = CTL_BYTES;
constexpr size_t WS_XN = WS_RSS + (size_t)NRSS * RSS_STRIDE * 4;
constexpr size_t WS_W = WS_XN + (size_t)MPAD * D * 2;
constexpr size_t W_GU0 = 0;
constexpr size_t W_GU1 = W_GU0 + (size_t)2 * FF * D * 2;
constexpr size_t W_D0 = W_GU1 + (size_t)2 * FF * D * 2;
constexpr size_t W_D1 = W_D0 + (size_t)D * FF * 2;
constexpr size_t W_IN = W_D1 + (size_t)D * FF * 2;
constexpr size_t W_GLU = W_IN + (size_t)DIN * D * 2;
constexpr size_t W_OUT = W_GLU + (size_t)DSS * DSS * 2;
constexpr size_t W_SET = W_OUT + (size_t)D * D * 2;
constexpr size_t WS_WBT = WS_W + 2 * W_SET;
constexpr size_t WS_BMT = WS_WBT + (size_t)SG * 256 * 384 * 2;
constexpr size_t WS_APOW = WS_BMT + (size_t)SG * 256 * 256 * 2;
constexpr int NPOW = 18;
constexpr size_t WS_BBAR = WS_APOW + (size_t)NL * NPOW * SG * SP * 8;
constexpr size_t WS_R = WS_BBAR + (size_t)NL * SG * SP * SH * 8;
constexpr size_t WS_H = WS_R;
constexpr size_t WS_PROJ = WS_R;
constexpr size_t WS_MIXED = WS_PROJ + (size_t)MPAD * DIN * 2;
constexpr size_t WS_YS = WS_MIXED + (size_t)MPAD * D * 2;
constexpr size_t WS_SLOC = WS_YS + (size_t)MPAD * DSS * 2;
constexpr int CPG = 2304, UGLD = 384;
constexpr size_t WS_UG = WS_SLOC + (size_t)NCHUNK * SG * 128 * 4;
constexpr size_t WS_XB8 = WS_UG + (size_t)SG * CPG * UGLD * 2;
constexpr size_t WS_DUMMY_ = 0;
constexpr size_t WS_END_A = WS_H + (size_t)MPAD * FF * 2, WS_CS = WS_XB8 + (size_t)MPAD * D;
constexpr size_t WS_QF = WS_CS + (size_t)2 * 4 * FF * 4;
constexpr size_t WS_END_B = WS_QF + (size_t)MPAD * 4 + 1024;
constexpr size_t WS_END = WS_END_A > WS_END_B ? WS_END_A : WS_END_B;
static_assert(WS_R % 256 == 0 && WS_SLOC % 256 == 0, "alignment");
constexpr int CW_BAR = 4096;

constexpr int RING_OFF = 0, RING_BYTES = 131072;
constexpr int LDSCTL_OFF = RING_BYTES, MISC_OFF = LDSCTL_OFF + 320;
constexpr int RED_OFF = RING_BYTES + 512, RSSB_OFF = RED_OFF + 4096;
constexpr int LDS_BYTES = 147456;
static_assert(RSSB_OFF + 8192 <= LDS_BYTES && RSSB_OFF % 16 == 0, "LDS map");

__device__ __forceinline__ float wave_sum(float v) {
#pragma unroll
    for (int o = 1; o < 64; o <<= 1) v += __shfl_xor(v, o);
    return v;
}
__device__ __forceinline__ unsigned pkbf(float lo, float hi) { return pg8::cvt_pk_bf16(lo, hi); }
__device__ __forceinline__ float bflo(unsigned w) { return __uint_as_float(w << 16); }
__device__ __forceinline__ float bfhi(unsigned w) { return __uint_as_float(w & 0xffff0000u); }

__device__ __forceinline__ void transpose_item(const float* W, int K, int N, bf16* WT, int mode, const float* gain, LAS float* scr, int item, int lane, float f8scale = 0.f, int gk0 = 0, const float* cs8 = nullptr) {
    const int nblk = N / 32, kb = item / nblk, nb = item % nblk, k0 = 64 * kb, n0 = 32 * nb;
    const int drow0 = (mode == 0) ? n0 : (256 * (n0 >> 7) + 128 * (mode - 1) + (n0 & 127));
    const int nq = lane & 7, kr = lane >> 3;
    f32x4 v[8]; float csv[4] = {1.f, 1.f, 1.f, 1.f};
    if (cs8) {
#pragma unroll
        for (int j = 0; j < 4; ++j) csv[j] = cs8[n0 + (lane >> 3) + 8 * j]; }
#pragma unroll
    for (int i = 0; i < 8; ++i) v[i] = *(const f32x4*)(W + (size_t)(k0 + kr + 8 * i) * N + n0 + 4 * nq);
#pragma unroll
    for (int i = 0; i < 8; ++i) { const int kk_ = k0 + kr + 8 * i; const float gk = (gain && kk_ >= gk0) ? gain[kk_ - gk0] : 1.0f; LAS float* d = scr + (kr + 8 * i) * 33 + 4 * nq; d[0] = v[i].x * gk; d[1] = v[i].y * gk; d[2] = v[i].z * gk; d[3] = v[i].w * gk; }
    LDS_WAIT(); asm volatile("" ::: "memory");
    const int c = lane & 7;
#pragma unroll
    for (int j = 0; j < 4; ++j) { const int n = (lane >> 3) + 8 * j; const LAS float* s = scr + (8 * c) * 33 + n;
        if (cs8) {
            const float qs = 1.0f / csv[j]; unsigned b[8];
#pragma unroll
            for (int e = 0; e < 8; ++e) { float t = s[e * 33] * qs; t = fminf(fmaxf(t, -127.f), 127.f); b[e] = (unsigned)__float2int_rn(t) & 0xffu; }
            u32x2 o; o.x = b[0] | (b[1] << 8) | (b[2] << 16) | (b[3] << 24); o.y = b[4] | (b[5] << 8) | (b[6] << 16) | (b[7] << 24);
            *(u32x2*)((unsigned char*)WT + (size_t)(drow0 + n) * K + k0 + 8 * c) = o;
        } else if (f8scale != 0.f) {
            int w0 = __builtin_amdgcn_cvt_pk_fp8_f32(s[0 * 33] * f8scale, s[1 * 33] * f8scale, 0, false); w0 = __builtin_amdgcn_cvt_pk_fp8_f32(s[2 * 33] * f8scale, s[3 * 33] * f8scale, w0, true);
            int w1 = __builtin_amdgcn_cvt_pk_fp8_f32(s[4 * 33] * f8scale, s[5 * 33] * f8scale, 0, false); w1 = __builtin_amdgcn_cvt_pk_fp8_f32(s[6 * 33] * f8scale, s[7 * 33] * f8scale, w1, true);
            u32x2 o; o.x = (unsigned)w0; o.y = (unsigned)w1; *(u32x2*)((unsigned char*)WT + (size_t)(drow0 + n) * K + k0 + 8 * c) = o;
        } else {
        v4u o; o.x = pkbf(s[0 * 33], s[1 * 33]); o.y = pkbf(s[2 * 33], s[3 * 33]); o.z = pkbf(s[4 * 33], s[5 * 33]); o.w = pkbf(s[6 * 33], s[7 * 33]);
        *(v4u*)(WT + (size_t)(drow0 + n) * K + k0 + 8 * c) = o; } }
    LDS_WAIT(); asm volatile("" ::: "memory");
}

__device__ __forceinline__ void pmaxc_item(const float* W, int N, const float* gain, float* pmc, int item, int lane) {
    const int nblk = N / 32, kb = item / nblk, nb = item % nblk, k0 = 64 * kb, n0 = 32 * nb; const int nq = lane & 7, kr = lane >> 3;
    f32x4 v[8];
#pragma unroll
    for (int i = 0; i < 8; ++i) v[i] = *(const f32x4*)(W + (size_t)(k0 + kr + 8 * i) * N + n0 + 4 * nq);
    f32x4 m = {0.f, 0.f, 0.f, 0.f};
#pragma unroll
    for (int i = 0; i < 8; ++i) { const float gk = fabsf(gain[k0 + kr + 8 * i]); m.x = fmaxf(m.x, fabsf(v[i].x) * gk); m.y = fmaxf(m.y, fabsf(v[i].y) * gk); m.z = fmaxf(m.z, fabsf(v[i].z) * gk); m.w = fmaxf(m.w, fabsf(v[i].w) * gk); }
#pragma unroll
    for (int o = 8; o < 64; o <<= 1) { m.x = fmaxf(m.x, __shfl_xor(m.x, o)); m.y = fmaxf(m.y, __shfl_xor(m.y, o)); m.z = fmaxf(m.z, __shfl_xor(m.z, o)); m.w = fmaxf(m.w, __shfl_xor(m.w, o)); }
    if (lane < 8) *(f32x4*)(pmc + (size_t)kb * N + n0 + 4 * nq) = m;
}
__device__ __forceinline__ void colstep_reduce(const float* pmc, float* cs, int c) {
    const int q = c / FF, n = c - q * FF; const float* p = pmc + (size_t)q * 32 * FF + n; float m = 1e-30f;
#pragma unroll 8
    for (int kb = 0; kb < 32; ++kb) m = fmaxf(m, p[(size_t)kb * FF]);
    cs[c] = m * (1.0f / 127.0f);
}
__device__ __forceinline__ void gu_task(const float* W, const float* gain, unsigned char* WT, int mode, float* cs, LAS float* scr, LAS float* xch, int nb, int wave, int lane) {
    const int n0 = 32 * nb, nq = lane & 7, kr = lane >> 3, kw = 256 * wave;
    const int drow0 = 256 * (n0 >> 7) + 128 * (mode - 1) + (n0 & 127);
    f32x4 v[32];
    const unsigned loff = (unsigned)(kr * FF + 4 * nq) * 4u;
#pragma unroll
    for (int i = 0; i < 32; ++i) v[i] = *(const f32x4*)((const char*)(W + (size_t)(kw + 8 * i) * FF + n0) + loff);
    LAS float* gl = scr + 2304;
    *(LAS f32x4*)(gl + 4 * lane) = *(const f32x4*)(gain + kw + 4 * lane);
    LDS_WAIT(); asm volatile("" ::: "memory");
    f32x4 m = {0.f, 0.f, 0.f, 0.f};
#pragma unroll
    for (int i = 0; i < 32; ++i) { const float gk = gl[kr + 8 * i]; v[i] = v[i] * gk; m.x = fmaxf(m.x, fabsf(v[i].x)); m.y = fmaxf(m.y, fabsf(v[i].y)); m.z = fmaxf(m.z, fabsf(v[i].z)); m.w = fmaxf(m.w, fabsf(v[i].w)); }
#pragma unroll
    for (int o = 8; o < 64; o <<= 1) { m.x = fmaxf(m.x, __shfl_xor(m.x, o)); m.y = fmaxf(m.y, __shfl_xor(m.y, o)); m.z = fmaxf(m.z, __shfl_xor(m.z, o)); m.w = fmaxf(m.w, __shfl_xor(m.w, o)); }
    if (lane < 8) *(LAS f32x4*)(xch + wave * 32 + 4 * nq) = m;
    __syncthreads();
    float qs[4];
#pragma unroll
    for (int j = 0; j < 4; ++j) { float cm = 1e-30f;
#pragma unroll
        for (int w = 0; w < 8; ++w) cm = fmaxf(cm, xch[w * 32 + (lane >> 3) + 8 * j]);
        qs[j] = 127.0f / cm; if (wave == 0 && (lane & 7) == 0) cs[n0 + (lane >> 3) + 8 * j] = cm * (1.0f / 127.0f); }
    const int c = lane & 7;
#pragma unroll
    for (int t = 0; t < 4; ++t) {
#pragma unroll
        for (int i = 0; i < 8; ++i) { LAS float* d = scr + (kr + 8 * i) * 33 + 4 * nq; d[0] = v[8 * t + i].x; d[1] = v[8 * t + i].y; d[2] = v[8 * t + i].z; d[3] = v[8 * t + i].w; }
        LDS_WAIT(); asm volatile("" ::: "memory");
#pragma unroll
        for (int j = 0; j < 4; ++j) { const int n = (lane >> 3) + 8 * j; const LAS float* s = scr + (8 * c) * 33 + n; unsigned b[8];
#pragma unroll
            for (int e = 0; e < 8; ++e) { float x = s[e * 33] * qs[j]; x = fminf(fmaxf(x, -127.f), 127.f); b[e] = (unsigned)__float2int_rn(x) & 0xffu; }
            u32x2 o; o.x = b[0] | (b[1] << 8) | (b[2] << 16) | (b[3] << 24); o.y = b[4] | (b[5] << 8) | (b[6] << 16) | (b[7] << 24);
            *(u32x2*)(WT + (size_t)(drow0 + n) * D + kw + 64 * t + 8 * c) = o; }
        LDS_WAIT(); asm volatile("" ::: "memory");
    }
    __syncthreads();
}
static_assert((D / 64) * (FF / 32) == 5632, "gate/up item count");
__device__ __forceinline__ void quant_rows2(const bf16* x0, const bf16* x1, const float* rss0, const float* rss1, unsigned char* q0, unsigned char* q1, float* qf0, float* qf1, bool has1, int lane) {
    v4u a[2][4];
#pragma unroll
    for (int c = 0; c < 2; ++c) { const v4u* p0 = (const v4u*)(x0 + c * 1024 + 16 * lane); a[0][2 * c] = p0[0]; a[0][2 * c + 1] = p0[1]; const v4u* p1 = (const v4u*)(x1 + c * 1024 + 16 * lane); a[1][2 * c] = p1[0]; a[1][2 * c + 1] = p1[1]; }
    const float s0 = wave_sum(lane < 8 ? rss0[lane] : 0.f), s1 = wave_sum(lane < 8 ? rss1[lane] : 0.f);
    unsigned mx[2] = {0u, 0u};
#pragma unroll
    for (int w = 0; w < 2; ++w)
#pragma unroll
        for (int i = 0; i < 4; ++i)
#pragma unroll
            for (int d = 0; d < 4; ++d) { const unsigned u = a[w][i][d]; mx[w] = max(mx[w], max(u & 0x7fffu, (u >> 16) & 0x7fffu)); }
#pragma unroll
    for (int o = 1; o < 64; o <<= 1) { mx[0] = max(mx[0], (unsigned)__shfl_xor((int)mx[0], o)); mx[1] = max(mx[1], (unsigned)__shfl_xor((int)mx[1], o)); }
    const float am[2] = {fmaxf(__uint_as_float(mx[0] << 16), 1e-30f), fmaxf(__uint_as_float(mx[1] << 16), 1e-30f)};
    const float r[2] = {127.0f / am[0], 127.0f / am[1]};
    if (lane == 0) { qf0[0] = am[0] * (1.0f / 127.0f) * __builtin_amdgcn_rsqf(s0 * (1.0f / D) + EPS); if (has1) qf1[0] = am[1] * (1.0f / 127.0f) * __builtin_amdgcn_rsqf(s1 * (1.0f / D) + EPS); }
#pragma unroll
    for (int w = 0; w < 2; ++w) { if (w == 1 && !has1) break; unsigned char* q = w ? q1 : q0;
#pragma unroll
        for (int c = 0; c < 2; ++c) { v4u o;
#pragma unroll
            for (int d = 0; d < 4; ++d) {
                const unsigned w0 = a[w][2 * c + (d >> 1)][(2 * d) & 3], w1 = a[w][2 * c + (d >> 1)][(2 * d + 1) & 3];
                float t0 = bflo(w0) * r[w], t1 = bfhi(w0) * r[w], t2 = bflo(w1) * r[w], t3 = bfhi(w1) * r[w];
                t0 = fminf(fmaxf(t0, -127.f), 127.f); t1 = fminf(fmaxf(t1, -127.f), 127.f); t2 = fminf(fmaxf(t2, -127.f), 127.f); t3 = fminf(fmaxf(t3, -127.f), 127.f);
                o[d] = ((unsigned)__float2int_rn(t0) & 0xffu) | (((unsigned)__float2int_rn(t1) & 0xffu) << 8) | (((unsigned)__float2int_rn(t2) & 0xffu) << 16) | (((unsigned)__float2int_rn(t3) & 0xffu) << 24); }
            *(v4u*)(q + c * 1024 + 16 * lane) = o; } }
}
__device__ __forceinline__ void build_rows2(const float* src0, const float* src1, bf16* xb0, bf16* xb1, float* rss0, float* rss1, bool has1, int lane, unsigned char* xq0, unsigned char* xq1, float* qf0, float* qf1) {
    f32x4 v0[8], v1[8]; float s0 = 0.f, s1 = 0.f;
#pragma unroll
    for (int j = 0; j < 8; ++j) { v0[j] = src0 ? ((const f32x4*)src0 + lane)[64 * j] : (f32x4){0.f, 0.f, 0.f, 0.f}; v1[j] = src1 ? ((const f32x4*)src1 + lane)[64 * j] : (f32x4){0.f, 0.f, 0.f, 0.f}; }
#pragma unroll
    for (int j = 0; j < 8; ++j) { s0 += (v0[j].x * v0[j].x + v0[j].y * v0[j].y) + (v0[j].z * v0[j].z + v0[j].w * v0[j].w); s1 += (v1[j].x * v1[j].x + v1[j].y * v1[j].y) + (v1[j].z * v1[j].z + v1[j].w * v1[j].w); }
    u32x2* o0 = (u32x2*)xb0 + lane; u32x2* o1 = (u32x2*)xb1 + lane;
#pragma unroll
    for (int j = 0; j < 8; ++j) { u32x2 w; w.x = pkbf(v0[j].x, v0[j].y); w.y = pkbf(v0[j].z, v0[j].w); o0[64 * j] = w; if (has1) { u32x2 w1; w1.x = pkbf(v1[j].x, v1[j].y); w1.y = pkbf(v1[j].z, v1[j].w); o1[64 * j] = w1; } }
    s0 = wave_sum(s0); s1 = wave_sum(s1);
    if (lane < 8) { rss0[lane] = (lane == 0) ? s0 : 0.f; if (has1) rss1[lane] = (lane == 0) ? s1 : 0.f; }
    float a0 = 0.f, a1 = 0.f;
#pragma unroll
    for (int j = 0; j < 8; ++j) { a0 = fmaxf(a0, fmaxf(fmaxf(fabsf(v0[j].x), fabsf(v0[j].y)), fmaxf(fabsf(v0[j].z), fabsf(v0[j].w)))); a1 = fmaxf(a1, fmaxf(fmaxf(fabsf(v1[j].x), fabsf(v1[j].y)), fmaxf(fabsf(v1[j].z), fabsf(v1[j].w)))); }
#pragma unroll
    for (int o = 1; o < 64; o <<= 1) { a0 = fmaxf(a0, __shfl_xor(a0, o)); a1 = fmaxf(a1, __shfl_xor(a1, o)); }
    a0 = fmaxf(a0, 1e-30f); a1 = fmaxf(a1, 1e-30f);
    const float q0 = 127.0f / a0, q1 = 127.0f / a1;
    if (lane == 0) { qf0[0] = a0 * (1.0f / 127.0f) * __builtin_amdgcn_rsqf(s0 * (1.0f / D) + EPS); if (has1) qf1[0] = a1 * (1.0f / 127.0f) * __builtin_amdgcn_rsqf(s1 * (1.0f / D) + EPS); }
#pragma unroll
    for (int j = 0; j < 8; ++j) {
        ((unsigned*)xq0)[lane + 64 * j] = ((unsigned)__float2int_rn(v0[j].x * q0) & 0xffu) | (((unsigned)__float2int_rn(v0[j].y * q0) & 0xffu) << 8) | (((unsigned)__float2int_rn(v0[j].z * q0) & 0xffu) << 16) | (((unsigned)__float2int_rn(v0[j].w * q0) & 0xffu) << 24);
        if (has1) ((unsigned*)xq1)[lane + 64 * j] = ((unsigned)__float2int_rn(v1[j].x * q1) & 0xffu) | (((unsigned)__float2int_rn(v1[j].y * q1) & 0xffu) << 8) | (((unsigned)__float2int_rn(v1[j].z * q1) & 0xffu) << 16) | (((unsigned)__float2int_rn(v1[j].w * q1) & 0xffu) << 24); }
}
__device__ __forceinline__ void final_rows2(const bf16* src0, const bf16* src1, const float* gain, float* dst0, float* dst1, const float* rss0, const float* rss1, int lane) {
    u32x2 w0[8], w1[8];
#pragma unroll
    for (int j = 0; j < 8; ++j) { w0[j] = ((const u32x2*)src0 + lane)[64 * j]; w1[j] = dst1 ? ((const u32x2*)src1 + lane)[64 * j] : (u32x2){0u, 0u}; }
    const float q0 = lane < 8 ? rss0[lane] : 0.f, q1 = (dst1 && lane < 8) ? rss1[lane] : 0.f;
    const float r0 = 1.0f / sqrtf(wave_sum(q0) * (1.0f / D) + EPS), r1 = 1.0f / sqrtf(wave_sum(q1) * (1.0f / D) + EPS);
    const f32x4* gr = (const f32x4*)gain + lane; f32x4* o0 = (f32x4*)dst0 + lane; f32x4* o1 = (f32x4*)dst1 + lane;
#pragma unroll
    for (int j = 0; j < 8; ++j) { const f32x4 g = gr[64 * j]; o0[64 * j] = (f32x4){bflo(w0[j].x) * r0 * g.x, bfhi(w0[j].x) * r0 * g.y, bflo(w0[j].y) * r0 * g.z, bfhi(w0[j].y) * r0 * g.w};
        if (dst1) o1[64 * j] = (f32x4){bflo(w1[j].x) * r1 * g.x, bfhi(w1[j].x) * r1 * g.y, bflo(w1[j].y) * r1 * g.z, bfhi(w1[j].y) * r1 * g.w}; }
}
__device__ __forceinline__ const float* input_row(int r, const float* xp, const float* xs, const float* meta) {
    if (r < MPROMPT) { const int b = r / TP, pos = r - b * TP; return pos < NMETA ? meta + (size_t)pos * D : xp + ((size_t)b * SEQ + (pos - NMETA)) * D; }
    if (r < MREAL) return xs + (size_t)(r - MPROMPT) * D;
    return nullptr;
}

__device__ __forceinline__ void ssm_tables(int t, const float* lre_, const float* lim_, const float* ldt, const float* bre, const float* bim, f32x2* apow, f32x2* bbar) {
    const int l = t / (SG * SP), gp = t % (SG * SP), g = gp / SP;
    const double dtd = exp((double)ldt[l * SG + g]);
    const float lre = lre_[t], lim = lim_[t];
    const double xr = (double)lre * dtd, th = (double)lim * dtd;
    float c1 = 1.f, s1 = 0.f;
    for (int k = 0; k < NPOW; ++k) {
        const double kk = (k <= 16) ? (double)k : 16.0 * 65.0;
        const double ang = th * kk; const double n = rint(ang * 0.15915494309189535); const float r = (float)(ang - n * 6.283185307179586);
        const float mag = expf((float)(xr * kk)); const float cs = cosf(r), sn = sinf(r);
        apow[((size_t)(l * NPOW + k)) * (SG * SP) + gp] = (f32x2){mag * cs, mag * sn};
        if (k == 1) { c1 = cs; s1 = sn; }
    }
    const float em1 = expm1f((float)xr);
    const float hv = 0.5f * (1.0f - c1);
    const float are = em1 * c1 - 2.0f * hv, aim = (1.0f + em1) * s1;
    const float den = 1.0f / (lre * lre + lim * lim);
    const float qre = (are * lre + aim * lim) * den, qim = (aim * lre - are * lim) * den;
    const float* br = bre + (size_t)t * SH; const float* bi = bim + (size_t)t * SH; f32x2* bo = bbar + (size_t)t * SH;
#pragma unroll 4
    for (int h = 0; h < SH; ++h) { const float x = br[h], y = bi[h]; bo[h] = (f32x2){qre * x - qim * y, qre * y + qim * x}; }
}
__device__ __forceinline__ void ssm_matrices(int l, size_t t0, size_t tstride, const f32x2* apow, const f32x2* bbar, const float* cre, const float* cim, const float* dsk, bf16* WBT, bf16* BMT) {
    const f32x2* ap = apow + (size_t)l * NPOW * SG * SP; const f32x2* bb = bbar + (size_t)l * SG * SP * SH;
    const float* cr = cre + (size_t)l * SG * SH * SP; const float* ci = cim + (size_t)l * SG * SH * SP; const float* dd = dsk + (size_t)l * SG * SH;
    constexpr size_t NA = (size_t)SG * 16 * 256, NB = (size_t)SG * 256 * SP, NC = (size_t)SG * SP * 256;
    for (size_t t = t0; t < NA + NB + NC; t += tstride) {
        if (t < NA) {
            const int g = (int)(t / 4096), k = (int)(t / 256) % 16, h = (int)(t / 16) % 16, hp = (int)t % 16;
            float s = 0.f;
            for (int p = 0; p < SP; ++p) { const f32x2 a = ap[((size_t)k * SG + g) * SP + p], b = bb[((size_t)g * SP + p) * SH + hp]; const float x = cr[((size_t)g * SH + h) * SP + p], y = ci[((size_t)g * SH + h) * SP + p];
                const float abr = a.x * b.x - a.y * b.y, abi = a.x * b.y + a.y * b.x; s += x * abr - y * abi; }
            if (k == 0 && h == hp) s += dd[g * SH + h];
            const unsigned short sv = (unsigned short)(pkbf(s, 0.f) & 0xffffu);
            for (int m = 0; m + k < 16; ++m) { WBT[((size_t)g * 256 + (size_t)(k + m) * 16 + h) * 384 + m * 16 + hp] = sv;
                if (k > 0) WBT[((size_t)g * 256 + (size_t)m * 16 + h) * 384 + (k + m) * 16 + hp] = 0; }
        } else if (t < NA + NB) {
            const size_t u = t - NA; const int g = (int)(u / 16384), i = (int)(u / 1024) % 16, h = (int)(u / 64) % 16, p = (int)u % 64;
            const f32x2 a = ap[((size_t)(i + 1) * SG + g) * SP + p]; const float x = cr[((size_t)g * SH + h) * SP + p], y = ci[((size_t)g * SH + h) * SP + p];
            const size_t o = ((size_t)g * 256 + i * 16 + h) * 384 + 256 + p;
            WBT[o] = (unsigned short)(pkbf(x * a.x - y * a.y, 0.f) & 0xffffu); WBT[o + 64] = (unsigned short)(pkbf(-(x * a.y + y * a.x), 0.f) & 0xffffu);
        } else {
            const size_t u = t - NA - NB; const int g = (int)(u / 16384), p = (int)(u / 256) % 64, j = (int)(u / 16) % 16, hp = (int)u % 16;
            const f32x2 a = ap[((size_t)(15 - j) * SG + g) * SP + p], b = bb[((size_t)g * SP + p) * SH + hp];
            const size_t o = ((size_t)g * 256 + p) * 256 + j * 16 + hp;
            BMT[o] = (unsigned short)(pkbf(a.x * b.x - a.y * b.y, 0.f) & 0xffffu); BMT[o + (size_t)64 * 256] = (unsigned short)(pkbf(a.x * b.y + a.y * b.x, 0.f) & 0xffffu);
        }
    }
}

__device__ __forceinline__ float gelu_tanh(float x) { const float z = 0.7978845608028654f * (x + 0.044715f * x * x * x); return x * __builtin_amdgcn_rcpf(1.0f + __expf(-2.0f * z)); }

__device__ __forceinline__ void conv_rows4(int r0, int l, const bf16* PROJ, bf16* MIXED, const float* cache, const float* convw, const float* cgain, float* out, int lane) {
    if (r0 >= MREAL) {
#pragma unroll
        for (int q = 0; q < 4; ++q) { v4u* mo = (v4u*)(MIXED + (size_t)(r0 + q) * D); mo[lane] = (v4u){0u, 0u, 0u, 0u}; mo[64 + lane] = (v4u){0u, 0u, 0u, 0u}; }
        return; }
    int pos0, T; const float* cb = nullptr; float* ob;
    if (r0 < MPROMPT) { const int b = r0 / TP; pos0 = r0 - b * TP; T = TP; ob = out + O_CVP + (size_t)(l * NBP + b) * 2 * DCV; }
    else { const int s = (r0 - MPROMPT) / TS; pos0 = (r0 - MPROMPT) - s * TS; T = TS; cb = cache + (size_t)(l * NBS + s) * 2 * DCV; ob = out + O_CVS + (size_t)(l * NBS + s) * 2 * DCV; }
    float ss[4] = {0.f, 0.f, 0.f, 0.f}; float y[4][16];
#pragma unroll
    for (int hf = 0; hf < 2; ++hf) {
        const int c0 = hf * 512 + lane * 8;
        const bf16* pr = PROJ + (size_t)r0 * DIN + c0;
        v4u cg[6], hg[6], bg[4];
#pragma unroll
        for (int j = 0; j < 6; ++j) { if (j >= 2 || pos0 >= 2 - j) { cg[j] = *(const v4u*)(pr + (ptrdiff_t)(j - 2) * DIN + DCV); hg[j] = *(const v4u*)(pr + (ptrdiff_t)(j - 2) * DIN + 2 * DCV); } else { cg[j] = (v4u){0u, 0u, 0u, 0u}; hg[j] = cg[j]; } }
#pragma unroll
        for (int q = 0; q < 4; ++q) bg[q] = *(const v4u*)(pr + (size_t)q * DIN);
        float cbv[2][8];
#pragma unroll
        for (int e = 0; e < 8; ++e) { cbv[0][e] = (cb && pos0 < 2) ? cb[c0 + e] : 0.f; cbv[1][e] = (cb && pos0 < 1) ? cb[DCV + c0 + e] : 0.f; }
        const float* w = convw + (size_t)l * 3 * DCV + c0;
        float w0[8], w1[8], w2[8];
#pragma unroll
        for (int e = 0; e < 8; ++e) { w0[e] = w[e]; w1[e] = w[DCV + e]; w2[e] = w[2 * DCV + e]; }
        float v[6][8];
#pragma unroll
        for (int j = 0; j < 6; ++j)
#pragma unroll
            for (int qq = 0; qq < 4; ++qq) { v[j][2 * qq] = bflo(cg[j][qq]) * bflo(hg[j][qq]); v[j][2 * qq + 1] = bfhi(cg[j][qq]) * bfhi(hg[j][qq]); }
        if (pos0 == 0) {
#pragma unroll
            for (int e = 0; e < 8; ++e) { v[0][e] = cbv[0][e]; v[1][e] = cbv[1][e]; } }
#pragma unroll
        for (int q = 0; q < 4; ++q)
#pragma unroll
            for (int e = 0; e < 8; ++e) { const float bgv = (e & 1) ? bfhi(bg[q][e >> 1]) : bflo(bg[q][e >> 1]);
                const float yy = bgv * (w0[e] * v[q][e] + w1[e] * v[q + 1][e] + w2[e] * v[q + 2][e]); y[q][hf * 8 + e] = yy; ss[q] += yy * yy; }
        if (pos0 + 4 == T) {
#pragma unroll
            for (int e = 0; e < 8; ++e) { ob[c0 + e] = v[4][e]; ob[DCV + c0 + e] = v[5][e]; } }
    }
#pragma unroll
    for (int q = 0; q < 4; ++q) { const float rn = 1.0f / sqrtf(wave_sum(ss[q]) * (1.0f / DCV) + EPS); v4u* mo = (v4u*)(MIXED + (size_t)(r0 + q) * D);
#pragma unroll
        for (int hf = 0; hf < 2; ++hf) { const float* g = cgain + (size_t)l * DCV + hf * 512 + lane * 8; v4u wv;
#pragma unroll
            for (int qq = 0; qq < 4; ++qq) wv[qq] = pkbf(y[q][hf * 8 + 2 * qq] * rn * g[2 * qq], y[q][hf * 8 + 2 * qq + 1] * rn * g[2 * qq + 1]);
            mo[hf * 64 + lane] = wv; } }
}
__device__ __forceinline__ void norm_s_row(int r, bf16* MIXED, const float* gain, int lane) {
    v4u* p = (v4u*)(MIXED + (size_t)r * D + DCV); const v4u a = p[lane], b = p[64 + lane]; float v[16]; float ss = 0.f;
#pragma unroll
    for (int q = 0; q < 4; ++q) { v[2 * q] = bflo(a[q]); v[2 * q + 1] = bfhi(a[q]); v[8 + 2 * q] = bflo(b[q]); v[8 + 2 * q + 1] = bfhi(b[q]); }
#pragma unroll
    for (int e = 0; e < 16; ++e) ss += v[e] * v[e];
    const float rn = 1.0f / sqrtf(wave_sum(ss) * (1.0f / DSS) + EPS);
    v4u wa, wb; const float* g0 = gain + lane * 8; const float* g1 = gain + 512 + lane * 8;
#pragma unroll
    for (int q = 0; q < 4; ++q) { wa[q] = pkbf(v[2 * q] * rn * g0[2 * q], v[2 * q + 1] * rn * g0[2 * q + 1]); wb[q] = pkbf(v[8 + 2 * q] * rn * g1[2 * q], v[8 + 2 * q + 1] * rn * g1[2 * q + 1]); }
    p[lane] = wa; p[64 + lane] = wb;
}

template <bool WRITE> __device__ __forceinline__ void carry_run(const float* sl, bf16* so, int nc, const f32x2 a, float& sr, float& si) {
    constexpr size_t CS = (size_t)SG * 128, CO = (size_t)UGLD; constexpr int NB = 16;
#define CARRY_LOAD(LR, LI, c0) do { _Pragma("unroll") for (int q = 0; q < NB; ++q) { LR[q] = sl[(size_t)((c0) + q) * CS]; LI[q] = sl[(size_t)((c0) + q) * CS + 64]; } } while (0)
#define CARRY_STEP(LR, LI, c0) do { _Pragma("unroll") for (int q = 0; q < NB; ++q) { \
        if (WRITE) { so[(size_t)((c0) + q) * CO] = (unsigned short)(pkbf(sr, 0.f) & 0xffffu); so[(size_t)((c0) + q) * CO + 64] = (unsigned short)(pkbf(si, 0.f) & 0xffffu); } \
        const float nr = a.x * sr - a.y * si + LR[q], ni = a.x * si + a.y * sr + LI[q]; sr = nr; si = ni; } } while (0)
    float ar[NB], ai[NB], br[NB], bi[NB];
    int c = 0;
    if (nc >= NB) CARRY_LOAD(ar, ai, 0);
    while (c + NB <= nc) {
        if (c + 2 * NB <= nc) CARRY_LOAD(br, bi, c + NB);
        CARRY_STEP(ar, ai, c); c += NB;
        if (c + NB > nc) break;
        if (c + 2 * NB <= nc) CARRY_LOAD(ar, ai, c + NB);
        CARRY_STEP(br, bi, c); c += NB;
    }
#undef CARRY_LOAD
#undef CARRY_STEP
    for (; c < nc; ++c) { const float lr = sl[(size_t)c * CS], li = sl[(size_t)c * CS + 64];
        if (WRITE) { so[(size_t)c * CO] = (unsigned short)(pkbf(sr, 0.f) & 0xffffu); so[(size_t)c * CO + 64] = (unsigned short)(pkbf(si, 0.f) & 0xffffu); }
        const float nr = a.x * sr - a.y * si + lr, ni = a.x * si + a.y * sr + li; sr = nr; si = ni; }
}
constexpr int CSEG = 65, NSEG = 16;
static_assert(NSEG * CSEG >= CH_PER_SEQ && (NSEG - 1) * CSEG < CH_PER_SEQ, "carry segments");
__device__ __forceinline__ void carry_totals2(const float* sa, int na, const float* sb, int nb, const f32x2 a, float& ar, float& ai, float& br, float& bi) {
    constexpr size_t CS = (size_t)SG * 128; constexpr int NB = 8;
    const int nmin = na < nb ? na : nb; int c = 0;
    for (; c + NB <= nmin; c += NB) { float xr[NB], xi[NB], yr[NB], yi[NB];
#pragma unroll
        for (int q = 0; q < NB; ++q) { xr[q] = sa[(size_t)(c + q) * CS]; xi[q] = sa[(size_t)(c + q) * CS + 64]; yr[q] = sb[(size_t)(c + q) * CS]; yi[q] = sb[(size_t)(c + q) * CS + 64]; }
#pragma unroll
        for (int q = 0; q < NB; ++q) { const float n0 = a.x * ar - a.y * ai + xr[q], n1 = a.x * ai + a.y * ar + xi[q]; ar = n0; ai = n1; const float m0 = a.x * br - a.y * bi + yr[q], m1 = a.x * bi + a.y * br + yi[q]; br = m0; bi = m1; } }
    for (int k = c; k < na; ++k) { const float x0 = sa[(size_t)k * CS], x1 = sa[(size_t)k * CS + 64]; const float n0 = a.x * ar - a.y * ai + x0, n1 = a.x * ai + a.y * ar + x1; ar = n0; ai = n1; }
    for (int k = c; k < nb; ++k) { const float y0 = sb[(size_t)k * CS], y1 = sb[(size_t)k * CS + 64]; const float m0 = a.x * br - a.y * bi + y0, m1 = a.x * bi + a.y * br + y1; br = m0; bi = m1; }
}
__device__ __forceinline__ void ssm_carry_prompt(int b, int g, int hb, int l, const f32x2* apow, const float* SLOC, bf16* UG, float* out, LAS float* sh, int wave, int lane) {
    const f32x2 a = apow[((size_t)(l * NPOW + 16) * SG + g) * SP + lane], aseg = apow[((size_t)(l * NPOW + 17) * SG + g) * SP + lane];
    const int seg = 8 * hb + wave, cs = seg * CSEG, len = (CH_PER_SEQ - cs) < CSEG ? (CH_PER_SEQ - cs) : CSEG, c0 = b * CH_PER_SEQ + cs;
    const float* sl = SLOC + ((size_t)c0 * SG + g) * 128 + lane; bf16* so = UG + ((size_t)g * CPG + c0) * UGLD + 256 + lane;
    float tr = 0.f, ti = 0.f, pr = 0.f, pi = 0.f;
    if (hb) { const float* sp = SLOC + ((size_t)(b * CH_PER_SEQ + wave * CSEG) * SG + g) * 128 + lane; carry_totals2(sp, CSEG, sl, len, a, pr, pi, tr, ti);
        sh[(wave * 2) * 64 + lane] = pr; sh[(wave * 2 + 1) * 64 + lane] = pi; }
    else carry_run<false>(sl, so, len, a, tr, ti);
    sh[(seg * 2) * 64 + lane] = tr; sh[(seg * 2 + 1) * 64 + lane] = ti;
    LDS_WAIT(); __syncthreads();
    float sr = 0.f, si = 0.f;
    for (int w = 0; w < seg; ++w) { const float xr = sh[(w * 2) * 64 + lane], xi = sh[(w * 2 + 1) * 64 + lane]; const float nr = aseg.x * sr - aseg.y * si + xr, ni = aseg.x * si + aseg.y * sr + xi; sr = nr; si = ni; }
    carry_run<true>(sl, so, len, a, sr, si);
    if (seg == NSEG - 1) { out[O_REP + ((size_t)(l * NBP + b) * SG + g) * SP + lane] = sr; out[O_IMP + ((size_t)(l * NBP + b) * SG + g) * SP + lane] = si; }
    __syncthreads();
}
__device__ __forceinline__ void ssm_carry_small(int w, int l, const f32x2* apow, const float* SLOC, bf16* UG, const float* sre, const float* sim, float* out, int lane) {
    if (w >= NBS * SG) { const int u = w - NBS * SG; const int c = NCH_REAL + u / SG, g = u % SG; if (c >= NCHUNK) return;
        ((unsigned*)(UG + ((size_t)g * CPG + c) * UGLD + 256))[lane] = 0u; return; }
    const int s = w / SG, g = w % SG, c0 = NBP * CH_PER_SEQ + s * (TS / 16); const size_t o = ((size_t)(l * NBS + s) * SG + g) * SP + lane;
    float sr = sre[o], si = sim[o];
    const f32x2 a = apow[((size_t)(l * NPOW + 16) * SG + g) * SP + lane];
    carry_run<true>(SLOC + ((size_t)c0 * SG + g) * 128 + lane, UG + ((size_t)g * CPG + c0) * UGLD + 256 + lane, TS / 16, a, sr, si);
    out[O_RES + o] = sr; out[O_IMS + o] = si;
}
struct Args { const float* in[N_IN]; float* out; unsigned char* ws; };
static_assert(sizeof(Args) == 8 * (N_IN + 2), "no padding in Args");
typedef const __attribute__((address_space(4))) Args* ArgsP;
#ifdef PROBE_REP
#define PROBE_N(w) ((PROBE_WHICH == (w) || (PROBE_WHICH == 99 && (w) != 6)) ? PROBE_REP : 1)
#define PROBE_SET_REP(S) do { if (PROBE_WHICH == 1 || PROBE_WHICH == 99) (S).rep = PROBE_REP; } while (0)
#define PROBE_SET_REP3(S) do { if (PROBE_WHICH == 3 || PROBE_WHICH == 99) (S).rep = PROBE_REP; } while (0)
#define PROBE_SET_REP_R(S, E) do { if (PROBE_WHICH == 2 || PROBE_WHICH == 99) { (S).rep = PROBE_REP; (E).scale *= 1.0f / PROBE_REP; } } while (0)
#define PROBE_UNSCALE_R(E) do { if (PROBE_WHICH == 2 || PROBE_WHICH == 99) { (E).scale *= (float)PROBE_REP; } } while (0)
#else
#define PROBE_N(w) 1
#define PROBE_SET_REP(S) do {} while (0)
#define PROBE_SET_REP3(S) do {} while (0)
#define PROBE_SET_REP_R(S, E) do {} while (0)
#define PROBE_UNSCALE_R(E) do {} while (0)
#endif

#define PHASE_BEGIN() \
    int tid = threadIdx.x; asm volatile("" : "+v"(tid)); \
    ArgsP A = (ArgsP)__builtin_amdgcn_kernarg_segment_ptr(); asm volatile("" : "+s"(A)); \
    const int lane = tid & 63, wave = __builtin_amdgcn_readfirstlane(tid >> 6); \
    const int gw = vcu * NWAVES + wave, NGW = G * NWAVES; \
    unsigned char* ws = A->ws; (void)lane; (void)gw; (void)NGW; (void)ws;

__device__ __forceinline__ void convert_layer(int l, ArgsP A, unsigned char* ws, LAS float* scr, int gw, int NGW, int lane) {
    unsigned char* wset = ws + WS_W + (size_t)(l & 1) * W_SET;
    constexpr int I_DN = (FF / 64) * (D / 32), I_IN = (D / 64) * (DIN / 32), I_GL = (DSS / 64) * (DSS / 32), I_OUT = (D / 64) * (D / 32);
    constexpr int NITEMS = 2 * I_DN + I_IN + I_GL + I_OUT;
    for (int it = gw; it < NITEMS; it += NGW) {
        int r = it;
        if (r < 2 * I_DN) { const int q = r / I_DN; r -= q * I_DN;
            transpose_item(A->in[q ? I_F2D : I_F1D] + (size_t)l * FF * D, FF, D, (bf16*)(wset + (q ? W_D1 : W_D0)), 0, nullptr, scr, r, lane, (2 * l + q >= FP8_FROM_HL) ? WD8_SCALE : 0.f); continue; }
        r -= 2 * I_DN;
        if (r < I_IN) { transpose_item(A->in[I_WIN] + (size_t)l * D * DIN, D, DIN, (bf16*)(wset + W_IN), 0, A->in[I_MIXN] + (size_t)l * D, scr, r, lane); continue; }
        r -= I_IN;
        if (r < I_GL) { transpose_item(A->in[I_GLU] + (size_t)l * DSS * DSS, DSS, DSS, (bf16*)(wset + W_GLU), 0, nullptr, scr, r, lane); continue; }
        r -= I_GL;
        transpose_item(A->in[I_WOUT] + (size_t)l * D * D, D, D, (bf16*)(wset + W_OUT), 0, A->in[I_SSMN] + (size_t)l * DSS, scr, r, lane, 0.f, DCV);
    }
}
__device__ __forceinline__ void convert_gu(int l, ArgsP A, unsigned char* ws, LAS float* scr, LAS float* xch, int cu, int ncu, int wave, int lane) {
    unsigned char* wset = ws + WS_W + (size_t)(l & 1) * W_SET;
    for (int it = cu; it < 4 * (FF / 32); it += ncu) { const int q = it / (FF / 32), nb = it - q * (FF / 32);
        gu_task(A->in[q == 0 ? I_F1G : q == 1 ? I_F1U : q == 2 ? I_F2G : I_F2U] + (size_t)l * D * FF, A->in[q < 2 ? I_F1N : I_F2N] + (size_t)l * D, wset + (q < 2 ? W_GU0 : W_GU1), 1 + (q & 1),
                (float*)(ws + WS_CS) + (size_t)((l & 1) * 4 + q) * FF, scr, xch, nb, wave, lane); }
}

__global__ void __launch_bounds__(NWAVES * 64, 2) hymba_fwd(Args args_unused) {
    extern __shared__ __attribute__((aligned(16))) unsigned char lds_raw[];
    LAS unsigned char* lds = (LAS unsigned char*)lds_raw;
    const int G = gridDim.x; const int bx = blockIdx.x; const int vcu = (G % 8 == 0) ? (bx % 8) * (G / 8) + bx / 8 : bx;
    XcdBarrier bar;
    {
        PHASE_BEGIN();
        for (int u = tid; u < (LDS_BYTES - LDSCTL_OFF) / 4; u += NWAVES * 64) ((LAS unsigned*)(lds + LDSCTL_OFF))[u] = 0u;
        __syncthreads();
        bar = xcd_barrier_post((unsigned*)(ws) + CW_BAR, (volatile LAS unsigned*)(lds + MISC_OFF) + 8);
    }
#define GRID_BAR() do { for (int prep_ = 0; prep_ < PROBE_N(6); ++prep_) xcd_barrier(bar); } while (0)
    {
        PHASE_BEGIN();
        for (int prep = 0; prep < PROBE_N(7); ++prep)
        for (int t = bx * (NWAVES * 64) + tid; t < NL * SG * SP; t += G * NWAVES * 64)
            ssm_tables(t, A->in[I_LRE], A->in[I_LIM], A->in[I_LDT], A->in[I_BRE], A->in[I_BIM], (f32x2*)(ws + WS_APOW), (f32x2*)(ws + WS_BBAR));
    }
    {
        PHASE_BEGIN();
        for (int prep = 0; prep < PROBE_N(9); ++prep) convert_gu(0, A, ws, (LAS float*)(lds + RING_OFF + wave * 16384), (LAS float*)(lds + RING_OFF + 12288), vcu, G, wave, lane);
        for (int prep = 0; prep < PROBE_N(9); ++prep) convert_layer(0, A, ws, (LAS float*)(lds + RING_OFF + wave * 16384), gw, NGW, lane);
    }
    {
        PHASE_BEGIN();
        v4u* z = (v4u*)(ws + WS_BMT);
        for (int i = bx * (NWAVES * 64) + tid; i < SG * 128 * 256 * 2 / 16; i += G * NWAVES * 64) { const int g = i / (128 * 256 * 2 / 16), o = i % (128 * 256 * 2 / 16); z[(size_t)g * (256 * 256 * 2 / 16) + (128 * 256 * 2 / 16) + o] = (v4u){0u, 0u, 0u, 0u}; }
    }
    {
        PHASE_BEGIN();
        bf16* XB = (bf16*)(ws + WS_XN); float* rss = (float*)(ws + WS_RSS);
        const float* xp = A->in[I_XP]; const float* xs = A->in[I_XS]; const float* meta = A->in[I_META];
        for (int prep = 0; prep < PROBE_N(7); ++prep)
        for (int r = gw; r < MPAD; r += 2 * NGW) { const int r1 = r + NGW; const bool h1 = r1 < MPAD; const int rr = h1 ? r1 : r;
            build_rows2(input_row(r, xp, xs, meta), h1 ? input_row(r1, xp, xs, meta) : nullptr, XB + (size_t)r * D, XB + (size_t)rr * D, rss + (size_t)r * 8, rss + (size_t)rr * 8, h1, lane,
                        ws + WS_XB8 + (size_t)r * D, ws + WS_XB8 + (size_t)rr * D, (float*)(ws + WS_QF) + r, (float*)(ws + WS_QF) + rr); }
    }
    GRID_BAR();
    for (int hl = 0; hl < 2 * NL; ++hl) {
        const int l = hl >> 1, second = hl & 1;
        if (hl >= UPQ_FROM && hl > 0) {
            PHASE_BEGIN();
            const bf16* XB = (const bf16*)(ws + WS_XN); unsigned char* XQ = ws + WS_XB8; const float* rss = (const float*)(ws + WS_RSS) + (size_t)(3 * l + (second ? 2 : 0)) * RSS_STRIDE;
            for (int prep = 0; prep < PROBE_N(8); ++prep)
            for (int r = gw; r < MPAD; r += 2 * NGW) { const int r1 = r + NGW; const bool h1 = r1 < MPAD; const int rr = h1 ? r1 : r;
                quant_rows2(XB + (size_t)r * D, XB + (size_t)rr * D, rss + (size_t)r * 8, rss + (size_t)rr * 8, XQ + (size_t)r * D, XQ + (size_t)rr * D, (float*)(ws + WS_QF) + r, (float*)(ws + WS_QF) + rr, h1, lane); }
        }
        if (hl >= UPQ_FROM && hl > 0) GRID_BAR();
        if (hl >= UPQ_FROM) {
            PHASE_BEGIN();
            const float* cs = (const float*)(ws + WS_CS) + (size_t)((l & 1) * 4 + 2 * second) * FF;
            pg8::Gemm g{(const bf16*)(ws + WS_XB8), (const bf16*)(ws + WS_W + (size_t)(l & 1) * W_SET + (second ? W_GU1 : W_GU0)), MPAD, 2 * FF, D / 2, D / 2, D / 2, 0, 0};   pg8::StaticOrder S; S.init(MPAD, 2 * FF, G, bx); PROBE_SET_REP(S);
            pg8::EpiSwigluQ E{(const float*)(ws + WS_QF), (unsigned char*)(ws + WS_H), cs, FF, cs + FF, (hl >= FP8_FROM_HL) ? 1 : 0, (hl >= FP8_FROM_HL) ? H8_SCALE : 1.0f, (const LAS float*)(lds + RSSB_OFF)};
            S.split = 1;
            S.pass = 0; pg8::gemm_phase<pg8::EpiSwigluQ, pg8::StaticOrder, true, true, 2, false>(lds + RING_OFF, g, S, E, tid); S.pass = 1; pg8::gemm_phase<pg8::EpiSwigluQ, pg8::StaticOrder, true, true, 2, true>(lds + RING_OFF, g, S, E, tid);
        } else
#ifdef PROBE_SPLIT
        for (int part = 0; part < 2; ++part)
#endif
        {
            PHASE_BEGIN();
            pg8::Gemm g{(const bf16*)(ws + WS_XN), (const bf16*)(ws + WS_W + (size_t)(l & 1) * W_SET + (second ? W_GU1 : W_GU0)), MPAD, 2 * FF, D, D, D, 0, 0}; pg8::StaticOrder S; S.init(MPAD, 2 * FF, G, bx); PROBE_SET_REP(S);
#ifdef PROBE_SPLIT
            if (part == 0) S.r1 = 11; else S.r0 = 11;
#endif
            pg8::EpiSwiglu E{(unsigned char*)(ws + WS_H), FF, (const float*)(ws + WS_RSS) + (size_t)(3 * l + (second ? 2 : 0)) * RSS_STRIDE, (const LAS float*)(lds + RSSB_OFF), 1.0f / D, EPS, (hl >= FP8_FROM_HL) ? H8_SCALE : 1.0f, 1.0f, (hl >= FP8_FROM_HL) ? 1 : 0};
            S.split = 1;
            S.pass = 0; pg8::gemm_phase<pg8::EpiSwiglu, pg8::StaticOrder, true, true, false, false>(lds + RING_OFF, g, S, E, tid); S.pass = 1; pg8::gemm_phase<pg8::EpiSwiglu, pg8::StaticOrder, true, true, false, true>(lds + RING_OFF, g, S, E, tid);
#ifdef PROBE_SPLIT
            if (part == 0) GRID_BAR();
#endif
        }
        GRID_BAR();
        if (hl >= FP8_FROM_HL) {
            PHASE_BEGIN();
            pg8::Gemm g{(const bf16*)(ws + WS_H), (const bf16*)(ws + WS_W + (size_t)(l & 1) * W_SET + (second ? W_D1 : W_D0)), MPAD, D, FF / 2, FF / 2, FF / 2, 0, 0};   pg8::StaticOrder S; S.init(MPAD, D, G, bx);
            pg8::EpiResidNorm<false> E{(bf16*)(ws + WS_XN), D, 0.5f / (H8_SCALE * WD8_SCALE), (float*)(ws + WS_RSS) + (size_t)(second ? 3 * (l + 1) : 3 * l + 1) * RSS_STRIDE, (second && hl + 1 >= FP8_UP_FROM && hl + 1 < 2 * NL) ? (unsigned char*)(ws + WS_XB8) : nullptr, (LAS float*)(lds + RED_OFF), nullptr, nullptr, 0.f, 0.f};
            PROBE_SET_REP_R(S, E);
            S.split = 1;
            S.pass = 0; pg8::gemm_phase<pg8::EpiResidNorm<false>, pg8::StaticOrder, true, true, true, false>(lds + RING_OFF, g, S, E, tid); S.pass = 1; PROBE_UNSCALE_R(E); pg8::gemm_phase<pg8::EpiResidNorm<false>, pg8::StaticOrder, true, true, true, true>(lds + RING_OFF, g, S, E, tid);
        } else {
            PHASE_BEGIN();
            pg8::Gemm g{(const bf16*)(ws + WS_H), (const bf16*)(ws + WS_W + (size_t)(l & 1) * W_SET + (second ? W_D1 : W_D0)), MPAD, D, FF, FF, FF, 0, 0}; pg8::StaticOrder S; S.init(MPAD, D, G, bx);
            pg8::EpiResidNorm<false> E{(bf16*)(ws + WS_XN), D, 0.5f, (float*)(ws + WS_RSS) + (size_t)(second ? 3 * (l + 1) : 3 * l + 1) * RSS_STRIDE, (second && hl + 1 >= FP8_UP_FROM && hl + 1 < 2 * NL) ? (unsigned char*)(ws + WS_XB8) : nullptr, (LAS float*)(lds + RED_OFF), nullptr, nullptr, 0.f, 0.f};
            PROBE_SET_REP_R(S, E);
            S.split = 1;
            S.pass = 0; pg8::gemm_phase<pg8::EpiResidNorm<false>, pg8::StaticOrder, true, true, false, false>(lds + RING_OFF, g, S, E, tid); S.pass = 1; PROBE_UNSCALE_R(E); pg8::gemm_phase<pg8::EpiResidNorm<false>, pg8::StaticOrder, true, true, false, true>(lds + RING_OFF, g, S, E, tid);
        }
        if (l + 1 < NL) {
            PHASE_BEGIN();
            constexpr int NTAIL = 2 * (((MPAD / 256) * (D / 256)) % 256);
            for (int prep = 0; prep < PROBE_N(9); ++prep)
            if (G > 2 * NTAIL) { if (bx >= NTAIL) { if (!second) convert_layer(l + 1, A, ws, (LAS float*)(lds + RING_OFF + wave * 16384), (bx - NTAIL) * NWAVES + wave, (G - NTAIL) * NWAVES, lane);
                                                     else convert_gu(l + 1, A, ws, (LAS float*)(lds + RING_OFF + wave * 16384), (LAS float*)(lds + RING_OFF + 12288), bx - NTAIL, G - NTAIL, wave, lane); } }
            else { if (!second) convert_layer(l + 1, A, ws, (LAS float*)(lds + RING_OFF + wave * 16384), gw, NGW, lane); else convert_gu(l + 1, A, ws, (LAS float*)(lds + RING_OFF + wave * 16384), (LAS float*)(lds + RING_OFF + 12288), bx, G, wave, lane); }
        }
        GRID_BAR();
        if (second) continue;
        {
            PHASE_BEGIN();
            pg8::Gemm g{(const bf16*)(ws + WS_XN), (const bf16*)(ws + WS_W + (size_t)(l & 1) * W_SET + W_IN), MPAD, DIN, D, D, D, 0, 0}; pg8::StaticOrder S; S.init(MPAD, DIN, G, bx); PROBE_SET_REP(S);
            pg8::EpiStoreBf16 E{(bf16*)(ws + WS_PROJ), DIN, (const float*)(ws + WS_RSS) + (size_t)(3 * l + 1) * RSS_STRIDE, (const LAS float*)(lds + RSSB_OFF), 1.0f / D, EPS, (bf16*)(ws + WS_UG), 3 * DCV, CPG, UGLD};
            S.split = 1;
            S.pass = 0; pg8::gemm_phase<pg8::EpiStoreBf16, pg8::StaticOrder, true, true, false, false>(lds + RING_OFF, g, S, E, tid); S.pass = 1; pg8::gemm_phase<pg8::EpiStoreBf16, pg8::StaticOrder, true, true, false, true>(lds + RING_OFF, g, S, E, tid);
        }
        {
            PHASE_BEGIN();
            for (int prep = 0; prep < PROBE_N(5); ++prep)
            {
                constexpr int NT_IN = 2 * (((MPAD / 256) * (DIN / 256)) % 256);
                const bool sub = G > 2 * NT_IN; if (!sub || bx >= NT_IN)
                ssm_matrices(l, (size_t)(sub ? bx - NT_IN : bx) * (NWAVES * 64) + tid, (size_t)(sub ? G - NT_IN : G) * NWAVES * 64, (const f32x2*)(ws + WS_APOW), (const f32x2*)(ws + WS_BBAR), A->in[I_CRE], A->in[I_CIM], A->in[I_SD],
                         (bf16*)(ws + WS_WBT), (bf16*)(ws + WS_BMT)); }
        }
        GRID_BAR();
        {
            PHASE_BEGIN();
            const bf16* PROJ = (const bf16*)(ws + WS_PROJ);
            for (int prep = 0; prep < PROBE_N(3); ++prep) {
            { bf16* MIXED = (bf16*)(ws + WS_MIXED); const float* cache = A->in[I_CACHE]; const float* convw = A->in[I_CONVW]; const float* cgain = A->in[I_CONVN]; float* out = A->out;
              for (int r = 4 * gw; r < MPAD; r += 4 * NGW) conv_rows4(r, l, PROJ, MIXED, cache, convw, cgain, out, lane); }
            }
        }
        {
            PHASE_BEGIN();
            pg8::Gemm g{(const bf16*)(ws + WS_UG), (const bf16*)(ws + WS_BMT), SG * CPG, 256, 256, UGLD, 256, CPG / 256, (size_t)256 * 256 * 2}; pg8::StaticOrder S; S.init(SG * CPG, 256, G, bx);
            pg8::EpiSloc E{(float*)(ws + WS_SLOC), CPG, NCHUNK, SG};
            PROBE_SET_REP3(S);
            S.split = 1;
            S.pass = 0; pg8::gemm_phase<pg8::EpiSloc, pg8::StaticOrder, true, true, false, false>(lds + RING_OFF, g, S, E, tid); S.pass = 1; pg8::gemm_phase<pg8::EpiSloc, pg8::StaticOrder, true, true, false, true>(lds + RING_OFF, g, S, E, tid);
        }
        GRID_BAR();
        {
            PHASE_BEGIN();
            const f32x2* apow = (const f32x2*)(ws + WS_APOW); const float* SLOC = (const float*)(ws + WS_SLOC); bf16* UG = (bf16*)(ws + WS_UG);
            for (int prep = 0; prep < PROBE_N(3); ++prep) {
            for (int pi = vcu; pi < 2 * NBP * SG; pi += G) ssm_carry_prompt((pi >> 1) / SG, (pi >> 1) % SG, pi & 1, l, apow, SLOC, UG, A->out, (LAS float*)(lds + RING_OFF), wave, lane);
            for (int w = gw; w < NBS * SG + (NCHUNK - NCH_REAL) * SG; w += NGW) ssm_carry_small(w, l, apow, SLOC, UG, A->in[I_SRE], A->in[I_SIM], A->out, lane);
            }
        }
        GRID_BAR();
        {
            PHASE_BEGIN();
            pg8::Gemm g{(const bf16*)(ws + WS_UG), (const bf16*)(ws + WS_WBT), SG * CPG, 256, UGLD, UGLD, UGLD, CPG / 256, (size_t)256 * UGLD * 2}; pg8::StaticOrder S; S.init(SG * CPG, 256, G, bx);
            pg8::EpiYs E{(bf16*)(ws + WS_YS), DSS, CPG, NCHUNK};
            PROBE_SET_REP3(S);
            S.split = 1;
            S.pass = 0; pg8::gemm_phase<pg8::EpiYs, pg8::StaticOrder, true, true, false, false>(lds + RING_OFF, g, S, E, tid); S.pass = 1; pg8::gemm_phase<pg8::EpiYs, pg8::StaticOrder, true, true, false, true>(lds + RING_OFF, g, S, E, tid);
        }
        GRID_BAR();
        {
            PHASE_BEGIN();
            pg8::Gemm g{(const bf16*)(ws + WS_YS), (const bf16*)(ws + WS_W + (size_t)(l & 1) * W_SET + W_GLU), MPAD, DSS, DSS, DSS, DSS, 0, 0}; pg8::StaticOrder S; S.init(MPAD, DSS, G, bx); PROBE_SET_REP(S);
            pg8::EpiGlu E{(const bf16*)(ws + WS_YS), DSS, (bf16*)(ws + WS_MIXED) + DCV, D, (float*)(ws + WS_RSS) + (size_t)(3 * NL + 1 + l) * RSS_STRIDE, (LAS float*)(lds + RED_OFF)};
            S.split = 1;
            S.pass = 0; pg8::gemm_phase<pg8::EpiGlu, pg8::StaticOrder, true, true, false, false>(lds + RING_OFF, g, S, E, tid); S.pass = 1; pg8::gemm_phase<pg8::EpiGlu, pg8::StaticOrder, true, true, false, true>(lds + RING_OFF, g, S, E, tid);
        }
        GRID_BAR();
        {
            PHASE_BEGIN();
            pg8::Gemm g{(const bf16*)(ws + WS_MIXED), (const bf16*)(ws + WS_W + (size_t)(l & 1) * W_SET + W_OUT), MPAD, D, D, D, D, 0, 0}; pg8::StaticOrder S; S.init(MPAD, D, G, bx);
            pg8::EpiResidNorm<true> E{(bf16*)(ws + WS_XN), D, 1.0f, (float*)(ws + WS_RSS) + (size_t)(3 * l + 2) * RSS_STRIDE, (hl + 1 >= FP8_UP_FROM) ? (unsigned char*)(ws + WS_XB8) : nullptr, (LAS float*)(lds + RED_OFF), (const float*)(ws + WS_RSS) + (size_t)(3 * NL + 1 + l) * RSS_STRIDE, (const LAS float*)(lds + RSSB_OFF), 1.0f / DSS, EPS};
            PROBE_SET_REP_R(S, E);
            S.split = 1;
            S.pass = 0; pg8::gemm_phase<pg8::EpiResidNorm<true>, pg8::StaticOrder, true, true, false, false>(lds + RING_OFF, g, S, E, tid); S.pass = 1; PROBE_UNSCALE_R(E); pg8::gemm_phase<pg8::EpiResidNorm<true>, pg8::StaticOrder, true, true, false, true>(lds + RING_OFF, g, S, E, tid);
        }
        GRID_BAR();
    }
    {
        PHASE_BEGIN();
        const bf16* X = (const bf16*)(ws + WS_XN); float* out = A->out; const float* gain = A->in[I_FINN]; const float* rss = (const float*)(ws + WS_RSS) + (size_t)(3 * NL) * RSS_STRIDE;
        for (int prep = 0; prep < PROBE_N(7); ++prep)
#define OUT_ROW(r) ((r) < MPROMPT ? (((r) % TP) < NMETA ? (float*)nullptr : out + O_YP + ((size_t)((r) / TP) * SEQ + (((r) % TP) - NMETA)) * D) : out + O_YS + (size_t)((r) - MPROMPT) * D)
        for (int r = gw; r < MREAL; r += 2 * NGW) { const int r1 = r + NGW;
            float* d0 = OUT_ROW(r); float* d1 = (r1 < MREAL) ? OUT_ROW(r1) : (float*)nullptr; int ra = r, rb = r1;
            if (!d0) { d0 = d1; d1 = nullptr; ra = r1; }
            if (d0) final_rows2(X + (size_t)ra * D, X + (size_t)(d1 ? rb : ra) * D, gain, d0, d1, rss + (size_t)ra * 8, rss + (size_t)(d1 ? rb : ra) * 8, lane); }
#undef OUT_ROW
    }
}
}

extern "C" void kernel_launch(void* const* d_in, const int* in_sizes, int n_in, void* d_out, int out_size, void* d_ws, size_t ws_size, hipStream_t stream) {
    using namespace mk;
    static int grid = 0;
    if (grid == 0) {
        if (n_in != N_IN || (size_t)out_size != O_END || ws_size < WS_END) { fprintf(stderr, "kernel_launch: unexpected shapes (n_in %d, out %d, ws %zu, need %zu)\n", n_in, out_size, ws_size, (size_t)WS_END); grid = -1; return; }
        int dev = 0, cus = 0, per_cu = 0;
        if (hipGetDevice(&dev) != hipSuccess || hipDeviceGetAttribute(&cus, hipDeviceAttributeMultiprocessorCount, dev) != hipSuccess) { grid = -1; return; }
        if (hipFuncSetAttribute((const void*)hymba_fwd, hipFuncAttributeMaxDynamicSharedMemorySize, LDS_BYTES) != hipSuccess) { fprintf(stderr, "kernel_launch: hipFuncSetAttribute failed\n"); grid = -1; return; }
        if (hipOccupancyMaxActiveBlocksPerMultiprocessor(&per_cu, (const void*)hymba_fwd, NWAVES * 64, LDS_BYTES) != hipSuccess || per_cu < 1) { fprintf(stderr, "kernel_launch: occupancy query says %d\n", per_cu); }
        (void)hipGetLastError();
        grid = cus;
    }
    if (grid < 0) return;
    if (hipMemsetAsync(d_ws, 0, ZERO_BYTES, stream) != hipSuccess) return;
    Args a{};
    for (int i = 0; i < N_IN; ++i) a.in[i] = (const float*)d_in[i];
    a.out = (float*)d_out; a.ws = (unsigned char*)d_ws;
    hipLaunchKernelGGL(hymba_fwd, dim3(grid), dim3(NWAVES * 64), LDS_BYTES, stream, a);
}
```

```cpp
#include <hip/hip_runtime.h>
#include <cstdio>
#include <cstdint>
namespace pg8 {
#define PG8_LAS __attribute__((address_space(3)))
typedef unsigned short bf16_t;
typedef short bf16x8 __attribute__((ext_vector_type(8)));
typedef float f32x4 __attribute__((ext_vector_type(4)));
typedef unsigned u32x4 __attribute__((ext_vector_type(4)));
typedef int i32x4 __attribute__((ext_vector_type(4)));
typedef int i32x8 __attribute__((ext_vector_type(8)));
typedef unsigned u32x2 __attribute__((ext_vector_type(2)));
constexpr int BM = 256, BK = 64, HALF = 128, HTB = HALF * BK * 2  , STAGE_BYTES = 8 * HTB, NXCD = 8, WGM = 4;

__host__ __device__ __forceinline__ int lds_byte(int r, int c) { const int st = (r >> 4) * 2 + (c >> 5), rr = r & 15, cc = c & 31, ob = rr * 64 + cc * 2; return st * 1024 + (ob ^ (((ob >> 9) & 1) << 5)); }
__host__ __device__ __forceinline__ void stage_rc(int b, int& R, int& C) { const int st = b / 1024, sb = b % 1024, swz = sb ^ (((sb >> 9) & 1) << 5); R = (st >> 1) * 16 + swz / 64; C = (st & 1) * 32 + (swz % 64) / 2; }
__host__ __device__ __forceinline__ int perm32(int rho) { const int n = rho >> 4, i = rho & 15; return 8 * (i >> 2) + 4 * n + (i & 3); }

struct Unit { int pm, pn, mh; };
struct Gemm { const bf16_t* A; const bf16_t* Bt; int M, N, K; int lda, ldb; int gpanels; size_t gstride; };

struct StaticOrder {
    int nM, nN, nwg, G, c, split, pass;
#ifdef PROBE_SPLIT
    int r0, r1;
#endif
#ifdef PROBE_REP
    int rep;
#else
    static constexpr int rep = 1;
#endif
    __host__ __device__ void init(int M, int N, int G_, int c_) { nM = M / BM; nN = N / BM; nwg = nM * nN; G = G_; c = c_; split = 0; pass = 0;
#ifdef PROBE_SPLIT
        r0 = 0; r1 = 1 << 30;
#endif
#ifdef PROBE_REP
        rep = 1;
#endif
    }
    __host__ __device__ bool next(int i, Unit& u) const {
        const int nfull = split ? (nwg / G) * G : nwg;
        long L; u.mh = -1;
        if (pass == 0) { L = (long)(i / rep) * G + c; if (L >= nfull) return false; }
        else { const long hq = (long)i * G + c; if (hq >= 2 * (long)(nwg - nfull)) return false; L = nfull + (hq >> 1); u.mh = (int)(hq & 1); }
        int wgid = (int)L; { const int q = nwg / NXCD, r = nwg % NXCD, xcd = wgid % NXCD, off = wgid / NXCD; wgid = (xcd < r ? xcd * (q + 1) : r * (q + 1) + (xcd - r) * q) + off; }
        const int nig = WGM * nN, gid = wgid / nig, fm = gid * WGM, gsz = (nM - fm) < WGM ? (nM - fm) : WGM;
        u.pm = fm + ((wgid % nig) % gsz); u.pn = (wgid % nig) / gsz; return true;
    }
    __device__ __forceinline__ void a_ready(const Unit&) const {}
    __device__ __forceinline__ void done(const Unit&) const {}
};
__device__ __forceinline__ unsigned cvt_pk_bf16(float lo, float hi) { unsigned r; asm volatile("v_cvt_pk_bf16_f32 %0, %1, %2" : "=v"(r) : "v"(lo), "v"(hi)); return r; }
typedef float f32x2 __attribute__((ext_vector_type(2)));
__device__ __forceinline__ float fast_sigmoid(float z) { return __builtin_amdgcn_rcpf(1.0f + __expf(-z)); }
__device__ __forceinline__ float row_rnorm_lds(const PG8_LAS float* rssl, int lr, float inv_n, float eps) {
    const PG8_LAS f32x4* p = (const PG8_LAS f32x4*)(rssl + lr * 8); const f32x4 a = p[0], b = p[1];
    const float s = ((a[0] + a[1]) + (a[2] + a[3])) + ((b[0] + b[1]) + (b[2] + b[3]));
    return __builtin_amdgcn_rsqf(s * inv_n + eps); }
struct EpiSwiglu {
    static constexpr bool MID = false;
    static constexpr bool PERM = true, AFTER_DRAIN = false, QPRE = false;
    static constexpr bool RSS = true;
    unsigned char* H; int ldc; const float* rss; const PG8_LAS float* rssl; float inv_n, eps, oscale, iscale; int f8;
    __device__ __forceinline__ void operator()(const f32x4 (&acc)[2][2][4][2], const Unit& u, int wr, int wc, int fr, int fq) const {
        const int nai = u.mh < 0 ? 2 : 1, row0 = u.pm * BM + (u.mh > 0 ? HALF : 0) + wr * 64 + fr, col0 = u.pn * HALF + wc * 32 + 8 * fq;
#pragma unroll
        for (int ai = 0; ai < 2; ++ai) if (ai < nai)
#pragma unroll
            for (int m = 0; m < 4; ++m) { const int row = row0 + ai * HALF + m * 16; const float r = row_rnorm_lds(rssl, ai * HALF + wr * 64 + m * 16 + fr, inv_n, eps) * iscale;
                float o[8]; const float ru = r * oscale;
#pragma unroll
                for (int n = 0; n < 2; ++n)
#pragma unroll
                    for (int j = 0; j < 4; j += 2) {
                        const f32x2 g = (f32x2){acc[ai][0][m][n][j], acc[ai][0][m][n][j + 1]} * r, up = (f32x2){acc[ai][1][m][n][j], acc[ai][1][m][n][j + 1]} * ru;
                        f32x2 e = g * (-1.4426950408889634f); e.x = __builtin_amdgcn_exp2f(e.x); e.y = __builtin_amdgcn_exp2f(e.y); e = e + 1.0f;
                        f32x2 sg; sg.x = __builtin_amdgcn_rcpf(e.x); sg.y = __builtin_amdgcn_rcpf(e.y);
                        const f32x2 ov = (g * up) * sg; o[4 * n + j] = ov.x; o[4 * n + j + 1] = ov.y; }
                if (f8) {
                    int w0 = __builtin_amdgcn_cvt_pk_fp8_f32(o[0], o[1], 0, false); w0 = __builtin_amdgcn_cvt_pk_fp8_f32(o[2], o[3], w0, true);
                    int w1 = __builtin_amdgcn_cvt_pk_fp8_f32(o[4], o[5], 0, false); w1 = __builtin_amdgcn_cvt_pk_fp8_f32(o[6], o[7], w1, true);
                    u32x2 w; w.x = (unsigned)w0; w.y = (unsigned)w1; *(u32x2*)(H + (size_t)row * ldc + col0) = w;
                } else {
                    u32x4 w; w.x = cvt_pk_bf16(o[0], o[1]); w.y = cvt_pk_bf16(o[2], o[3]); w.z = cvt_pk_bf16(o[4], o[5]); w.w = cvt_pk_bf16(o[6], o[7]);
                    *(u32x4*)((bf16_t*)H + (size_t)row * ldc + col0) = w; } }
    }
};
template <bool MIDS> struct EpiResidNorm {
    static constexpr bool PERM = true, AFTER_DRAIN = false, QPRE = false;
    static constexpr bool RSS = MIDS, MID = MIDS;
    bf16_t* XB; int ldc; float scale; float* rss_out; unsigned char* XB8; PG8_LAS float* red; const float* rss; const PG8_LAS float* rssl; float inv_n, eps;
    __device__ __forceinline__ void mid(f32x4 (&acc)[2][2][4][2], const Unit& u, int wr, int fr) const {
        const int nai = u.mh < 0 ? 2 : 1;
#pragma unroll
        for (int ai = 0; ai < 2; ++ai) if (ai < nai)
#pragma unroll
            for (int m = 0; m < 4; ++m) { const PG8_LAS f32x4* p = (const PG8_LAS f32x4*)(rssl + (ai * HALF + wr * 64 + m * 16 + fr) * 8); const f32x4 a = p[0], b = p[1];
                const float c = __builtin_amdgcn_sqrtf((((a[0] + a[1]) + (a[2] + a[3])) + ((b[0] + b[1]) + (b[2] + b[3]))) * inv_n + eps);
#pragma unroll
                for (int bj = 0; bj < 2; ++bj)
#pragma unroll
                    for (int n = 0; n < 2; ++n) acc[ai][bj][m][n] = acc[ai][bj][m][n] * c; }
    }
    __device__ __forceinline__ void operator()(const f32x4 (&acc)[2][2][4][2], const Unit& u, int wr, int wc, int fr, int fq) const {
        const int nai = u.mh < 0 ? 2 : 1, row0 = u.pm * BM + (u.mh > 0 ? HALF : 0) + wr * 64 + fr, col0 = u.pn * BM + wc * 32 + 8 * fq;
#pragma unroll
        for (int ai = 0; ai < 2; ++ai) if (ai < nai) {
            u32x4 xin[4][2];
#pragma unroll
            for (int m = 0; m < 4; ++m)
#pragma unroll
                for (int bj = 0; bj < 2; ++bj) xin[m][bj] = *(const u32x4*)(XB + (size_t)(row0 + ai * HALF + m * 16) * ldc + col0 + bj * HALF);
#pragma unroll
            for (int m = 0; m < 4; ++m) { const int row = row0 + ai * HALF + m * 16; bf16_t* rowb = XB + (size_t)row * ldc + col0; float ss = 0.f;
                const float scale = MIDS ? this->scale * row_rnorm_lds(rssl, ai * HALF + wr * 64 + m * 16 + fr, inv_n, eps) : this->scale;
#pragma unroll
                for (int bj = 0; bj < 2; ++bj) { const u32x4 xo = xin[m][bj]; const f32x4 a0 = acc[ai][bj][m][0], a1 = acc[ai][bj][m][1];
                    f32x4 v0, v1;
                    v0[0] = __uint_as_float(xo.x << 16) + a0[0] * scale; v0[1] = __uint_as_float(xo.x & 0xffff0000u) + a0[1] * scale; v0[2] = __uint_as_float(xo.y << 16) + a0[2] * scale; v0[3] = __uint_as_float(xo.y & 0xffff0000u) + a0[3] * scale;
                    v1[0] = __uint_as_float(xo.z << 16) + a1[0] * scale; v1[1] = __uint_as_float(xo.z & 0xffff0000u) + a1[1] * scale; v1[2] = __uint_as_float(xo.w << 16) + a1[2] * scale; v1[3] = __uint_as_float(xo.w & 0xffff0000u) + a1[3] * scale;
                    ss += (v0[0] * v0[0] + v0[1] * v0[1]) + (v0[2] * v0[2] + v0[3] * v0[3]) + (v1[0] * v1[0] + v1[1] * v1[1]) + (v1[2] * v1[2] + v1[3] * v1[3]);
                    u32x4 w; w.x = cvt_pk_bf16(v0[0], v0[1]); w.y = cvt_pk_bf16(v0[2], v0[3]); w.z = cvt_pk_bf16(v1[0], v1[1]); w.w = cvt_pk_bf16(v1[2], v1[3]);
                    *(u32x4*)(rowb + bj * HALF) = w;
                    if (XB8) { int w0 = __builtin_amdgcn_cvt_pk_fp8_f32(v0[0], v0[1], 0, false); w0 = __builtin_amdgcn_cvt_pk_fp8_f32(v0[2], v0[3], w0, true);
                        int w1 = __builtin_amdgcn_cvt_pk_fp8_f32(v1[0], v1[1], 0, false); w1 = __builtin_amdgcn_cvt_pk_fp8_f32(v1[2], v1[3], w1, true);
                        u32x2 w8; w8.x = (unsigned)w0; w8.y = (unsigned)w1; *(u32x2*)(XB8 + (size_t)row * ldc + col0 + bj * HALF) = w8; } }
                ss += __shfl_xor(ss, 16); ss += __shfl_xor(ss, 32);
                if (fq == 0) red[(ai * HALF + wr * 64 + m * 16 + fr) * 4 + wc] = ss; }
            asm volatile("" ::: "memory"); }
        asm volatile("s_waitcnt lgkmcnt(0)" ::: "memory"); __builtin_amdgcn_s_barrier(); asm volatile("" ::: "memory");
        { const int t = (wr * 4 + wc) * 64 + fq * 16 + fr;
          if (t < nai * HALF) { const f32x4 q = *(const PG8_LAS f32x4*)(red + t * 4); rss_out[((size_t)u.pm * BM + (u.mh > 0 ? HALF : 0) + t) * 8 + u.pn] = (q[0] + q[1]) + (q[2] + q[3]); } }
    }
};
struct EpiStoreBf16 {
    static constexpr bool MID = false;
    static constexpr bool PERM = true, AFTER_DRAIN = false, QPRE = false;
    static constexpr bool RSS = true;
    bf16_t* O; int ldc; const float* rss; const PG8_LAS float* rssl; float inv_n, eps; bf16_t* UG; int ucol0, ug_chunks, ug_ld;
    __device__ __forceinline__ void operator()(const f32x4 (&acc)[2][2][4][2], const Unit& u, int wr, int wc, int fr, int fq) const {
        const int nai = u.mh < 0 ? 2 : 1, row0 = u.pm * BM + (u.mh > 0 ? HALF : 0) + wr * 64 + fr, col0 = u.pn * BM + wc * 32 + 8 * fq; const bool isu = (u.pn * BM >= ucol0);
#pragma unroll
        for (int ai = 0; ai < 2; ++ai) if (ai < nai)
#pragma unroll
            for (int m = 0; m < 4; ++m) { const int row = row0 + ai * HALF + m * 16; const float r = row_rnorm_lds(rssl, ai * HALF + wr * 64 + m * 16 + fr, inv_n, eps);
#pragma unroll
                for (int bj = 0; bj < 2; ++bj) { const f32x4 v0 = acc[ai][bj][m][0] * r, v1 = acc[ai][bj][m][1] * r;
                    u32x4 w; w.x = cvt_pk_bf16(v0[0], v0[1]); w.y = cvt_pk_bf16(v0[2], v0[3]); w.z = cvt_pk_bf16(v1[0], v1[1]); w.w = cvt_pk_bf16(v1[2], v1[3]);
                    const int c = col0 + bj * HALF;
                    bf16_t* dst = isu ? UG + ((size_t)((c - ucol0) >> 4) * ug_chunks + (row >> 4)) * ug_ld + (row & 15) * 16 + (c & 15) : O + (size_t)row * ldc + c;
                    *(u32x4*)dst = w; } }
    }
};
struct EpiSloc {
    static constexpr bool MID = false;
    static constexpr bool RSS = false;
    static constexpr bool PERM = false, AFTER_DRAIN = false, QPRE = false;
    float* S; int cpg, nchunk, ngrp;
    __device__ __forceinline__ void operator()(const f32x4 (&acc)[2][2][4][2], const Unit& u, int wr, int wc, int fr, int fq) const {
        const int nai = u.mh < 0 ? 2 : 1, R0 = u.pm * BM + (u.mh > 0 ? HALF : 0) + wr * 64 + fr, g = R0 / cpg, c0 = R0 - g * cpg, col0 = wc * 32 + 4 * fq;
#pragma unroll
        for (int ai = 0; ai < 2; ++ai) if (ai < nai)
#pragma unroll
            for (int m = 0; m < 4; ++m) { const int chunk = c0 + ai * HALF + m * 16; if (chunk < nchunk) { float* p = S + ((size_t)chunk * ngrp + g) * 128 + col0;
#pragma unroll
                for (int n = 0; n < 2; ++n) *(f32x4*)(p + n * 16) = acc[ai][0][m][n]; } }
    }
};
struct EpiYs {
    static constexpr bool MID = false;
    static constexpr bool RSS = false;
    static constexpr bool PERM = true, AFTER_DRAIN = false, QPRE = false;
    bf16_t* Y; int ldy, cpg, nchunk;
    __device__ __forceinline__ void operator()(const f32x4 (&acc)[2][2][4][2], const Unit& u, int wr, int wc, int fr, int fq) const {
        const int nai = u.mh < 0 ? 2 : 1, R0 = u.pm * BM + (u.mh > 0 ? HALF : 0) + wr * 64 + fr, g = R0 / cpg, c0 = R0 - g * cpg, col0 = wc * 32 + 8 * fq;
#pragma unroll
        for (int ai = 0; ai < 2; ++ai) if (ai < nai)
#pragma unroll
            for (int m = 0; m < 4; ++m) { const int chunk = c0 + ai * HALF + m * 16; if (chunk < nchunk) {
#pragma unroll
                for (int bj = 0; bj < 2; ++bj) { const int c = col0 + bj * HALF; float o[8];
#pragma unroll
                    for (int n = 0; n < 2; ++n)
#pragma unroll
                        for (int j = 0; j < 4; ++j) { const float x = acc[ai][bj][m][n][j]; const float z = 0.7978845608028654f * (x + 0.044715f * x * x * x); o[4 * n + j] = x * fast_sigmoid(2.0f * z); }
                    u32x4 w; w.x = cvt_pk_bf16(o[0], o[1]); w.y = cvt_pk_bf16(o[2], o[3]); w.z = cvt_pk_bf16(o[4], o[5]); w.w = cvt_pk_bf16(o[6], o[7]);
                    *(u32x4*)(Y + ((size_t)chunk * 16 + (c >> 4)) * ldy + g * 16 + (c & 15)) = w; } } }
    }
};
struct EpiGlu {
    static constexpr bool MID = false;
    static constexpr bool RSS = false;
    static constexpr bool PERM = true, AFTER_DRAIN = false, QPRE = false;
    const bf16_t* Y; int ldy; bf16_t* O; int ldo; float* rss_out; PG8_LAS float* red;
    __device__ __forceinline__ void operator()(const f32x4 (&acc)[2][2][4][2], const Unit& u, int wr, int wc, int fr, int fq) const {
        const int nai = u.mh < 0 ? 2 : 1, row0 = u.pm * BM + (u.mh > 0 ? HALF : 0) + wr * 64 + fr, col0 = u.pn * BM + wc * 32 + 8 * fq;
#pragma unroll
        for (int ai = 0; ai < 2; ++ai) if (ai < nai) {
            u32x4 yin[4][2];
#pragma unroll
            for (int m = 0; m < 4; ++m)
#pragma unroll
                for (int bj = 0; bj < 2; ++bj) yin[m][bj] = *(const u32x4*)(Y + (size_t)(row0 + ai * HALF + m * 16) * ldy + col0 + bj * HALF);
#pragma unroll
            for (int m = 0; m < 4; ++m) { const size_t r = (size_t)(row0 + ai * HALF + m * 16); float ss = 0.f;
#pragma unroll
                for (int bj = 0; bj < 2; ++bj) { const u32x4 yv = yin[m][bj]; const f32x4 z0 = acc[ai][bj][m][0], z1 = acc[ai][bj][m][1];
                    float o[8];
#pragma unroll
                    for (int q = 0; q < 4; ++q) { const unsigned w = yv[q]; const float ylo = __uint_as_float(w << 16), yhi = __uint_as_float(w & 0xffff0000u);
                        const float za = (q < 2) ? z0[2 * q] : z1[2 * q - 4], zb = (q < 2) ? z0[2 * q + 1] : z1[2 * q - 3];
                        o[2 * q] = ylo * fast_sigmoid(za); o[2 * q + 1] = yhi * fast_sigmoid(zb); ss += o[2 * q] * o[2 * q] + o[2 * q + 1] * o[2 * q + 1]; }
                    u32x4 w; w.x = cvt_pk_bf16(o[0], o[1]); w.y = cvt_pk_bf16(o[2], o[3]); w.z = cvt_pk_bf16(o[4], o[5]); w.w = cvt_pk_bf16(o[6], o[7]);
                    *(u32x4*)(O + r * ldo + col0 + bj * HALF) = w; }
                ss += __shfl_xor(ss, 16); ss += __shfl_xor(ss, 32);
                if (fq == 0) red[(ai * HALF + wr * 64 + m * 16 + fr) * 4 + wc] = ss; }
            asm volatile("" ::: "memory"); }
        asm volatile("s_waitcnt lgkmcnt(0)" ::: "memory"); __builtin_amdgcn_s_barrier(); asm volatile("" ::: "memory");
        { const int t = (wr * 4 + wc) * 64 + fq * 16 + fr;
          if (t < nai * HALF) { const f32x4 q = *(const PG8_LAS f32x4*)(red + t * 4); float* ro = rss_out + ((size_t)u.pm * BM + (u.mh > 0 ? HALF : 0) + t) * 8 + u.pn; ro[0] = (q[0] + q[1]) + (q[2] + q[3]); ro[4] = 0.f; } }
    }
};
struct EpiSwigluQ {
    static constexpr bool MID = false, RSS = true;
    static constexpr bool PERM = true, AFTER_DRAIN = false, QPRE = true;
    const float* QF; unsigned char* H; const float* CSG; int ldc; const float* CSU; int f8; float oscale; const PG8_LAS float* rssl;
    __device__ __forceinline__ const void* pre_src(const Unit& u, int wid, int lane) const {
        return wid == 0 ? (const void*)(QF + (size_t)u.pm * BM + (u.mh > 0 ? HALF : 0) + lane * 4) : (const void*)((lane < 32 ? CSG : CSU) + u.pn * HALF + (lane & 31) * 4); }
    __device__ __forceinline__ void operator()(const f32x4 (&acc)[2][2][4][2], const Unit& u, int wr, int wc, int fr, int fq) const {
        const int nai = u.mh < 0 ? 2 : 1, row0 = u.pm * BM + (u.mh > 0 ? HALF : 0) + wr * 64 + fr, col0 = u.pn * HALF + wc * 32 + 8 * fq;
        f32x4 cg[2], cu[2]; const PG8_LAS f32x4* cp = (const PG8_LAS f32x4*)(rssl + 256 + wc * 32 + 8 * fq); cg[0] = cp[0]; cg[1] = cp[1]; cu[0] = cp[32] * oscale; cu[1] = cp[33] * oscale;
        float qf[2][4];
#pragma unroll
        for (int ai = 0; ai < 2; ++ai)
#pragma unroll
            for (int m = 0; m < 4; ++m) qf[ai][m] = (ai < nai) ? rssl[ai * HALF + wr * 64 + m * 16 + fr] : 0.f;
        f32x2 cl[2][2], cpr[2][2];
#pragma unroll
        for (int n = 0; n < 2; ++n)
#pragma unroll
            for (int h = 0; h < 2; ++h) { const f32x2 g2 = (f32x2){cg[n][2 * h], cg[n][2 * h + 1]}, u2 = (f32x2){cu[n][2 * h], cu[n][2 * h + 1]}; cl[n][h] = g2 * (-1.4426950408889634f); cpr[n][h] = g2 * u2; }
#pragma unroll
        for (int ai = 0; ai < 2; ++ai) if (ai < nai)
#pragma unroll
            for (int m = 0; m < 4; ++m) { const int row = row0 + ai * HALF + m * 16;
                float o[8]; const float q1 = qf[ai][m], q2 = q1 * q1;
#pragma unroll
                for (int n = 0; n < 2; ++n)
#pragma unroll
                    for (int j = 0; j < 4; j += 2) { const f32x4 ag = acc[ai][0][m][n], au = acc[ai][1][m][n];
                        const float g0 = ag[j], g1 = ag[j + 1], u0 = au[j], u1 = au[j + 1];
                        const f32x2 gi = (f32x2){(float)__float_as_int(g0), (float)__float_as_int(g1)}, ui = (f32x2){(float)__float_as_int(u0), (float)__float_as_int(u1)};
                        f32x2 e = gi * (cl[n][j >> 1] * q1); e.x = __builtin_amdgcn_exp2f(e.x); e.y = __builtin_amdgcn_exp2f(e.y); e = e + 1.0f;
                        f32x2 sgm; sgm.x = __builtin_amdgcn_rcpf(e.x); sgm.y = __builtin_amdgcn_rcpf(e.y);
                        const f32x2 ov = ((gi * ui) * (cpr[n][j >> 1] * q2)) * sgm; o[4 * n + j] = ov.x; o[4 * n + j + 1] = ov.y; }
                if (f8) {
                    int w0 = __builtin_amdgcn_cvt_pk_fp8_f32(o[0], o[1], 0, false); w0 = __builtin_amdgcn_cvt_pk_fp8_f32(o[2], o[3], w0, true);
                    int w1 = __builtin_amdgcn_cvt_pk_fp8_f32(o[4], o[5], 0, false); w1 = __builtin_amdgcn_cvt_pk_fp8_f32(o[6], o[7], w1, true);
                    u32x2 w; w.x = (unsigned)w0; w.y = (unsigned)w1; *(u32x2*)(H + (size_t)row * ldc + col0) = w;
                } else {
                    u32x4 w; w.x = cvt_pk_bf16(o[0], o[1]); w.y = cvt_pk_bf16(o[2], o[3]); w.z = cvt_pk_bf16(o[4], o[5]); w.w = cvt_pk_bf16(o[6], o[7]);
                    *(u32x4*)((bf16_t*)H + (size_t)row * ldc + col0) = w; } }
    }
};
template <class Epi, class Sched, bool ALIGN_EPI = false, bool SP2 = false, int FP8 = 0, bool HM = false>
__device__ __forceinline__ void gemm_phase(PG8_LAS unsigned char* lds, const Gemm g, const Sched& S, const Epi& E, const int tid_in) {   constexpr bool hm = HM;
    const int tid = tid_in, wid = __builtin_amdgcn_readfirstlane(tid >> 6), lane = tid & 63, wr = wid >> 2, wc = wid & 3, fr = lane & 15, fq = lane >> 4;
    const int K = g.K, nt = K / BK;
    unsigned voffA[2], voffB[2];
#pragma unroll
    for (int i = 0; i < 2; ++i) { int R, C; stage_rc(tid * 16 + i * 8192, R, C); const int Rb = Epi::PERM ? ((R & ~31) + perm32(R & 31)) : R;
        voffA[i] = (unsigned)(R * g.lda + C) * 2u; voffB[i] = (unsigned)(Rb * g.ldb + C) * 2u; }
    const size_t kstep = (size_t)(BK * 2);
    const size_t hstepA = (size_t)HALF * g.lda * 2, hstepB = (size_t)HALF * g.ldb * 2;
    const size_t tstepA = 2 * hstepA, tstepB = 2 * hstepB;
    const unsigned ldsw = (unsigned)wid * 1024u;
    const int aoff = lds_byte(wr * 64 + fr, fq * 8), boff = lds_byte(wc * 32 + fr, fq * 8);
#define PG8_SA(b, h) (((b) * 2 + (h)) * HTB)
#define PG8_SB(b, h) ((4 + (b) * 2 + (h)) * HTB)
#define PG8_STAGE(bufoff, gbase, voff) do { _Pragma("unroll") for (int _i = 0; _i < 2; ++_i) \
        __builtin_amdgcn_global_load_lds((const unsigned*)((const char*)(gbase) + (voff)[_i]), (PG8_LAS unsigned*)(lds + (bufoff) + ldsw + _i * 8192), 16, 0, 0); } while (0)
#define PG8_LDA(dst, b, h) do { if constexpr (FP8 == 1) { _Pragma("unroll") for (int m = 0; m < 4; ++m) { const i32x4 lo_ = *(const PG8_LAS i32x4*)(lds + PG8_SA(b, h) + aoff + m * 2048), hi_ = *(const PG8_LAS i32x4*)(lds + PG8_SA(b, h) + aoff + m * 2048 + 1024); \
            dst##8[m] = __builtin_shufflevector(lo_, hi_, 0, 1, 2, 3, 4, 5, 6, 7); } } \
        else { _Pragma("unroll") for (int m = 0; m < 4; ++m) _Pragma("unroll") for (int k = 0; k < 2; ++k) dst[m][k] = *(const PG8_LAS bf16x8*)(lds + PG8_SA(b, h) + aoff + m * 2048 + k * 1024); } } while (0)
#define PG8_LDB(dst, b, h) do { if constexpr (FP8 == 1) { _Pragma("unroll") for (int n = 0; n < 2; ++n) { const i32x4 lo_ = *(const PG8_LAS i32x4*)(lds + PG8_SB(b, h) + boff + n * 2048), hi_ = *(const PG8_LAS i32x4*)(lds + PG8_SB(b, h) + boff + n * 2048 + 1024); \
            dst##8[n] = __builtin_shufflevector(lo_, hi_, 0, 1, 2, 3, 4, 5, 6, 7); } } \
        else { _Pragma("unroll") for (int n = 0; n < 2; ++n) _Pragma("unroll") for (int k = 0; k < 2; ++k) dst[n][k] = *(const PG8_LAS bf16x8*)(lds + PG8_SB(b, h) + boff + n * 2048 + k * 1024); } } while (0)
#define PG8_MMA(ai, bj, At, Bt) do { __builtin_amdgcn_s_setprio(1); \
        if constexpr (FP8 == 1) { _Pragma("unroll") for (int m = 0; m < 4; ++m) _Pragma("unroll") for (int n = 0; n < 2; ++n) \
            asm volatile("v_mfma_scale_f32_16x16x128_f8f6f4 %0, %1, %2, %0, %3, %3 op_sel_hi:[0,0,0]" : "+v"(acc[ai][bj][m][n]) : "v"(Bt##8[n]), "v"(At##8[m]), "v"(one_scale)); } \
        else if constexpr (FP8 == 2) { _Pragma("unroll") for (int m = 0; m < 4; ++m) _Pragma("unroll") for (int n = 0; n < 2; ++n) _Pragma("unroll") for (int k = 0; k < 2; ++k) \
            acc[ai][bj][m][n] = __builtin_bit_cast(f32x4, __builtin_amdgcn_mfma_i32_16x16x64_i8(__builtin_bit_cast(i32x4, Bt[n][k]), __builtin_bit_cast(i32x4, At[m][k]), __builtin_bit_cast(i32x4, acc[ai][bj][m][n]), 0, 0, 0)); } \
        else { _Pragma("unroll") for (int m = 0; m < 4; ++m) _Pragma("unroll") for (int n = 0; n < 2; ++n) _Pragma("unroll") for (int k = 0; k < 2; ++k) \
            acc[ai][bj][m][n] = __builtin_amdgcn_mfma_f32_16x16x32_bf16(Bt[n][k], At[m][k], acc[ai][bj][m][n], 0, 0, 0); } \
        __builtin_amdgcn_s_setprio(0); } while (0)
#define PG8_RSS_DMA() do { if constexpr (Epi::RSS) { if (t == 0) { if constexpr (Epi::QPRE) { if (wid < 2) __builtin_amdgcn_global_load_lds((const unsigned*)E.pre_src(cur, wid, lane), (PG8_LAS unsigned*)((PG8_LAS unsigned char*)E.rssl + ldsw), 16, 0, 0); } \
        else __builtin_amdgcn_global_load_lds((const unsigned*)((const char*)E.rss + ((size_t)cur.pm * BM + (cur.mh > 0 ? HALF : 0)) * 32 + (size_t)tid * 16), \
        (PG8_LAS unsigned*)((PG8_LAS unsigned char*)E.rssl + ldsw), 16, 0, 0); } } } while (0)
#define PG8_WAIT_V(n) asm volatile("s_waitcnt vmcnt(" #n ")" ::: "memory")
#define PG8_WAIT_L(n) asm volatile("s_waitcnt lgkmcnt(" #n ")" ::: "memory")
#define PG8_BAR __builtin_amdgcn_s_barrier()
#define PG8_SCHED __builtin_amdgcn_sched_barrier(0)
    Unit cur, nxt; int ui = 0;
    if (!S.next(0, cur)) return;
    f32x4 acc[2][2][4][2];
#pragma unroll
    for (int a = 0; a < 2; ++a)
#pragma unroll
        for (int b = 0; b < 2; ++b)
#pragma unroll
            for (int m = 0; m < 4; ++m)
#pragma unroll
                for (int n = 0; n < 2; ++n) acc[a][b][m][n] = (f32x4){0.f, 0.f, 0.f, 0.f};
    int one_scale = 0x7f7f7f7f; asm volatile("" : "+v"(one_scale));
    bf16x8 At[4][2], B0[2][2], B1[2][2]; i32x8 At8[4], B08[2], B18[2];
    const char* cA = (const char*)g.A + (size_t)cur.pm * tstepA + (cur.mh > 0 ? hstepA : (size_t)0); const char* cB = (const char*)g.Bt + (size_t)cur.pn * tstepB + (g.gpanels ? (size_t)(cur.pm / g.gpanels) * g.gstride : (size_t)0);
    S.a_ready(cur);
    if constexpr (SP2) {
        if constexpr (HM) {
        PG8_STAGE(PG8_SB(0, 0), cB, voffB); PG8_STAGE(PG8_SB(0, 1), cB + hstepB, voffB); PG8_STAGE(PG8_SA(0, 0), cA, voffA);
        if (wr == 1) PG8_BAR;
        PG8_WAIT_V(0); PG8_BAR;
        PG8_STAGE(PG8_SB(1, 0), cB + kstep, voffB); PG8_STAGE(PG8_SA(1, 0), cA + kstep, voffA); PG8_STAGE(PG8_SB(1, 1), cB + hstepB + kstep, voffB);
        PG8_BAR;
        } else {
        PG8_STAGE(PG8_SB(0, 0), cB, voffB); PG8_STAGE(PG8_SB(0, 1), cB + hstepB, voffB); PG8_STAGE(PG8_SA(0, 0), cA, voffA); PG8_STAGE(PG8_SA(0, 1), cA + hstepA, voffA);
        if (wr == 1) PG8_BAR;
        PG8_WAIT_V(2); PG8_BAR;
        PG8_STAGE(PG8_SB(1, 0), cB + kstep, voffB); PG8_STAGE(PG8_SA(1, 0), cA + kstep, voffA); PG8_STAGE(PG8_SB(1, 1), cB + hstepB + kstep, voffB);
        PG8_WAIT_V(6); PG8_BAR;
        }
    } else {
        PG8_STAGE(PG8_SB(0, 0), cB, voffB); PG8_STAGE(PG8_SA(0, 0), cA, voffA); PG8_STAGE(PG8_SB(0, 1), cB + hstepB, voffB); PG8_STAGE(PG8_SA(0, 1), cA + hstepA, voffA);
        if (wr == 1) PG8_BAR;
        PG8_WAIT_V(4); PG8_BAR;
        PG8_STAGE(PG8_SB(1, 0), cB + kstep, voffB); PG8_STAGE(PG8_SA(1, 0), cA + kstep, voffA); PG8_STAGE(PG8_SB(1, 1), cB + hstepB + kstep, voffB);
        PG8_WAIT_V(6); PG8_BAR;
    }
    for (;;) {
        const bool has_next = S.next(ui + 1, nxt);
        const char* nA = has_next ? (const char*)g.A + (size_t)nxt.pm * tstepA + (nxt.mh > 0 ? hstepA : (size_t)0) : cA; const char* nB = has_next ? (const char*)g.Bt + (size_t)nxt.pn * tstepB + (g.gpanels ? (size_t)(nxt.pm / g.gpanels) * g.gstride : (size_t)0) : cB;
#pragma nounroll
        for (int t = 0; t < nt; t += 2) {
            const bool last = (t == nt - 2);
            const char* a1 = cA + (size_t)(t + 1) * kstep;
            const char* a2 = last ? nA : cA + (size_t)(t + 2) * kstep; const char* b2 = last ? nB : cB + (size_t)(t + 2) * kstep;
            const char* a3 = a2 + kstep; const char* b3 = b2 + kstep;
            if (last && has_next) S.a_ready(nxt);
            if constexpr (Epi::MID) { if (t == (nt >> 1)) E.mid(acc, cur, wr, fr); }
            if constexpr (SP2) {
            if constexpr (HM) {
            PG8_LDB(B0, 0, 0); PG8_LDB(B1, 0, 1); PG8_SCHED; PG8_LDA(At, 0, 0);
            PG8_WAIT_L(0); PG8_BAR; PG8_RSS_DMA(); PG8_MMA(0, 0, At, B0); PG8_MMA(0, 1, At, B1); PG8_BAR; PG8_SCHED;
            PG8_STAGE(PG8_SB(0, 0), b2, voffB); PG8_STAGE(PG8_SB(0, 1), b2 + hstepB, voffB); PG8_STAGE(PG8_SA(0, 0), a2, voffA);
            PG8_WAIT_V(6); PG8_BAR; PG8_BAR; PG8_SCHED;
            PG8_LDB(B0, 1, 0); PG8_LDB(B1, 1, 1); PG8_SCHED; PG8_LDA(At, 1, 0);
            PG8_WAIT_L(0); PG8_BAR; PG8_MMA(0, 0, At, B0); PG8_MMA(0, 1, At, B1); PG8_BAR; PG8_SCHED;
            PG8_STAGE(PG8_SB(1, 0), b3, voffB); PG8_STAGE(PG8_SB(1, 1), b3 + hstepB, voffB); PG8_STAGE(PG8_SA(1, 0), a3, voffA);
            PG8_WAIT_V(6); PG8_BAR; PG8_BAR; PG8_SCHED;
            } else {
            PG8_LDB(B0, 0, 0); PG8_LDB(B1, 0, 1); PG8_SCHED; PG8_LDA(At, 0, 0); PG8_STAGE(PG8_SA(1, 1), a1 + hstepA, voffA);
            PG8_WAIT_V(8); PG8_WAIT_L(0); PG8_BAR; PG8_RSS_DMA(); PG8_MMA(0, 0, At, B0); PG8_MMA(0, 1, At, B1); PG8_BAR; PG8_SCHED;
            PG8_LDA(At, 0, 1); PG8_STAGE(PG8_SB(0, 0), b2, voffB); PG8_STAGE(PG8_SB(0, 1), b2 + hstepB, voffB); PG8_STAGE(PG8_SA(0, 0), a2, voffA);
            PG8_WAIT_V(8); PG8_WAIT_L(0); PG8_BAR; PG8_MMA(1, 0, At, B0); PG8_MMA(1, 1, At, B1); PG8_BAR; PG8_SCHED;
            PG8_LDB(B0, 1, 0); PG8_LDB(B1, 1, 1); PG8_SCHED; PG8_LDA(At, 1, 0); PG8_STAGE(PG8_SA(0, 1), a2 + hstepA, voffA);
            PG8_WAIT_V(8); PG8_WAIT_L(0); PG8_BAR; PG8_MMA(0, 0, At, B0); PG8_MMA(0, 1, At, B1); PG8_BAR; PG8_SCHED;
            PG8_LDA(At, 1, 1); PG8_STAGE(PG8_SB(1, 0), b3, voffB); PG8_STAGE(PG8_SB(1, 1), b3 + hstepB, voffB); PG8_STAGE(PG8_SA(1, 0), a3, voffA);
            PG8_WAIT_V(8); PG8_WAIT_L(0); PG8_BAR; PG8_MMA(1, 0, At, B0); PG8_MMA(1, 1, At, B1); PG8_BAR; PG8_SCHED;
            }
            } else {
            PG8_LDB(B0, 0, 0); PG8_SCHED; PG8_LDA(At, 0, 0); PG8_STAGE(PG8_SA(1, 1), a1 + hstepA, voffA);
            PG8_WAIT_L(8); PG8_BAR; PG8_WAIT_L(0); PG8_MMA(0, 0, At, B0); PG8_BAR; PG8_SCHED;
            PG8_LDB(B1, 0, 1); PG8_STAGE(PG8_SB(0, 0), b2, voffB);
            PG8_BAR; PG8_WAIT_L(0); PG8_MMA(0, 1, At, B1); PG8_BAR;
            PG8_LDA(At, 0, 1); PG8_STAGE(PG8_SA(0, 0), a2, voffA);
            PG8_BAR; PG8_WAIT_L(0); PG8_MMA(1, 0, At, B0); PG8_BAR; PG8_SCHED;
            PG8_STAGE(PG8_SB(0, 1), b2 + hstepB, voffB);
            PG8_WAIT_V(6); PG8_BAR; PG8_MMA(1, 1, At, B1); PG8_BAR;
            PG8_LDB(B0, 1, 0); PG8_SCHED; PG8_LDA(At, 1, 0); PG8_STAGE(PG8_SA(0, 1), a2 + hstepA, voffA);
            PG8_WAIT_L(8); PG8_BAR; PG8_WAIT_L(0); PG8_MMA(0, 0, At, B0); PG8_BAR; PG8_SCHED;
            PG8_LDB(B1, 1, 1); PG8_STAGE(PG8_SB(1, 0), b3, voffB);
            PG8_BAR; PG8_WAIT_L(0); PG8_MMA(0, 1, At, B1); PG8_BAR;
            PG8_LDA(At, 1, 1); PG8_STAGE(PG8_SA(1, 0), a3, voffA);
            PG8_BAR; PG8_WAIT_L(0); PG8_MMA(1, 0, At, B0); PG8_BAR; PG8_SCHED;
            PG8_STAGE(PG8_SB(1, 1), b3 + hstepB, voffB);
            PG8_WAIT_V(6); PG8_BAR; PG8_MMA(1, 1, At, B1); PG8_BAR;
            }
        }
        if constexpr (ALIGN_EPI) { if (wr == 0) PG8_BAR; }
        if constexpr (!Epi::AFTER_DRAIN) {
            if constexpr (FP8 == 1) asm volatile("s_nop 15\n\ts_nop 15" ::: "memory");
            int tz = tid; asm volatile("" : "+v"(tz)); const int lz = tz & 63, wz = __builtin_amdgcn_readfirstlane(tz >> 6);
            E(acc, cur, wz >> 2, wz & 3, lz & 15, lz >> 4); S.done(cur); }
        if (!has_next) break;
#pragma unroll
        for (int a = 0; a < 2; ++a)
#pragma unroll
            for (int b = 0; b < 2; ++b)
#pragma unroll
                for (int m = 0; m < 4; ++m)
#pragma unroll
                    for (int n = 0; n < 2; ++n) acc[a][b][m][n] = (f32x4){0.f, 0.f, 0.f, 0.f};
        cur = nxt; cA = nA; cB = nB; ++ui;
        if constexpr (ALIGN_EPI) { if (wr == 1) PG8_BAR; }
    }
    PG8_WAIT_V(0);
    if constexpr (!ALIGN_EPI) { if (wr == 0) PG8_BAR; }
    PG8_BAR;
    if constexpr (Epi::AFTER_DRAIN) { E.fused(acc, cur, wr, wc, fr, fq, lds, wid, lane); S.done(cur); }
#undef PG8_SA
#undef PG8_SB
#undef PG8_STAGE
#undef PG8_LDA
#undef PG8_LDB
#undef PG8_MMA
#undef PG8_WAIT_V
#undef PG8_RSS_DMA
#undef PG8_WAIT_L
#undef PG8_BAR
#undef PG8_SCHED
}
}
#define GAS __attribute__((address_space(1)))
#define LAS __attribute__((address_space(3)))
typedef unsigned short bf16;
typedef unsigned v4u __attribute__((ext_vector_type(4)));
typedef float f32x4 __attribute__((ext_vector_type(4)));
typedef short bf16x8 __attribute__((ext_vector_type(8)));
typedef GAS unsigned gu32;
typedef GAS unsigned long long gu64;
#define RLX_AGENT __ATOMIC_RELAXED, __HIP_MEMORY_SCOPE_AGENT
#define LDS_WAIT() asm volatile("s_waitcnt lgkmcnt(0)" ::: "memory")
#define VM_WAIT() asm volatile("s_waitcnt vmcnt(0)" ::: "memory")
__device__ __forceinline__ unsigned long long rt() { return __builtin_amdgcn_s_memrealtime(); }
__device__ __forceinline__ unsigned f2bf(float f) { unsigned u = __builtin_bit_cast(unsigned, f); return (u + 0x7fffu + ((u >> 16) & 1u)) >> 16; }
__device__ __forceinline__ unsigned pk2(float lo, float hi) { return f2bf(lo) | (f2bf(hi) << 16); }

#define XB_TMO      128
#define XB_XCNT(j)  (256  + 64 * (j))
#define XB_XSUB(j)  (1280 + 64 * (j))
#define XB_XGEN(j)  (2304 + 64 * (j))
#define XB_TOP      3328
#define XB_TOPGEN   3392
#define XCD_BAR_WORDS 3456
#define XB_SPIN_CAP (1u << 18)

__device__ __forceinline__ unsigned xb_ld(unsigned* p)              { return __hip_atomic_load(p, __ATOMIC_RELAXED, __HIP_MEMORY_SCOPE_AGENT); }
__device__ __forceinline__ unsigned xb_add(unsigned* p, unsigned v) { return __hip_atomic_fetch_add(p, v, __ATOMIC_RELAXED, __HIP_MEMORY_SCOPE_AGENT); }
__device__ __forceinline__ unsigned xb_xcc_id() { return (unsigned)__builtin_amdgcn_s_getreg((3 << 11) | 20) & 0xFu; }
#define XB_SPIN(cond, bar) do { unsigned _sp = 0; while (cond) { __builtin_amdgcn_s_sleep(1); \
    if ((++_sp & 255u) == 0u) { if (xb_ld(&(bar)[XB_TMO])) break; if (_sp > XB_SPIN_CAP) { atomicAdd(&(bar)[XB_TMO], 1u); break; } } } } while (0)

struct XcdBarrier {
    unsigned* bar; unsigned x;
    volatile LAS unsigned* st;
};

__device__ __forceinline__ XcdBarrier xcd_barrier_post(unsigned* bar, volatile LAS unsigned* st) {
    XcdBarrier b; b.bar = bar; b.x = xb_xcc_id(); b.st = st;
    if (threadIdx.x == 0) (void)xb_add(&bar[XB_XCNT(b.x)], 1u);
    return b;
}
__device__ __forceinline__ void xcd_barrier_complete(unsigned* bar, unsigned x, unsigned& nloc, unsigned& nx) {
    const unsigned G = gridDim.x * gridDim.y * gridDim.z;
    unsigned sum, cnt, mine, sp = 0u;
    for (;;) {
        sum = 0u; cnt = 0u; mine = 0u;
#pragma unroll
        for (unsigned j = 0; j < 16; ++j) { const unsigned c = xb_ld(&bar[XB_XCNT(j)]); sum += c; cnt += (c > 0u) ? 1u : 0u; mine = (j == x) ? c : mine; }
        if (sum == G) break;
        __builtin_amdgcn_s_sleep(1);
        if ((++sp & 255u) == 0u) { if (xb_ld(&bar[XB_TMO])) break; if (sp > XB_SPIN_CAP) { atomicAdd(&bar[XB_TMO], 1u); break; } }
    }
    nloc = mine > 0u ? mine : 1u; nx = cnt > 0u ? cnt : 1u;
}

__device__ __forceinline__ void xcd_barrier(const XcdBarrier& b) {
    asm volatile("s_waitcnt vmcnt(0)" ::: "memory");
    __syncthreads();
    if (threadIdx.x == 0) {
        unsigned* bar = b.bar;
        __builtin_amdgcn_s_waitcnt(0);
        unsigned nloc = b.st[0], nx = b.st[1];
        if (nloc == 0u) { xcd_barrier_complete(bar, b.x, nloc, nx); b.st[0] = nloc; b.st[1] = nx; }
        const unsigned old = xb_add(&bar[XB_XSUB(b.x)], 1u);
        const unsigned gen = old / nloc;
        if (old + 1u == (gen + 1u) * nloc) {
            __builtin_amdgcn_fence(__ATOMIC_RELEASE, "agent");
            asm volatile("s_waitcnt vmcnt(0)" ::: "memory");
            const unsigned og = xb_add(&bar[XB_TOP], 1u);
            const unsigned tg = og / nx;
            if (og + 1u == (tg + 1u) * nx) xb_add(&bar[XB_TOPGEN], 1u);
            else XB_SPIN(xb_ld(&bar[XB_TOPGEN]) == tg, bar);
            __builtin_amdgcn_fence(__ATOMIC_ACQUIRE, "agent");
            xb_add(&bar[XB_XGEN(b.x)], 1u);
            asm volatile("s_waitcnt vmcnt(0)" ::: "memory");
        } else {
            XB_SPIN(xb_ld(&bar[XB_XGEN(b.x)]) == gen, bar);
            __builtin_amdgcn_fence(__ATOMIC_ACQUIRE, "agent");
            asm volatile("s_waitcnt vmcnt(0)" ::: "memory");
        }
    }
    __syncthreads();
}
namespace mk {
typedef float f32x2 __attribute__((ext_vector_type(2)));
typedef unsigned u32x2 __attribute__((ext_vector_type(2)));
constexpr int NWAVES = 8;
constexpr int D = 2048, FF = 5632, DCV = 1024, DSS = 1024, DIN = 4096, NL = 4;
constexpr int SEQ = 16384, NMETA = 16, TP = SEQ + NMETA, NBP = 2, NBS = 8, TS = 32;
constexpr int MPROMPT = NBP * TP;
constexpr int MREAL = MPROMPT + NBS * TS;
constexpr int MPAD = 33280;
constexpr int NCHUNK = MPAD / 16;
constexpr int NCH_REAL = MREAL / 16;
constexpr int CH_PER_SEQ = TP / 16;
constexpr int NCT = NCHUNK / 16;
constexpr int SG = 64, SP = 64, SH = 16;
constexpr float EPS = 1e-6f;
constexpr int FP8_FROM_HL = 2;
constexpr int FP8_UP_FROM = 2 * NL;
constexpr int UPQ_FROM = 0;
constexpr float QALPHA_UNUSED = 5.5f;
constexpr float H8_SCALE = 4.0f, WD8_SCALE = 256.0f, WGU8_SCALE = 256.0f;
static_assert(MPAD % 256 == 0 && MPAD >= MREAL && MREAL % 16 == 0 && TP % 16 == 0 && TS % 4 == 0 && TP >= 8 && TS >= 8, "row geometry");

enum { I_XP = 0, I_XS, I_CACHE, I_SRE, I_SIM, I_META, I_F1N, I_F1G, I_F1U, I_F1D, I_MIXN, I_WIN, I_CONVW, I_CONVN, I_LRE, I_LIM, I_LDT, I_BRE, I_BIM, I_CRE, I_CIM, I_SD,
       I_GLU, I_SSMN, I_WOUT, I_F2N, I_F2G, I_F2U, I_F2D, I_FINN, N_IN };
constexpr size_t O_YP = 0, O_YS = O_YP + (size_t)NBP * SEQ * D, O_CVP = O_YS + (size_t)NBS * TS * D, O_REP = O_CVP + (size_t)NL * NBP * 2 * DCV,
                 O_IMP = O_REP + (size_t)NL * NBP * SG * SP, O_CVS = O_IMP + (size_t)NL * NBP * SG * SP, O_RES = O_CVS + (size_t)NL * NBS * 2 * DCV,
                 O_IMS = O_RES + (size_t)NL * NBS * SG * SP, O_END = O_IMS + (size_t)NL * NBS * SG * SP;
static_assert(O_END == 68042752, "output size");

constexpr size_t CTL_BYTES = 1u << 20;
constexpr int NRSS = 4 * NL + 1;
constexpr size_t ZERO_BYTES = CTL_BYTES;
constexpr size_t RSS_STRIDE = (size_t)MPAD * 8 + 2048;
constexpr size_t WS_RSS = CTL_BYTES;
constexpr size_t WS_XN = WS_RSS + (size_t)NRSS * RSS_STRIDE * 4;
constexpr size_t WS_W = WS_XN + (size_t)MPAD * D * 2;
constexpr size_t W_GU0 = 0;
constexpr size_t W_GU1 = W_GU0 + (size_t)2 * FF * D * 2;
constexpr size_t W_D0 = W_GU1 + (size_t)2 * FF * D * 2;
constexpr size_t W_D1 = W_D0 + (size_t)D * FF * 2;
constexpr size_t W_IN = W_D1 + (size_t)D * FF * 2;
constexpr size_t W_GLU = W_IN + (size_t)DIN * D * 2;
constexpr size_t W_OUT = W_GLU + (size_t)DSS * DSS * 2;
constexpr size_t W_SET = W_OUT + (size_t)D * D * 2;
constexpr size_t WS_WBT = WS_W + 2 * W_SET;
constexpr size_t WS_BMT = WS_WBT + (size_t)SG * 256 * 384 * 2;
constexpr size_t WS_APOW = WS_BMT + (size_t)SG * 256 * 256 * 2;
constexpr int NPOW = 18;
constexpr size_t WS_BBAR = WS_APOW + (size_t)NL * NPOW * SG * SP * 8;
constexpr size_t WS_R = WS_BBAR + (size_t)NL * SG * SP * SH * 8;
constexpr size_t WS_H = WS_R;
constexpr size_t WS_PROJ = WS_R;
constexpr size_t WS_MIXED = WS_PROJ + (size_t)MPAD * DIN * 2;
constexpr size_t WS_YS = WS_MIXED + (size_t)MPAD * D * 2;
constexpr size_t WS_SLOC = WS_YS + (size_t)MPAD * DSS * 2;
constexpr int CPG = 2304, UGLD = 384;
constexpr size_t WS_UG = WS_SLOC + (size_t)NCHUNK * SG * 128 * 4;
constexpr size_t WS_XB8 = WS_UG + (size_t)SG * CPG * UGLD * 2;
constexpr size_t WS_DUMMY_ = 0;
constexpr size_t WS_END_A = WS_H + (size_t)MPAD * FF * 2, WS_CS = WS_XB8 + (size_t)MPAD * D;
constexpr size_t WS_QF = WS_CS + (size_t)2 * 4 * FF * 4;
constexpr size_t WS_END_B = WS_QF + (size_t)MPAD * 4 + 1024;
constexpr size_t WS_END = WS_END_A > WS_END_B ? WS_END_A : WS_END_B;
static_assert(WS_R % 256 == 0 && WS_SLOC % 256 == 0, "alignment");
constexpr int CW_BAR = 4096;

constexpr int RING_OFF = 0, RING_BYTES = 131072;
constexpr int LDSCTL_OFF = RING_BYTES, MISC_OFF = LDSCTL_OFF + 320;
constexpr int RED_OFF = RING_BYTES + 512, RSSB_OFF = RED_OFF + 4096;
constexpr int LDS_BYTES = 147456;
static_assert(RSSB_OFF + 8192 <= LDS_BYTES && RSSB_OFF % 16 == 0, "LDS map");

__device__ __forceinline__ float wave_sum(float v) {
#pragma unroll
    for (int o = 1; o < 64; o <<= 1) v += __shfl_xor(v, o);
    return v;
}
__device__ __forceinline__ unsigned pkbf(float lo, float hi) { return pg8::cvt_pk_bf16(lo, hi); }
__device__ __forceinline__ float bflo(unsigned w) { return __uint_as_float(w << 16); }
__device__ __forceinline__ float bfhi(unsigned w) { return __uint_as_float(w & 0xffff0000u); }

__device__ __forceinline__ void transpose_item(const float* W, int K, int N, bf16* WT, int mode, const float* gain, LAS float* scr, int item, int lane, float f8scale = 0.f, int gk0 = 0, const float* cs8 = nullptr) {
    const int nblk = N / 32, kb = item / nblk, nb = item % nblk, k0 = 64 * kb, n0 = 32 * nb;
    const int drow0 = (mode == 0) ? n0 : (256 * (n0 >> 7) + 128 * (mode - 1) + (n0 & 127));
    const int nq = lane & 7, kr = lane >> 3;
    f32x4 v[8]; float csv[4] = {1.f, 1.f, 1.f, 1.f};
    if (cs8) {
#pragma unroll
        for (int j = 0; j < 4; ++j) csv[j] = cs8[n0 + (lane >> 3) + 8 * j]; }
#pragma unroll
    for (int i = 0; i < 8; ++i) v[i] = *(const f32x4*)(W + (size_t)(k0 + kr + 8 * i) * N + n0 + 4 * nq);
#pragma unroll
    for (int i = 0; i < 8; ++i) { const int kk_ = k0 + kr + 8 * i; const float gk = (gain && kk_ >= gk0) ? gain[kk_ - gk0] : 1.0f; LAS float* d = scr + (kr + 8 * i) * 33 + 4 * nq; d[0] = v[i].x * gk; d[1] = v[i].y * gk; d[2] = v[i].z * gk; d[3] = v[i].w * gk; }
    LDS_WAIT(); asm volatile("" ::: "memory");
    const int c = lane & 7;
#pragma unroll
    for (int j = 0; j < 4; ++j) { const int n = (lane >> 3) + 8 * j; const LAS float* s = scr + (8 * c) * 33 + n;
        if (cs8) {
            const float qs = 1.0f / csv[j]; unsigned b[8];
#pragma unroll
            for (int e = 0; e < 8; ++e) { float t = s[e * 33] * qs; t = fminf(fmaxf(t, -127.f), 127.f); b[e] = (unsigned)__float2int_rn(t) & 0xffu; }
            u32x2 o; o.x = b[0] | (b[1] << 8) | (b[2] << 16) | (b[3] << 24); o.y = b[4] | (b[5] << 8) | (b[6] << 16) | (b[7] << 24);
            *(u32x2*)((unsigned char*)WT + (size_t)(drow0 + n) * K + k0 + 8 * c) = o;
        } else if (f8scale != 0.f) {
            int w0 = __builtin_amdgcn_cvt_pk_fp8_f32(s[0 * 33] * f8scale, s[1 * 33] * f8scale, 0, false); w0 = __builtin_amdgcn_cvt_pk_fp8_f32(s[2 * 33] * f8scale, s[3 * 33] * f8scale, w0, true);
            int w1 = __builtin_amdgcn_cvt_pk_fp8_f32(s[4 * 33] * f8scale, s[5 * 33] * f8scale, 0, false); w1 = __builtin_amdgcn_cvt_pk_fp8_f32(s[6 * 33] * f8scale, s[7 * 33] * f8scale, w1, true);
            u32x2 o; o.x = (unsigned)w0; o.y = (unsigned)w1; *(u32x2*)((unsigned char*)WT + (size_t)(drow0 + n) * K + k0 + 8 * c) = o;
        } else {
        v4u o; o.x = pkbf(s[0 * 33], s[1 * 33]); o.y = pkbf(s[2 * 33], s[3 * 33]); o.z = pkbf(s[4 * 33], s[5 * 33]); o.w = pkbf(s[6 * 33], s[7 * 33]);
        *(v4u*)(WT + (size_t)(drow0 + n) * K + k0 + 8 * c) = o; } }
    LDS_WAIT(); asm volatile("" ::: "memory");
}

__device__ __forceinline__ void pmaxc_item(const float* W, int N, const float* gain, float* pmc, int item, int lane) {
    const int nblk = N / 32, kb = item / nblk, nb = item % nblk, k0 = 64 * kb, n0 = 32 * nb; const int nq = lane & 7, kr = lane >> 3;
    f32x4 v[8];
#pragma unroll
    for (int i = 0; i < 8; ++i) v[i] = *(const f32x4*)(W + (size_t)(k0 + kr + 8 * i) * N + n0 + 4 * nq);
    f32x4 m = {0.f, 0.f, 0.f, 0.f};
#pragma unroll
    for (int i = 0; i < 8; ++i) { const float gk = fabsf(gain[k0 + kr + 8 * i]); m.x = fmaxf(m.x, fabsf(v[i].x) * gk); m.y = fmaxf(m.y, fabsf(v[i].y) * gk); m.z = fmaxf(m.z, fabsf(v[i].z) * gk); m.w = fmaxf(m.w, fabsf(v[i].w) * gk); }
#pragma unroll
    for (int o = 8; o < 64; o <<= 1) { m.x = fmaxf(m.x, __shfl_xor(m.x, o)); m.y = fmaxf(m.y, __shfl_xor(m.y, o)); m.z = fmaxf(m.z, __shfl_xor(m.z, o)); m.w = fmaxf(m.w, __shfl_xor(m.w, o)); }
    if (lane < 8) *(f32x4*)(pmc + (size_t)kb * N + n0 + 4 * nq) = m;
}
__device__ __forceinline__ void colstep_reduce(const float* pmc, float* cs, int c) {
    const int q = c / FF, n = c - q * FF; const float* p = pmc + (size_t)q * 32 * FF + n; float m = 1e-30f;
#pragma unroll 8
    for (int kb = 0; kb < 32; ++kb) m = fmaxf(m, p[(size_t)kb * FF]);
    cs[c] = m * (1.0f / 127.0f);
}
__device__ __forceinline__ void gu_task(const float* W, const float* gain, unsigned char* WT, int mode, float* cs, LAS float* scr, LAS float* xch, int nb, int wave, int lane) {
    const int n0 = 32 * nb, nq = lane & 7, kr = lane >> 3, kw = 256 * wave;
    const int drow0 = 256 * (n0 >> 7) + 128 * (mode - 1) + (n0 & 127);
    f32x4 v[32];
    const unsigned loff = (unsigned)(kr * FF + 4 * nq) * 4u;
#pragma unroll
    for (int i = 0; i < 32; ++i) v[i] = *(const f32x4*)((const char*)(W + (size_t)(kw + 8 * i) * FF + n0) + loff);
    LAS float* gl = scr + 2304;
    *(LAS f32x4*)(gl + 4 * lane) = *(const f32x4*)(gain + kw + 4 * lane);
    LDS_WAIT(); asm volatile("" ::: "memory");
    f32x4 m = {0.f, 0.f, 0.f, 0.f};
#pragma unroll
    for (int i = 0; i < 32; ++i) { const float gk = gl[kr + 8 * i]; v[i] = v[i] * gk; m.x = fmaxf(m.x, fabsf(v[i].x)); m.y = fmaxf(m.y, fabsf(v[i].y)); m.z = fmaxf(m.z, fabsf(v[i].z)); m.w = fmaxf(m.w, fabsf(v[i].w)); }
#pragma unroll
    for (int o = 8; o < 64; o <<= 1) { m.x = fmaxf(m.x, __shfl_xor(m.x, o)); m.y = fmaxf(m.y, __shfl_xor(m.y, o)); m.z = fmaxf(m.z, __shfl_xor(m.z, o)); m.w = fmaxf(m.w, __shfl_xor(m.w, o)); }
    if (lane < 8) *(LAS f32x4*)(xch + wave * 32 + 4 * nq) = m;
    __syncthreads();
    float qs[4];
#pragma unroll
    for (int j = 0; j < 4; ++j) { float cm = 1e-30f;
#pragma unroll
        for (int w = 0; w < 8; ++w) cm = fmaxf(cm, xch[w * 32 + (lane >> 3) + 8 * j]);
        qs[j] = 127.0f / cm; if (wave == 0 && (lane & 7) == 0) cs[n0 + (lane >> 3) + 8 * j] = cm * (1.0f / 127.0f); }
    const int c = lane & 7;
#pragma unroll
    for (int t = 0; t < 4; ++t) {
#pragma unroll
        for (int i = 0; i < 8; ++i) { LAS float* d = scr + (kr + 8 * i) * 33 + 4 * nq; d[0] = v[8 * t + i].x; d[1] = v[8 * t + i].y; d[2] = v[8 * t + i].z; d[3] = v[8 * t + i].w; }
        LDS_WAIT(); asm volatile("" ::: "memory");
#pragma unroll
        for (int j = 0; j < 4; ++j) { const int n = (lane >> 3) + 8 * j; const LAS float* s = scr + (8 * c) * 33 + n; unsigned b[8];
#pragma unroll
            for (int e = 0; e < 8; ++e) { float x = s[e * 33] * qs[j]; x = fminf(fmaxf(x, -127.f), 127.f); b[e] = (unsigned)__float2int_rn(x) & 0xffu; }
            u32x2 o; o.x = b[0] | (b[1] << 8) | (b[2] << 16) | (b[3] << 24); o.y = b[4] | (b[5] << 8) | (b[6] << 16) | (b[7] << 24);
            *(u32x2*)(WT + (size_t)(drow0 + n) * D + kw + 64 * t + 8 * c) = o; }
        LDS_WAIT(); asm volatile("" ::: "memory");
    }
    __syncthreads();
}
static_assert((D / 64) * (FF / 32) == 5632, "gate/up item count");
__device__ __forceinline__ void quant_rows2(const bf16* x0, const bf16* x1, const float* rss0, const float* rss1, unsigned char* q0, unsigned char* q1, float* qf0, float* qf1, bool has1, int lane) {
    v4u a[2][4];
#pragma unroll
    for (int c = 0; c < 2; ++c) { const v4u* p0 = (const v4u*)(x0 + c * 1024 + 16 * lane); a[0][2 * c] = p0[0]; a[0][2 * c + 1] = p0[1]; const v4u* p1 = (const v4u*)(x1 + c * 1024 + 16 * lane); a[1][2 * c] = p1[0]; a[1][2 * c + 1] = p1[1]; }
    const float s0 = wave_sum(lane < 8 ? rss0[lane] : 0.f), s1 = wave_sum(lane < 8 ? rss1[lane] : 0.f);
    unsigned mx[2] = {0u, 0u};
#pragma unroll
    for (int w = 0; w < 2; ++w)
#pragma unroll
        for (int i = 0; i < 4; ++i)
#pragma unroll
            for (int d = 0; d < 4; ++d) { const unsigned u = a[w][i][d]; mx[w] = max(mx[w], max(u & 0x7fffu, (u >> 16) & 0x7fffu)); }
#pragma unroll
    for (int o = 1; o < 64; o <<= 1) { mx[0] = max(mx[0], (unsigned)__shfl_xor((int)mx[0], o)); mx[1] = max(mx[1], (unsigned)__shfl_xor((int)mx[1], o)); }
    const float am[2] = {fmaxf(__uint_as_float(mx[0] << 16), 1e-30f), fmaxf(__uint_as_float(mx[1] << 16), 1e-30f)};
    const float r[2] = {127.0f / am[0], 127.0f / am[1]};
    if (lane == 0) { qf0[0] = am[0] * (1.0f / 127.0f) * __builtin_amdgcn_rsqf(s0 * (1.0f / D) + EPS); if (has1) qf1[0] = am[1] * (1.0f / 127.0f) * __builtin_amdgcn_rsqf(s1 * (1.0f / D) + EPS); }
#pragma unroll
    for (int w = 0; w < 2; ++w) { if (w == 1 && !has1) break; unsigned char* q = w ? q1 : q0;
#pragma unroll
        for (int c = 0; c < 2; ++c) { v4u o;
#pragma unroll
            for (int d = 0; d < 4; ++d) {
                const unsigned w0 = a[w][2 * c + (d >> 1)][(2 * d) & 3], w1 = a[w][2 * c + (d >> 1)][(2 * d + 1) & 3];
                float t0 = bflo(w0) * r[w], t1 = bfhi(w0) * r[w], t2 = bflo(w1) * r[w], t3 = bfhi(w1) * r[w];
                t0 = fminf(fmaxf(t0, -127.f), 127.f); t1 = fminf(fmaxf(t1, -127.f), 127.f); t2 = fminf(fmaxf(t2, -127.f), 127.f); t3 = fminf(fmaxf(t3, -127.f), 127.f);
                o[d] = ((unsigned)__float2int_rn(t0) & 0xffu) | (((unsigned)__float2int_rn(t1) & 0xffu) << 8) | (((unsigned)__float2int_rn(t2) & 0xffu) << 16) | (((unsigned)__float2int_rn(t3) & 0xffu) << 24); }
            *(v4u*)(q + c * 1024 + 16 * lane) = o; } }
}
__device__ __forceinline__ void build_rows2(const float* src0, const float* src1, bf16* xb0, bf16* xb1, float* rss0, float* rss1, bool has1, int lane, unsigned char* xq0, unsigned char* xq1, float* qf0, float* qf1) {
    f32x4 v0[8], v1[8]; float s0 = 0.f, s1 = 0.f;
#pragma unroll
    for (int j = 0; j < 8; ++j) { v0[j] = src0 ? ((const f32x4*)src0 + lane)[64 * j] : (f32x4){0.f, 0.f, 0.f, 0.f}; v1[j] = src1 ? ((const f32x4*)src1 + lane)[64 * j] : (f32x4){0.f, 0.f, 0.f, 0.f}; }
#pragma unroll
    for (int j = 0; j < 8; ++j) { s0 += (v0[j].x * v0[j].x + v0[j].y * v0[j].y) + (v0[j].z * v0[j].z + v0[j].w * v0[j].w); s1 += (v1[j].x * v1[j].x + v1[j].y * v1[j].y) + (v1[j].z * v1[j].z + v1[j].w * v1[j].w); }
    u32x2* o0 = (u32x2*)xb0 + lane; u32x2* o1 = (u32x2*)xb1 + lane;
#pragma unroll
    for (int j = 0; j < 8; ++j) { u32x2 w; w.x = pkbf(v0[j].x, v0[j].y); w.y = pkbf(v0[j].z, v0[j].w); o0[64 * j] = w; if (has1) { u32x2 w1; w1.x = pkbf(v1[j].x, v1[j].y); w1.y = pkbf(v1[j].z, v1[j].w); o1[64 * j] = w1; } }
    s0 = wave_sum(s0); s1 = wave_sum(s1);
    if (lane < 8) { rss0[lane] = (lane == 0) ? s0 : 0.f; if (has1) rss1[lane] = (lane == 0) ? s1 : 0.f; }
    float a0 = 0.f, a1 = 0.f;
#pragma unroll
    for (int j = 0; j < 8; ++j) { a0 = fmaxf(a0, fmaxf(fmaxf(fabsf(v0[j].x), fabsf(v0[j].y)), fmaxf(fabsf(v0[j].z), fabsf(v0[j].w)))); a1 = fmaxf(a1, fmaxf(fmaxf(fabsf(v1[j].x), fabsf(v1[j].y)), fmaxf(fabsf(v1[j].z), fabsf(v1[j].w)))); }
#pragma unroll
    for (int o = 1; o < 64; o <<= 1) { a0 = fmaxf(a0, __shfl_xor(a0, o)); a1 = fmaxf(a1, __shfl_xor(a1, o)); }
    a0 = fmaxf(a0, 1e-30f); a1 = fmaxf(a1, 1e-30f);
    const float q0 = 127.0f / a0, q1 = 127.0f / a1;
    if (lane == 0) { qf0[0] = a0 * (1.0f / 127.0f) * __builtin_amdgcn_rsqf(s0 * (1.0f / D) + EPS); if (has1) qf1[0] = a1 * (1.0f / 127.0f) * __builtin_amdgcn_rsqf(s1 * (1.0f / D) + EPS); }
#pragma unroll
    for (int j = 0; j < 8; ++j) {
        ((unsigned*)xq0)[lane + 64 * j] = ((unsigned)__float2int_rn(v0[j].x * q0) & 0xffu) | (((unsigned)__float2int_rn(v0[j].y * q0) & 0xffu) << 8) | (((unsigned)__float2int_rn(v0[j].z * q0) & 0xffu) << 16) | (((unsigned)__float2int_rn(v0[j].w * q0) & 0xffu) << 24);
        if (has1) ((unsigned*)xq1)[lane + 64 * j] = ((unsigned)__float2int_rn(v1[j].x * q1) & 0xffu) | (((unsigned)__float2int_rn(v1[j].y * q1) & 0xffu) << 8) | (((unsigned)__float2int_rn(v1[j].z * q1) & 0xffu) << 16) | (((unsigned)__float2int_rn(v1[j].w * q1) & 0xffu) << 24); }
}
__device__ __forceinline__ void final_rows2(const bf16* src0, const bf16* src1, const float* gain, float* dst0, float* dst1, const float* rss0, const float* rss1, int lane) {
    u32x2 w0[8], w1[8];
#pragma unroll
    for (int j = 0; j < 8; ++j) { w0[j] = ((const u32x2*)src0 + lane)[64 * j]; w1[j] = dst1 ? ((const u32x2*)src1 + lane)[64 * j] : (u32x2){0u, 0u}; }
    const float q0 = lane < 8 ? rss0[lane] : 0.f, q1 = (dst1 && lane < 8) ? rss1[lane] : 0.f;
    const float r0 = 1.0f / sqrtf(wave_sum(q0) * (1.0f / D) + EPS), r1 = 1.0f / sqrtf(wave_sum(q1) * (1.0f / D) + EPS);
    const f32x4* gr = (const f32x4*)gain + lane; f32x4* o0 = (f32x4*)dst0 + lane; f32x4* o1 = (f32x4*)dst1 + lane;
#pragma unroll
    for (int j = 0; j < 8; ++j) { const f32x4 g = gr[64 * j]; o0[64 * j] = (f32x4){bflo(w0[j].x) * r0 * g.x, bfhi(w0[j].x) * r0 * g.y, bflo(w0[j].y) * r0 * g.z, bfhi(w0[j].y) * r0 * g.w};
        if (dst1) o1[64 * j] = (f32x4){bflo(w1[j].x) * r1 * g.x, bfhi(w1[j].x) * r1 * g.y, bflo(w1[j].y) * r1 * g.z, bfhi(w1[j].y) * r1 * g.w}; }
}
__device__ __forceinline__ const float* input_row(int r, const float* xp, const float* xs, const float* meta) {
    if (r < MPROMPT) { const int b = r / TP, pos = r - b * TP; return pos < NMETA ? meta + (size_t)pos * D : xp + ((size_t)b * SEQ + (pos - NMETA)) * D; }
    if (r < MREAL) return xs + (size_t)(r - MPROMPT) * D;
    return nullptr;
}

__device__ __forceinline__ void ssm_tables(int t, const float* lre_, const float* lim_, const float* ldt, const float* bre, const float* bim, f32x2* apow, f32x2* bbar) {
    const int l = t / (SG * SP), gp = t % (SG * SP), g = gp / SP;
    const double dtd = exp((double)ldt[l * SG + g]);
    const float lre = lre_[t], lim = lim_[t];
    const double xr = (double)lre * dtd, th = (double)lim * dtd;
    float c1 = 1.f, s1 = 0.f;
    for (int k = 0; k < NPOW; ++k) {
        const double kk = (k <= 16) ? (double)k : 16.0 * 65.0;
        const double ang = th * kk; const double n = rint(ang * 0.15915494309189535); const float r = (float)(ang - n * 6.283185307179586);
        const float mag = expf((float)(xr * kk)); const float cs = cosf(r), sn = sinf(r);
        apow[((size_t)(l * NPOW + k)) * (SG * SP) + gp] = (f32x2){mag * cs, mag * sn};
        if (k == 1) { c1 = cs; s1 = sn; }
    }
    const float em1 = expm1f((float)xr);
    const float hv = 0.5f * (1.0f - c1);
    const float are = em1 * c1 - 2.0f * hv, aim = (1.0f + em1) * s1;
    const float den = 1.0f / (lre * lre + lim * lim);
    const float qre = (are * lre + aim * lim) * den, qim = (aim * lre - are * lim) * den;
    const float* br = bre + (size_t)t * SH; const float* bi = bim + (size_t)t * SH; f32x2* bo = bbar + (size_t)t * SH;
#pragma unroll 4
    for (int h = 0; h < SH; ++h) { const float x = br[h], y = bi[h]; bo[h] = (f32x2){qre * x - qim * y, qre * y + qim * x}; }
}
__device__ __forceinline__ void ssm_matrices(int l, size_t t0, size_t tstride, const f32x2* apow, const f32x2* bbar, const float* cre, const float* cim, const float* dsk, bf16* WBT, bf16* BMT) {
    const f32x2* ap = apow + (size_t)l * NPOW * SG * SP; const f32x2* bb = bbar + (size_t)l * SG * SP * SH;
    const float* cr = cre + (size_t)l * SG * SH * SP; const float* ci = cim + (size_t)l * SG * SH * SP; const float* dd = dsk + (size_t)l * SG * SH;
    constexpr size_t NA = (size_t)SG * 16 * 256, NB = (size_t)SG * 256 * SP, NC = (size_t)SG * SP * 256;
    for (size_t t = t0; t < NA + NB + NC; t += tstride) {
        if (t < NA) {
            const int g = (int)(t / 4096), k = (int)(t / 256) % 16, h = (int)(t / 16) % 16, hp = (int)t % 16;
            float s = 0.f;
            for (int p = 0; p < SP; ++p) { const f32x2 a = ap[((size_t)k * SG + g) * SP + p], b = bb[((size_t)g * SP + p) * SH + hp]; const float x = cr[((size_t)g * SH + h) * SP + p], y = ci[((size_t)g * SH + h) * SP + p];
                const float abr = a.x * b.x - a.y * b.y, abi = a.x * b.y + a.y * b.x; s += x * abr - y * abi; }
            if (k == 0 && h == hp) s += dd[g * SH + h];
            const unsigned short sv = (unsigned short)(pkbf(s, 0.f) & 0xffffu);
            for (int m = 0; m + k < 16; ++m) { WBT[((size_t)g * 256 + (size_t)(k + m) * 16 + h) * 384 + m * 16 + hp] = sv;
                if (k > 0) WBT[((size_t)g * 256 + (size_t)m * 16 + h) * 384 + (k + m) * 16 + hp] = 0; }
        } else if (t < NA + NB) {
            const size_t u = t - NA; const int g = (int)(u / 16384), i = (int)(u / 1024) % 16, h = (int)(u / 64) % 16, p = (int)u % 64;
            const f32x2 a = ap[((size_t)(i + 1) * SG + g) * SP + p]; const float x = cr[((size_t)g * SH + h) * SP + p], y = ci[((size_t)g * SH + h) * SP + p];
            const size_t o = ((size_t)g * 256 + i * 16 + h) * 384 + 256 + p;
            WBT[o] = (unsigned short)(pkbf(x * a.x - y * a.y, 0.f) & 0xffffu); WBT[o + 64] = (unsigned short)(pkbf(-(x * a.y + y * a.x), 0.f) & 0xffffu);
        } else {
            const size_t u = t - NA - NB; const int g = (int)(u / 16384), p = (int)(u / 256) % 64, j = (int)(u / 16) % 16, hp = (int)u % 16;
            const f32x2 a = ap[((size_t)(15 - j) * SG + g) * SP + p], b = bb[((size_t)g * SP + p) * SH + hp];
            const size_t o = ((size_t)g * 256 + p) * 256 + j * 16 + hp;
            BMT[o] = (unsigned short)(pkbf(a.x * b.x - a.y * b.y, 0.f) & 0xffffu); BMT[o + (size_t)64 * 256] = (unsigned short)(pkbf(a.x * b.y + a.y * b.x, 0.f) & 0xffffu);
        }
    }
}

__device__ __forceinline__ float gelu_tanh(float x) { const float z = 0.7978845608028654f * (x + 0.044715f * x * x * x); return x * __builtin_amdgcn_rcpf(1.0f + __expf(-2.0f * z)); }

__device__ __forceinline__ void conv_rows4(int r0, int l, const bf16* PROJ, bf16* MIXED, const float* cache, const float* convw, const float* cgain, float* out, int lane) {
    if (r0 >= MREAL) {
#pragma unroll
        for (int q = 0; q < 4; ++q) { v4u* mo = (v4u*)(MIXED + (size_t)(r0 + q) * D); mo[lane] = (v4u){0u, 0u, 0u, 0u}; mo[64 + lane] = (v4u){0u, 0u, 0u, 0u}; }
        return; }
    int pos0, T; const float* cb = nullptr; float* ob;
    if (r0 < MPROMPT) { const int b = r0 / TP; pos0 = r0 - b * TP; T = TP; ob = out + O_CVP + (size_t)(l * NBP + b) * 2 * DCV; }
    else { const int s = (r0 - MPROMPT) / TS; pos0 = (r0 - MPROMPT) - s * TS; T = TS; cb = cache + (size_t)(l * NBS + s) * 2 * DCV; ob = out + O_CVS + (size_t)(l * NBS + s) * 2 * DCV; }
    float ss[4] = {0.f, 0.f, 0.f, 0.f}; float y[4][16];
#pragma unroll
    for (int hf = 0; hf < 2; ++hf) {
        const int c0 = hf * 512 + lane * 8;
        const bf16* pr = PROJ + (size_t)r0 * DIN + c0;
        v4u cg[6], hg[6], bg[4];
#pragma unroll
        for (int j = 0; j < 6; ++j) { if (j >= 2 || pos0 >= 2 - j) { cg[j] = *(const v4u*)(pr + (ptrdiff_t)(j - 2) * DIN + DCV); hg[j] = *(const v4u*)(pr + (ptrdiff_t)(j - 2) * DIN + 2 * DCV); } else { cg[j] = (v4u){0u, 0u, 0u, 0u}; hg[j] = cg[j]; } }
#pragma unroll
        for (int q = 0; q < 4; ++q) bg[q] = *(const v4u*)(pr + (size_t)q * DIN);
        float cbv[2][8];
#pragma unroll
        for (int e = 0; e < 8; ++e) { cbv[0][e] = (cb && pos0 < 2) ? cb[c0 + e] : 0.f; cbv[1][e] = (cb && pos0 < 1) ? cb[DCV + c0 + e] : 0.f; }
        const float* w = convw + (size_t)l * 3 * DCV + c0;
        float w0[8], w1[8], w2[8];
#pragma unroll
        for (int e = 0; e < 8; ++e) { w0[e] = w[e]; w1[e] = w[DCV + e]; w2[e] = w[2 * DCV + e]; }
        float v[6][8];
#pragma unroll
        for (int j = 0; j < 6; ++j)
#pragma unroll
            for (int qq = 0; qq < 4; ++qq) { v[j][2 * qq] = bflo(cg[j][qq]) * bflo(hg[j][qq]); v[j][2 * qq + 1] = bfhi(cg[j][qq]) * bfhi(hg[j][qq]); }
        if (pos0 == 0) {
#pragma unroll
            for (int e = 0; e < 8; ++e) { v[0][e] = cbv[0][e]; v[1][e] = cbv[1][e]; } }
#pragma unroll
        for (int q = 0; q < 4; ++q)
#pragma unroll
            for (int e = 0; e < 8; ++e) { const float bgv = (e & 1) ? bfhi(bg[q][e >> 1]) : bflo(bg[q][e >> 1]);
                const float yy = bgv * (w0[e] * v[q][e] + w1[e] * v[q + 1][e] + w2[e] * v[q + 2][e]); y[q][hf * 8 + e] = yy; ss[q] += yy * yy; }
        if (pos0 + 4 == T) {
#pragma unroll
            for (int e = 0; e < 8; ++e) { ob[c0 + e] = v[4][e]; ob[DCV + c0 + e] = v[5][e]; } }
    }
#pragma unroll
    for (int q = 0; q < 4; ++q) { const float rn = 1.0f / sqrtf(wave_sum(ss[q]) * (1.0f / DCV) + EPS); v4u* mo = (v4u*)(MIXED + (size_t)(r0 + q) * D);
#pragma unroll
        for (int hf = 0; hf < 2; ++hf) { const float* g = cgain + (size_t)l * DCV + hf * 512 + lane * 8; v4u wv;
#pragma unroll
            for (int qq = 0; qq < 4; ++qq) wv[qq] = pkbf(y[q][hf * 8 + 2 * qq] * rn * g[2 * qq], y[q][hf * 8 + 2 * qq + 1] * rn * g[2 * qq + 1]);
            mo[hf * 64 + lane] = wv; } }
}
__device__ __forceinline__ void norm_s_row(int r, bf16* MIXED, const float* gain, int lane) {
    v4u* p = (v4u*)(MIXED + (size_t)r * D + DCV); const v4u a = p[lane], b = p[64 + lane]; float v[16]; float ss = 0.f;
#pragma unroll
    for (int q = 0; q < 4; ++q) { v[2 * q] = bflo(a[q]); v[2 * q + 1] = bfhi(a[q]); v[8 + 2 * q] = bflo(b[q]); v[8 + 2 * q + 1] = bfhi(b[q]); }
#pragma unroll
    for (int e = 0; e < 16; ++e) ss += v[e] * v[e];
    const float rn = 1.0f / sqrtf(wave_sum(ss) * (1.0f / DSS) + EPS);
    v4u wa, wb; const float* g0 = gain + lane * 8; const float* g1 = gain + 512 + lane * 8;
#pragma unroll
    for (int q = 0; q < 4; ++q) { wa[q] = pkbf(v[2 * q] * rn * g0[2 * q], v[2 * q + 1] * rn * g0[2 * q + 1]); wb[q] = pkbf(v[8 + 2 * q] * rn * g1[2 * q], v[8 + 2 * q + 1] * rn * g1[2 * q + 1]); }
    p[lane] = wa; p[64 + lane] = wb;
}

template <bool WRITE> __device__ __forceinline__ void carry_run(const float* sl, bf16* so, int nc, const f32x2 a, float& sr, float& si) {
    constexpr size_t CS = (size_t)SG * 128, CO = (size_t)UGLD; constexpr int NB = 16;
#define CARRY_LOAD(LR, LI, c0) do { _Pragma("unroll") for (int q = 0; q < NB; ++q) { LR[q] = sl[(size_t)((c0) + q) * CS]; LI[q] = sl[(size_t)((c0) + q) * CS + 64]; } } while (0)
#define CARRY_STEP(LR, LI, c0) do { _Pragma("unroll") for (int q = 0; q < NB; ++q) { \
        if (WRITE) { so[(size_t)((c0) + q) * CO] = (unsigned short)(pkbf(sr, 0.f) & 0xffffu); so[(size_t)((c0) + q) * CO + 64] = (unsigned short)(pkbf(si, 0.f) & 0xffffu); } \
        const float nr = a.x * sr - a.y * si + LR[q], ni = a.x * si + a.y * sr + LI[q]; sr = nr; si = ni; } } while (0)
    float ar[NB], ai[NB], br[NB], bi[NB];
    int c = 0;
    if (nc >= NB) CARRY_LOAD(ar, ai, 0);
    while (c + NB <= nc) {
        if (c + 2 * NB <= nc) CARRY_LOAD(br, bi, c + NB);
        CARRY_STEP(ar, ai, c); c += NB;
        if (c + NB > nc) break;
        if (c + 2 * NB <= nc) CARRY_LOAD(ar, ai, c + NB);
        CARRY_STEP(br, bi, c); c += NB;
    }
#undef CARRY_LOAD
#undef CARRY_STEP
    for (; c < nc; ++c) { const float lr = sl[(size_t)c * CS], li = sl[(size_t)c * CS + 64];
        if (WRITE) { so[(size_t)c * CO] = (unsigned short)(pkbf(sr, 0.f) & 0xffffu); so[(size_t)c * CO + 64] = (unsigned short)(pkbf(si, 0.f) & 0xffffu); }
        const float nr = a.x * sr - a.y * si + lr, ni = a.x * si + a.y * sr + li; sr = nr; si = ni; }
}
constexpr int CSEG = 65, NSEG = 16;
static_assert(NSEG * CSEG >= CH_PER_SEQ && (NSEG - 1) * CSEG < CH_PER_SEQ, "carry segments");
__device__ __forceinline__ void carry_totals2(const float* sa, int na, const float* sb, int nb, const f32x2 a, float& ar, float& ai, float& br, float& bi) {
    constexpr size_t CS = (size_t)SG * 128; constexpr int NB = 8;
    const int nmin = na < nb ? na : nb; int c = 0;
    for (; c + NB <= nmin; c += NB) { float xr[NB], xi[NB], yr[NB], yi[NB];
#pragma unroll
        for (int q = 0; q < NB; ++q) { xr[q] = sa[(size_t)(c + q) * CS]; xi[q] = sa[(size_t)(c + q) * CS + 64]; yr[q] = sb[(size_t)(c + q) * CS]; yi[q] = sb[(size_t)(c + q) * CS + 64]; }
#pragma unroll
        for (int q = 0; q < NB; ++q) { const float n0 = a.x * ar - a.y * ai + xr[q], n1 = a.x * ai + a.y * ar + xi[q]; ar = n0; ai = n1; const float m0 = a.x * br - a.y * bi + yr[q], m1 = a.x * bi + a.y * br + yi[q]; br = m0; bi = m1; } }
    for (int k = c; k < na; ++k) { const float x0 = sa[(size_t)k * CS], x1 = sa[(size_t)k * CS + 64]; const float n0 = a.x * ar - a.y * ai + x0, n1 = a.x * ai + a.y * ar + x1; ar = n0; ai = n1; }
    for (int k = c; k < nb; ++k) { const float y0 = sb[(size_t)k * CS], y1 = sb[(size_t)k * CS + 64]; const float m0 = a.x * br - a.y * bi + y0, m1 = a.x * bi + a.y * br + y1; br = m0; bi = m1; }
}
__device__ __forceinline__ void ssm_carry_prompt(int b, int g, int hb, int l, const f32x2* apow, const float* SLOC, bf16* UG, float* out, LAS float* sh, int wave, int lane) {
    const f32x2 a = apow[((size_t)(l * NPOW + 16) * SG + g) * SP + lane], aseg = apow[((size_t)(l * NPOW + 17) * SG + g) * SP + lane];
    const int seg = 8 * hb + wave, cs = seg * CSEG, len = (CH_PER_SEQ - cs) < CSEG ? (CH_PER_SEQ - cs) : CSEG, c0 = b * CH_PER_SEQ + cs;
    const float* sl = SLOC + ((size_t)c0 * SG + g) * 128 + lane; bf16* so = UG + ((size_t)g * CPG + c0) * UGLD + 256 + lane;
    float tr = 0.f, ti = 0.f, pr = 0.f, pi = 0.f;
    if (hb) { const float* sp = SLOC + ((size_t)(b * CH_PER_SEQ + wave * CSEG) * SG + g) * 128 + lane; carry_totals2(sp, CSEG, sl, len, a, pr, pi, tr, ti);
        sh[(wave * 2) * 64 + lane] = pr; sh[(wave * 2 + 1) * 64 + lane] = pi; }
    else carry_run<false>(sl, so, len, a, tr, ti);
    sh[(seg * 2) * 64 + lane] = tr; sh[(seg * 2 + 1) * 64 + lane] = ti;
    LDS_WAIT(); __syncthreads();
    float sr = 0.f, si = 0.f;
    for (int w = 0; w < seg; ++w) { const float xr = sh[(w * 2) * 64 + lane], xi = sh[(w * 2 + 1) * 64 + lane]; const float nr = aseg.x * sr - aseg.y * si + xr, ni = aseg.x * si + aseg.y * sr + xi; sr = nr; si = ni; }
    carry_run<true>(sl, so, len, a, sr, si);
    if (seg == NSEG - 1) { out[O_REP + ((size_t)(l * NBP + b) * SG + g) * SP + lane] = sr; out[O_IMP + ((size_t)(l * NBP + b) * SG + g) * SP + lane] = si; }
    __syncthreads();
}
__device__ __forceinline__ void ssm_carry_small(int w, int l, const f32x2* apow, const float* SLOC, bf16* UG, const float* sre, const float* sim, float* out, int lane) {
    if (w >= NBS * SG) { const int u = w - NBS * SG; const int c = NCH_REAL + u / SG, g = u % SG; if (c >= NCHUNK) return;
        ((unsigned*)(UG + ((size_t)g * CPG + c) * UGLD + 256))[lane] = 0u; return; }
    const int s = w / SG, g = w % SG, c0 = NBP * CH_PER_SEQ + s * (TS / 16); const size_t o = ((size_t)(l * NBS + s) * SG + g) * SP + lane;
    float sr = sre[o], si = sim[o];
    const f32x2 a = apow[((size_t)(l * NPOW + 16) * SG + g) * SP + lane];
    carry_run<true>(SLOC + ((size_t)c0 * SG + g) * 128 + lane, UG + ((size_t)g * CPG + c0) * UGLD + 256 + lane, TS / 16, a, sr, si);
    out[O_RES + o] = sr; out[O_IMS + o] = si;
}
struct Args { const float* in[N_IN]; float* out; unsigned char* ws; };
static_assert(sizeof(Args) == 8 * (N_IN + 2), "no padding in Args");
typedef const __attribute__((address_space(4))) Args* ArgsP;
#ifdef PROBE_REP
#define PROBE_N(w) ((PROBE_WHICH == (w) || (PROBE_WHICH == 99 && (w) != 6)) ? PROBE_REP : 1)
#define PROBE_SET_REP(S) do { if (PROBE_WHICH == 1 || PROBE_WHICH == 99) (S).rep = PROBE_REP; } while (0)
#define PROBE_SET_REP3(S) do { if (PROBE_WHICH == 3 || PROBE_WHICH == 99) (S).rep = PROBE_REP; } while (0)
#define PROBE_SET_REP_R(S, E) do { if (PROBE_WHICH == 2 || PROBE_WHICH == 99) { (S).rep = PROBE_REP; (E).scale *= 1.0f / PROBE_REP; } } while (0)
#define PROBE_UNSCALE_R(E) do { if (PROBE_WHICH == 2 || PROBE_WHICH == 99) { (E).scale *= (float)PROBE_REP; } } while (0)
#else
#define PROBE_N(w) 1
#define PROBE_SET_REP(S) do {} while (0)
#define PROBE_SET_REP3(S) do {} while (0)
#define PROBE_SET_REP_R(S, E) do {} while (0)
#define PROBE_UNSCALE_R(E) do {} while (0)
#endif

#define PHASE_BEGIN() \
    int tid = threadIdx.x; asm volatile("" : "+v"(tid)); \
    ArgsP A = (ArgsP)__builtin_amdgcn_kernarg_segment_ptr(); asm volatile("" : "+s"(A)); \
    const int lane = tid & 63, wave = __builtin_amdgcn_readfirstlane(tid >> 6); \
    const int gw = vcu * NWAVES + wave, NGW = G * NWAVES; \
    unsigned char* ws = A->ws; (void)lane; (void)gw; (void)NGW; (void)ws;

__device__ __forceinline__ void convert_layer(int l, ArgsP A, unsigned char* ws, LAS float* scr, int gw, int NGW, int lane) {
    unsigned char* wset = ws + WS_W + (size_t)(l & 1) * W_SET;
    constexpr int I_DN = (FF / 64) * (D / 32), I_IN = (D / 64) * (DIN / 32), I_GL = (DSS / 64) * (DSS / 32), I_OUT = (D / 64) * (D / 32);
    constexpr int NITEMS = 2 * I_DN + I_IN + I_GL + I_OUT;
    for (int it = gw; it < NITEMS; it += NGW) {
        int r = it;
        if (r < 2 * I_DN) { const int q = r / I_DN; r -= q * I_DN;
            transpose_item(A->in[q ? I_F2D : I_F1D] + (size_t)l * FF * D, FF, D, (bf16*)(wset + (q ? W_D1 : W_D0)), 0, nullptr, scr, r, lane, (2 * l + q >= FP8_FROM_HL) ? WD8_SCALE : 0.f); continue; }
        r -= 2 * I_DN;
        if (r < I_IN) { transpose_item(A->in[I_WIN] + (size_t)l * D * DIN, D, DIN, (bf16*)(wset + W_IN), 0, A->in[I_MIXN] + (size_t)l * D, scr, r, lane); continue; }
        r -= I_IN;
        if (r < I_GL) { transpose_item(A->in[I_GLU] + (size_t)l * DSS * DSS, DSS, DSS, (bf16*)(wset + W_GLU), 0, nullptr, scr, r, lane); continue; }
        r -= I_GL;
        transpose_item(A->in[I_WOUT] + (size_t)l * D * D, D, D, (bf16*)(wset + W_OUT), 0, A->in[I_SSMN] + (size_t)l * DSS, scr, r, lane, 0.f, DCV);
    }
}
__device__ __forceinline__ void convert_gu(int l, ArgsP A, unsigned char* ws, LAS float* scr, LAS float* xch, int cu, int ncu, int wave, int lane) {
    unsigned char* wset = ws + WS_W + (size_t)(l & 1) * W_SET;
    for (int it = cu; it < 4 * (FF / 32); it += ncu) { const int q = it / (FF / 32), nb = it - q * (FF / 32);
        gu_task(A->in[q == 0 ? I_F1G : q == 1 ? I_F1U : q == 2 ? I_F2G : I_F2U] + (size_t)l * D * FF, A->in[q < 2 ? I_F1N : I_F2N] + (size_t)l * D, wset + (q < 2 ? W_GU0 : W_GU1), 1 + (q & 1),
                (float*)(ws + WS_CS) + (size_t)((l & 1) * 4 + q) * FF, scr, xch, nb, wave, lane); }
}

__global__ void __launch_bounds__(NWAVES * 64, 2) hymba_fwd(Args args_unused) {
    extern __shared__ __attribute__((aligned(16))) unsigned char lds_raw[];
    LAS unsigned char* lds = (LAS unsigned char*)lds_raw;
    const int G = gridDim.x; const int bx = blockIdx.x; const int vcu = (G % 8 == 0) ? (bx % 8) * (G / 8) + bx / 8 : bx;
    XcdBarrier bar;
    {
        PHASE_BEGIN();
        for (int u = tid; u < (LDS_BYTES - LDSCTL_OFF) / 4; u += NWAVES * 64) ((LAS unsigned*)(lds + LDSCTL_OFF))[u] = 0u;
        __syncthreads();
        bar = xcd_barrier_post((unsigned*)(ws) + CW_BAR, (volatile LAS unsigned*)(lds + MISC_OFF) + 8);
    }
#define GRID_BAR() do { for (int prep_ = 0; prep_ < PROBE_N(6); ++prep_) xcd_barrier(bar); } while (0)
    {
        PHASE_BEGIN();
        for (int prep = 0; prep < PROBE_N(7); ++prep)
        for (int t = bx * (NWAVES * 64) + tid; t < NL * SG * SP; t += G * NWAVES * 64)
            ssm_tables(t, A->in[I_LRE], A->in[I_LIM], A->in[I_LDT], A->in[I_BRE], A->in[I_BIM], (f32x2*)(ws + WS_APOW), (f32x2*)(ws + WS_BBAR));
    }
    {
        PHASE_BEGIN();
        for (int prep = 0; prep < PROBE_N(9); ++prep) convert_gu(0, A, ws, (LAS float*)(lds + RING_OFF + wave * 16384), (LAS float*)(lds + RING_OFF + 12288), vcu, G, wave, lane);
        for (int prep = 0; prep < PROBE_N(9); ++prep) convert_layer(0, A, ws, (LAS float*)(lds + RING_OFF + wave * 16384), gw, NGW, lane);
    }
    {
        PHASE_BEGIN();
        v4u* z = (v4u*)(ws + WS_BMT);
        for (int i = bx * (NWAVES * 64) + tid; i < SG * 128 * 256 * 2 / 16; i += G * NWAVES * 64) { const int g = i / (128 * 256 * 2 / 16), o = i % (128 * 256 * 2 / 16); z[(size_t)g * (256 * 256 * 2 / 16) + (128 * 256 * 2 / 16) + o] = (v4u){0u, 0u, 0u, 0u}; }
    }
    {
        PHASE_BEGIN();
        bf16* XB = (bf16*)(ws + WS_XN); float* rss = (float*)(ws + WS_RSS);
        const float* xp = A->in[I_XP]; const float* xs = A->in[I_XS]; const float* meta = A->in[I_META];
        for (int prep = 0; prep < PROBE_N(7); ++prep)
        for (int r = gw; r < MPAD; r += 2 * NGW) { const int r1 = r + NGW; const bool h1 = r1 < MPAD; const int rr = h1 ? r1 : r;
            build_rows2(input_row(r, xp, xs, meta), h1 ? input_row(r1, xp, xs, meta) : nullptr, XB + (size_t)r * D, XB + (size_t)rr * D, rss + (size_t)r * 8, rss + (size_t)rr * 8, h1, lane,
                        ws + WS_XB8 + (size_t)r * D, ws + WS_XB8 + (size_t)rr * D, (float*)(ws + WS_QF) + r, (float*)(ws + WS_QF) + rr); }
    }
    GRID_BAR();
    for (int hl = 0; hl < 2 * NL; ++hl) {
        const int l = hl >> 1, second = hl & 1;
        if (hl >= UPQ_FROM && hl > 0) {
            PHASE_BEGIN();
            const bf16* XB = (const bf16*)(ws + WS_XN); unsigned char* XQ = ws + WS_XB8; const float* rss = (const float*)(ws + WS_RSS) + (size_t)(3 * l + (second ? 2 : 0)) * RSS_STRIDE;
            for (int prep = 0; prep < PROBE_N(8); ++prep)
            for (int r = gw; r < MPAD; r += 2 * NGW) { const int r1 = r + NGW; const bool h1 = r1 < MPAD; const int rr = h1 ? r1 : r;
                quant_rows2(XB + (size_t)r * D, XB + (size_t)rr * D, rss + (size_t)r * 8, rss + (size_t)rr * 8, XQ + (size_t)r * D, XQ + (size_t)rr * D, (float*)(ws + WS_QF) + r, (float*)(ws + WS_QF) + rr, h1, lane); }
        }
        if (hl >= UPQ_FROM && hl > 0) GRID_BAR();
        if (hl >= UPQ_FROM) {
            PHASE_BEGIN();
            const float* cs = (const float*)(ws + WS_CS) + (size_t)((l & 1) * 4 + 2 * second) * FF;
            pg8::Gemm g{(const bf16*)(ws + WS_XB8), (const bf16*)(ws + WS_W + (size_t)(l & 1) * W_SET + (second ? W_GU1 : W_GU0)), MPAD, 2 * FF, D / 2, D / 2, D / 2, 0, 0};   pg8::StaticOrder S; S.init(MPAD, 2 * FF, G, bx); PROBE_SET_REP(S);
            pg8::EpiSwigluQ E{(const float*)(ws + WS_QF), (unsigned char*)(ws + WS_H), cs, FF, cs + FF, (hl >= FP8_FROM_HL) ? 1 : 0, (hl >= FP8_FROM_HL) ? H8_SCALE : 1.0f, (const LAS float*)(lds + RSSB_OFF)};
            S.split = 1;
            S.pass = 0; pg8::gemm_phase<pg8::EpiSwigluQ, pg8::StaticOrder, true, true, 2, false>(lds + RING_OFF, g, S, E, tid); S.pass = 1; pg8::gemm_phase<pg8::EpiSwigluQ, pg8::StaticOrder, true, true, 2, true>(lds + RING_OFF, g, S, E, tid);
        } else
#ifdef PROBE_SPLIT
        for (int part = 0; part < 2; ++part)
#endif
        {
            PHASE_BEGIN();
            pg8::Gemm g{(const bf16*)(ws + WS_XN), (const bf16*)(ws + WS_W + (size_t)(l & 1) * W_SET + (second ? W_GU1 : W_GU0)), MPAD, 2 * FF, D, D, D, 0, 0}; pg8::StaticOrder S; S.init(MPAD, 2 * FF, G, bx); PROBE_SET_REP(S);
#ifdef PROBE_SPLIT
            if (part == 0) S.r1 = 11; else S.r0 = 11;
#endif
            pg8::EpiSwiglu E{(unsigned char*)(ws + WS_H), FF, (const float*)(ws + WS_RSS) + (size_t)(3 * l + (second ? 2 : 0)) * RSS_STRIDE, (const LAS float*)(lds + RSSB_OFF), 1.0f / D, EPS, (hl >= FP8_FROM_HL) ? H8_SCALE : 1.0f, 1.0f, (hl >= FP8_FROM_HL) ? 1 : 0};
            S.split = 1;
            S.pass = 0; pg8::gemm_phase<pg8::EpiSwiglu, pg8::StaticOrder, true, true, false, false>(lds + RING_OFF, g, S, E, tid); S.pass = 1; pg8::gemm_phase<pg8::EpiSwiglu, pg8::StaticOrder, true, true, false, true>(lds + RING_OFF, g, S, E, tid);
#ifdef PROBE_SPLIT
            if (part == 0) GRID_BAR();
#endif
        }
        GRID_BAR();
        if (hl >= FP8_FROM_HL) {
            PHASE_BEGIN();
            pg8::Gemm g{(const bf16*)(ws + WS_H), (const bf16*)(ws + WS_W + (size_t)(l & 1) * W_SET + (second ? W_D1 : W_D0)), MPAD, D, FF / 2, FF / 2, FF / 2, 0, 0};   pg8::StaticOrder S; S.init(MPAD, D, G, bx);
            pg8::EpiResidNorm<false> E{(bf16*)(ws + WS_XN), D, 0.5f / (H8_SCALE * WD8_SCALE), (float*)(ws + WS_RSS) + (size_t)(second ? 3 * (l + 1) : 3 * l + 1) * RSS_STRIDE, (second && hl + 1 >= FP8_UP_FROM && hl + 1 < 2 * NL) ? (unsigned char*)(ws + WS_XB8) : nullptr, (LAS float*)(lds + RED_OFF), nullptr, nullptr, 0.f, 0.f};
            PROBE_SET_REP_R(S, E);
            S.split = 1;
            S.pass = 0; pg8::gemm_phase<pg8::EpiResidNorm<false>, pg8::StaticOrder, true, true, true, false>(lds + RING_OFF, g, S, E, tid); S.pass = 1; PROBE_UNSCALE_R(E); pg8::gemm_phase<pg8::EpiResidNorm<false>, pg8::StaticOrder, true, true, true, true>(lds + RING_OFF, g, S, E, tid);
        } else {
            PHASE_BEGIN();
            pg8::Gemm g{(const bf16*)(ws + WS_H), (const bf16*)(ws + WS_W + (size_t)(l & 1) * W_SET + (second ? W_D1 : W_D0)), MPAD, D, FF, FF, FF, 0, 0}; pg8::StaticOrder S; S.init(MPAD, D, G, bx);
            pg8::EpiResidNorm<false> E{(bf16*)(ws + WS_XN), D, 0.5f, (float*)(ws + WS_RSS) + (size_t)(second ? 3 * (l + 1) : 3 * l + 1) * RSS_STRIDE, (second && hl + 1 >= FP8_UP_FROM && hl + 1 < 2 * NL) ? (unsigned char*)(ws + WS_XB8) : nullptr, (LAS float*)(lds + RED_OFF), nullptr, nullptr, 0.f, 0.f};
            PROBE_SET_REP_R(S, E);
            S.split = 1;
            S.pass = 0; pg8::gemm_phase<pg8::EpiResidNorm<false>, pg8::StaticOrder, true, true, false, false>(lds + RING_OFF, g, S, E, tid); S.pass = 1; PROBE_UNSCALE_R(E); pg8::gemm_phase<pg8::EpiResidNorm<false>, pg8::StaticOrder, true, true, false, true>(lds + RING_OFF, g, S, E, tid);
        }
        if (l + 1 < NL) {
            PHASE_BEGIN();
            constexpr int NTAIL = 2 * (((MPAD / 256) * (D / 256)) % 256);
            for (int prep = 0; prep < PROBE_N(9); ++prep)
            if (G > 2 * NTAIL) { if (bx >= NTAIL) { if (!second) convert_layer(l + 1, A, ws, (LAS float*)(lds + RING_OFF + wave * 16384), (bx - NTAIL) * NWAVES + wave, (G - NTAIL) * NWAVES, lane);
                                                     else convert_gu(l + 1, A, ws, (LAS float*)(lds + RING_OFF + wave * 16384), (LAS float*)(lds + RING_OFF + 12288), bx - NTAIL, G - NTAIL, wave, lane); } }
            else { if (!second) convert_layer(l + 1, A, ws, (LAS float*)(lds + RING_OFF + wave * 16384), gw, NGW, lane); else convert_gu(l + 1, A, ws, (LAS float*)(lds + RING_OFF + wave * 16384), (LAS float*)(lds + RING_OFF + 12288), bx, G, wave, lane); }
        }
        GRID_BAR();
        if (second) continue;
        {
            PHASE_BEGIN();
            pg8::Gemm g{(const bf16*)(ws + WS_XN), (const bf16*)(ws + WS_W + (size_t)(l & 1) * W_SET + W_IN), MPAD, DIN, D, D, D, 0, 0}; pg8::StaticOrder S; S.init(MPAD, DIN, G, bx); PROBE_SET_REP(S);
            pg8::EpiStoreBf16 E{(bf16*)(ws + WS_PROJ), DIN, (const float*)(ws + WS_RSS) + (size_t)(3 * l + 1) * RSS_STRIDE, (const LAS float*)(lds + RSSB_OFF), 1.0f / D, EPS, (bf16*)(ws + WS_UG), 3 * DCV, CPG, UGLD};
            S.split = 1;
            S.pass = 0; pg8::gemm_phase<pg8::EpiStoreBf16, pg8::StaticOrder, true, true, false, false>(lds + RING_OFF, g, S, E, tid); S.pass = 1; pg8::gemm_phase<pg8::EpiStoreBf16, pg8::StaticOrder, true, true, false, true>(lds + RING_OFF, g, S, E, tid);
        }
        {
            PHASE_BEGIN();
            for (int prep = 0; prep < PROBE_N(5); ++prep)
            {
                constexpr int NT_IN = 2 * (((MPAD / 256) * (DIN / 256)) % 256);
                const bool sub = G > 2 * NT_IN; if (!sub || bx >= NT_IN)
                ssm_matrices(l, (size_t)(sub ? bx - NT_IN : bx) * (NWAVES * 64) + tid, (size_t)(sub ? G - NT_IN : G) * NWAVES * 64, (const f32x2*)(ws + WS_APOW), (const f32x2*)(ws + WS_BBAR), A->in[I_CRE], A->in[I_CIM], A->in[I_SD],
                         (bf16*)(ws + WS_WBT), (bf16*)(ws + WS_BMT)); }
        }
        GRID_BAR();
        {
            PHASE_BEGIN();
            const bf16* PROJ = (const bf16*)(ws + WS_PROJ);
            for (int prep = 0; prep < PROBE_N(3); ++prep) {
            { bf16* MIXED = (bf16*)(ws + WS_MIXED); const float* cache = A->in[I_CACHE]; const float* convw = A->in[I_CONVW]; const float* cgain = A->in[I_CONVN]; float* out = A->out;
              for (int r = 4 * gw; r < MPAD; r += 4 * NGW) conv_rows4(r, l, PROJ, MIXED, cache, convw, cgain, out, lane); }
            }
        }
        {
            PHASE_BEGIN();
            pg8::Gemm g{(const bf16*)(ws + WS_UG), (const bf16*)(ws + WS_BMT), SG * CPG, 256, 256, UGLD, 256, CPG / 256, (size_t)256 * 256 * 2}; pg8::StaticOrder S; S.init(SG * CPG, 256, G, bx);
            pg8::EpiSloc E{(float*)(ws + WS_SLOC), CPG, NCHUNK, SG};
            PROBE_SET_REP3(S);
            S.split = 1;
            S.pass = 0; pg8::gemm_phase<pg8::EpiSloc, pg8::StaticOrder, true, true, false, false>(lds + RING_OFF, g, S, E, tid); S.pass = 1; pg8::gemm_phase<pg8::EpiSloc, pg8::StaticOrder, true, true, false, true>(lds + RING_OFF, g, S, E, tid);
        }
        GRID_BAR();
        {
            PHASE_BEGIN();
            const f32x2* apow = (const f32x2*)(ws + WS_APOW); const float* SLOC = (const float*)(ws + WS_SLOC); bf16* UG = (bf16*)(ws + WS_UG);
            for (int prep = 0; prep < PROBE_N(3); ++prep) {
            for (int pi = vcu; pi < 2 * NBP * SG; pi += G) ssm_carry_prompt((pi >> 1) / SG, (pi >> 1) % SG, pi & 1, l, apow, SLOC, UG, A->out, (LAS float*)(lds + RING_OFF), wave, lane);
            for (int w = gw; w < NBS * SG + (NCHUNK - NCH_REAL) * SG; w += NGW) ssm_carry_small(w, l, apow, SLOC, UG, A->in[I_SRE], A->in[I_SIM], A->out, lane);
            }
        }
        GRID_BAR();
        {
            PHASE_BEGIN();
            pg8::Gemm g{(const bf16*)(ws + WS_UG), (const bf16*)(ws + WS_WBT), SG * CPG, 256, UGLD, UGLD, UGLD, CPG / 256, (size_t)256 * UGLD * 2}; pg8::StaticOrder S; S.init(SG * CPG, 256, G, bx);
            pg8::EpiYs E{(bf16*)(ws + WS_YS), DSS, CPG, NCHUNK};
            PROBE_SET_REP3(S);
            S.split = 1;
            S.pass = 0; pg8::gemm_phase<pg8::EpiYs, pg8::StaticOrder, true, true, false, false>(lds + RING_OFF, g, S, E, tid); S.pass = 1; pg8::gemm_phase<pg8::EpiYs, pg8::StaticOrder, true, true, false, true>(lds + RING_OFF, g, S, E, tid);
        }
        GRID_BAR();
        {
            PHASE_BEGIN();
            pg8::Gemm g{(const bf16*)(ws + WS_YS), (const bf16*)(ws + WS_W + (size_t)(l & 1) * W_SET + W_GLU), MPAD, DSS, DSS, DSS, DSS, 0, 0}; pg8::StaticOrder S; S.init(MPAD, DSS, G, bx); PROBE_SET_REP(S);
            pg8::EpiGlu E{(const bf16*)(ws + WS_YS), DSS, (bf16*)(ws + WS_MIXED) + DCV, D, (float*)(ws + WS_RSS) + (size_t)(3 * NL + 1 + l) * RSS_STRIDE, (LAS float*)(lds + RED_OFF)};
            S.split = 1;
            S.pass = 0; pg8::gemm_phase<pg8::EpiGlu, pg8::StaticOrder, true, true, false, false>(lds + RING_OFF, g, S, E, tid); S.pass = 1; pg8::gemm_phase<pg8::EpiGlu, pg8::StaticOrder, true, true, false, true>(lds + RING_OFF, g, S, E, tid);
        }
        GRID_BAR();
        {
            PHASE_BEGIN();
            pg8::Gemm g{(const bf16*)(ws + WS_MIXED), (const bf16*)(ws + WS_W + (size_t)(l & 1) * W_SET + W_OUT), MPAD, D, D, D, D, 0, 0}; pg8::StaticOrder S; S.init(MPAD, D, G, bx);
            pg8::EpiResidNorm<true> E{(bf16*)(ws + WS_XN), D, 1.0f, (float*)(ws + WS_RSS) + (size_t)(3 * l + 2) * RSS_STRIDE, (hl + 1 >= FP8_UP_FROM) ? (unsigned char*)(ws + WS_XB8) : nullptr, (LAS float*)(lds + RED_OFF), (const float*)(ws + WS_RSS) + (size_t)(3 * NL + 1 + l) * RSS_STRIDE, (const LAS float*)(lds + RSSB_OFF), 1.0f / DSS, EPS};
            PROBE_SET_REP_R(S, E);
            S.split = 1;
            S.pass = 0; pg8::gemm_phase<pg8::EpiResidNorm<true>, pg8::StaticOrder, true, true, false, false>(lds + RING_OFF, g, S, E, tid); S.pass = 1; PROBE_UNSCALE_R(E); pg8::gemm_phase<pg8::EpiResidNorm<true>, pg8::StaticOrder, true, true, false, true>(lds + RING_OFF, g, S, E, tid);
        }
        GRID_BAR();
    }
    {
        PHASE_BEGIN();
        const bf16* X = (const bf16*)(ws + WS_XN); float* out = A->out; const float* gain = A->in[I_FINN]; const float* rss = (const float*)(ws + WS_RSS) + (size_t)(3 * NL) * RSS_STRIDE;
        for (int prep = 0; prep < PROBE_N(7); ++prep)
#define OUT_ROW(r) ((r) < MPROMPT ? (((r) % TP) < NMETA ? (float*)nullptr : out + O_YP + ((size_t)((r) / TP) * SEQ + (((r) % TP) - NMETA)) * D) : out + O_YS + (size_t)((r) - MPROMPT) * D)
        for (int r = gw; r < MREAL; r += 2 * NGW) { const int r1 = r + NGW;
            float* d0 = OUT_ROW(r); float* d1 = (r1 < MREAL) ? OUT_ROW(r1) : (float*)nullptr; int ra = r, rb = r1;
            if (!d0) { d0 = d1; d1 = nullptr; ra = r1; }
            if (d0) final_rows2(X + (size_t)ra * D, X + (size_t)(d1 ? rb : ra) * D, gain, d0, d1, rss + (size_t)ra * 8, rss + (size_t)(d1 ? rb : ra) * 8, lane); }
#undef OUT_ROW
    }
}
}

extern "C" void kernel_launch(void* const* d_in, const int* in_sizes, int n_in, void* d_out, int out_size, void* d_ws, size_t ws_size, hipStream_t stream) {
    using namespace mk;
    static int grid = 0;
    if (grid == 0) {
        if (n_in != N_IN || (size_t)out_size != O_END || ws_size < WS_END) { fprintf(stderr, "kernel_launch: unexpected shapes (n_in %d, out %d, ws %zu, need %zu)\n", n_in, out_size, ws_size, (size_t)WS_END); grid = -1; return; }
        int dev = 0, cus = 0, per_cu = 0;
        if (hipGetDevice(&dev) != hipSuccess || hipDeviceGetAttribute(&cus, hipDeviceAttributeMultiprocessorCount, dev) != hipSuccess) { grid = -1; return; }
        if (hipFuncSetAttribute((const void*)hymba_fwd, hipFuncAttributeMaxDynamicSharedMemorySize, LDS_BYTES) != hipSuccess) { fprintf(stderr, "kernel_launch: hipFuncSetAttribute failed\n"); grid = -1; return; }
        if (hipOccupancyMaxActiveBlocksPerMultiprocessor(&per_cu, (const void*)hymba_fwd, NWAVES * 64, LDS_BYTES) != hipSuccess || per_cu < 1) { fprintf(stderr, "kernel_launch: occupancy query says %d\n", per_cu); }
        (void)hipGetLastError();
        grid = cus;
    }
    if (grid < 0) return;
    if (hipMemsetAsync(d_ws, 0, ZERO_BYTES, stream) != hipSuccess) return;
    Args a{};
    for (int i = 0; i < N_IN; ++i) a.in[i] = (const float*)d_in[i];
    a.out = (float*)d_out; a.ws = (unsigned char*)d_ws;
    hipLaunchKernelGGL(hymba_fwd, dim3(grid), dim3(NWAVES * 64), LDS_BYTES, stream, a);
}
```
